# Optimizing an MI355X kernel written in HIP

```python
import math
import jax, jax.numpy as jnp
from jax import lax
import numpy as np

D_MODEL = 2048
BATCH = 2
SEQ = 4096
DEPTH = 1

CHUNK = 64
N_META = 16
D_MIX = D_MODEL
ATTN_WIDTH = D_MIX // 2
N_DIFF_HEADS = 8
DIFF_HEAD_DIM = ATTN_WIDTH // (2 * N_DIFF_HEADS)
V_HEAD_DIM = 2 * DIFF_HEAD_DIM
ROT_DIM = DIFF_HEAD_DIM // 4
ROPE_THETA = 500000.0
Q_BLOCK = 128
SSD_WIDTH = D_MIX - ATTN_WIDTH
SSD_HEAD_DIM = 64
N_SSD_HEADS = SSD_WIDTH // SSD_HEAD_DIM
N_SSD_GROUPS = 2
HEADS_PER_GROUP = N_SSD_HEADS // N_SSD_GROUPS
D_STATE = 128
CONV_WIDTH = 4
CONV_DIM = SSD_WIDTH + 2 * N_SSD_GROUPS * D_STATE
D_FF = 5632
EPS = 1e-6
IN_PROJ_DIM = 3 * ATTN_WIDTH + SSD_WIDTH + CONV_DIM + N_SSD_HEADS

kernel_name = "hymba_diffattn_ssd_macaron_block"


def _rmsnorm(x, w):
    x32 = x.astype(jnp.float32)
    y = x32 * lax.rsqrt(jnp.mean(x32 * x32, axis=-1, keepdims=True) + EPS)
    return (y * w.astype(jnp.float32)).astype(x.dtype)


def _swiglu(h, w_gate, w_up, w_down):
    return (jax.nn.silu(h @ w_gate) * (h @ w_up)) @ w_down


def _chunk_ids(n_pos):
    p = jnp.arange(n_pos, dtype=jnp.int32)
    return jnp.where(p < N_META, 0, (p - N_META) // CHUNK + 1)


def _rope_tables(n_pos):
    inv = jnp.power(ROPE_THETA, -jnp.arange(0, ROT_DIM, 2, dtype=jnp.float32) / ROT_DIM)
    ang = jnp.arange(n_pos, dtype=jnp.float32)[:, None] * inv[None, :]
    return jnp.cos(ang), jnp.sin(ang)


def _partial_rope(x, cos, sin):
    c = cos[None, :, None, None, :].astype(x.dtype)
    s = sin[None, :, None, None, :].astype(x.dtype)
    half = ROT_DIM // 2
    x1 = x[..., :half]
    x2 = x[..., half:ROT_DIM]
    return jnp.concatenate([x1 * c - x2 * s, x2 * c + x1 * s, x[..., ROT_DIM:]], axis=-1)


def _diff_attend(q_blk, q_cid, k, v, k_cid, lam):
    s = jnp.einsum('bqhsd,bkhsd->bhsqk', q_blk, k,
                   preferred_element_type=jnp.float32) * (DIFF_HEAD_DIM ** -0.5)
    mask = k_cid[None, :] <= q_cid[:, None]
    s = jnp.where(mask, s, -jnp.inf)
    p = jax.nn.softmax(s, axis=-1)
    w = p[:, :, 0] - lam * p[:, :, 1]
    return jnp.einsum('bhqk,bkhv->bqhv', w.astype(v.dtype), v)


def _diff_attention(q, k, v, cid, lam):
    bsz, n_pos = q.shape[0], q.shape[1]
    n_real = n_pos - N_META
    n_blocks = n_real // Q_BLOCK
    out_meta = _diff_attend(q[:, :N_META], cid[:N_META], k, v, cid, lam)
    qb = jnp.moveaxis(q[:, N_META:].reshape(bsz, n_blocks, Q_BLOCK, N_DIFF_HEADS, 2, DIFF_HEAD_DIM), 1, 0)
    cb = cid[N_META:].reshape(n_blocks, Q_BLOCK)
    out_real = lax.map(lambda a: _diff_attend(a[0], a[1], k, v, cid, lam), (qb, cb))
    out_real = jnp.moveaxis(out_real, 0, 1).reshape(bsz, n_real, N_DIFF_HEADS, V_HEAD_DIM)
    return jnp.concatenate([out_meta, out_real], axis=1)


def _ssd_mixer(z, xbc, dt_raw, conv_w, conv_b, dt_bias, a_log, d_skip, norm_w):
    bsz, n_pos, _ = xbc.shape
    G, E, P, N = N_SSD_GROUPS, HEADS_PER_GROUP, SSD_HEAD_DIM, D_STATE
    xbc = lax.conv_general_dilated(xbc, conv_w[:, None, :], window_strides=(1,),
                                   padding=[(CONV_WIDTH - 1, 0)],
                                   dimension_numbers=('NWC', 'WIO', 'NWC'),
                                   feature_group_count=CONV_DIM)
    xbc = jax.nn.silu(xbc + conv_b)
    x_s = xbc[..., :SSD_WIDTH]
    b_s = xbc[..., SSD_WIDTH:SSD_WIDTH + G * N]
    c_s = xbc[..., SSD_WIDTH + G * N:]
    dt = jax.nn.softplus(dt_raw.astype(jnp.float32) + dt_bias.astype(jnp.float32))
    pad = (-n_pos) % CHUNK
    def padl(t):
        return jnp.pad(t, [(0, 0), (pad, 0)] + [(0, 0)] * (t.ndim - 2))
    x_s, b_s, c_s, dt = padl(x_s), padl(b_s), padl(c_s), padl(dt)
    n_chunks = (n_pos + pad) // CHUNK
    X = x_s.reshape(bsz, n_chunks, CHUNK, G, E, P)
    Bm = b_s.reshape(bsz, n_chunks, CHUNK, G, N)
    Cm = c_s.reshape(bsz, n_chunks, CHUNK, G, N)
    dt = dt.reshape(bsz, n_chunks, CHUNK, G, E)
    A = -jnp.exp(a_log.astype(jnp.float32)).reshape(G, E)
    dA = dt * A
    Xdt = X * dt[..., None].astype(X.dtype)
    a_cs = jnp.cumsum(dA, axis=2)
    tril = jnp.tril(jnp.ones((CHUNK, CHUNK), dtype=bool))
    seg = a_cs[:, :, :, None] - a_cs[:, :, None, :]
    decay_in = jnp.exp(jnp.where(tril[None, None, :, :, None, None], seg, -jnp.inf))
    cb = jnp.einsum('bclgn,bcsgn->bclsg', Cm, Bm)
    y_diag = jnp.einsum('bclsg,bclsge,bcsgep->bclgep', cb, decay_in.astype(cb.dtype), Xdt)
    decay_to_end = jnp.exp(a_cs[:, :, -1:] - a_cs)
    chunk_states = jnp.einsum('bclgn,bclge,bclgep->bcgepn', Bm, decay_to_end.astype(Bm.dtype), Xdt)
    chunk_decay = jnp.exp(a_cs[:, :, -1])

    def step(state, inp):
        cs, dec = inp
        return state * dec[..., None, None] + cs, state

    init = jnp.zeros((bsz, G, E, P, N), jnp.float32)
    _, states_in = lax.scan(step, init, (jnp.moveaxis(chunk_states, 1, 0), jnp.moveaxis(chunk_decay, 1, 0)))
    states_in = jnp.moveaxis(states_in, 0, 1).astype(Cm.dtype)
    y_off = jnp.einsum('bclgn,bcgepn,bclge->bclgep', Cm, states_in, jnp.exp(a_cs).astype(Cm.dtype))
    y = y_diag + y_off + X * d_skip.reshape(G, E)[:, :, None].astype(X.dtype)
    y = y.reshape(bsz, n_pos + pad, SSD_WIDTH)[:, pad:].astype(z.dtype)
    return _rmsnorm(y * jax.nn.silu(z), norm_w)


def setup_inputs(seed: int = 0) -> dict:
    key = jax.random.key(seed)
    ks = jax.random.split(key, 32)
    f32 = jnp.float32

    def nrm(k, shape, scale):
        return jax.random.normal(k, shape, f32) * scale

    def gain(k, dim):
        return 1.0 + 0.01 * jax.random.normal(k, (DEPTH, dim), f32)

    dt0 = jnp.exp(jax.random.uniform(ks[20], (DEPTH, N_SSD_HEADS), f32,
                                     minval=math.log(1e-3), maxval=math.log(1e-1)))
    return {
        "x": nrm(ks[0], (BATCH, SEQ, D_MODEL), 1.0),
        "meta_tokens": nrm(ks[1], (N_META, D_MODEL), 1.0),
        "ffn1_norm": gain(ks[2], D_MODEL),
        "ffn1_w_gate": nrm(ks[3], (DEPTH, D_MODEL, D_FF), D_MODEL ** -0.5),
        "ffn1_w_up": nrm(ks[4], (DEPTH, D_MODEL, D_FF), D_MODEL ** -0.5),
        "ffn1_w_down": nrm(ks[5], (DEPTH, D_FF, D_MODEL), D_FF ** -0.5),
        "mix_norm": gain(ks[6], D_MODEL),
        "w_in": nrm(ks[7], (DEPTH, D_MODEL, IN_PROJ_DIM), D_MODEL ** -0.5),
        "q_norm": gain(ks[8], DIFF_HEAD_DIM),
        "k_norm": gain(ks[9], DIFF_HEAD_DIM),
        "lambda_q1": nrm(ks[10], (DEPTH, DIFF_HEAD_DIM), 0.1),
        "lambda_k1": nrm(ks[11], (DEPTH, DIFF_HEAD_DIM), 0.1),
        "lambda_q2": nrm(ks[12], (DEPTH, DIFF_HEAD_DIM), 0.1),
        "lambda_k2": nrm(ks[13], (DEPTH, DIFF_HEAD_DIM), 0.1),
        "attn_out_norm": gain(ks[14], V_HEAD_DIM),
        "conv_w": nrm(ks[15], (DEPTH, CONV_WIDTH, CONV_DIM), CONV_WIDTH ** -0.5),
        "conv_b": nrm(ks[16], (DEPTH, CONV_DIM), 0.01),
        "dt_bias": dt0 + jnp.log(-jnp.expm1(-dt0)),
        "a_log": jnp.log(jax.random.uniform(ks[17], (DEPTH, N_SSD_HEADS), f32, minval=1.0, maxval=16.0)),
        "d_skip": 1.0 + 0.01 * jax.random.normal(ks[18], (DEPTH, N_SSD_HEADS), f32),
        "ssd_norm": gain(ks[19], SSD_WIDTH),
        "w_out": nrm(ks[21], (DEPTH, D_MIX, D_MODEL), D_MIX ** -0.5),
        "ffn2_norm": gain(ks[22], D_MODEL),
        "ffn2_w_gate": nrm(ks[23], (DEPTH, D_MODEL, D_FF), D_MODEL ** -0.5),
        "ffn2_w_up": nrm(ks[24], (DEPTH, D_MODEL, D_FF), D_MODEL ** -0.5),
        "ffn2_w_down": nrm(ks[25], (DEPTH, D_FF, D_MODEL), D_FF ** -0.5),
    }


def reference(x, meta_tokens, ffn1_norm, ffn1_w_gate, ffn1_w_up, ffn1_w_down, mix_norm, w_in,
              q_norm, k_norm, lambda_q1, lambda_k1, lambda_q2, lambda_k2, attn_out_norm,
              conv_w, conv_b, dt_bias, a_log, d_skip, ssd_norm, w_out,
              ffn2_norm, ffn2_w_gate, ffn2_w_up, ffn2_w_down):
    bsz = x.shape[0]
    meta = jnp.broadcast_to(meta_tokens.astype(x.dtype)[None], (bsz, N_META, D_MODEL))
    h = jnp.concatenate([meta, x], axis=1)
    n_pos = h.shape[1]
    cid = _chunk_ids(n_pos)
    cos, sin = _rope_tables(n_pos)

    for l in range(DEPTH):
        h = h + 0.5 * _swiglu(_rmsnorm(h, ffn1_norm[l]), ffn1_w_gate[l], ffn1_w_up[l], ffn1_w_down[l])

        u = _rmsnorm(h, mix_norm[l]) @ w_in[l]
        o = 0
        q = u[..., o:o + ATTN_WIDTH]; o += ATTN_WIDTH
        k = u[..., o:o + ATTN_WIDTH]; o += ATTN_WIDTH
        v = u[..., o:o + ATTN_WIDTH]; o += ATTN_WIDTH
        z = u[..., o:o + SSD_WIDTH]; o += SSD_WIDTH
        xbc = u[..., o:o + CONV_DIM]; o += CONV_DIM
        dt_raw = u[..., o:o + N_SSD_HEADS]

        q = q.reshape(bsz, n_pos, N_DIFF_HEADS, 2, DIFF_HEAD_DIM)
        k = k.reshape(bsz, n_pos, N_DIFF_HEADS, 2, DIFF_HEAD_DIM)
        v = v.reshape(bsz, n_pos, N_DIFF_HEADS, V_HEAD_DIM)
        q = _partial_rope(_rmsnorm(q, q_norm[l]), cos, sin)
        k = _partial_rope(_rmsnorm(k, k_norm[l]), cos, sin)
        lam_init = 0.8 - 0.6 * math.exp(-0.3 * l)
        lam = (jnp.exp(jnp.sum(lambda_q1[l].astype(jnp.float32) * lambda_k1[l].astype(jnp.float32)))
               - jnp.exp(jnp.sum(lambda_q2[l].astype(jnp.float32) * lambda_k2[l].astype(jnp.float32)))
               + lam_init)
        attn = _diff_attention(q, k, v, cid, lam)
        attn = (_rmsnorm(attn, attn_out_norm[l]) * (1.0 - lam_init)).reshape(bsz, n_pos, ATTN_WIDTH)

        ssd = _ssd_mixer(z, xbc, dt_raw, conv_w[l], conv_b[l], dt_bias[l], a_log[l], d_skip[l], ssd_norm[l])

        h = h + jnp.concatenate([attn, ssd.astype(attn.dtype)], axis=-1) @ w_out[l]

        h = h + 0.5 * _swiglu(_rmsnorm(h, ffn2_norm[l]), ffn2_w_gate[l], ffn2_w_up[l], ffn2_w_down[l])

    return h[:, N_META:]
```

```cpp
#include <hip/hip_runtime.h>
#include <cstdio>
#include <cstdint>
#include <cmath>
namespace pg8 {
#define PG8_LAS __attribute__((address_space(3)))
typedef unsigned short bf16_t;
typedef short bf16x8 __attribute__((ext_vector_type(8)));
typedef float f32x4 __attribute__((ext_vector_type(4)));
typedef unsigned u32x4 __attribute__((ext_vector_type(4)));
constexpr int BM = 256, BK = 64, HALF = 128, HTB = HALF * BK * 2  , STAGE_BYTES = 8 * HTB, NXCD = 8, WGM = 8;

__host__ __device__ __forceinline__ int lds_byte(int r, int c) { const int st = (r >> 4) * 2 + (c >> 5), rr = r & 15, cc = c & 31, ob = rr * 64 + cc * 2; return st * 1024 + (ob ^ (((ob >> 9) & 1) << 5)); }
__host__ __device__ __forceinline__ void stage_rc(int b, int& R, int& C) { const int st = b / 1024, sb = b % 1024, swz = sb ^ (((sb >> 9) & 1) << 5); R = (st >> 1) * 16 + swz / 64; C = (st & 1) * 32 + (swz % 64) / 2; }
__host__ __device__ __forceinline__ int perm32(int rho) { const int n = rho >> 4, i = rho & 15; return 8 * (i >> 2) + 4 * n + (i & 3); }

struct Unit { int pm, pn; };
struct Gemm { const bf16_t* A; const bf16_t* Bt; int M, N, K; };

struct StaticOrder {
    int nM, nN, nwg, G, c;
    __host__ __device__ void init(int M, int N, int G_, int c_) { nM = M / BM; nN = N / BM; nwg = nM * nN; G = G_; c = c_; }
    __host__ __device__ bool next(int i, Unit& u) const {
        const long L = (long)i * G + c; if (L >= nwg) return false;
        int wgid = (int)L; { const int q = nwg / NXCD, r = nwg % NXCD, xcd = wgid % NXCD, off = wgid / NXCD; wgid = (xcd < r ? xcd * (q + 1) : r * (q + 1) + (xcd - r) * q) + off; }
        const int nig = WGM * nN, gid = wgid / nig, fm = gid * WGM, gsz = (nM - fm) < WGM ? (nM - fm) : WGM;
        u.pm = fm + ((wgid % nig) % gsz); u.pn = (wgid % nig) / gsz; return true;
    }
    __device__ __forceinline__ void a_ready(const Unit&) const {}
    __device__ __forceinline__ void done(const Unit&) const {}
};


__device__ __forceinline__ unsigned cvt_pk_bf16(float lo, float hi) { unsigned r; asm volatile("v_cvt_pk_bf16_f32 %0, %1, %2" : "=v"(r) : "v"(lo), "v"(hi)); return r; }
typedef unsigned u32x2 __attribute__((ext_vector_type(2)));
constexpr float RMS_EPS = 1e-6f;
__device__ __forceinline__ float row_rs(const float* ssq, int np, int row) {
    float s;
    if (np == 1) s = ssq[row];
    else { const f32x4* p = (const f32x4*)(ssq + (size_t)row * 32); f32x4 a = p[0];
#pragma unroll
        for (int i = 1; i < 8; ++i) a += p[i];
        s = (a[0] + a[1]) + (a[2] + a[3]); }
    return __builtin_amdgcn_rsqf(s * (1.0f / 2048.0f) + RMS_EPS);
}
__device__ __forceinline__ float silu_f(float g) { return g * __builtin_amdgcn_rcpf(1.0f + __builtin_amdgcn_exp2f(-1.4426950408889634f * g)); }

struct EpiSwiGLU {
    static constexpr bool PERM = true, AFTER_DRAIN = false, HAS_MID = false;
    bf16_t* O; int ldc; const float* ssq; int np;
    __device__ __forceinline__ void mid(f32x4 (&)[2][2][4][2], const Unit&, int, int, int, int) const {}
    __device__ __forceinline__ void operator()(const f32x4 (&acc)[2][2][4][2], const Unit& u, int wr, int wc, int fr, int fq) const {
        const int row0 = u.pm * BM + wr * 64 + fr, col0 = u.pn * HALF + wc * 32 + 8 * fq;
#pragma unroll
        for (int ai = 0; ai < 2; ++ai)
#pragma unroll
            for (int m = 0; m < 4; ++m) { const int row = row0 + ai * HALF + m * 16; const float rs = row_rs(ssq, np, row);
                float a[8];
#pragma unroll
                for (int n = 0; n < 2; ++n)
#pragma unroll
                    for (int i = 0; i < 4; ++i) { const float g = acc[ai][0][m][n][i] * rs, up = acc[ai][1][m][n][i] * rs; a[4 * n + i] = silu_f(g) * up; }
                u32x4 w; w.x = cvt_pk_bf16(a[0], a[1]); w.y = cvt_pk_bf16(a[2], a[3]); w.z = cvt_pk_bf16(a[4], a[5]); w.w = cvt_pk_bf16(a[6], a[7]);
                *(u32x4*)(O + (size_t)row * ldc + col0) = w; }
    }
};
template <bool MID> struct EpiResT {
    static constexpr bool PERM = false, AFTER_DRAIN = false, HAS_MID = MID;
    const float* base; float* out; bf16_t* xn; float* ssq; float scale; int ldc; const float* rsm; int kmid;
    __device__ __forceinline__ void mid(f32x4 (&acc)[2][2][4][2], const Unit& u, int wr, int wc, int fr, int fq) const {
        const int row0 = u.pm * BM + wr * 64 + fr;
#pragma unroll
        for (int ai = 0; ai < 2; ++ai)
#pragma unroll
            for (int m = 0; m < 4; ++m) { const float r = rsm[row0 + ai * HALF + m * 16];
#pragma unroll
                for (int bj = 0; bj < 2; ++bj)
#pragma unroll
                    for (int n = 0; n < 2; ++n) acc[ai][bj][m][n] *= r; }
    }
    __device__ __forceinline__ void operator()(const f32x4 (&acc)[2][2][4][2], const Unit& u, int wr, int wc, int fr, int fq) const {
        const int row0 = u.pm * BM + wr * 64 + fr, col0 = u.pn * BM + wc * 32 + 4 * fq;
#pragma unroll
        for (int ai = 0; ai < 2; ++ai)
#pragma unroll
            for (int m = 0; m < 4; ++m) { const int row = row0 + ai * HALF + m * 16; const size_t off = (size_t)row * ldc + col0; float sq = 0.f;
#pragma unroll
                for (int bj = 0; bj < 2; ++bj)
#pragma unroll
                    for (int n = 0; n < 2; ++n) { const f32x4 b = *(const f32x4*)(base + off + bj * HALF + n * 16); const f32x4 o = b + acc[ai][bj][m][n] * scale;
                        *(f32x4*)(out + off + bj * HALF + n * 16) = o;
                        if (xn) { sq += (o[0] * o[0] + o[1] * o[1]) + (o[2] * o[2] + o[3] * o[3]); u32x2 w; w.x = cvt_pk_bf16(o[0], o[1]); w.y = cvt_pk_bf16(o[2], o[3]); *(u32x2*)(xn + off + bj * HALF + n * 16) = w; } }
                if (xn) { sq += __shfl_xor(sq, 16); sq += __shfl_xor(sq, 32); if (fq == 0) ssq[(size_t)row * 32 + u.pn * 4 + wc] = sq; } }
    }
};
struct EpiInProj {
    static constexpr bool PERM = true, AFTER_DRAIN = false, HAS_MID = false;
    bf16_t* U; int ldc; const float* ssq; const float* qn; const float* kn; const float* rope;
    __device__ __forceinline__ void mid(f32x4 (&)[2][2][4][2], const Unit&, int, int, int, int) const {}
    __device__ __forceinline__ void operator()(const f32x4 (&acc)[2][2][4][2], const Unit& u, int wr, int wc, int fr, int fq) const {
        const int row0 = u.pm * BM + wr * 64 + fr, col0 = u.pn * BM + wc * 64 + 8 * fq;
        const bool isqk = u.pn < 8;
        f32x4 wv[2][2];
        if (isqk) { const float* wn = (u.pn < 4) ? qn : kn;
#pragma unroll
            for (int bj = 0; bj < 2; ++bj)
#pragma unroll
                for (int n = 0; n < 2; ++n) wv[bj][n] = *(const f32x4*)(wn + 32 * bj + 8 * fq + 4 * n); }
#pragma unroll
        for (int ai = 0; ai < 2; ++ai)
#pragma unroll
            for (int m = 0; m < 4; ++m) { const int row = row0 + ai * HALF + m * 16; const float rs = row_rs(ssq, 32, row);
                f32x4 v[2][2];
#pragma unroll
                for (int bj = 0; bj < 2; ++bj)
#pragma unroll
                    for (int n = 0; n < 2; ++n) v[bj][n] = acc[ai][bj][m][n] * rs;
                if (isqk) {
                    float sq = 0.f;
#pragma unroll
                    for (int bj = 0; bj < 2; ++bj)
#pragma unroll
                        for (int n = 0; n < 2; ++n) sq += (v[bj][n][0] * v[bj][n][0] + v[bj][n][1] * v[bj][n][1]) + (v[bj][n][2] * v[bj][n][2] + v[bj][n][3] * v[bj][n][3]);
                    sq += __shfl_xor(sq, 16); sq += __shfl_xor(sq, 32);
                    const float r = __builtin_amdgcn_rsqf(sq * (1.0f / 64.0f) + RMS_EPS);
#pragma unroll
                    for (int bj = 0; bj < 2; ++bj)
#pragma unroll
                        for (int n = 0; n < 2; ++n) v[bj][n] = v[bj][n] * r * wv[bj][n];
                    const int pos = (row & 4095) + 16;
                    const f32x4 c0 = *(const f32x4*)(rope + pos * 16), c1 = *(const f32x4*)(rope + pos * 16 + 4), s0 = *(const f32x4*)(rope + pos * 16 + 8), s1 = *(const f32x4*)(rope + pos * 16 + 12);
                    f32x4 p0, p1;
#pragma unroll
                    for (int i = 0; i < 4; ++i) { p0[i] = __shfl_xor(v[0][0][i], 16); p1[i] = __shfl_xor(v[0][1][i], 16); }
                    if (fq == 0) { v[0][0] = v[0][0] * c0 - p0 * s0; v[0][1] = v[0][1] * c1 - p1 * s1; }
                    else if (fq == 1) { v[0][0] = v[0][0] * c0 + p0 * s0; v[0][1] = v[0][1] * c1 + p1 * s1; }
                }
#pragma unroll
                for (int bj = 0; bj < 2; ++bj) { u32x4 w; w.x = cvt_pk_bf16(v[bj][0][0], v[bj][0][1]); w.y = cvt_pk_bf16(v[bj][0][2], v[bj][0][3]); w.z = cvt_pk_bf16(v[bj][1][0], v[bj][1][1]); w.w = cvt_pk_bf16(v[bj][1][2], v[bj][1][3]);
                    *(u32x4*)(U + (size_t)row * ldc + col0 + 32 * bj) = w; } }
    }
};

template <class Epi, class Sched, bool ALIGN_EPI = false, bool SP2 = false>
__device__ __forceinline__ void gemm_phase(PG8_LAS unsigned char* lds, const Gemm g, const Sched& S, const Epi& E) {
    const int tid = threadIdx.x, wid = __builtin_amdgcn_readfirstlane(tid >> 6), lane = tid & 63, wr = wid >> 2, wc = wid & 3, fr = lane & 15, fq = lane >> 4;
    const int K = g.K, nt = K / BK;
    unsigned voffA[2], voffB[2];
#pragma unroll
    for (int i = 0; i < 2; ++i) { int R, C; stage_rc(tid * 16 + i * 8192, R, C); const int Rb = Epi::PERM ? ((R & ~31) + perm32(R & 31)) : R;
        voffA[i] = (unsigned)(R * K + C) * 2u; voffB[i] = (unsigned)(Rb * K + C) * 2u; }
    const size_t kstep = (size_t)(BK * 2);
    const size_t hstep = (size_t)HALF * K * 2;
    const size_t tstep = 2 * hstep;
    const unsigned ldsw = (unsigned)wid * 1024u;
    const int aoff = lds_byte(wr * 64 + fr, fq * 8), boff = lds_byte(wc * 32 + fr, fq * 8);
#define PG8_SA(b, h) (((b) * 2 + (h)) * HTB)
#define PG8_SB(b, h) ((4 + (b) * 2 + (h)) * HTB)
#define PG8_STAGE(bufoff, gbase, voff) do { _Pragma("unroll") for (int _i = 0; _i < 2; ++_i) \
        __builtin_amdgcn_global_load_lds((const unsigned*)((const char*)(gbase) + (voff)[_i]), (PG8_LAS unsigned*)(lds + (bufoff) + ldsw + _i * 8192), 16, 0, 0); } while (0)
#define PG8_LDA(dst, b, h) do { _Pragma("unroll") for (int m = 0; m < 4; ++m) _Pragma("unroll") for (int k = 0; k < 2; ++k) dst[m][k] = *(const PG8_LAS bf16x8*)(lds + PG8_SA(b, h) + aoff + m * 2048 + k * 1024); } while (0)
#define PG8_LDB(dst, b, h) do { _Pragma("unroll") for (int n = 0; n < 2; ++n) _Pragma("unroll") for (int k = 0; k < 2; ++k) dst[n][k] = *(const PG8_LAS bf16x8*)(lds + PG8_SB(b, h) + boff + n * 2048 + k * 1024); } while (0)
#define PG8_MMA(ai, bj, At, Bt) do { __builtin_amdgcn_s_setprio(1); _Pragma("unroll") for (int m = 0; m < 4; ++m) _Pragma("unroll") for (int n = 0; n < 2; ++n) _Pragma("unroll") for (int k = 0; k < 2; ++k) \
        acc[ai][bj][m][n] = __builtin_amdgcn_mfma_f32_16x16x32_bf16(Bt[n][k], At[m][k], acc[ai][bj][m][n], 0, 0, 0); __builtin_amdgcn_s_setprio(0); } while (0)
#define PG8_WAIT_V(n) asm volatile("s_waitcnt vmcnt(" #n ")" ::: "memory")
#define PG8_WAIT_L(n) asm volatile("s_waitcnt lgkmcnt(" #n ")" ::: "memory")
#define PG8_BAR __builtin_amdgcn_s_barrier()
#define PG8_SCHED __builtin_amdgcn_sched_barrier(0)
    Unit cur, nxt; int ui = 0;
    if (!S.next(0, cur)) return;
    f32x4 acc[2][2][4][2];
#pragma unroll
    for (int a = 0; a < 2; ++a)
#pragma unroll
        for (int b = 0; b < 2; ++b)
#pragma unroll
            for (int m = 0; m < 4; ++m)
#pragma unroll
                for (int n = 0; n < 2; ++n) acc[a][b][m][n] = (f32x4){0.f, 0.f, 0.f, 0.f};
    bf16x8 At[4][2], B0[2][2], B1[2][2];
    const char* cA = (const char*)g.A + (size_t)cur.pm * tstep; const char* cB = (const char*)g.Bt + (size_t)cur.pn * tstep;
    S.a_ready(cur);
    if constexpr (SP2) {
        PG8_STAGE(PG8_SB(0, 0), cB, voffB); PG8_STAGE(PG8_SB(0, 1), cB + hstep, voffB); PG8_STAGE(PG8_SA(0, 0), cA, voffA); PG8_STAGE(PG8_SA(0, 1), cA + hstep, voffA);
        if (wr == 1) PG8_BAR;
        PG8_WAIT_V(2); PG8_BAR;
        PG8_STAGE(PG8_SB(1, 0), cB + kstep, voffB); PG8_STAGE(PG8_SA(1, 0), cA + kstep, voffA); PG8_STAGE(PG8_SB(1, 1), cB + hstep + kstep, voffB);
        PG8_WAIT_V(6); PG8_BAR;
    } else {
        PG8_STAGE(PG8_SB(0, 0), cB, voffB); PG8_STAGE(PG8_SA(0, 0), cA, voffA); PG8_STAGE(PG8_SB(0, 1), cB + hstep, voffB); PG8_STAGE(PG8_SA(0, 1), cA + hstep, voffA);
        if (wr == 1) PG8_BAR;
        PG8_WAIT_V(4); PG8_BAR;
        PG8_STAGE(PG8_SB(1, 0), cB + kstep, voffB); PG8_STAGE(PG8_SA(1, 0), cA + kstep, voffA); PG8_STAGE(PG8_SB(1, 1), cB + hstep + kstep, voffB);
        PG8_WAIT_V(6); PG8_BAR;
    }
    for (;;) {
        const bool has_next = S.next(ui + 1, nxt);
        const char* nA = has_next ? (const char*)g.A + (size_t)nxt.pm * tstep : cA; const char* nB = has_next ? (const char*)g.Bt + (size_t)nxt.pn * tstep : cB;
        for (int t = 0; t < nt; t += 2) {
            const bool last = (t == nt - 2);
            if constexpr (Epi::HAS_MID) { if (t == E.kmid) E.mid(acc, cur, wr, wc, fr, fq); }
            const char* a1 = cA + (size_t)(t + 1) * kstep;
            const char* a2 = last ? nA : cA + (size_t)(t + 2) * kstep; const char* b2 = last ? nB : cB + (size_t)(t + 2) * kstep;
            const char* a3 = a2 + kstep; const char* b3 = b2 + kstep;
            if (last && has_next) S.a_ready(nxt);
            if constexpr (SP2) {
            PG8_LDB(B0, 0, 0); PG8_LDB(B1, 0, 1); PG8_SCHED; PG8_LDA(At, 0, 0); PG8_STAGE(PG8_SA(1, 1), a1 + hstep, voffA);
            PG8_WAIT_V(8); PG8_WAIT_L(0); PG8_BAR; PG8_MMA(0, 0, At, B0); PG8_MMA(0, 1, At, B1); PG8_BAR; PG8_SCHED;
            PG8_LDA(At, 0, 1); PG8_STAGE(PG8_SB(0, 0), b2, voffB); PG8_STAGE(PG8_SB(0, 1), b2 + hstep, voffB); PG8_STAGE(PG8_SA(0, 0), a2, voffA);
            PG8_WAIT_V(8); PG8_WAIT_L(0); PG8_BAR; PG8_MMA(1, 0, At, B0); PG8_MMA(1, 1, At, B1); PG8_BAR; PG8_SCHED;
            PG8_LDB(B0, 1, 0); PG8_LDB(B1, 1, 1); PG8_SCHED; PG8_LDA(At, 1, 0); PG8_STAGE(PG8_SA(0, 1), a2 + hstep, voffA);
            PG8_WAIT_V(8); PG8_WAIT_L(0); PG8_BAR; PG8_MMA(0, 0, At, B0); PG8_MMA(0, 1, At, B1); PG8_BAR; PG8_SCHED;
            PG8_LDA(At, 1, 1); PG8_STAGE(PG8_SB(1, 0), b3, voffB); PG8_STAGE(PG8_SB(1, 1), b3 + hstep, voffB); PG8_STAGE(PG8_SA(1, 0), a3, voffA);
            PG8_WAIT_V(8); PG8_WAIT_L(0); PG8_BAR; PG8_MMA(1, 0, At, B0); PG8_MMA(1, 1, At, B1); PG8_BAR; PG8_SCHED;
            } else {
            PG8_LDB(B0, 0, 0); PG8_SCHED; PG8_LDA(At, 0, 0); PG8_STAGE(PG8_SA(1, 1), a1 + hstep, voffA);
            PG8_WAIT_L(8); PG8_BAR; PG8_WAIT_L(0); PG8_MMA(0, 0, At, B0); PG8_BAR; PG8_SCHED;
            PG8_LDB(B1, 0, 1); PG8_STAGE(PG8_SB(0, 0), b2, voffB);
            PG8_BAR; PG8_WAIT_L(0); PG8_MMA(0, 1, At, B1); PG8_BAR;
            PG8_LDA(At, 0, 1); PG8_STAGE(PG8_SA(0, 0), a2, voffA);
            PG8_BAR; PG8_WAIT_L(0); PG8_MMA(1, 0, At, B0); PG8_BAR; PG8_SCHED;
            PG8_STAGE(PG8_SB(0, 1), b2 + hstep, voffB);
            PG8_WAIT_V(6); PG8_BAR; PG8_MMA(1, 1, At, B1); PG8_BAR;
            PG8_LDB(B0, 1, 0); PG8_SCHED; PG8_LDA(At, 1, 0); PG8_STAGE(PG8_SA(0, 1), a2 + hstep, voffA);
            PG8_WAIT_L(8); PG8_BAR; PG8_WAIT_L(0); PG8_MMA(0, 0, At, B0); PG8_BAR; PG8_SCHED;
            PG8_LDB(B1, 1, 1); PG8_STAGE(PG8_SB(1, 0), b3, voffB);
            PG8_BAR; PG8_WAIT_L(0); PG8_MMA(0, 1, At, B1); PG8_BAR;
            PG8_LDA(At, 1, 1); PG8_STAGE(PG8_SA(1, 0), a3, voffA);
            PG8_BAR; PG8_WAIT_L(0); PG8_MMA(1, 0, At, B0); PG8_BAR; PG8_SCHED;
            PG8_STAGE(PG8_SB(1, 1), b3 + hstep, voffB);
            PG8_WAIT_V(6); PG8_BAR; PG8_MMA(1, 1, At, B1); PG8_BAR;
            }
        }
        if constexpr (ALIGN_EPI) { if (wr == 0) PG8_BAR; }
        if constexpr (!Epi::AFTER_DRAIN) { E(acc, cur, wr, wc, fr, fq); S.done(cur); }
        if (!has_next) break;
#pragma unroll
        for (int a = 0; a < 2; ++a)
#pragma unroll
            for (int b = 0; b < 2; ++b)
#pragma unroll
                for (int m = 0; m < 4; ++m)
#pragma unroll
                    for (int n = 0; n < 2; ++n) acc[a][b][m][n] = (f32x4){0.f, 0.f, 0.f, 0.f};
        cur = nxt; cA = nA; cB = nB; ++ui;
        if constexpr (ALIGN_EPI) { if (wr == 1) PG8_BAR; }
    }
    PG8_WAIT_V(0);
    if constexpr (!ALIGN_EPI) { if (wr == 0) PG8_BAR; }
    PG8_BAR;
    if constexpr (Epi::AFTER_DRAIN) { E.fused(acc, cur, wr, wc, fr, fq, lds, wid, lane); S.done(cur); }
#undef PG8_SA
#undef PG8_SB
#undef PG8_STAGE
#undef PG8_LDA
#undef PG8_LDB
#undef PG8_MMA
#undef PG8_WAIT_V
#undef PG8_WAIT_L
#undef PG8_BAR
#undef PG8_SCHED
}
}

#ifndef PG8_SP2
#define PG8_SP2 true
#endif

constexpr int NWAVES = 8;
constexpr int DM = 2048, SEQ = 4096, NBATCH = 2, MR = NBATCH * SEQ, NMETA = 16, LPOS = SEQ + NMETA;
constexpr int DFF = 5632, NGU = 2 * DFF;
constexpr int NHEAD = 8, SH = 16, CONVD = 1536, NIN = 5648, NINP = 5632;
constexpr int PPAD = 48, LPAD = LPOS + PPAD;
constexpr float EPS = 1e-6f;
#ifndef MK_N_LAUNCHES
#define MK_N_LAUNCHES 10
#endif
constexpr int NPH = 10;
constexpr int N_LAUNCHES = MK_N_LAUNCHES;

constexpr size_t MiB = 1u << 20;
constexpr size_t WS_CTL = 0, CTL_ZERO_BYTES = 1 * MiB;
constexpr size_t WS_W1GU = 2 * MiB, WS_W1D = 46 * MiB, WS_WIN = 68 * MiB, WS_WOUT = 91 * MiB, WS_W2GU = 99 * MiB, WS_W2D = 143 * MiB;
constexpr size_t WS_XN = 165 * MiB;
constexpr size_t WS_ACT = 197 * MiB;
constexpr size_t WS_MIX = 285 * MiB;
constexpr size_t WS_SSQ0 = 317 * MiB;
constexpr size_t WS_SSQ1 = 318 * MiB, WS_SSQ2 = 319 * MiB;
constexpr size_t WS_DTR = 320 * MiB;
constexpr size_t WS_ROPE = 321 * MiB;
constexpr size_t WS_META = 322 * MiB;
constexpr size_t MO_XN = 0, MO_SSQ0 = 65536, MO_ACT = 131072, MO_H1 = 327680, MO_XN1 = 458752, MO_U = 524288, MO_KM = 917504, MO_VM = 950272;
constexpr size_t WS_XS = 324 * MiB;
constexpr size_t WS_BC = 341 * MiB;
constexpr size_t WS_DT = 350 * MiB;
constexpr size_t WS_END = 352 * MiB;
constexpr int CW_BAR = 4096;

constexpr int RING_OFF = 0, RING_BYTES = 131072;
constexpr int LDS_BYTES = 147456, MISC_OFF = LDS_BYTES - 512;

#define GAS __attribute__((address_space(1)))
#define LAS __attribute__((address_space(3)))
typedef unsigned short bf16;
typedef unsigned v4u __attribute__((ext_vector_type(4)));
typedef float f32x4 __attribute__((ext_vector_type(4)));
typedef short bf16x8 __attribute__((ext_vector_type(8)));
typedef GAS unsigned gu32;
typedef GAS unsigned long long gu64;
#define RLX_AGENT __ATOMIC_RELAXED, __HIP_MEMORY_SCOPE_AGENT
#define LDS_WAIT() asm volatile("s_waitcnt lgkmcnt(0)" ::: "memory")
#define VM_WAIT() asm volatile("s_waitcnt vmcnt(0)" ::: "memory")
__device__ __forceinline__ unsigned long long rt() { return __builtin_amdgcn_s_memrealtime(); }
__device__ __forceinline__ unsigned f2bf(float f) { unsigned u = __builtin_bit_cast(unsigned, f); return (u + 0x7fffu + ((u >> 16) & 1u)) >> 16; }
__device__ __forceinline__ unsigned pk2(float lo, float hi) { return f2bf(lo) | (f2bf(hi) << 16); }

#define XB_TMO      128
#define XB_XCNT(j)  (256  + 64 * (j))
#define XB_XSUB(j)  (1280 + 64 * (j))
#define XB_XGEN(j)  (2304 + 64 * (j))
#define XB_TOP      3328
#define XB_TOPGEN   3392
#define XCD_BAR_WORDS 3456
#define XB_SPIN_CAP (1u << 18)

__device__ __forceinline__ unsigned xb_ld(unsigned* p)              { return __hip_atomic_load(p, __ATOMIC_RELAXED, __HIP_MEMORY_SCOPE_AGENT); }
__device__ __forceinline__ unsigned xb_add(unsigned* p, unsigned v) { return __hip_atomic_fetch_add(p, v, __ATOMIC_RELAXED, __HIP_MEMORY_SCOPE_AGENT); }
__device__ __forceinline__ unsigned xb_xcc_id() { return (unsigned)__builtin_amdgcn_s_getreg((3 << 11) | 20) & 0xFu; }
#define XB_SPIN(cond, bar) do { unsigned _sp = 0; while (cond) { __builtin_amdgcn_s_sleep(1); \
    if ((++_sp & 255u) == 0u) { if (xb_ld(&(bar)[XB_TMO])) break; if (_sp > XB_SPIN_CAP) { atomicAdd(&(bar)[XB_TMO], 1u); break; } } } } while (0)

struct XcdBarrier {
    unsigned* bar; unsigned x;
    volatile LAS unsigned* st;
};

__device__ __forceinline__ XcdBarrier xcd_barrier_post(unsigned* bar, volatile LAS unsigned* st) {
    XcdBarrier b; b.bar = bar; b.x = xb_xcc_id(); b.st = st;
    if (threadIdx.x == 0) (void)xb_add(&bar[XB_XCNT(b.x)], 1u);
    return b;
}
__device__ __forceinline__ void xcd_barrier_complete(unsigned* bar, unsigned x, unsigned& nloc, unsigned& nx) {
    const unsigned G = gridDim.x * gridDim.y * gridDim.z;
    unsigned sum, cnt, mine, sp = 0u;
    for (;;) {
        sum = 0u; cnt = 0u; mine = 0u;
#pragma unroll
        for (unsigned j = 0; j < 16; ++j) { const unsigned c = xb_ld(&bar[XB_XCNT(j)]); sum += c; cnt += (c > 0u) ? 1u : 0u; mine = (j == x) ? c : mine; }
        if (sum == G) break;
        __builtin_amdgcn_s_sleep(1);
        if ((++sp & 255u) == 0u) { if (xb_ld(&bar[XB_TMO])) break; if (sp > XB_SPIN_CAP) { atomicAdd(&bar[XB_TMO], 1u); break; } }
    }
    nloc = mine > 0u ? mine : 1u; nx = cnt > 0u ? cnt : 1u;
}

__device__ __forceinline__ void xcd_barrier(const XcdBarrier& b) {
    asm volatile("s_waitcnt vmcnt(0)" ::: "memory");
    __syncthreads();
    if (threadIdx.x == 0) {
        unsigned* bar = b.bar;
        __builtin_amdgcn_s_waitcnt(0);
        unsigned nloc = b.st[0], nx = b.st[1];
        if (nloc == 0u) { xcd_barrier_complete(bar, b.x, nloc, nx); b.st[0] = nloc; b.st[1] = nx; }
        const unsigned old = xb_add(&bar[XB_XSUB(b.x)], 1u);
        const unsigned gen = old / nloc;
        if (old + 1u == (gen + 1u) * nloc) {
            __builtin_amdgcn_fence(__ATOMIC_RELEASE, "agent");
            asm volatile("s_waitcnt vmcnt(0)" ::: "memory");
            const unsigned og = xb_add(&bar[XB_TOP], 1u);
            const unsigned tg = og / nx;
            if (og + 1u == (tg + 1u) * nx) xb_add(&bar[XB_TOPGEN], 1u);
            else XB_SPIN(xb_ld(&bar[XB_TOPGEN]) == tg, bar);
            __builtin_amdgcn_fence(__ATOMIC_ACQUIRE, "agent");
            xb_add(&bar[XB_XGEN(b.x)], 1u);
            asm volatile("s_waitcnt vmcnt(0)" ::: "memory");
        } else {
            XB_SPIN(xb_ld(&bar[XB_XGEN(b.x)]) == gen, bar);
            __builtin_amdgcn_fence(__ATOMIC_ACQUIRE, "agent");
            asm volatile("s_waitcnt vmcnt(0)" ::: "memory");
        }
    }
    __syncthreads();
}


typedef unsigned u32x2v __attribute__((ext_vector_type(2)));
__device__ __forceinline__ float bf2f(unsigned b) { return __uint_as_float(b << 16); }
__device__ __forceinline__ float wave_sum(float v) {
#pragma unroll
    for (int o = 1; o < 64; o <<= 1) v += __shfl_xor(v, o);
    return v;
}
__device__ __forceinline__ float wave_max(float v) {
#pragma unroll
    for (int o = 1; o < 64; o <<= 1) v = fmaxf(v, __shfl_xor(v, o));
    return v;
}
__device__ __forceinline__ float silu1(float g) { return g * __builtin_amdgcn_rcpf(1.0f + __builtin_amdgcn_exp2f(-1.4426950408889634f * g)); }

struct Frame {
    LAS unsigned char* lds;
    int tid, lane, wave, G, gw, NGW;
    const float* in[26]; float* out; unsigned char* ws;
};
#define WSP(T, off) ((T*)(F.ws + (off)))

__device__ __forceinline__ int rowmap(int kind, int n) {
    if (kind == 1) return 256 * (n >> 7) + (n & 127);
    if (kind == 2) return 256 * (n >> 7) + 128 + (n & 127);
    if (kind == 3) { if (n >= NINP) return n; const int pn = n >> 8, rem = n & 255, wc = rem >> 6, bj = (rem >> 5) & 1, j = rem & 31; return 256 * pn + 128 * bj + 32 * wc + j; }
    return n;
}
__device__ __forceinline__ void transpose_item(const float* W, int K, int N, const float* kscale, bf16* WT, int kind, LAS float* scr, int item, int lane) {
    const int nblk = (N + 63) >> 6, kb = item / nblk, nb = item - kb * nblk, k0 = 64 * kb, n0 = 64 * nb;
    const int nl = n0 + 4 * (lane & 15);
#pragma unroll 4
    for (int i = 0; i < 16; ++i) { const int kk = 4 * i + (lane >> 4);
        f32x4 v = (f32x4){0.f, 0.f, 0.f, 0.f};
        if (nl < N) v = *(const f32x4*)(W + (size_t)(k0 + kk) * N + nl);
        if (kscale) v = v * kscale[k0 + kk];
        LAS float* s = scr + kk * 65 + 4 * (lane & 15); s[0] = v[0]; s[1] = v[1]; s[2] = v[2]; s[3] = v[3]; }
    LDS_WAIT(); asm volatile("" ::: "memory");
    const int c = lane & 7;
#pragma unroll
    for (int j = 0; j < 8; ++j) { const int n_l = (lane >> 3) + 8 * j, n = n0 + n_l; const LAS float* s = scr + (8 * c) * 65 + n_l;
        v4u o; o.x = pk2(s[0 * 65], s[1 * 65]); o.y = pk2(s[2 * 65], s[3 * 65]); o.z = pk2(s[4 * 65], s[5 * 65]); o.w = pk2(s[6 * 65], s[7 * 65]);
        if (n < N) *(v4u*)(WT + (size_t)rowmap(kind, n) * K + k0 + 8 * c) = o; }
    LDS_WAIT(); asm volatile("" ::: "memory");
}
__device__ __forceinline__ void row_to_bf16(const float* xrow, bf16* orow, float* ssq, int lane) {
    const f32x4* xr = (const f32x4*)xrow + lane; float s = 0.f; f32x4 v[8];
#pragma unroll
    for (int j = 0; j < 8; ++j) { v[j] = xr[64 * j]; s += (v[j][0] * v[j][0] + v[j][1] * v[j][1]) + (v[j][2] * v[j][2] + v[j][3] * v[j][3]); }
    s = wave_sum(s);
    u32x2v* o8 = (u32x2v*)orow + lane;
#pragma unroll
    for (int j = 0; j < 8; ++j) { u32x2v w; w.x = pk2(v[j][0], v[j][1]); w.y = pk2(v[j][2], v[j][3]); o8[64 * j] = w; }
    if (lane == 0) *ssq = s;
}
__constant__ float ROPE_INV[8] = {1.0f, 0.1939227432012558f, 0.03760603070259094f, 0.007292664609849453f, 0.0014142135623842478f, 0.00027424818836152554f, 5.318296098266728e-05f, 1.0313386155758053e-05f};
__device__ __forceinline__ void p0_prologue(Frame& F) {
    LAS float* scr = (LAS float*)(F.lds + F.wave * 16640);
    constexpr int I_G = 32 * 88, I_D = 88 * 32, I_IN = 32 * 89, I_O = 32 * 32;
    constexpr int NITEMS = 2 * (2 * I_G + I_D) + I_IN + I_O;
    for (int it = F.gw; it < NITEMS; it += F.NGW) {
        int r = it;
        if (r < I_G) { transpose_item(F.in[3], DM, DFF, F.in[2], WSP(bf16, WS_W1GU), 1, scr, r, F.lane); continue; } r -= I_G;
        if (r < I_G) { transpose_item(F.in[4], DM, DFF, F.in[2], WSP(bf16, WS_W1GU), 2, scr, r, F.lane); continue; } r -= I_G;
        if (r < I_D) { transpose_item(F.in[5], DFF, DM, nullptr, WSP(bf16, WS_W1D), 0, scr, r, F.lane); continue; } r -= I_D;
        if (r < I_G) { transpose_item(F.in[23], DM, DFF, F.in[22], WSP(bf16, WS_W2GU), 1, scr, r, F.lane); continue; } r -= I_G;
        if (r < I_G) { transpose_item(F.in[24], DM, DFF, F.in[22], WSP(bf16, WS_W2GU), 2, scr, r, F.lane); continue; } r -= I_G;
        if (r < I_D) { transpose_item(F.in[25], DFF, DM, nullptr, WSP(bf16, WS_W2D), 0, scr, r, F.lane); continue; } r -= I_D;
        if (r < I_IN) { transpose_item(F.in[7], DM, NIN, F.in[6], WSP(bf16, WS_WIN), 3, scr, r, F.lane); continue; } r -= I_IN;
        transpose_item(F.in[21], DM, DM, nullptr, WSP(bf16, WS_WOUT), 0, scr, r, F.lane);
    }
    for (int m = F.gw; m < MR + NMETA; m += F.NGW) {
        if (m < MR) row_to_bf16(F.in[0] + (size_t)m * DM, WSP(bf16, WS_XN) + (size_t)m * DM, WSP(float, WS_SSQ0) + m, F.lane);
        else { const int p = m - MR; row_to_bf16(F.in[1] + (size_t)p * DM, WSP(bf16, WS_META + MO_XN) + (size_t)p * DM, WSP(float, WS_META + MO_SSQ0) + p, F.lane); }
    }
    for (int e = F.gw * 64 + F.lane; e < LPOS * 8; e += F.NGW * 64) { const int pos = e >> 3, i = e & 7;
        const float ang = (float)pos * ROPE_INV[i];
        double tr = (double)ang * 0.15915494309189535; tr -= __builtin_rint(tr);
        const float tf = (float)tr;
        WSP(float, WS_ROPE)[pos * 16 + i] = __builtin_amdgcn_cosf(tf); WSP(float, WS_ROPE)[pos * 16 + 8 + i] = __builtin_amdgcn_sinf(tf); }
}

__device__ __forceinline__ f32x4 skinny16(const bf16* A, int lda, const bf16* Bt, int ldb, int k0, int k1, int lane, f32x4 acc) {
    const bf16* ap = A + (size_t)(lane & 15) * lda + 8 * (lane >> 4);
    const bf16* bp = Bt + (size_t)(lane & 15) * ldb + 8 * (lane >> 4);
#pragma unroll 4
    for (int k = k0; k < k1; k += 32) { const bf16x8 a = *(const bf16x8*)(ap + k), b = *(const bf16x8*)(bp + k);
        acc = __builtin_amdgcn_mfma_f32_16x16x32_bf16(a, b, acc, 0, 0, 0); }
    return acc;
}
__device__ __forceinline__ void meta_gateup(Frame& F) {
    const bf16* A = WSP(bf16, WS_META + MO_XN); const float* ssq = WSP(float, WS_META + MO_SSQ0); bf16* act = WSP(bf16, WS_META + MO_ACT);
    for (int it = F.gw; it < DFF / 16; it += F.NGW) { const int c0 = 16 * it, rg = 256 * (c0 >> 7) + (c0 & 127);
        f32x4 g = (f32x4){0.f, 0.f, 0.f, 0.f}, u = g;
        g = skinny16(A, DM, WSP(bf16, WS_W1GU) + (size_t)rg * DM, DM, 0, DM, F.lane, g);
        u = skinny16(A, DM, WSP(bf16, WS_W1GU) + (size_t)(rg + 128) * DM, DM, 0, DM, F.lane, u);
#pragma unroll
        for (int i = 0; i < 4; ++i) { const int row = 4 * (F.lane >> 4) + i; const float rs = __builtin_amdgcn_rsqf(ssq[row] * (1.0f / 2048.0f) + EPS);
            act[row * DFF + c0 + (F.lane & 15)] = (bf16)f2bf(silu1(g[i] * rs) * (u[i] * rs)); } }
}
__device__ __forceinline__ void meta_down(Frame& F) {
    const bf16* A = WSP(bf16, WS_META + MO_ACT); float* h1 = WSP(float, WS_META + MO_H1); bf16* xn1 = WSP(bf16, WS_META + MO_XN1);
    for (int it = F.gw; it < DM / 16; it += F.NGW) { const int c0 = 16 * it;
        f32x4 a = (f32x4){0.f, 0.f, 0.f, 0.f};
        a = skinny16(A, DFF, WSP(bf16, WS_W1D) + (size_t)c0 * DFF, DFF, 0, DFF, F.lane, a);
#pragma unroll
        for (int i = 0; i < 4; ++i) { const int row = 4 * (F.lane >> 4) + i, col = c0 + (F.lane & 15); const float o = F.in[1][row * DM + col] + 0.5f * a[i];
            h1[row * DM + col] = o; xn1[row * DM + col] = (bf16)f2bf(o); } }
}
__device__ __forceinline__ void meta_inproj_and_dt(Frame& F) {
    const int nmeta = NIN / 16, ndt = MR / 16;
    for (int it = F.gw; it < nmeta + ndt; it += F.NGW) {
        if (it < nmeta) {
            const float* h1 = WSP(float, WS_META + MO_H1); float* um = WSP(float, WS_META + MO_U);
            float rs[4];
#pragma unroll
            for (int i = 0; i < 4; ++i) { const f32x4* hr = (const f32x4*)(h1 + (size_t)(4 * (F.lane >> 4) + i) * DM) + (F.lane & 15); float s = 0.f;
#pragma unroll 8
                for (int j = 0; j < 32; ++j) { const f32x4 v = hr[16 * j]; s += (v[0] * v[0] + v[1] * v[1]) + (v[2] * v[2] + v[3] * v[3]); }
                s += __shfl_xor(s, 1); s += __shfl_xor(s, 2); s += __shfl_xor(s, 4); s += __shfl_xor(s, 8);
                rs[i] = __builtin_amdgcn_rsqf(s * (1.0f / 2048.0f) + EPS); }
            const int r0 = 16 * it;
            int c0;
            if (r0 >= NINP) c0 = r0; else { const int pn = r0 >> 8, rem = r0 & 255, bj = rem >> 7, wc = (rem & 127) >> 5, j = rem & 31; c0 = 256 * pn + 64 * wc + 32 * bj + j; }
            f32x4 a = (f32x4){0.f, 0.f, 0.f, 0.f};
            a = skinny16(WSP(bf16, WS_META + MO_XN1), DM, WSP(bf16, WS_WIN) + (size_t)r0 * DM, DM, 0, DM, F.lane, a);
#pragma unroll
            for (int i = 0; i < 4; ++i) um[(size_t)(4 * (F.lane >> 4) + i) * NIN + c0 + (F.lane & 15)] = a[i] * rs[i];
        } else {
            const int m0 = 16 * (it - nmeta);
            f32x4 a = (f32x4){0.f, 0.f, 0.f, 0.f};
            a = skinny16(WSP(bf16, WS_XN) + (size_t)m0 * DM, DM, WSP(bf16, WS_WIN) + (size_t)NINP * DM, DM, 0, DM, F.lane, a);
#pragma unroll
            for (int i = 0; i < 4; ++i) { const int row = m0 + 4 * (F.lane >> 4) + i; WSP(float, WS_DTR)[(size_t)row * 16 + (F.lane & 15)] = a[i] * pg8::row_rs(WSP(float, WS_SSQ1), 32, row); }
        }
    }
}

__device__ __forceinline__ void p4_conv(Frame& F) {
    const bf16* U = WSP(bf16, WS_ACT); const float* um = WSP(float, WS_META + MO_U);
    const float* cw = F.in[15]; const float* cb = F.in[16];
    const int gt = F.gw * 64 + F.lane, NT = F.NGW * 64;
    for (int it = gt; it < NBATCH * LPAD * (CONVD / 8); it += NT) {
        const int cg = it % (CONVD / 8), pp = (it / (CONVD / 8)) % LPAD, b = it / ((CONVD / 8) * LPAD), c = 8 * cg, p = pp - PPAD;
        float a[8];
#pragma unroll
        for (int e = 0; e < 8; ++e) a[e] = 0.f;
        if (p >= 0) {
#pragma unroll
            for (int e = 0; e < 8; ++e) a[e] = cb[c + e];
#pragma unroll
            for (int w = 0; w < 4; ++w) { const int ps = p - 3 + w;
                if (ps >= 0) { float r[8];
                    if (ps < NMETA) { const f32x4 r0 = *(const f32x4*)(um + (size_t)ps * NIN + 4096 + c), r1 = *(const f32x4*)(um + (size_t)ps * NIN + 4096 + c + 4);
                        r[0] = r0[0]; r[1] = r0[1]; r[2] = r0[2]; r[3] = r0[3]; r[4] = r1[0]; r[5] = r1[1]; r[6] = r1[2]; r[7] = r1[3]; }
                    else { const v4u rv = *(const v4u*)(U + (size_t)(b * SEQ + ps - NMETA) * NINP + 4096 + c);
                        r[0] = bf2f(rv.x & 0xffffu); r[1] = bf2f(rv.x >> 16); r[2] = bf2f(rv.y & 0xffffu); r[3] = bf2f(rv.y >> 16); r[4] = bf2f(rv.z & 0xffffu); r[5] = bf2f(rv.z >> 16); r[6] = bf2f(rv.w & 0xffffu); r[7] = bf2f(rv.w >> 16); }
                    const f32x4 w0 = *(const f32x4*)(cw + w * CONVD + c), w1 = *(const f32x4*)(cw + w * CONVD + c + 4);
                    a[0] += r[0] * w0[0]; a[1] += r[1] * w0[1]; a[2] += r[2] * w0[2]; a[3] += r[3] * w0[3]; a[4] += r[4] * w1[0]; a[5] += r[5] * w1[1]; a[6] += r[6] * w1[2]; a[7] += r[7] * w1[3]; } }
#pragma unroll
            for (int e = 0; e < 8; ++e) a[e] = silu1(a[e]);
        }
        v4u o; o.x = pk2(a[0], a[1]); o.y = pk2(a[2], a[3]); o.z = pk2(a[4], a[5]); o.w = pk2(a[6], a[7]);
        if (c < 1024) *(v4u*)(WSP(bf16, WS_XS) + (size_t)(b * LPAD + pp) * 1024 + c) = o;
        else *(v4u*)(WSP(bf16, WS_BC) + (size_t)(b * LPAD + pp) * 512 + (c - 1024)) = o;
    }
    for (int it = gt; it < NBATCH * LPAD * SH; it += NT) { const int hd = it & 15, pp = (it >> 4) % LPAD, b = (it >> 4) / LPAD, p = pp - PPAD;
        float v = 0.f;
        if (p >= 0) { const float x = (p < NMETA ? um[(size_t)p * NIN + NINP + hd] : WSP(float, WS_DTR)[(size_t)(b * SEQ + p - NMETA) * 16 + hd]) + F.in[17][hd];
            v = fmaxf(x, 0.f) + log1pf(__expf(-fabsf(x))); }
        WSP(float, WS_DT)[it] = v; }
    for (int it = F.gw; it < NMETA * 16; it += F.NGW) { const int p = it >> 4, sh = it & 15, d = F.lane;
        float v = um[(size_t)p * NIN + 1024 + sh * 64 + d];
        const float r = __builtin_amdgcn_rsqf(wave_sum(v * v) * (1.0f / 64.0f) + EPS);
        v = v * r * F.in[9][d];
        const float pr = __shfl_xor(v, 8); const float* rp = WSP(float, WS_ROPE) + p * 16;
        if (d < 8) v = v * rp[d] - pr * rp[8 + d]; else if (d < 16) v = v * rp[d - 8] + pr * rp[d];
        WSP(bf16, WS_META + MO_KM)[p * 1024 + sh * 64 + d] = (bf16)f2bf(v); }
    for (int it = gt; it < NMETA * 1024; it += NT) WSP(bf16, WS_META + MO_VM)[it] = (bf16)f2bf(um[(size_t)(it >> 10) * NIN + 2048 + (it & 1023)]);
}

__device__ __forceinline__ void attn_simple(Frame& F, int item, LAS float* wl, float lam) {
    const bf16* U = WSP(bf16, WS_ACT); const bf16* Km = WSP(bf16, WS_META + MO_KM); const bf16* Vm = WSP(bf16, WS_META + MO_VM);
    const int lane = F.lane, t = item & (SEQ - 1), h = (item >> 12) & 7, b = item >> 15, row = b * SEQ + t;
    wl[lane] = bf2f(U[(size_t)row * NINP + h * 128 + lane]) * 0.125f; wl[64 + lane] = bf2f(U[(size_t)row * NINP + h * 128 + 64 + lane]) * 0.125f;
    LDS_WAIT(); asm volatile("" ::: "memory");
    const int nk = NMETA + 64 * ((t >> 6) + 1);
    float m0 = -INFINITY, m1 = -INFINITY, l0 = 0.f, l1 = 0.f, o0a = 0.f, o0b = 0.f, o1a = 0.f, o1b = 0.f;
    for (int kb = 0; kb * 64 < nk; ++kb) {
        const int j = kb * 64 + lane; const bool valid = j < nk;
        float s0 = -INFINITY, s1 = -INFINITY;
        if (valid) { const bf16* kp = (j < NMETA) ? Km + j * 1024 + h * 128 : U + (size_t)(b * SEQ + j - NMETA) * NINP + 1024 + h * 128;
            s0 = 0.f; s1 = 0.f;
#pragma unroll
            for (int d8 = 0; d8 < 8; ++d8) { const v4u k0 = *(const v4u*)(kp + 8 * d8), k1 = *(const v4u*)(kp + 64 + 8 * d8); const LAS float* q0 = wl + 8 * d8; const LAS float* q1 = wl + 64 + 8 * d8;
                s0 += q0[0] * bf2f(k0.x & 0xffffu) + q0[1] * bf2f(k0.x >> 16) + q0[2] * bf2f(k0.y & 0xffffu) + q0[3] * bf2f(k0.y >> 16) + q0[4] * bf2f(k0.z & 0xffffu) + q0[5] * bf2f(k0.z >> 16) + q0[6] * bf2f(k0.w & 0xffffu) + q0[7] * bf2f(k0.w >> 16);
                s1 += q1[0] * bf2f(k1.x & 0xffffu) + q1[1] * bf2f(k1.x >> 16) + q1[2] * bf2f(k1.y & 0xffffu) + q1[3] * bf2f(k1.y >> 16) + q1[4] * bf2f(k1.z & 0xffffu) + q1[5] * bf2f(k1.z >> 16) + q1[6] * bf2f(k1.w & 0xffffu) + q1[7] * bf2f(k1.w >> 16); } }
        const float mn0 = fmaxf(m0, wave_max(s0)), mn1 = fmaxf(m1, wave_max(s1));
        const float al0 = __expf(m0 - mn0), al1 = __expf(m1 - mn1), p0 = __expf(s0 - mn0), p1 = __expf(s1 - mn1);
        m0 = mn0; m1 = mn1; l0 = l0 * al0 + wave_sum(p0); l1 = l1 * al1 + wave_sum(p1);
        o0a *= al0; o0b *= al0; o1a *= al1; o1b *= al1;
        wl[128 + lane] = p0; wl[192 + lane] = p1;
        LDS_WAIT(); asm volatile("" ::: "memory");
        const int jn = (nk - kb * 64) < 64 ? (nk - kb * 64) : 64;
        for (int jj = 0; jj < jn; ++jj) { const int jk = kb * 64 + jj;
            const bf16* vp = (jk < NMETA) ? Vm + jk * 1024 + h * 128 : U + (size_t)(b * SEQ + jk - NMETA) * NINP + 2048 + h * 128;
            const unsigned vv = *(const unsigned*)(vp + 2 * lane); const float va = bf2f(vv & 0xffffu), vb = bf2f(vv >> 16), q0 = wl[128 + jj], q1 = wl[192 + jj];
            o0a += q0 * va; o0b += q0 * vb; o1a += q1 * va; o1b += q1 * vb; }
        LDS_WAIT(); asm volatile("" ::: "memory");
    }
    const float i0 = 1.0f / l0, i1 = lam / l1;
    const float oa = o0a * i0 - o1a * i1, ob = o0b * i0 - o1b * i1;
    const float r = __builtin_amdgcn_rsqf(wave_sum(oa * oa + ob * ob) * (1.0f / 128.0f) + EPS) * 0.8f;
    *(unsigned*)(WSP(bf16, WS_MIX) + (size_t)row * DM + h * 128 + 2 * lane) = pk2(oa * r * F.in[14][2 * lane], ob * r * F.in[14][2 * lane + 1]);
}
__device__ __forceinline__ void ssd_simple(Frame& F, int item) {
    const int lane = F.lane, pq = item & 3, hd = (item >> 2) & 15, b = item >> 6, g = hd >> 3, pl = lane & 15, nq = lane >> 4;
    const float A = -__expf(F.in[18][hd]), Dk = F.in[19][hd];
    const bf16* U = WSP(bf16, WS_ACT);
    const bf16* xs = WSP(bf16, WS_XS) + (size_t)b * LPAD * 1024 + hd * 64 + pq * 16 + pl;
    const bf16* bc = WSP(bf16, WS_BC) + (size_t)b * LPAD * 512 + g * 128 + nq * 32;
    const float* dtp = WSP(float, WS_DT) + (size_t)b * LPAD * 16 + hd;
    float hs[32];
#pragma unroll
    for (int i = 0; i < 32; ++i) hs[i] = 0.f;
    for (int pp = PPAD; pp < LPAD; ++pp) {
        const float dt = dtp[pp * 16], dec = __expf(dt * A), x = bf2f(xs[(size_t)pp * 1024]), xdt = x * dt;
        float y = 0.f;
#pragma unroll
        for (int q = 0; q < 4; ++q) { const v4u bv = *(const v4u*)(bc + (size_t)pp * 512 + 8 * q), cv = *(const v4u*)(bc + (size_t)pp * 512 + 256 + 8 * q);
            const unsigned bw[4] = {bv.x, bv.y, bv.z, bv.w}, cwv[4] = {cv.x, cv.y, cv.z, cv.w};
#pragma unroll
            for (int e = 0; e < 4; ++e) { float& h0 = hs[8 * q + 2 * e]; float& h1 = hs[8 * q + 2 * e + 1];
                h0 = dec * h0 + xdt * bf2f(bw[e] & 0xffffu); h1 = dec * h1 + xdt * bf2f(bw[e] >> 16);
                y += bf2f(cwv[e] & 0xffffu) * h0 + bf2f(cwv[e] >> 16) * h1; } }
        y += __shfl_xor(y, 16); y += __shfl_xor(y, 32);
        if (pp >= 64 && nq == 0) { const int row = b * SEQ + pp - 64, col = hd * 64 + pq * 16 + pl;
            const float z = bf2f(U[(size_t)row * NINP + 3072 + col]);
            WSP(bf16, WS_MIX)[(size_t)row * DM + 1024 + col] = (bf16)f2bf((y + x * Dk) * silu1(z)); }
    }
}
__device__ __forceinline__ void p5_mixer(Frame& F) {
    const float s1 = wave_sum(F.in[10][F.lane] * F.in[11][F.lane]), s2 = wave_sum(F.in[12][F.lane] * F.in[13][F.lane]);
    const float lam = __expf(s1) - __expf(s2) + 0.2f;
    for (int it = F.gw; it < NBATCH * SH * 4; it += F.NGW) ssd_simple(F, it);
    LAS float* wl = (LAS float*)(F.lds + F.wave * 1024);
    for (int it = F.gw; it < NBATCH * NHEAD * SEQ; it += F.NGW) attn_simple(F, it, wl, lam);
}
__device__ __forceinline__ void p6_ssdnorm(Frame& F) {
    for (int m = F.gw; m < MR; m += F.NGW) { bf16* rowp = WSP(bf16, WS_MIX) + (size_t)m * DM + 1024 + 16 * F.lane;
        const v4u a = *(const v4u*)rowp, b2 = *(const v4u*)(rowp + 8); const unsigned w[8] = {a.x, a.y, a.z, a.w, b2.x, b2.y, b2.z, b2.w};
        float v[16], s = 0.f;
#pragma unroll
        for (int e = 0; e < 8; ++e) { v[2 * e] = bf2f(w[e] & 0xffffu); v[2 * e + 1] = bf2f(w[e] >> 16); s += v[2 * e] * v[2 * e] + v[2 * e + 1] * v[2 * e + 1]; }
        const float r = __builtin_amdgcn_rsqf(wave_sum(s) * (1.0f / 1024.0f) + EPS);
        const float* nw = F.in[20] + 16 * F.lane;
        v4u o0, o1; o0.x = pk2(v[0] * r * nw[0], v[1] * r * nw[1]); o0.y = pk2(v[2] * r * nw[2], v[3] * r * nw[3]); o0.z = pk2(v[4] * r * nw[4], v[5] * r * nw[5]); o0.w = pk2(v[6] * r * nw[6], v[7] * r * nw[7]);
        o1.x = pk2(v[8] * r * nw[8], v[9] * r * nw[9]); o1.y = pk2(v[10] * r * nw[10], v[11] * r * nw[11]); o1.z = pk2(v[12] * r * nw[12], v[13] * r * nw[13]); o1.w = pk2(v[14] * r * nw[14], v[15] * r * nw[15]);
        *(v4u*)rowp = o0; *(v4u*)(rowp + 8) = o1; }
}

struct Args { const float* in[26]; float* out; unsigned char* ws; int ph_lo, ph_hi; };
__global__ void __launch_bounds__(NWAVES * 64, 2) hymba_fwd(Args args) {
    extern __shared__ __attribute__((aligned(16))) unsigned char lds[];
    Frame F;
    F.lds = (LAS unsigned char*)lds;
    F.tid = threadIdx.x; F.lane = F.tid & 63; F.wave = __builtin_amdgcn_readfirstlane(F.tid >> 6);
    F.G = gridDim.x; F.gw = blockIdx.x * NWAVES + F.wave; F.NGW = F.G * NWAVES;
#pragma unroll
    for (int i = 0; i < 26; ++i) F.in[i] = args.in[i];
    F.out = args.out; F.ws = args.ws;
    volatile LAS unsigned* MISC = (volatile LAS unsigned*)(F.lds + MISC_OFF);
    for (int u = F.tid; u < 128; u += NWAVES * 64) MISC[u] = 0u;
    __syncthreads();
    XcdBarrier bar; bar.bar = (unsigned*)(F.ws + WS_CTL) + CW_BAR; bar.x = 0; bar.st = nullptr;
    if (N_LAUNCHES == 1) bar = xcd_barrier_post((unsigned*)(F.ws + WS_CTL) + CW_BAR, MISC + 8);
    const int lo = args.ph_lo, hi = args.ph_hi;
#define IN(k) (lo <= (k) && (k) < hi)
#define SEAM(k) do { if (IN(k) && IN((k) + 1)) xcd_barrier(bar); } while (0)
    using pg8::Gemm; using pg8::StaticOrder;
    LAS unsigned char* ring = F.lds + RING_OFF;

    if (IN(0)) { p0_prologue(F); SEAM(0); }
    if (IN(1)) {
        meta_gateup(F);
        Gemm g{WSP(bf16, WS_XN), WSP(bf16, WS_W1GU), MR, NGU, DM}; StaticOrder S; S.init(MR, NGU, F.G, (int)blockIdx.x);
        pg8::EpiSwiGLU E{WSP(bf16, WS_ACT), DFF, WSP(float, WS_SSQ0), 1};
        pg8::gemm_phase<pg8::EpiSwiGLU, StaticOrder, true, true>(ring, g, S, E);
        SEAM(1);
    }
    if (IN(2)) {
        meta_down(F);
        Gemm g{WSP(bf16, WS_ACT), WSP(bf16, WS_W1D), MR, DM, DFF}; StaticOrder S; S.init(MR, DM, F.G, (int)blockIdx.x);
        pg8::EpiResT<false> E{F.in[0], F.out, WSP(bf16, WS_XN), WSP(float, WS_SSQ1), 0.5f, DM, nullptr, 0};
        pg8::gemm_phase<pg8::EpiResT<false>, StaticOrder, true, true>(ring, g, S, E);
        SEAM(2);
    }
    if (IN(3)) {
        meta_inproj_and_dt(F);
        Gemm g{WSP(bf16, WS_XN), WSP(bf16, WS_WIN), MR, NINP, DM}; StaticOrder S; S.init(MR, NINP, F.G, (int)blockIdx.x);
        pg8::EpiInProj E{WSP(bf16, WS_ACT), NINP, WSP(float, WS_SSQ1), F.in[8], F.in[9], WSP(float, WS_ROPE)};
        pg8::gemm_phase<pg8::EpiInProj, StaticOrder, true, true>(ring, g, S, E);
        SEAM(3);
    }
    if (IN(4)) { p4_conv(F); SEAM(4); }
    if (IN(5)) { p5_mixer(F); SEAM(5); }
    if (IN(6)) { p6_ssdnorm(F); SEAM(6); }
    if (IN(7)) {
        Gemm g{WSP(bf16, WS_MIX), WSP(bf16, WS_WOUT), MR, DM, DM}; StaticOrder S; S.init(MR, DM, F.G, (int)blockIdx.x);
        pg8::EpiResT<false> E{F.out, F.out, WSP(bf16, WS_XN), WSP(float, WS_SSQ2), 1.0f, DM, nullptr, 0};
        pg8::gemm_phase<pg8::EpiResT<false>, StaticOrder, true, true>(ring, g, S, E);
        SEAM(7);
    }
    if (IN(8)) {
        Gemm g{WSP(bf16, WS_XN), WSP(bf16, WS_W2GU), MR, NGU, DM}; StaticOrder S; S.init(MR, NGU, F.G, (int)blockIdx.x);
        pg8::EpiSwiGLU E{WSP(bf16, WS_ACT), DFF, WSP(float, WS_SSQ2), 32};
        pg8::gemm_phase<pg8::EpiSwiGLU, StaticOrder, true, true>(ring, g, S, E);
        SEAM(8);
    }
    if (IN(9)) {
        Gemm g{WSP(bf16, WS_ACT), WSP(bf16, WS_W2D), MR, DM, DFF}; StaticOrder S; S.init(MR, DM, F.G, (int)blockIdx.x);
        pg8::EpiResT<false> E{F.out, F.out, nullptr, nullptr, 0.5f, DM, nullptr, 0};
        pg8::gemm_phase<pg8::EpiResT<false>, StaticOrder, true, true>(ring, g, S, E);
    }
#undef IN
#undef SEAM
}

extern "C" void kernel_launch(void* const* d_in, const int* in_sizes, int n_in, void* d_out, int out_size, void* d_ws, size_t ws_size, hipStream_t stream) {
    static int grid = 0;
    if (grid == 0) {
        if (n_in != 26 || in_sizes[0] != MR * DM || out_size != MR * DM || ws_size < WS_END) { fprintf(stderr, "kernel_launch: unexpected shapes (n_in %d, in0 %d, out %d, ws %zu)\n", n_in, n_in > 0 ? in_sizes[0] : -1, out_size, ws_size); grid = -1; return; }
        int dev = 0, cus = 0, per_cu = 0;
        if (hipGetDevice(&dev) != hipSuccess || hipDeviceGetAttribute(&cus, hipDeviceAttributeMultiprocessorCount, dev) != hipSuccess) { grid = -1; return; }
        if (hipFuncSetAttribute((const void*)hymba_fwd, hipFuncAttributeMaxDynamicSharedMemorySize, LDS_BYTES) != hipSuccess) { fprintf(stderr, "kernel_launch: hipFuncSetAttribute failed\n"); grid = -1; return; }
        if (hipOccupancyMaxActiveBlocksPerMultiprocessor(&per_cu, (const void*)hymba_fwd, NWAVES * 64, LDS_BYTES) != hipSuccess || per_cu < 1) { fprintf(stderr, "kernel_launch: occupancy query says %d blocks per CU\n", per_cu); (void)hipGetLastError(); grid = -1; return; }
        grid = cus;
    }
    if (grid < 0) return;
    (void)hipMemsetAsync((char*)d_ws + WS_CTL, 0, CTL_ZERO_BYTES, stream);
    Args a{};
    for (int i = 0; i < 26; ++i) a.in[i] = (const float*)d_in[i];
    a.out = (float*)d_out; a.ws = (unsigned char*)d_ws;
    for (int li = 0; li < N_LAUNCHES; ++li) {
        a.ph_lo = (N_LAUNCHES == 1) ? 0 : li; a.ph_hi = (N_LAUNCHES == 1) ? NPH : li + 1;
        hipLaunchKernelGGL(hymba_fwd, dim3(grid), dim3(NWAVES * 64), LDS_BYTES, stream, a);
    }
}
```

```cpp
#include <hip/hip_runtime.h>
#include <cstdio>
#include <cstdint>
#include <cmath>
#ifndef MK_AMP
#define MK_AMP 0
#endif
namespace pg8 {
#define PG8_LAS __attribute__((address_space(3)))
typedef unsigned short bf16_t;
typedef short bf16x8 __attribute__((ext_vector_type(8)));
typedef float f32x4 __attribute__((ext_vector_type(4)));
typedef unsigned u32x4 __attribute__((ext_vector_type(4)));
constexpr int BM = 256, BK = 64, HALF = 128, HTB = HALF * BK * 2  , STAGE_BYTES = 8 * HTB, NXCD = 8, WGM = 8;

__host__ __device__ __forceinline__ int lds_byte(int r, int c) { const int st = (r >> 4) * 2 + (c >> 5), rr = r & 15, cc = c & 31, ob = rr * 64 + cc * 2; return st * 1024 + (ob ^ (((ob >> 9) & 1) << 5)); }
__host__ __device__ __forceinline__ void stage_rc(int b, int& R, int& C) { const int st = b / 1024, sb = b % 1024, swz = sb ^ (((sb >> 9) & 1) << 5); R = (st >> 1) * 16 + swz / 64; C = (st & 1) * 32 + (swz % 64) / 2; }
__host__ __device__ __forceinline__ int perm32(int rho) { const int n = rho >> 4, i = rho & 15; return 8 * (i >> 2) + 4 * n + (i & 3); }

struct Unit { int pm, pn; };
struct Gemm { const bf16_t* A; const bf16_t* Bt; int M, N, K; };

struct StaticOrder {
    int nM, nN, nwg, G, c;
    __host__ __device__ void init(int M, int N, int G_, int c_) { nM = M / BM; nN = N / BM; nwg = nM * nN; G = G_; c = c_; }
    __host__ __device__ __forceinline__ bool next(int i, Unit& u) const {
        const long L = (long)i * G + c; if (L >= nwg) return false;
        int wgid = (int)L; { const int q = nwg / NXCD, r = nwg % NXCD, xcd = wgid % NXCD, off = wgid / NXCD; wgid = (xcd < r ? xcd * (q + 1) : r * (q + 1) + (xcd - r) * q) + off; }
        const int nig = WGM * nN, gid = wgid / nig, fm = gid * WGM, gsz = (nM - fm) < WGM ? (nM - fm) : WGM;
        u.pm = fm + ((wgid % nig) % gsz); u.pn = (wgid % nig) / gsz; return true;
    }
    __device__ __forceinline__ void a_ready(const Unit&) const {}
    __device__ __forceinline__ void done(const Unit&) const {}
};


__device__ __forceinline__ unsigned cvt_pk_bf16(float lo, float hi) { unsigned r; asm volatile("v_cvt_pk_bf16_f32 %0, %1, %2" : "=v"(r) : "v"(lo), "v"(hi)); return r; }
typedef unsigned u32x2 __attribute__((ext_vector_type(2)));
constexpr float RMS_EPS = 1e-6f;
__device__ __forceinline__ float row_rs(const float* ssq, int np, int row, float inv_n = 1.0f / 2048.0f) {
    float s;
    if (np == 1) s = ssq[row];
    else { const f32x4* p = (const f32x4*)(ssq + (size_t)row * 32); f32x4 a = p[0];
#pragma unroll
        for (int i = 1; i < 8; ++i) a += p[i];
        s = (a[0] + a[1]) + (a[2] + a[3]); }
    return __builtin_amdgcn_rsqf(s * inv_n + RMS_EPS);
}
struct RsTable { const PG8_LAS float* t; int tpm, tpm2; };
__device__ __forceinline__ float row_rs_t(const RsTable& T, const float* ssq, int np, float inv_n, int pm, int rin) { return (pm == T.tpm) ? T.t[rin] : (pm == T.tpm2) ? T.t[256 + rin] : row_rs(ssq, np, pm * BM + rin, inv_n); }
__device__ __forceinline__ float silu_f(float g) { return g * __builtin_amdgcn_rcpf(1.0f + __builtin_amdgcn_exp2f(-1.4426950408889634f * g)); }

struct EpiSwiGLU {
    static constexpr bool PERM = true, AFTER_DRAIN = false, HAS_MID = false, AMP = (MK_AMP == 11);
    bf16_t* O; int ldc; const float* ssq; int np; RsTable T;
    __device__ __forceinline__ void mid(f32x4 (&)[2][2][4][2], const Unit&, int, int, int, int) const {}
    __device__ __forceinline__ void operator()(const f32x4 (&acc)[2][2][4][2], const Unit& u, int wr, int wc, int fr, int fq) const {
        const int row0 = u.pm * BM + wr * 64 + fr, col0 = u.pn * HALF + wc * 32 + 8 * fq;
#pragma unroll
        for (int ai = 0; ai < 2; ++ai)
#pragma unroll
            for (int m = 0; m < 4; ++m) { const int row = row0 + ai * HALF + m * 16; const float rs = row_rs_t(T, ssq, np, 1.0f / 2048.0f, u.pm, wr * 64 + fr + ai * HALF + m * 16);
                float a[8];
#pragma unroll
                for (int n = 0; n < 2; ++n)
#pragma unroll
                    for (int i = 0; i < 4; ++i) { const float g = acc[ai][0][m][n][i] * rs, up = acc[ai][1][m][n][i] * rs; a[4 * n + i] = silu_f(g) * up; }
                u32x4 w; w.x = cvt_pk_bf16(a[0], a[1]); w.y = cvt_pk_bf16(a[2], a[3]); w.z = cvt_pk_bf16(a[4], a[5]); w.w = cvt_pk_bf16(a[6], a[7]);
                *(u32x4*)(O + (size_t)row * ldc + col0) = w; }
    }
};
template <bool MID> struct EpiResT {
    static constexpr bool PERM = false, AFTER_DRAIN = false, HAS_MID = MID, AMP = false;
    const float* basef; const bf16_t* baseh; float* out; bf16_t* xn; float* ssq; float scale; int ldc; const float* rsm; int kmid; RsTable T;
    __device__ __forceinline__ void mid(f32x4 (&acc)[2][2][4][2], const Unit& u, int wr, int wc, int fr, int fq) const {
        int fro = fr; asm volatile("" : "+v"(fro));
        const int rin0 = wr * 64 + fro;
#pragma unroll
        for (int ai = 0; ai < 2; ++ai)
#pragma unroll
            for (int m = 0; m < 4; ++m) { const float r = row_rs_t(T, rsm, 32, 1.0f / 1024.0f, u.pm, rin0 + ai * HALF + m * 16);
#pragma unroll
                for (int bj = 0; bj < 2; ++bj)
#pragma unroll
                    for (int n = 0; n < 2; ++n) acc[ai][bj][m][n] *= r; }
    }
    __device__ __forceinline__ void operator()(const f32x4 (&acc)[2][2][4][2], const Unit& u, int wr, int wc, int fr, int fq) const {
        const int row0 = u.pm * BM + wr * 64 + fr, col0 = u.pn * BM + wc * 32 + 4 * fq;
#pragma unroll
        for (int ai = 0; ai < 2; ++ai) {
            f32x4 bf[4][2][2]; u32x2 bh[4][2][2];
#pragma unroll
            for (int m = 0; m < 4; ++m)
#pragma unroll
                for (int bj = 0; bj < 2; ++bj)
#pragma unroll
                    for (int n = 0; n < 2; ++n) { const size_t o1 = (size_t)(row0 + ai * HALF + m * 16) * ldc + col0 + bj * HALF + n * 16;
                        if (basef) bf[m][bj][n] = *(const f32x4*)(basef + o1); else bh[m][bj][n] = *(const u32x2*)(baseh + o1); }
#pragma unroll
            for (int m = 0; m < 4; ++m) { const int row = row0 + ai * HALF + m * 16; const size_t off = (size_t)row * ldc + col0; float sq = 0.f;
#pragma unroll
                for (int bj = 0; bj < 2; ++bj)
#pragma unroll
                    for (int n = 0; n < 2; ++n) { const size_t o1 = off + bj * HALF + n * 16; f32x4 b;
                        if (basef) b = bf[m][bj][n];
                        else { const u32x2 h = bh[m][bj][n]; b[0] = __uint_as_float(h.x << 16); b[1] = __uint_as_float(h.x & 0xffff0000u); b[2] = __uint_as_float(h.y << 16); b[3] = __uint_as_float(h.y & 0xffff0000u); }
                        const f32x4 o = b + acc[ai][bj][m][n] * scale;
                        if (out) *(f32x4*)(out + o1) = o;
                        if (xn) { sq += (o[0] * o[0] + o[1] * o[1]) + (o[2] * o[2] + o[3] * o[3]); u32x2 w; w.x = cvt_pk_bf16(o[0], o[1]); w.y = cvt_pk_bf16(o[2], o[3]); *(u32x2*)(xn + o1) = w; } }
                if (xn) { sq += __shfl_xor(sq, 16); sq += __shfl_xor(sq, 32); if (fq == 0) ssq[(size_t)row * 32 + u.pn * 4 + wc] = sq; } }
        }
    }
};
struct EpiInProj {
    static constexpr bool PERM = true, AFTER_DRAIN = false, HAS_MID = false, AMP = (MK_AMP == 12);
    bf16_t* U; int ldc; const float* ssq; const float* qn; const float* kn; const float* rope; RsTable T;
    __device__ __forceinline__ void mid(f32x4 (&)[2][2][4][2], const Unit&, int, int, int, int) const {}
    __device__ __forceinline__ void operator()(const f32x4 (&acc)[2][2][4][2], const Unit& u, int wr, int wc, int fr, int fq) const {
        const int row0 = u.pm * BM + wr * 64 + fr, col0 = u.pn * BM + wc * 64 + 8 * fq;
        const bool isqk = u.pn < 8;
        f32x4 wv[2][2];
        if (isqk) { const float* wn = (u.pn < 4) ? qn : kn;
#pragma unroll
            for (int bj = 0; bj < 2; ++bj)
#pragma unroll
                for (int n = 0; n < 2; ++n) wv[bj][n] = *(const f32x4*)(wn + 32 * bj + 8 * fq + 4 * n); }
#pragma unroll
        for (int ai = 0; ai < 2; ++ai)
#pragma unroll
            for (int m = 0; m < 4; ++m) { const int row = row0 + ai * HALF + m * 16; const float rs = row_rs_t(T, ssq, 32, 1.0f / 2048.0f, u.pm, wr * 64 + fr + ai * HALF + m * 16);
                f32x4 v[2][2];
#pragma unroll
                for (int bj = 0; bj < 2; ++bj)
#pragma unroll
                    for (int n = 0; n < 2; ++n) v[bj][n] = acc[ai][bj][m][n] * rs;
                if (isqk) {
                    float sq = 0.f;
#pragma unroll
                    for (int bj = 0; bj < 2; ++bj)
#pragma unroll
                        for (int n = 0; n < 2; ++n) sq += (v[bj][n][0] * v[bj][n][0] + v[bj][n][1] * v[bj][n][1]) + (v[bj][n][2] * v[bj][n][2] + v[bj][n][3] * v[bj][n][3]);
                    sq += __shfl_xor(sq, 16); sq += __shfl_xor(sq, 32);
                    const float r = __builtin_amdgcn_rsqf(sq * (1.0f / 64.0f) + RMS_EPS);
#pragma unroll
                    for (int bj = 0; bj < 2; ++bj)
#pragma unroll
                        for (int n = 0; n < 2; ++n) v[bj][n] = v[bj][n] * r * wv[bj][n];
                    const int pos = (row & 4095) + 16;
                    const f32x4 c0 = *(const f32x4*)(rope + pos * 16), c1 = *(const f32x4*)(rope + pos * 16 + 4), s0 = *(const f32x4*)(rope + pos * 16 + 8), s1 = *(const f32x4*)(rope + pos * 16 + 12);
                    f32x4 p0, p1;
#pragma unroll
                    for (int i = 0; i < 4; ++i) { p0[i] = __shfl_xor(v[0][0][i], 16); p1[i] = __shfl_xor(v[0][1][i], 16); }
                    if (fq == 0) { v[0][0] = v[0][0] * c0 - p0 * s0; v[0][1] = v[0][1] * c1 - p1 * s1; }
                    else if (fq == 1) { v[0][0] = v[0][0] * c0 + p0 * s0; v[0][1] = v[0][1] * c1 + p1 * s1; }
                    if (u.pn < 4) { v[0][0] *= 0.18033688011112042f; v[0][1] *= 0.18033688011112042f; v[1][0] *= 0.18033688011112042f; v[1][1] *= 0.18033688011112042f; }
                }
#pragma unroll
                for (int bj = 0; bj < 2; ++bj) { u32x4 w; w.x = cvt_pk_bf16(v[bj][0][0], v[bj][0][1]); w.y = cvt_pk_bf16(v[bj][0][2], v[bj][0][3]); w.z = cvt_pk_bf16(v[bj][1][0], v[bj][1][1]); w.w = cvt_pk_bf16(v[bj][1][2], v[bj][1][3]);
                    *(u32x4*)(U + (size_t)row * ldc + col0 + 32 * bj) = w; } }
    }
};

template <class Epi, class Sched, bool ALIGN_EPI = false, bool SP2 = false>
__device__ __forceinline__ void gemm_phase(PG8_LAS unsigned char* lds, const Gemm g, const Sched& S, const Epi& E) {
    const int tid = threadIdx.x, wid = __builtin_amdgcn_readfirstlane(tid >> 6), lane = tid & 63, wr = wid >> 2, wc = wid & 3, fr = lane & 15, fq = lane >> 4;
    const int K = g.K, nt = K / BK;
    unsigned voffA[2], voffB[2];
#pragma unroll
    for (int i = 0; i < 2; ++i) { int R, C; stage_rc(tid * 16 + i * 8192, R, C); const int Rb = Epi::PERM ? ((R & ~31) + perm32(R & 31)) : R;
        voffA[i] = (unsigned)(R * K + C) * 2u; voffB[i] = (unsigned)(Rb * K + C) * 2u; }
    const size_t kstep = (size_t)(BK * 2);
    const size_t hstep = (size_t)HALF * K * 2;
    const size_t tstep = 2 * hstep;
    const unsigned ldsw = (unsigned)wid * 1024u;
    const int aoff = lds_byte(wr * 64 + fr, fq * 8), boff = lds_byte(wc * 32 + fr, fq * 8);
#define PG8_SA(b, h) (((b) * 2 + (h)) * HTB)
#define PG8_SB(b, h) ((4 + (b) * 2 + (h)) * HTB)
#define PG8_STAGE(bufoff, gbase, voff) do { _Pragma("unroll") for (int _i = 0; _i < 2; ++_i) \
        __builtin_amdgcn_global_load_lds((const unsigned*)((const char*)(gbase) + (voff)[_i]), (PG8_LAS unsigned*)(lds + (bufoff) + ldsw + _i * 8192), 16, 0, 0); } while (0)
#define PG8_LDA(dst, b, h) do { _Pragma("unroll") for (int m = 0; m < 4; ++m) _Pragma("unroll") for (int k = 0; k < 2; ++k) dst[m][k] = *(const PG8_LAS bf16x8*)(lds + PG8_SA(b, h) + aoff + m * 2048 + k * 1024); } while (0)
#define PG8_LDB(dst, b, h) do { _Pragma("unroll") for (int n = 0; n < 2; ++n) _Pragma("unroll") for (int k = 0; k < 2; ++k) dst[n][k] = *(const PG8_LAS bf16x8*)(lds + PG8_SB(b, h) + boff + n * 2048 + k * 1024); } while (0)
#define PG8_MMA(ai, bj, At, Bt) do { __builtin_amdgcn_s_setprio(1); _Pragma("unroll") for (int m = 0; m < 4; ++m) _Pragma("unroll") for (int n = 0; n < 2; ++n) _Pragma("unroll") for (int k = 0; k < 2; ++k) \
        acc[ai][bj][m][n] = __builtin_amdgcn_mfma_f32_16x16x32_bf16(Bt[n][k], At[m][k], acc[ai][bj][m][n], 0, 0, 0); __builtin_amdgcn_s_setprio(0); } while (0)
#define PG8_WAIT_V(n) asm volatile("s_waitcnt vmcnt(" #n ")" ::: "memory")
#define PG8_WAIT_L(n) asm volatile("s_waitcnt lgkmcnt(" #n ")" ::: "memory")
#define PG8_BAR __builtin_amdgcn_s_barrier()
#define PG8_SCHED __builtin_amdgcn_sched_barrier(0)
    Unit cur, nxt; int ui = 0;
    if (!S.next(0, cur)) return;
    f32x4 acc[2][2][4][2];
#pragma unroll
    for (int a = 0; a < 2; ++a)
#pragma unroll
        for (int b = 0; b < 2; ++b)
#pragma unroll
            for (int m = 0; m < 4; ++m)
#pragma unroll
                for (int n = 0; n < 2; ++n) acc[a][b][m][n] = (f32x4){0.f, 0.f, 0.f, 0.f};
    bf16x8 At[4][2], B0[2][2], B1[2][2];
    const char* cA = (const char*)g.A + (size_t)cur.pm * tstep; const char* cB = (const char*)g.Bt + (size_t)cur.pn * tstep;
    S.a_ready(cur);
    if constexpr (SP2) {
        PG8_STAGE(PG8_SB(0, 0), cB, voffB); PG8_STAGE(PG8_SB(0, 1), cB + hstep, voffB); PG8_STAGE(PG8_SA(0, 0), cA, voffA); PG8_STAGE(PG8_SA(0, 1), cA + hstep, voffA);
        if (wr == 1) PG8_BAR;
        PG8_WAIT_V(2); PG8_BAR;
        PG8_STAGE(PG8_SB(1, 0), cB + kstep, voffB); PG8_STAGE(PG8_SA(1, 0), cA + kstep, voffA); PG8_STAGE(PG8_SB(1, 1), cB + hstep + kstep, voffB);
        PG8_WAIT_V(6); PG8_BAR;
    } else {
        PG8_STAGE(PG8_SB(0, 0), cB, voffB); PG8_STAGE(PG8_SA(0, 0), cA, voffA); PG8_STAGE(PG8_SB(0, 1), cB + hstep, voffB); PG8_STAGE(PG8_SA(0, 1), cA + hstep, voffA);
        if (wr == 1) PG8_BAR;
        PG8_WAIT_V(4); PG8_BAR;
        PG8_STAGE(PG8_SB(1, 0), cB + kstep, voffB); PG8_STAGE(PG8_SA(1, 0), cA + kstep, voffA); PG8_STAGE(PG8_SB(1, 1), cB + hstep + kstep, voffB);
        PG8_WAIT_V(6); PG8_BAR;
    }
    for (;;) {
        const bool has_next = S.next(ui + 1, nxt);
        const char* nA = has_next ? (const char*)g.A + (size_t)nxt.pm * tstep : cA; const char* nB = has_next ? (const char*)g.Bt + (size_t)nxt.pn * tstep : cB;
        for (int t = 0; t < nt; t += 2) {
            const bool last = (t == nt - 2);
            if constexpr (Epi::HAS_MID) { if (t == E.kmid) E.mid(acc, cur, wr, wc, fr, fq); }
            const char* a1 = cA + (size_t)(t + 1) * kstep;
            const char* a2 = last ? nA : cA + (size_t)(t + 2) * kstep; const char* b2 = last ? nB : cB + (size_t)(t + 2) * kstep;
            const char* a3 = a2 + kstep; const char* b3 = b2 + kstep;
            if (last && has_next) S.a_ready(nxt);
            if constexpr (SP2) {
            PG8_LDB(B0, 0, 0); PG8_LDB(B1, 0, 1); PG8_SCHED; PG8_LDA(At, 0, 0); PG8_STAGE(PG8_SA(1, 1), a1 + hstep, voffA);
            PG8_WAIT_V(8); PG8_WAIT_L(0); PG8_BAR; PG8_MMA(0, 0, At, B0); PG8_MMA(0, 1, At, B1); PG8_BAR; PG8_SCHED;
            PG8_LDA(At, 0, 1); PG8_STAGE(PG8_SB(0, 0), b2, voffB); PG8_STAGE(PG8_SB(0, 1), b2 + hstep, voffB); PG8_STAGE(PG8_SA(0, 0), a2, voffA);
            PG8_WAIT_V(8); PG8_WAIT_L(0); PG8_BAR; PG8_MMA(1, 0, At, B0); PG8_MMA(1, 1, At, B1); PG8_BAR; PG8_SCHED;
            PG8_LDB(B0, 1, 0); PG8_LDB(B1, 1, 1); PG8_SCHED; PG8_LDA(At, 1, 0); PG8_STAGE(PG8_SA(0, 1), a2 + hstep, voffA);
            PG8_WAIT_V(8); PG8_WAIT_L(0); PG8_BAR; PG8_MMA(0, 0, At, B0); PG8_MMA(0, 1, At, B1); PG8_BAR; PG8_SCHED;
            PG8_LDA(At, 1, 1); PG8_STAGE(PG8_SB(1, 0), b3, voffB); PG8_STAGE(PG8_SB(1, 1), b3 + hstep, voffB); PG8_STAGE(PG8_SA(1, 0), a3, voffA);
            PG8_WAIT_V(8); PG8_WAIT_L(0); PG8_BAR; PG8_MMA(1, 0, At, B0); PG8_MMA(1, 1, At, B1); PG8_BAR; PG8_SCHED;
            } else {
            PG8_LDB(B0, 0, 0); PG8_SCHED; PG8_LDA(At, 0, 0); PG8_STAGE(PG8_SA(1, 1), a1 + hstep, voffA);
            PG8_WAIT_L(8); PG8_BAR; PG8_WAIT_L(0); PG8_MMA(0, 0, At, B0); PG8_BAR; PG8_SCHED;
            PG8_LDB(B1, 0, 1); PG8_STAGE(PG8_SB(0, 0), b2, voffB);
            PG8_BAR; PG8_WAIT_L(0); PG8_MMA(0, 1, At, B1); PG8_BAR;
            PG8_LDA(At, 0, 1); PG8_STAGE(PG8_SA(0, 0), a2, voffA);
            PG8_BAR; PG8_WAIT_L(0); PG8_MMA(1, 0, At, B0); PG8_BAR; PG8_SCHED;
            PG8_STAGE(PG8_SB(0, 1), b2 + hstep, voffB);
            PG8_WAIT_V(6); PG8_BAR; PG8_MMA(1, 1, At, B1); PG8_BAR;
            PG8_LDB(B0, 1, 0); PG8_SCHED; PG8_LDA(At, 1, 0); PG8_STAGE(PG8_SA(0, 1), a2 + hstep, voffA);
            PG8_WAIT_L(8); PG8_BAR; PG8_WAIT_L(0); PG8_MMA(0, 0, At, B0); PG8_BAR; PG8_SCHED;
            PG8_LDB(B1, 1, 1); PG8_STAGE(PG8_SB(1, 0), b3, voffB);
            PG8_BAR; PG8_WAIT_L(0); PG8_MMA(0, 1, At, B1); PG8_BAR;
            PG8_LDA(At, 1, 1); PG8_STAGE(PG8_SA(1, 0), a3, voffA);
            PG8_BAR; PG8_WAIT_L(0); PG8_MMA(1, 0, At, B0); PG8_BAR; PG8_SCHED;
            PG8_STAGE(PG8_SB(1, 1), b3 + hstep, voffB);
            PG8_WAIT_V(6); PG8_BAR; PG8_MMA(1, 1, At, B1); PG8_BAR;
            }
        }
        if constexpr (ALIGN_EPI) { if (wr == 0) PG8_BAR; }
        if constexpr (!Epi::AFTER_DRAIN) { for (int amp_ = 0; amp_ < (Epi::AMP ? 3 : 1); ++amp_) { E(acc, cur, wr, wc, fr, fq); asm volatile("" ::: "memory"); } S.done(cur); }
        if (!has_next) break;
#pragma unroll
        for (int a = 0; a < 2; ++a)
#pragma unroll
            for (int b = 0; b < 2; ++b)
#pragma unroll
                for (int m = 0; m < 4; ++m)
#pragma unroll
                    for (int n = 0; n < 2; ++n) acc[a][b][m][n] = (f32x4){0.f, 0.f, 0.f, 0.f};
        cur = nxt; cA = nA; cB = nB; ++ui;
        if constexpr (ALIGN_EPI) { if (wr == 1) PG8_BAR; }
    }
    PG8_WAIT_V(0);
    if constexpr (!ALIGN_EPI) { if (wr == 0) PG8_BAR; }
    PG8_BAR;
    if constexpr (Epi::AFTER_DRAIN) { E.fused(acc, cur, wr, wc, fr, fq, lds, wid, lane); S.done(cur); }
#undef PG8_SA
#undef PG8_SB
#undef PG8_STAGE
#undef PG8_LDA
#undef PG8_LDB
#undef PG8_MMA
#undef PG8_WAIT_V
#undef PG8_WAIT_L
#undef PG8_BAR
#undef PG8_SCHED
}
}

#ifndef PG8_SP2
#define PG8_SP2 true
#endif

constexpr int NWAVES = 8;
constexpr int DM = 2048, SEQ = 4096, NBATCH = 2, MR = NBATCH * SEQ, NMETA = 16, LPOS = SEQ + NMETA;
constexpr int DFF = 5632, NGU = 2 * DFF;
constexpr int NHEAD = 8, SH = 16, CONVD = 1536, NIN = 5648, NINP = 5632;
constexpr int PPAD = 48, LPAD = LPOS + PPAD;
constexpr float EPS = 1e-6f;
#ifndef MK_REPEAT_PHASE
#define MK_REPEAT_PHASE -1
#endif
#ifndef MK_N_LAUNCHES
#define MK_N_LAUNCHES 1
#endif
constexpr int NPH = 10;
constexpr int N_LAUNCHES = MK_N_LAUNCHES;

constexpr size_t MiB = 1u << 20;
constexpr size_t WS_CTL = 0, CTL_ZERO_BYTES = 1 * MiB;
constexpr size_t WS_W1GU = 2 * MiB, WS_W1D = 46 * MiB, WS_WIN = 68 * MiB, WS_WOUT = 91 * MiB, WS_W2GU = 99 * MiB, WS_W2D = 143 * MiB;
constexpr size_t WS_XN = 165 * MiB;
constexpr size_t WS_ACT = 197 * MiB;
constexpr size_t WS_MIX = 285 * MiB;
constexpr size_t WS_SSQ0 = 317 * MiB;
constexpr size_t WS_SSQ1 = 318 * MiB, WS_SSQ2 = 319 * MiB;
constexpr size_t WS_DTR = 320 * MiB;
constexpr size_t WS_ROPE = 321 * MiB;
constexpr size_t WS_META = 322 * MiB;
constexpr size_t MO_XN = 0, MO_SSQ0 = 65536, MO_ACT = 131072, MO_H1 = 327680, MO_XN1 = 458752, MO_U = 524288, MO_KM = 917504, MO_VM = 950272, MO_SSQ1 = 69632;
constexpr size_t WS_SST = 324 * MiB;
constexpr size_t WS_ATOT = 333 * MiB;
constexpr size_t WS_SSQS = 334 * MiB;
constexpr size_t WS_XS = 336 * MiB;
constexpr size_t WS_BC = 353 * MiB;
constexpr size_t WS_DT = 362 * MiB;
constexpr size_t WS_END = 363 * MiB;
constexpr int CW_BAR = 4096;

constexpr int RING_OFF = 0, RING_BYTES = 131072;
constexpr int LDS_BYTES = 147456, MISC_OFF = LDS_BYTES - 512;

#define GAS __attribute__((address_space(1)))
#define LAS __attribute__((address_space(3)))
typedef unsigned short bf16;
typedef unsigned v4u __attribute__((ext_vector_type(4)));
typedef float f32x4 __attribute__((ext_vector_type(4)));
typedef short bf16x8 __attribute__((ext_vector_type(8)));
typedef GAS unsigned gu32;
typedef GAS unsigned long long gu64;
#define RLX_AGENT __ATOMIC_RELAXED, __HIP_MEMORY_SCOPE_AGENT
#define LDS_WAIT() asm volatile("s_waitcnt lgkmcnt(0)" ::: "memory")
#define VM_WAIT() asm volatile("s_waitcnt vmcnt(0)" ::: "memory")
__device__ __forceinline__ unsigned long long rt() { return __builtin_amdgcn_s_memrealtime(); }
__device__ __forceinline__ unsigned f2bf(float f) { unsigned u = __builtin_bit_cast(unsigned, f); return (u + 0x7fffu + ((u >> 16) & 1u)) >> 16; }
__device__ __forceinline__ unsigned pk2(float lo, float hi) { return f2bf(lo) | (f2bf(hi) << 16); }

#define XB_TMO      128
#define XB_XCNT(j)  (256  + 64 * (j))
#define XB_XSUB(j)  (1280 + 64 * (j))
#define XB_XGEN(j)  (2304 + 64 * (j))
#define XB_TOP      3328
#define XB_TOPGEN   3392
#define XCD_BAR_WORDS 3456
#define XB_SPIN_CAP (1u << 18)

__device__ __forceinline__ unsigned xb_ld(unsigned* p)              { return __hip_atomic_load(p, __ATOMIC_RELAXED, __HIP_MEMORY_SCOPE_AGENT); }
__device__ __forceinline__ unsigned xb_add(unsigned* p, unsigned v) { return __hip_atomic_fetch_add(p, v, __ATOMIC_RELAXED, __HIP_MEMORY_SCOPE_AGENT); }
__device__ __forceinline__ unsigned xb_xcc_id() { return (unsigned)__builtin_amdgcn_s_getreg((3 << 11) | 20) & 0xFu; }
#define XB_SPIN(cond, bar) do { unsigned _sp = 0; while (cond) { __builtin_amdgcn_s_sleep(1); \
    if ((++_sp & 255u) == 0u) { if (xb_ld(&(bar)[XB_TMO])) break; if (_sp > XB_SPIN_CAP) { atomicAdd(&(bar)[XB_TMO], 1u); break; } } } } while (0)

struct XcdBarrier {
    unsigned* bar; unsigned x;
    volatile LAS unsigned* st;
};

__device__ __forceinline__ XcdBarrier xcd_barrier_post(unsigned* bar, volatile LAS unsigned* st) {
    XcdBarrier b; b.bar = bar; b.x = xb_xcc_id(); b.st = st;
    if (threadIdx.x == 0) (void)xb_add(&bar[XB_XCNT(b.x)], 1u);
    return b;
}
__device__ __forceinline__ void xcd_barrier_complete(unsigned* bar, unsigned x, unsigned& nloc, unsigned& nx) {
    const unsigned G = gridDim.x * gridDim.y * gridDim.z;
    unsigned sum, cnt, mine, sp = 0u;
    for (;;) {
        sum = 0u; cnt = 0u; mine = 0u;
#pragma unroll
        for (unsigned j = 0; j < 16; ++j) { const unsigned c = xb_ld(&bar[XB_XCNT(j)]); sum += c; cnt += (c > 0u) ? 1u : 0u; mine = (j == x) ? c : mine; }
        if (sum == G) break;
        __builtin_amdgcn_s_sleep(1);
        if ((++sp & 255u) == 0u) { if (xb_ld(&bar[XB_TMO])) break; if (sp > XB_SPIN_CAP) { atomicAdd(&bar[XB_TMO], 1u); break; } }
    }
    nloc = mine > 0u ? mine : 1u; nx = cnt > 0u ? cnt : 1u;
}

__device__ __forceinline__ void xcd_barrier(const XcdBarrier& b) {
    asm volatile("s_waitcnt vmcnt(0)" ::: "memory");
    __syncthreads();
    if (threadIdx.x == 0) {
        unsigned* bar = b.bar;
        __builtin_amdgcn_s_waitcnt(0);
        unsigned nloc = b.st[0], nx = b.st[1];
        if (nloc == 0u) { xcd_barrier_complete(bar, b.x, nloc, nx); b.st[0] = nloc; b.st[1] = nx; }
        const unsigned old = xb_add(&bar[XB_XSUB(b.x)], 1u);
        const unsigned gen = old / nloc;
        if (old + 1u == (gen + 1u) * nloc) {
            __builtin_amdgcn_fence(__ATOMIC_RELEASE, "agent");
            asm volatile("s_waitcnt vmcnt(0)" ::: "memory");
            const unsigned og = xb_add(&bar[XB_TOP], 1u);
            const unsigned tg = og / nx;
            if (og + 1u == (tg + 1u) * nx) xb_add(&bar[XB_TOPGEN], 1u);
            else XB_SPIN(xb_ld(&bar[XB_TOPGEN]) == tg, bar);
            __builtin_amdgcn_fence(__ATOMIC_ACQUIRE, "agent");
            xb_add(&bar[XB_XGEN(b.x)], 1u);
            asm volatile("s_waitcnt vmcnt(0)" ::: "memory");
        } else {
            XB_SPIN(xb_ld(&bar[XB_XGEN(b.x)]) == gen, bar);
            __builtin_amdgcn_fence(__ATOMIC_ACQUIRE, "agent");
            asm volatile("s_waitcnt vmcnt(0)" ::: "memory");
        }
    }
    __syncthreads();
}


typedef unsigned u32x2v __attribute__((ext_vector_type(2)));
__device__ __forceinline__ float bf2f(unsigned b) { return __uint_as_float(b << 16); }
__device__ __forceinline__ float wave_sum(float v) {
#pragma unroll
    for (int o = 1; o < 64; o <<= 1) v += __shfl_xor(v, o);
    return v;
}
__device__ __forceinline__ float wave_max(float v) {
#pragma unroll
    for (int o = 1; o < 64; o <<= 1) v = fmaxf(v, __shfl_xor(v, o));
    return v;
}
__device__ __forceinline__ float silu1(float g) { return g * __builtin_amdgcn_rcpf(1.0f + __builtin_amdgcn_exp2f(-1.4426950408889634f * g)); }

struct Frame {
    LAS unsigned char* lds;
    int tid, lane, wave, G, gw, NGW;
    const float* in[26]; float* out; unsigned char* ws; const float* const* inp;
};
#define WSP(T, off) ((T*)(F.ws + (off)))

constexpr int RST_OFF = RING_BYTES;
__device__ __forceinline__ pg8::RsTable build_rs_table(Frame& F, const float* ssq, int np, float inv_n, int pm, int pm2 = -1) {
    LAS float* t = (LAS float*)(F.lds + RST_OFF);
    if (F.tid < 256) t[F.tid] = pg8::row_rs(ssq, np, pm * 256 + F.tid, inv_n);
    else if (pm2 >= 0) t[F.tid] = pg8::row_rs(ssq, np, pm2 * 256 + F.tid - 256, inv_n);
    __syncthreads();
    return pg8::RsTable{t, pm, pm2};
}
__device__ __forceinline__ int rowmap(int kind, int n) {
    if (kind == 1) return 256 * (n >> 7) + (n & 127);
    if (kind == 2) return 256 * (n >> 7) + 128 + (n & 127);
    if (kind == 3) { if (n >= NINP) return n; const int pn = n >> 8, rem = n & 255, wc = rem >> 6, bj = (rem >> 5) & 1, j = rem & 31; return 256 * pn + 128 * bj + 32 * wc + j; }
    return n;
}
struct TItem { const float* W; int K, N; const float* kscale; bf16* WT; int kind, item, ks_off, krot; };
__device__ __forceinline__ void transpose_load(const TItem& t, int lane, f32x4 (&v)[16]) {
    const int nblk = (t.N + 63) >> 6, kb = t.item / nblk, nb = t.item - kb * nblk, k0 = 64 * kb, n0 = 64 * nb;
    const float* src = t.W + (size_t)(k0 + 8 * (lane >> 3)) * t.N;
#pragma unroll
    for (int h = 0; h < 2; ++h) { int nl = n0 + 32 * h + 4 * (lane & 7); nl = nl < t.N ? nl : t.N - 4;
#pragma unroll
        for (int i = 0; i < 8; ++i) v[8 * h + i] = __builtin_nontemporal_load((const f32x4*)(src + (size_t)i * t.N + nl)); }
}
__device__ __forceinline__ void transpose_finish(const TItem& t, int lane, f32x4 (&v)[16]) {
    const int nblk = (t.N + 63) >> 6, kb = t.item / nblk, nb = t.item - kb * nblk, k0 = 64 * kb, n0 = 64 * nb, r = lane >> 3;
    float sc[8];
    if (t.kscale && k0 >= t.ks_off) { const f32x4 s0 = *(const f32x4*)(t.kscale + k0 + 8 * r - t.ks_off), s1 = *(const f32x4*)(t.kscale + k0 + 8 * r - t.ks_off + 4);
        sc[0] = s0[0]; sc[1] = s0[1]; sc[2] = s0[2]; sc[3] = s0[3]; sc[4] = s1[0]; sc[5] = s1[1]; sc[6] = s1[2]; sc[7] = s1[3]; }
    else {
#pragma unroll
        for (int i = 0; i < 8; ++i) sc[i] = 1.0f; }
    int kd = k0 + t.krot; if (kd >= t.K) kd -= t.K;
#pragma unroll
    for (int h = 0; h < 2; ++h)
#pragma unroll
        for (int j = 0; j < 4; ++j) { const int n = n0 + 32 * h + 4 * (lane & 7) + j;
            v4u o; o.x = pg8::cvt_pk_bf16(v[8 * h + 0][j] * sc[0], v[8 * h + 1][j] * sc[1]); o.y = pg8::cvt_pk_bf16(v[8 * h + 2][j] * sc[2], v[8 * h + 3][j] * sc[3]);
            o.z = pg8::cvt_pk_bf16(v[8 * h + 4][j] * sc[4], v[8 * h + 5][j] * sc[5]); o.w = pg8::cvt_pk_bf16(v[8 * h + 6][j] * sc[6], v[8 * h + 7][j] * sc[7]);
            if (n < t.N) *(v4u*)(t.WT + (size_t)rowmap(t.kind, n) * t.K + kd + 8 * r) = o; }
}
__device__ __forceinline__ void row_to_bf16(const float* xrow, bf16* orow, float* ssq, int lane) {
    const f32x4* xr = (const f32x4*)xrow + lane; float s = 0.f; f32x4 v[8];
#pragma unroll
    for (int j = 0; j < 8; ++j) { v[j] = __builtin_nontemporal_load(xr + 64 * j); s += (v[j][0] * v[j][0] + v[j][1] * v[j][1]) + (v[j][2] * v[j][2] + v[j][3] * v[j][3]); }
    s = wave_sum(s);
    u32x2v* o8 = (u32x2v*)orow + lane;
#pragma unroll
    for (int j = 0; j < 8; ++j) { u32x2v w; w.x = pk2(v[j][0], v[j][1]); w.y = pk2(v[j][2], v[j][3]); o8[64 * j] = w; }
    if (lane == 0) *ssq = s;
}
__constant__ float ROPE_INV[8] = {1.0f, 0.1939227432012558f, 0.03760603070259094f, 0.007292664609849453f, 0.0014142135623842478f, 0.00027424818836152554f, 5.318296098266728e-05f, 1.0313386155758053e-05f};
constexpr int I_G = 32 * 88, I_D = 88 * 32, I_IN = 32 * 89, I_O = 32 * 32;
constexpr int IT_W1G = 0, IT_W1U = IT_W1G + I_G, IT_W1D = IT_W1U + I_G, IT_WIN = IT_W1D + I_D, IT_WOUT = IT_WIN + I_IN, IT_W2U = IT_WOUT + I_O, IT_W2G = IT_W2U + I_G, IT_W2D = IT_W2G + I_G, IT_END = IT_W2D + I_D;
#ifndef MK_N1
#define MK_N1 4264
#endif
constexpr int IT_BG = IT_WOUT, BG_P = (IT_END - IT_BG + 7) / 8;
constexpr int IT_CUT0 = IT_BG - MK_N1;
static_assert(IT_CUT0 >= IT_W1D, "W1 gate/up are needed by P1");
__device__ __forceinline__ TItem mk_item(Frame& F, int it) {
    const int m = (it >= IT_W1U) + (it >= IT_W1D) + (it >= IT_WIN) + (it >= IT_WOUT) + (it >= IT_W2U) + (it >= IT_W2G) + (it >= IT_W2D);
    const int start = m == 0 ? IT_W1G : m == 1 ? IT_W1U : m == 2 ? IT_W1D : m == 3 ? IT_WIN : m == 4 ? IT_WOUT : m == 5 ? IT_W2U : m == 6 ? IT_W2G : IT_W2D;
    const unsigned long long WI = 0x1917181507050403ull, SI = 0xff16161406ff0202ull;
    const int wi = (int)((WI >> (8 * m)) & 0xffu), si = (int)((SI >> (8 * m)) & 0xffu);
    const bool down = (m == 2 || m == 7);
    const size_t wto = m < 2 ? WS_W1GU : m == 2 ? WS_W1D : m == 3 ? WS_WIN : m == 4 ? WS_WOUT : m < 7 ? WS_W2GU : WS_W2D;
    const int kind = (m == 0 || m == 6) ? 1 : (m == 1 || m == 5) ? 2 : m == 3 ? 3 : 0;
    TItem t; t.W = F.inp[wi]; t.K = down ? DFF : DM; t.N = down ? DM : m == 4 ? DM : m == 3 ? NIN : DFF; t.kscale = si == 0xff ? nullptr : F.inp[si]; t.WT = WSP(bf16, wto); t.kind = kind; t.item = it - start;
    t.ks_off = m == 4 ? 1024 : 0; t.krot = m == 4 ? 1024 : 0;
    return t;
}
__device__ __forceinline__ void convert_items(Frame& F, int lo, int hi, int w, int nw) {
    if (w < 0) return;
    f32x4 va[16], vb[16]; int it = lo + w;
    if (it < hi) { TItem ta = mk_item(F, it); transpose_load(ta, F.lane, va);
        for (;;) {
            const int itb = it + nw; TItem tb = mk_item(F, itb < hi ? itb : it);
            if (itb < hi) transpose_load(tb, F.lane, vb);
            transpose_finish(ta, F.lane, va);
            if (itb >= hi) break;
            const int itc = itb + nw; ta = mk_item(F, itc < hi ? itc : itb);
            if (itc < hi) transpose_load(ta, F.lane, va);
            transpose_finish(tb, F.lane, vb);
            if (itc >= hi) break;
            it = itc;
        } }
}
__device__ __forceinline__ void p0_prologue(Frame& F) {
    convert_items(F, 0, IT_CUT0, F.gw, F.NGW);
    for (int m = F.gw; m < MR; m += 2 * F.NGW) {
        const int m2 = m + F.NGW;
        const f32x4* xa = (const f32x4*)(F.in[0] + (size_t)m * DM) + F.lane; const f32x4* xb = (const f32x4*)(F.in[0] + (size_t)(m2 < MR ? m2 : m) * DM) + F.lane;
        f32x4 va[8], vb[8]; float sa = 0.f, sb = 0.f;
#pragma unroll
        for (int j = 0; j < 8; ++j) { va[j] = __builtin_nontemporal_load(xa + 64 * j); vb[j] = __builtin_nontemporal_load(xb + 64 * j); }
#pragma unroll
        for (int j = 0; j < 8; ++j) { sa += (va[j][0] * va[j][0] + va[j][1] * va[j][1]) + (va[j][2] * va[j][2] + va[j][3] * va[j][3]); sb += (vb[j][0] * vb[j][0] + vb[j][1] * vb[j][1]) + (vb[j][2] * vb[j][2] + vb[j][3] * vb[j][3]); }
        sa = wave_sum(sa); sb = wave_sum(sb);
        u32x2v* oa = (u32x2v*)(WSP(bf16, WS_XN) + (size_t)m * DM) + F.lane; u32x2v* ob = (u32x2v*)(WSP(bf16, WS_XN) + (size_t)m2 * DM) + F.lane;
#pragma unroll
        for (int j = 0; j < 8; ++j) { u32x2v w; w.x = pk2(va[j][0], va[j][1]); w.y = pk2(va[j][2], va[j][3]); oa[64 * j] = w; }
        if (F.lane == 0) WSP(float, WS_SSQ0)[m] = sa;
        if (m2 < MR) {
#pragma unroll
            for (int j = 0; j < 8; ++j) { u32x2v w; w.x = pk2(vb[j][0], vb[j][1]); w.y = pk2(vb[j][2], vb[j][3]); ob[64 * j] = w; }
            if (F.lane == 0) WSP(float, WS_SSQ0)[m2] = sb; }
    }
    for (int p = F.gw; p < NMETA; p += F.NGW) row_to_bf16(F.in[1] + (size_t)p * DM, WSP(bf16, WS_META + MO_XN) + (size_t)p * DM, WSP(float, WS_META + MO_SSQ0) + p, F.lane);
    for (int e = F.gw * 64 + F.lane; e < LPOS * 8; e += F.NGW * 64) { const int pos = e >> 3, i = e & 7;
        const float ang = (float)pos * ROPE_INV[i];
        double tr = (double)ang * 0.15915494309189535; tr -= __builtin_rint(tr);
        const float tf = (float)tr;
        WSP(float, WS_ROPE)[pos * 16 + i] = __builtin_amdgcn_cosf(tf); WSP(float, WS_ROPE)[pos * 16 + 8 + i] = __builtin_amdgcn_sinf(tf); }
}

__device__ __forceinline__ f32x4 skinny16(const bf16* A, int lda, const bf16* Bt, int ldb, int k0, int k1, int lane, f32x4 acc) {
    const bf16* ap = A + (size_t)(lane & 15) * lda + 8 * (lane >> 4);
    const bf16* bp = Bt + (size_t)(lane & 15) * ldb + 8 * (lane >> 4);
#pragma unroll 16
    for (int k = k0; k < k1; k += 32) { const bf16x8 a = *(const bf16x8*)(ap + k), b = *(const bf16x8*)(bp + k);
        acc = __builtin_amdgcn_mfma_f32_16x16x32_bf16(a, b, acc, 0, 0, 0); }
    asm volatile("s_nop 15\n\ts_nop 3" : "+v"(acc));
    return acc;
}
__device__ __forceinline__ void meta_gateup(Frame& F, int w0, int wstride) {
    const bf16* A = WSP(bf16, WS_META + MO_XN); const float* ssq = WSP(float, WS_META + MO_SSQ0); bf16* act = WSP(bf16, WS_META + MO_ACT);
    if (w0 < 0) return;
    for (int it = w0; it < DFF / 16; it += wstride) { const int c0 = 16 * it, rg = 256 * (c0 >> 7) + (c0 & 127);
        f32x4 g = (f32x4){0.f, 0.f, 0.f, 0.f}, u = g;
        g = skinny16(A, DM, WSP(bf16, WS_W1GU) + (size_t)rg * DM, DM, 0, DM, F.lane, g);
        u = skinny16(A, DM, WSP(bf16, WS_W1GU) + (size_t)(rg + 128) * DM, DM, 0, DM, F.lane, u);
#pragma unroll
        for (int i = 0; i < 4; ++i) { const int row = 4 * (F.lane >> 4) + i; const float rs = __builtin_amdgcn_rsqf(ssq[row] * (1.0f / 2048.0f) + EPS);
            act[row * DFF + c0 + (F.lane & 15)] = (bf16)f2bf(silu1(g[i] * rs) * (u[i] * rs)); } }
}
__device__ __forceinline__ void meta_down(Frame& F) {
    const bf16* A = WSP(bf16, WS_META + MO_ACT); float* ssq1 = WSP(float, WS_META + MO_SSQ1); bf16* xn1 = WSP(bf16, WS_META + MO_XN1);
    LAS f32x4* red = (LAS f32x4*)(F.lds + 65536);
    for (int it = blockIdx.x; it < DM / 16; it += F.G) { const int c0 = 16 * it;
        __syncthreads();
        f32x4 a = (f32x4){0.f, 0.f, 0.f, 0.f};
        a = skinny16(A, DFF, WSP(bf16, WS_W1D) + (size_t)c0 * DFF, DFF, F.wave * (DFF / 8), (F.wave + 1) * (DFF / 8), F.lane, a);
        red[F.wave * 64 + F.lane] = a;
        __syncthreads();
        if (F.wave == 0) {
#pragma unroll
            for (int w = 1; w < 8; ++w) a += red[w * 64 + F.lane];
#pragma unroll
            for (int i = 0; i < 4; ++i) { const int row = 4 * (F.lane >> 4) + i, col = c0 + (F.lane & 15); const float o = F.in[1][row * DM + col] + 0.5f * a[i];
                xn1[row * DM + col] = (bf16)f2bf(o);
                float sq = o * o; sq += __shfl_xor(sq, 1); sq += __shfl_xor(sq, 2); sq += __shfl_xor(sq, 4); sq += __shfl_xor(sq, 8);
                if ((F.lane & 15) == 0) ssq1[row * 128 + it] = sq; } }
        __syncthreads();
    }
}
constexpr int NMETA_IT = NIN / 16, NDT_IT = MR / 16;
__device__ __forceinline__ void meta_inproj_and_dt(Frame& F, int it0, int it_end, int wstride) {
    const int nmeta = NMETA_IT;
    if (it0 < 0) return;
    for (int it = it0; it < it_end; it += wstride) {
        if (it < nmeta) {
            const float* ssq1 = WSP(float, WS_META + MO_SSQ1); float* um = WSP(float, WS_META + MO_U);
            float rs[4];
#pragma unroll
            for (int i = 0; i < 4; ++i) { const f32x4* pp = (const f32x4*)(ssq1 + (4 * (F.lane >> 4) + i) * 128 + 8 * (F.lane & 15)); const f32x4 v = pp[0] + pp[1]; float s2 = (v[0] + v[1]) + (v[2] + v[3]);
                s2 += __shfl_xor(s2, 1); s2 += __shfl_xor(s2, 2); s2 += __shfl_xor(s2, 4); s2 += __shfl_xor(s2, 8);
                rs[i] = __builtin_amdgcn_rsqf(s2 * (1.0f / 2048.0f) + EPS); }
            const int r0 = 16 * it;
            int c0;
            if (r0 >= NINP) c0 = r0; else { const int pn = r0 >> 8, rem = r0 & 255, bj = rem >> 7, wc = (rem & 127) >> 5, j = rem & 31; c0 = 256 * pn + 64 * wc + 32 * bj + j; }
            f32x4 a = (f32x4){0.f, 0.f, 0.f, 0.f};
            a = skinny16(WSP(bf16, WS_META + MO_XN1), DM, WSP(bf16, WS_WIN) + (size_t)r0 * DM, DM, 0, DM, F.lane, a);
#pragma unroll
            for (int i = 0; i < 4; ++i) um[(size_t)(4 * (F.lane >> 4) + i) * NIN + c0 + (F.lane & 15)] = a[i] * rs[i];
        } else {
            const int m0 = 16 * (it - nmeta);
            f32x4 a = (f32x4){0.f, 0.f, 0.f, 0.f};
            a = skinny16(WSP(bf16, WS_XN) + (size_t)m0 * DM, DM, WSP(bf16, WS_WIN) + (size_t)NINP * DM, DM, 0, DM, F.lane, a);
#pragma unroll
            for (int i = 0; i < 4; ++i) { const int row = m0 + 4 * (F.lane >> 4) + i; WSP(float, WS_DTR)[(size_t)row * 16 + (F.lane & 15)] = a[i] * pg8::row_rs(WSP(float, WS_SSQ1), 32, row); }
        }
    }
}


namespace att {
typedef float f32x16 __attribute__((ext_vector_type(16)));
typedef short s16x4 __attribute__((ext_vector_type(4)));
typedef short v4i16_t __attribute__((ext_vector_type(4)));
typedef float f32x2_t __attribute__((ext_vector_type(2))); typedef __bf16 bf16x2_t __attribute__((ext_vector_type(2)));
constexpr int STAGE = 32768, VOFF = 16384;
__device__ __forceinline__ int crow(int r, int hi) { return (r & 3) + 8 * (r >> 2) + 4 * hi; }
__device__ __forceinline__ unsigned cvtpk(float lo, float hi) { f32x2_t v = {lo, hi}; bf16x2_t b = __builtin_convertvector(v, bf16x2_t); return __builtin_bit_cast(unsigned, b); }
#define ATT_WAITBAR() asm volatile("s_waitcnt vmcnt(0) lgkmcnt(0)\n\ts_barrier" ::: "memory")
__device__ __forceinline__ void glds16(const void* gsrc, unsigned lds_dst) { unsigned keep;
    asm volatile("s_mov_b32 %0, m0\n\ts_mov_b32 m0, %2\n\ts_nop 0\n\tglobal_load_lds_dwordx4 %1, off\n\ts_mov_b32 m0, %0" : "=&s"(keep) : "v"(gsrc), "s"(lds_dst) : "memory"); }
#define ATT_DMA(src, dstoff) glds16((const void*)(src), (unsigned)__builtin_amdgcn_readfirstlane((int)(dstoff)))
#define ATT_MFMA(a, b, c) __builtin_amdgcn_mfma_f32_32x32x16_bf16((a), (b), (c), 0, 0, 0)
__device__ __forceinline__ float fadd_s(float a, float b) { float r; asm("v_add_f32 %0, %1, %2" : "=v"(r) : "v"(a), "v"(b)); return r; }

constexpr int KST = 16384, VST0 = 4 * KST, VSTB = 16384, WSF_OFF = VST0 + 3 * VSTB, STG_OFF = VST0, DUMMY_OFF = WSF_OFF + 1024;
__device__ __forceinline__ void attn_unit(Frame& F, int bh, int jq) {
    LAS unsigned char* lds = F.lds;
    const bf16* U = WSP(bf16, WS_ACT);
    int lane = F.lane; asm volatile("" : "+v"(lane));
    const int wave = F.wave, r32 = lane & 31, hi = lane >> 5;
    const int b = bh >> 3, h = bh & 7, rb = wave & 3, sub = wave >> 2;
    const int cw = 2 * jq + (rb >> 1);
    const int row0 = b * SEQ + 128 * jq + 32 * rb;
    const int T = 2 * jq + 2;
    const int kk0 = 8 * wave + (lane >> 4), kk1 = kk0 + 4;
    const bf16* kbase0 = U + (size_t)(b * SEQ + kk0) * NINP + 1024 + h * 128 + 8 * ((lane & 15) ^ (kk0 & 15));
    const bf16* kbase1 = U + (size_t)(b * SEQ + kk1) * NINP + 1024 + h * 128 + 8 * ((lane & 15) ^ (kk1 & 15));
    const int v0 = 2 * wave, v1 = 2 * wave + 1;
    const bf16* vbase0 = U + (size_t)(b * SEQ + 16 * (v0 & 3) + (lane >> 2)) * NINP + 2048 + h * 128 + 32 * (v0 >> 2) + 8 * (lane & 3);
    const bf16* vbase1 = U + (size_t)(b * SEQ + 16 * (v1 & 3) + (lane >> 2)) * NINP + 2048 + h * 128 + 32 * (v1 >> 2) + 8 * (lane & 3);
    const int kd0 = 2 * wave * 1024, kd1 = kd0 + 1024, vd0 = v0 * 1024, vd1 = v1 * 1024;
#define ATT_DMA_K(t, ks_) do { const size_t to_ = (size_t)(t) * 64 * NINP; ATT_DMA(kbase0 + to_, (ks_) + kd0); ATT_DMA(kbase1 + to_, (ks_) + kd1); } while (0)
#define ATT_DMA_V(t, vs_) do { const size_t to_ = (size_t)(t) * 64 * NINP; ATT_DMA(vbase0 + to_, (vs_) + vd0); ATT_DMA(vbase1 + to_, (vs_) + vd1); } while (0)
    ATT_DMA_K(0, 0); ATT_DMA_V(0, VST0); ATT_DMA_K(1, KST); ATT_DMA_V(1, VST0 + VSTB); if (T > 2) ATT_DMA_K(2, 2 * KST);
    { const float* um = WSP(float, WS_META + MO_U);
      float mv[4];
#pragma unroll
      for (int i4 = 0; i4 < 4; ++i4) { const int itm = 4 * wave + i4; mv[i4] = um[(size_t)(itm >> 1) * NIN + 1024 + h * 128 + (itm & 1) * 64 + lane]; }
#pragma unroll
      for (int i4 = 0; i4 < 4; ++i4) { const int itm = 4 * wave + i4, p = itm >> 1, sh = itm & 1, d = lane;
          float v = mv[i4];
          const float r = __builtin_amdgcn_rsqf(wave_sum(v * v) * (1.0f / 64.0f) + EPS);
          v = v * r * F.in[9][d];
          const float pr = __shfl_xor(v, 8); const float* rp = WSP(float, WS_ROPE) + p * 16;
          if (d < 8) v = v * rp[d] - pr * rp[8 + d]; else if (d < 16) v = v * rp[d - 8] + pr * rp[d];
          const int dd = sh * 64 + d;
          *(LAS bf16*)(lds + 3 * KST + p * 256 + (((dd >> 3) ^ p) << 4) + (dd & 7) * 2) = (bf16)f2bf(v); }
      { const int e = 4 * (wave * 64 + lane), key = e >> 7, d = e & 127; const f32x4 vv = *(const f32x4*)(um + (size_t)key * NIN + 2048 + h * 128 + d);
        u32x2v w2; w2.x = pk2(vv[0], vv[1]); w2.y = pk2(vv[2], vv[3]); *(LAS u32x2v*)(lds + VST0 + 2 * VSTB + (4 * (d >> 5)) * 1024 + key * 64 + (d & 31) * 2) = w2; } }
    bf16x8 qf[4];
#pragma unroll
    for (int ks = 0; ks < 4; ++ks) qf[ks] = *(const bf16x8*)(U + (size_t)(row0 + r32) * NINP + h * 128 + sub * 64 + 16 * ks + 8 * hi);
    f32x16 o[4];
#pragma unroll
    for (int d = 0; d < 4; ++d)
#pragma unroll
        for (int i = 0; i < 16; ++i) o[d][i] = 0.f;
    float lsum = 0.f;
    const f32x16 zero16 = {0.f, 0.f, 0.f, 0.f, 0.f, 0.f, 0.f, 0.f, 0.f, 0.f, 0.f, 0.f, 0.f, 0.f, 0.f, 0.f};
    const int koff = r32 * 256 + (((8 * sub + hi) ^ (r32 & 15)) << 4);
    const int voff = ((lane >> 4) & 1) * 32 + (lane & 3) * 8 + (4 * hi + ((lane & 15) >> 2)) * 64;
#define ATT_KF(kst_, half, ks) (*(const LAS bf16x8*)(lds + (kst_) + (half) * 8192 + (koff ^ ((ks) << 5))))
#define ATT_VTR(vst_, off) __builtin_bit_cast(s16x4, __builtin_amdgcn_ds_read_tr16_b64_v4i16((LAS v4i16_t*)(lds + (vst_) + voff + (off))))
    ATT_WAITBAR();
    f32x16 s0 = zero16, s1 = zero16;
    {
        f32x16 sc = zero16;
#pragma unroll
        for (int ks = 0; ks < 4; ++ks) sc = ATT_MFMA(ATT_KF(3 * KST, 0, ks), qf[ks], sc);
#pragma unroll
        for (int ks = 0; ks < 4; ++ks) { s0 = ATT_MFMA(ATT_KF(0, 0, ks), qf[ks], s0); s1 = ATT_MFMA(ATT_KF(0, 1, ks), qf[ks], s1); }
#pragma unroll
        for (int i = 0; i < 8; ++i) { sc[i] = __builtin_amdgcn_exp2f(sc[i]); lsum += sc[i]; }
        v4u pw; pw.x = cvtpk(sc[0], sc[1]); pw.y = cvtpk(sc[2], sc[3]); pw.z = cvtpk(sc[4], sc[5]); pw.w = cvtpk(sc[6], sc[7]);
        const bf16x8 pm = __builtin_bit_cast(bf16x8, pw);
#pragma unroll
        for (int d = 0; d < 4; ++d) { const s16x4 lo = ATT_VTR(VST0 + 2 * VSTB, d * 4096), hh = ATT_VTR(VST0 + 2 * VSTB, d * 4096 + 512);
            const bf16x8 vf = {lo[0], lo[1], lo[2], lo[3], hh[0], hh[1], hh[2], hh[3]};
            o[d] = ATT_MFMA(pm, vf, o[d]); }
    }
    ATT_WAITBAR();
    int vm0 = 0, vm2 = 2;
#define SBAR() __builtin_amdgcn_sched_barrier(0)
#define ATT_VTRP(vp_, off) __builtin_bit_cast(s16x4, __builtin_amdgcn_ds_read_tr16_b64_v4i16((LAS v4i16_t*)((vp_) + (off))))
#define ATT_VLOAD(buf, vst_, d, kp) do { _Pragma("unroll") for (int ks_ = 0; ks_ < 2; ++ks_) { vlo[buf][ks_] = ATT_VTRP(vst_, (d) * 4096 + (2 * (kp) + ks_) * 1024); vhi[buf][ks_] = ATT_VTRP(vst_, (d) * 4096 + (2 * (kp) + ks_) * 1024 + 512); } } while (0)
#define ATT_GQ(MF) do { __builtin_amdgcn_s_setprio(1); MF; __builtin_amdgcn_s_setprio(0); SBAR(); } while (0)
#define ATT_GS(NV, b4, PW, w0, w1) do { ls = (((ls + NV[b4]) + NV[b4 + 1]) + NV[b4 + 2]) + NV[b4 + 3];     PW[w0] = cvtpk(NV[b4], NV[b4 + 1]); PW[w1] = cvtpk(NV[b4 + 2], NV[b4 + 3]); } while (0)
#define ATT_GB(MF, NV, i0, GS) do { __builtin_amdgcn_s_setprio(1); MF; __builtin_amdgcn_s_setprio(0); NV[i0] = __builtin_amdgcn_exp2f(NV[i0]); NV[i0 + 1] = __builtin_amdgcn_exp2f(NV[i0 + 1]); GS; SBAR(); } while (0)
#define ATT_VF(buf, ks_) (bf16x8){vlo[buf][ks_][0], vlo[buf][ks_][1], vlo[buf][ks_][2], vlo[buf][ks_][3], vhi[buf][ks_][0], vhi[buf][ks_][1], vhi[buf][ks_][2], vhi[buf][ks_][3]}
#define ATT_STEP(C0, C1, C2, C3, D0, D1, D2, D3, tt) do { \
        const int t_ = (tt); const int knext = ((t_ + 1) & 3) * KST, kdst = ((t_ + 3) & 3) * KST, vdst = VST0 + vm2 * VSTB; \
        LAS unsigned char* vcur = lds + VST0 + vm0 * VSTB + voff; asm volatile("" : "+v"(vcur));     \
        const bool dk = t_ + 3 < T, dv = t_ + 2 < T; const size_t tok_ = dk ? (size_t)(t_ + 3) * 64 * NINP : 0, tov_ = dv ? (size_t)(t_ + 2) * 64 * NINP : 0; \
        const int dK0 = dk ? kdst + kd0 : DUMMY_OFF + wave * 1024, dK1 = dk ? kdst + kd1 : DUMMY_OFF + wave * 1024, dV0 = dv ? vdst + vd0 : DUMMY_OFF + wave * 1024, dV1 = dv ? vdst + vd1 : DUMMY_OFF + wave * 1024; \
        ATT_DMA(kbase0 + tok_, dK0); ATT_DMA(kbase1 + tok_, dK1); ATT_DMA(vbase0 + tov_, dV0); ATT_DMA(vbase1 + tov_, dV1); \
        if (t_ <= cw) { \
            bf16x8 kf[4]; s16x4 vlo[2][2], vhi[2][2]; f32x16 N0, N1; float ls = 0.f; \
            SBAR(); \
            kf[0] = ATT_KF(knext, 0, 0); kf[1] = ATT_KF(knext, 1, 0); kf[2] = ATT_KF(knext, 0, 1); kf[3] = ATT_KF(knext, 1, 1); SBAR(); \
            ATT_GQ(N0 = ATT_MFMA(kf[0], qf[0], zero16)); \
            ATT_GQ(N1 = ATT_MFMA(kf[1], qf[0], zero16)); \
            kf[0] = ATT_KF(knext, 0, 2); kf[1] = ATT_KF(knext, 1, 2); SBAR(); \
            ATT_GQ(N0 = ATT_MFMA(kf[2], qf[1], N0)); \
            ATT_GQ(N1 = ATT_MFMA(kf[3], qf[1], N1)); \
            kf[2] = ATT_KF(knext, 0, 3); kf[3] = ATT_KF(knext, 1, 3); SBAR(); \
            ATT_GQ(N0 = ATT_MFMA(kf[0], qf[2], N0)); \
            ATT_GQ(N1 = ATT_MFMA(kf[1], qf[2], N1)); \
            ATT_VLOAD(0, vcur, 0, 0); SBAR(); \
            ATT_GQ(N0 = ATT_MFMA(kf[2], qf[3], N0)); \
            ATT_GQ(N1 = ATT_MFMA(kf[3], qf[3], N1)); \
            const bf16x8 pf0 = __builtin_bit_cast(bf16x8, C0), pf1 = __builtin_bit_cast(bf16x8, C1), pf2 = __builtin_bit_cast(bf16x8, C2), pf3 = __builtin_bit_cast(bf16x8, C3); \
            ATT_VLOAD(1, vcur, 0, 1); SBAR(); \
            ATT_GB(o[0] = ATT_MFMA(pf0, ATT_VF(0, 0), o[0]), N0, 0, (void)0); ATT_GB(o[0] = ATT_MFMA(pf1, ATT_VF(0, 1), o[0]), N0, 2, (void)0); \
            ATT_VLOAD(0, vcur, 1, 0); SBAR(); \
            ATT_GB(o[0] = ATT_MFMA(pf2, ATT_VF(1, 0), o[0]), N0, 4, ATT_GS(N0, 0, D0, 0, 1)); ATT_GB(o[0] = ATT_MFMA(pf3, ATT_VF(1, 1), o[0]), N0, 6, (void)0); \
            ATT_VLOAD(1, vcur, 1, 1); SBAR(); \
            ATT_GB(o[1] = ATT_MFMA(pf0, ATT_VF(0, 0), o[1]), N0, 8, ATT_GS(N0, 4, D0, 2, 3)); ATT_GB(o[1] = ATT_MFMA(pf1, ATT_VF(0, 1), o[1]), N0, 10, (void)0); \
            ATT_VLOAD(0, vcur, 2, 0); SBAR(); \
            ATT_GB(o[1] = ATT_MFMA(pf2, ATT_VF(1, 0), o[1]), N0, 12, ATT_GS(N0, 8, D1, 0, 1)); ATT_GB(o[1] = ATT_MFMA(pf3, ATT_VF(1, 1), o[1]), N0, 14, (void)0); \
            ATT_VLOAD(1, vcur, 2, 1); SBAR(); \
            ATT_GB(o[2] = ATT_MFMA(pf0, ATT_VF(0, 0), o[2]), N1, 0, ATT_GS(N0, 12, D1, 2, 3)); ATT_GB(o[2] = ATT_MFMA(pf1, ATT_VF(0, 1), o[2]), N1, 2, (void)0); \
            ATT_VLOAD(0, vcur, 3, 0); SBAR(); \
            ATT_GB(o[2] = ATT_MFMA(pf2, ATT_VF(1, 0), o[2]), N1, 4, ATT_GS(N1, 0, D2, 0, 1)); ATT_GB(o[2] = ATT_MFMA(pf3, ATT_VF(1, 1), o[2]), N1, 6, (void)0); \
            ATT_VLOAD(1, vcur, 3, 1); SBAR(); \
            ATT_GB(o[3] = ATT_MFMA(pf0, ATT_VF(0, 0), o[3]), N1, 8, ATT_GS(N1, 4, D2, 2, 3)); ATT_GB(o[3] = ATT_MFMA(pf1, ATT_VF(0, 1), o[3]), N1, 10, (void)0); \
            ATT_GB(o[3] = ATT_MFMA(pf2, ATT_VF(1, 0), o[3]), N1, 12, ATT_GS(N1, 8, D3, 0, 1)); ATT_GB(o[3] = ATT_MFMA(pf3, ATT_VF(1, 1), o[3]), N1, 14, (void)0); \
            ATT_GS(N1, 12, D3, 2, 3); \
            lsum += (t_ < cw) ? ls : 0.f;     \
        } \
          \
        asm volatile("s_waitcnt vmcnt(4) lgkmcnt(0)\n\ts_barrier" ::: "memory"); \
        vm0 = (vm0 == 2) ? 0 : vm0 + 1; vm2 = (vm2 == 2) ? 0 : vm2 + 1; \
    } while (0)
    v4u pa0, pa1, pa2, pa3, pb0, pb1, pb2, pb3;
    pb0 = pb1 = pb2 = pb3 = (v4u){0u, 0u, 0u, 0u};
    {
#pragma unroll
        for (int i = 0; i < 16; ++i) { s0[i] = __builtin_amdgcn_exp2f(s0[i]); s1[i] = __builtin_amdgcn_exp2f(s1[i]); }
        float ls = 0.f;
        ATT_GS(s0, 0, pa0, 0, 1); ATT_GS(s0, 4, pa0, 2, 3); ATT_GS(s0, 8, pa1, 0, 1); ATT_GS(s0, 12, pa1, 2, 3);
        ATT_GS(s1, 0, pa2, 0, 1); ATT_GS(s1, 4, pa2, 2, 3); ATT_GS(s1, 8, pa3, 0, 1); ATT_GS(s1, 12, pa3, 2, 3);
        lsum += ls;
    }
    for (int t = 0; t < T; t += 2) { ATT_STEP(pa0, pa1, pa2, pa3, pb0, pb1, pb2, pb3, t); ATT_STEP(pb0, pb1, pb2, pb3, pa0, pa1, pa2, pa3, t + 1); }
    ATT_WAITBAR();
#undef ATT_STEP
#undef ATT_VLOAD
#undef ATT_GQ
#undef ATT_GS
#undef ATT_GB
#undef ATT_VF
#undef SBAR
    int le = lane; asm volatile("" : "+v"(le));
    const int r32e = le & 31, hie = le >> 5;
    lsum += __shfl_xor(lsum, 32);
    LAS float* wsf = (LAS float*)(lds + WSF_OFF + wave * 128);
    float fac;
    if (sub == 0) fac = 1.0f / lsum;
    else { const float s1 = wave_sum(F.in[10][le] * F.in[11][le]), s2 = wave_sum(F.in[12][le] * F.in[13][le]); fac = (__expf(s1) - __expf(s2) + 0.2f) / lsum; }
    if (hie == 0) wsf[r32e] = fac;
    LDS_WAIT(); asm volatile("" ::: "memory");
    LAS float* xo = (LAS float*)(lds + (wave & 3) * 16384) + le;
    if (sub == 1) {
#pragma unroll
        for (int i = 0; i < 16; ++i) { const float f = wsf[crow(i, hie)];
#pragma unroll
            for (int d = 0; d < 4; ++d) xo[(d * 16 + i) * 64] = o[d][i] * f; }
    }
    ATT_WAITBAR();
    if (sub == 0) {
        LAS bf16* stg = (LAS bf16*)(lds + STG_OFF + wave * 8192);
        float wn[4];
#pragma unroll
        for (int d = 0; d < 4; ++d) wn[d] = F.in[14][32 * d + r32e] * 0.8f;
#pragma unroll
        for (int i = 0; i < 16; ++i) { const int q = crow(i, hie); const float f1 = wsf[q];
            float v[4], ss = 0.f;
#pragma unroll
            for (int d = 0; d < 4; ++d) { v[d] = o[d][i] * f1 - xo[(d * 16 + i) * 64]; ss += v[d] * v[d]; }
            ss += __shfl_xor(ss, 1); ss += __shfl_xor(ss, 2); ss += __shfl_xor(ss, 4); ss += __shfl_xor(ss, 8); ss += __shfl_xor(ss, 16);
            const float r = __builtin_amdgcn_rsqf(ss * (1.0f / 128.0f) + EPS);
#pragma unroll
            for (int d = 0; d < 4; ++d) stg[q * 128 + 32 * d + r32e] = (bf16)f2bf(v[d] * r * wn[d]); }
        LDS_WAIT(); asm volatile("" ::: "memory");
#pragma unroll
        for (int it = 0; it < 8; ++it) { const int q = 4 * it + (le >> 4), ch = le & 15;
            const v4u val = *(const LAS v4u*)(stg + q * 128 + 8 * ch);
            *(v4u*)(WSP(bf16, WS_MIX) + (size_t)(row0 + q) * DM + 1024 + h * 128 + 8 * ch) = val; }
    }
    ATT_WAITBAR();
#undef ATT_DMA_K
#undef ATT_DMA_V
#undef ATT_KF
#undef ATT_VTR
}
}


namespace ssd {
constexpr int S64 = 144, S128 = 272;
constexpr int O_CC = 0, O_BC = 17408, O_BT = 34816, O_XT = 53248, O_XS = 62464, O_XC = 71680, O_M = 80896, O_SI = 90112, O_SC = 107520;
#define SSD_MF(a, b, c) __builtin_amdgcn_mfma_f32_16x16x32_bf16((a), (b), (c), 0, 0, 0)
#define SSD_FRAG(img, stride, row, k) (*(const LAS bf16x8*)(lds + (img) + (row) * (stride) + 2 * (k)))
#define SSD_BAR() do { asm volatile("s_waitcnt vmcnt(0) lgkmcnt(0)" ::: "memory"); __builtin_amdgcn_s_barrier(); asm volatile("" ::: "memory"); } while (0)

__device__ __forceinline__ v4u pack8(const float (&v)[8]) { v4u o; o.x = pk2(v[0], v[1]); o.y = pk2(v[2], v[3]); o.z = pk2(v[4], v[5]); o.w = pk2(v[6], v[7]); return o; }
__device__ __forceinline__ unsigned bfe16(const v4u& r, int e) { const unsigned w = (e < 2) ? r.x : (e < 4) ? r.y : (e < 6) ? r.z : r.w; return (e & 1) ? (w >> 16) : (w & 0xffffu); }

template <bool PASSB>
__device__ __forceinline__ void ssd_item(Frame& F, int item, int& bgj) {
    LAS unsigned char* lds = F.lds;
    int lane0 = F.lane; asm volatile("" : "+v"(lane0));
    const int wave = F.wave;
    const int k = item & 7, hd = (item >> 3) & 15, b = item >> 7, g = hd >> 3;
    const float Ah = -__expf(F.in[18][hd]), Dk = F.in[19][hd];
    LAS float* sc = (LAS float*)(lds + O_SC);
    const int pt = wave >> 1, nb = 4 * (wave & 1);
    f32x4 stt[4];
#pragma unroll
    for (int j = 0; j < 4; ++j) stt[j] = (f32x4){0.f, 0.f, 0.f, 0.f};
    float* sst = WSP(float, WS_SST) + (size_t)((b * SH + hd) * 8) * 8192;
    float* atot = WSP(float, WS_ATOT) + (b * SH + hd) * 8;
    if (PASSB) {
        const int fr = lane0 & 15, fq = lane0 >> 4;
        for (int kk = 0; kk < k; ++kk) { const float dec = __expf(atot[kk]);
#pragma unroll
            for (int j = 0; j < 4; ++j) { const f32x4 s = *(const f32x4*)(sst + (size_t)kk * 8192 + (16 * pt + fr) * 128 + 16 * (nb + j) + 4 * fq); stt[j] = stt[j] * dec + s; } }
    }
    float asum = 0.f;
    const int c_lo = (k == 0) ? 0 : 8 * k + 1, c_hi = 8 * k + 8;
    const int role = (wave < 2) ? 0 : (wave < 4) ? 1 : (wave < 6 && PASSB) ? 2 : 3;
    v4u raw[8]; float dtv = 0.f;
    { const int li = (wave * 64 + lane0) & 127, cg = (role == 0) ? (li & 7) : (li & 15), l0 = (role == 0) ? 4 * (li >> 3) : 8 * (li >> 4);
      if (role == 0) { const bf16* src = WSP(bf16, WS_XS) + (size_t)(b * LPAD + 64 * c_lo + l0) * 1024 + hd * 64 + 8 * cg;
#pragma unroll
          for (int i = 0; i < 4; ++i) raw[i] = *(const v4u*)(src + (size_t)i * 1024); }
      else if (role < 3) { const bf16* src = WSP(bf16, WS_BC) + (size_t)(b * LPAD + 64 * c_lo + l0) * 512 + (role == 2 ? 256 : 0) + g * 128 + 8 * cg;
#pragma unroll
          for (int i = 0; i < 8; ++i) raw[i] = *(const v4u*)(src + (size_t)i * 512); }
      if (wave == 7) dtv = WSP(float, WS_DT)[(size_t)(b * LPAD + 64 * c_lo + lane0) * 16 + hd]; }
    for (int c = c_lo; c <= c_hi; ++c) {
        int lane = lane0; asm volatile("" : "+v"(lane));
        const int tid = wave * 64 + lane, fr = lane & 15, fq = lane >> 4, li = tid & 127;
        const int cg = (role == 0) ? (li & 7) : (li & 15), l0 = (role == 0) ? 4 * (li >> 3) : 8 * (li >> 4);
        u32x2v zv[2];
        if (PASSB && c >= 1) {
#pragma unroll
            for (int j = 0; j < 2; ++j) zv[j] = *(const u32x2v*)(WSP(bf16, WS_ACT) + (size_t)(b * SEQ + 64 * (c - 1) + 16 * pt + fr) * NINP + 3072 + hd * 64 + 16 * (2 * (wave & 1) + j) + 4 * fq);
        }
        const int cn = (c < c_hi) ? c + 1 : c;
        f32x4 cv[16]; TItem ct; bool chave = false;
        if (role == 0) {
            if (PASSB) {
#pragma unroll
                for (int i = 0; i < 4; ++i) *(LAS v4u*)(lds + O_XC + (l0 + i) * S64 + 16 * cg) = raw[i]; }
#pragma unroll
            for (int e = 0; e < 8; ++e) { u32x2v w2; w2.x = bfe16(raw[0], e) | (bfe16(raw[1], e) << 16); w2.y = bfe16(raw[2], e) | (bfe16(raw[3], e) << 16); *(LAS u32x2v*)(lds + O_XT + (8 * cg + e) * S64 + 2 * l0) = w2; }
            const bf16* src = WSP(bf16, WS_XS) + (size_t)(b * LPAD + 64 * cn + l0) * 1024 + hd * 64 + 8 * cg;
#pragma unroll
            for (int i = 0; i < 4; ++i) raw[i] = *(const v4u*)(src + (size_t)i * 1024);
        } else if (role == 1) {
            if (PASSB) {
#pragma unroll
                for (int i = 0; i < 8; ++i) *(LAS v4u*)(lds + O_BC + (l0 + i) * S128 + 16 * cg) = raw[i]; }
#pragma unroll
            for (int e = 0; e < 8; ++e) { v4u w4; w4.x = bfe16(raw[0], e) | (bfe16(raw[1], e) << 16); w4.y = bfe16(raw[2], e) | (bfe16(raw[3], e) << 16); w4.z = bfe16(raw[4], e) | (bfe16(raw[5], e) << 16); w4.w = bfe16(raw[6], e) | (bfe16(raw[7], e) << 16);
                *(LAS v4u*)(lds + O_BT + (8 * cg + e) * S64 + 2 * l0) = w4; }
            const bf16* src = WSP(bf16, WS_BC) + (size_t)(b * LPAD + 64 * cn + l0) * 512 + g * 128 + 8 * cg;
#pragma unroll
            for (int i = 0; i < 8; ++i) raw[i] = *(const v4u*)(src + (size_t)i * 512);
        } else if (role == 2) {
#pragma unroll
            for (int i = 0; i < 8; ++i) *(LAS v4u*)(lds + O_CC + (l0 + i) * S128 + 16 * cg) = raw[i];
            const bf16* src = WSP(bf16, WS_BC) + (size_t)(b * LPAD + 64 * cn + l0) * 512 + 256 + g * 128 + 8 * cg;
#pragma unroll
            for (int i = 0; i < 8; ++i) raw[i] = *(const v4u*)(src + (size_t)i * 512);
        }
        if (wave == 7) {
            const float dt = dtv;
            dtv = WSP(float, WS_DT)[(size_t)(b * LPAD + 64 * cn + lane) * 16 + hd];
            float a = dt * Ah;
#pragma unroll
            for (int o2 = 1; o2 < 64; o2 <<= 1) { const float t = __shfl_up(a, o2); if (lane >= o2) a += t; }
            const float aend = __shfl(a, 63);
            sc[lane] = dt; sc[64 + lane] = a; sc[128 + lane] = dt * __expf(aend - a);
            if (lane == 0) sc[192] = aend;
        }
        if (PASSB && F.NGW == 2048) { const int slot = (F.gw + bgj * BG_P) & 2047, cit = IT_BG + bgj * BG_P + slot; chave = bgj < 8 && slot < BG_P && cit < IT_END; ++bgj;
            if (chave) { ct = mk_item(F, cit); transpose_load(ct, lane, cv); } }
        asm volatile("s_waitcnt lgkmcnt(0)" ::: "memory"); __builtin_amdgcn_s_barrier(); asm volatile("" ::: "memory");
        const float aend = sc[192];
        for (int amp2_ = 0; amp2_ < (MK_AMP == 2 ? 3 : 1); ++amp2_) {
        { const int p = tid >> 3, lg = (tid & 7) * 8;
          const v4u xv = *(const LAS v4u*)(lds + O_XT + p * S64 + 2 * lg); const unsigned xw[4] = {xv.x, xv.y, xv.z, xv.w}; float v[8];
#pragma unroll
          for (int e = 0; e < 4; ++e) { v[2 * e] = bf2f(xw[e] & 0xffffu) * sc[128 + lg + 2 * e]; v[2 * e + 1] = bf2f(xw[e] >> 16) * sc[128 + lg + 2 * e + 1]; }
          *(LAS v4u*)(lds + O_XS + p * S64 + 2 * lg) = pack8(v); }
        if (PASSB) {
#pragma unroll
            for (int j = 0; j < 4; ++j) { u32x2v w2; w2.x = pk2(stt[j][0], stt[j][1]); w2.y = pk2(stt[j][2], stt[j][3]); *(LAS u32x2v*)(lds + O_SI + (16 * pt + fr) * S128 + 2 * (16 * (nb + j) + 4 * fq)) = w2; }
            const int l = 16 * pt + fr; const float al = sc[64 + l];
#pragma unroll
            for (int j = 0; j < 2; ++j) { const int st = 2 * (wave & 1) + j; f32x4 acc = (f32x4){0.f, 0.f, 0.f, 0.f};
                if (st <= pt) {
#pragma unroll
                    for (int ks = 0; ks < 4; ++ks) acc = SSD_MF(SSD_FRAG(O_BC, S128, 16 * st + fr, 32 * ks + 8 * fq), SSD_FRAG(O_CC, S128, l, 32 * ks + 8 * fq), acc);
                    asm volatile("s_nop 15\n\ts_nop 3" : "+v"(acc)); }
                float m[4];
#pragma unroll
                for (int i = 0; i < 4; ++i) { const int s = 16 * st + 4 * fq + i; m[i] = (s <= l) ? acc[i] * __expf(al - sc[64 + s]) * sc[s] : 0.f; }
                u32x2v w2; w2.x = pk2(m[0], m[1]); w2.y = pk2(m[2], m[3]); *(LAS u32x2v*)(lds + O_M + l * S64 + 2 * (16 * st + 4 * fq)) = w2; }
        }
        }
        asm volatile("s_waitcnt lgkmcnt(0)" ::: "memory"); __builtin_amdgcn_s_barrier(); asm volatile("" ::: "memory");
        for (int amp3_ = 0; amp3_ < (MK_AMP == 3 ? 3 : 1); ++amp3_) {
        if (PASSB && c >= 1) {
            const int l = 16 * pt + fr, row = b * SEQ + 64 * (c - 1) + l; const float el = __expf(sc[64 + l]);
            float sq = 0.f;
#pragma unroll
            for (int j = 0; j < 2; ++j) { const int ptile = 2 * (wave & 1) + j; f32x4 acc = (f32x4){0.f, 0.f, 0.f, 0.f};
#pragma unroll
                for (int ks = 0; ks < 4; ++ks) acc = SSD_MF(SSD_FRAG(O_SI, S128, 16 * ptile + fr, 32 * ks + 8 * fq), SSD_FRAG(O_CC, S128, l, 32 * ks + 8 * fq), acc);
                acc = acc * el;
#pragma unroll
                for (int ks = 0; ks < 2; ++ks) acc = SSD_MF(SSD_FRAG(O_XT, S64, 16 * ptile + fr, 32 * ks + 8 * fq), SSD_FRAG(O_M, S64, l, 32 * ks + 8 * fq), acc);
                const int pc = 16 * ptile + 4 * fq;
                const u32x2v xv = *(const LAS u32x2v*)(lds + O_XC + l * S64 + 2 * pc);
                float y[4];
                y[0] = (acc[0] + Dk * bf2f(xv.x & 0xffffu)) * silu1(bf2f(zv[j].x & 0xffffu)); y[1] = (acc[1] + Dk * bf2f(xv.x >> 16)) * silu1(bf2f(zv[j].x >> 16));
                y[2] = (acc[2] + Dk * bf2f(xv.y & 0xffffu)) * silu1(bf2f(zv[j].y & 0xffffu)); y[3] = (acc[3] + Dk * bf2f(xv.y >> 16)) * silu1(bf2f(zv[j].y >> 16));
                sq += (y[0] * y[0] + y[1] * y[1]) + (y[2] * y[2] + y[3] * y[3]);
                u32x2v w2; w2.x = pk2(y[0], y[1]); w2.y = pk2(y[2], y[3]);
                *(u32x2v*)(WSP(bf16, WS_MIX) + (size_t)row * DM + hd * 64 + pc) = w2; }
            sq += __shfl_xor(sq, 16); sq += __shfl_xor(sq, 32);
            if (fq == 0) WSP(float, WS_SSQS)[(size_t)row * 32 + 2 * hd + (wave & 1)] = sq;
        }
        }
        { const float dec = __expf(aend);
#pragma unroll
          for (int j = 0; j < 4; ++j) { f32x4 acc = stt[j] * dec;
#pragma unroll
              for (int ks = 0; ks < 2; ++ks) acc = SSD_MF(SSD_FRAG(O_BT, S64, 16 * (nb + j) + fr, 32 * ks + 8 * fq), SSD_FRAG(O_XS, S64, 16 * pt + fr, 32 * ks + 8 * fq), acc);
              stt[j] = acc; } }
        asum += aend;
        if (PASSB) { if (chave) transpose_finish(ct, lane, cv); }
        asm volatile("s_waitcnt lgkmcnt(0)" ::: "memory"); __builtin_amdgcn_s_barrier(); asm volatile("" ::: "memory");
    }
    if (!PASSB) { const int fr = lane0 & 15, fq = lane0 >> 4;
#pragma unroll
        for (int j = 0; j < 4; ++j) *(f32x4*)(sst + (size_t)k * 8192 + (16 * pt + fr) * 128 + 16 * (nb + j) + 4 * fq) = stt[j];
        if (wave == 0 && lane0 == 0) atot[k] = asum;
    }
}
}

struct ConvItem { int c, pp, b, p; v4u rv[4]; bool fast; };
__device__ __forceinline__ void conv_issue(Frame& F, int it, ConvItem& q) {
    const bf16* U = WSP(bf16, WS_ACT); const float* um = WSP(float, WS_META + MO_U);
    const int cg = it % (CONVD / 8); q.pp = (it / (CONVD / 8)) % LPAD; q.b = it / ((CONVD / 8) * LPAD); q.c = 8 * cg; q.p = q.pp - PPAD;
#pragma unroll
    for (int w = 0; w < 4; ++w) q.rv[w] = (v4u){0u, 0u, 0u, 0u};
    if (q.p >= 0) {
        if (q.p - 3 >= NMETA) { const bf16* src = U + (size_t)(q.b * SEQ + q.p - 3 - NMETA) * NINP + 4096 + q.c;
#pragma unroll
            for (int w = 0; w < 4; ++w) q.rv[w] = *(const v4u*)(src + (size_t)w * NINP); }
        else {
#pragma unroll
            for (int w = 0; w < 4; ++w) { const int ps = q.p - 3 + w; v4u v = (v4u){0u, 0u, 0u, 0u};
                if (ps >= NMETA) v = *(const v4u*)(U + (size_t)(q.b * SEQ + ps - NMETA) * NINP + 4096 + q.c);
                else if (ps >= 0) { const f32x4 r0 = *(const f32x4*)(um + (size_t)ps * NIN + 4096 + q.c), r1 = *(const f32x4*)(um + (size_t)ps * NIN + 4096 + q.c + 4);
                    v.x = pk2(r0[0], r0[1]); v.y = pk2(r0[2], r0[3]); v.z = pk2(r1[0], r1[1]); v.w = pk2(r1[2], r1[3]); }
                q.rv[w] = v; } }
    }
}
__device__ __forceinline__ void conv_finish(Frame& F, const ConvItem& q) {
    const float* cw = F.in[15]; const float* cb = F.in[16]; const int c = q.c;
    float a[8];
#pragma unroll
    for (int e = 0; e < 8; ++e) a[e] = 0.f;
    if (q.p >= 0) {
        const f32x4 b0 = *(const f32x4*)(cb + c), b1 = *(const f32x4*)(cb + c + 4);
        a[0] = b0[0]; a[1] = b0[1]; a[2] = b0[2]; a[3] = b0[3]; a[4] = b1[0]; a[5] = b1[1]; a[6] = b1[2]; a[7] = b1[3];
#pragma unroll
        for (int w = 0; w < 4; ++w) { const f32x4 w0 = *(const f32x4*)(cw + w * CONVD + c), w1 = *(const f32x4*)(cw + w * CONVD + c + 4);
            a[0] += bf2f(q.rv[w].x & 0xffffu) * w0[0]; a[1] += bf2f(q.rv[w].x >> 16) * w0[1]; a[2] += bf2f(q.rv[w].y & 0xffffu) * w0[2]; a[3] += bf2f(q.rv[w].y >> 16) * w0[3];
            a[4] += bf2f(q.rv[w].z & 0xffffu) * w1[0]; a[5] += bf2f(q.rv[w].z >> 16) * w1[1]; a[6] += bf2f(q.rv[w].w & 0xffffu) * w1[2]; a[7] += bf2f(q.rv[w].w >> 16) * w1[3]; }
#pragma unroll
        for (int e = 0; e < 8; ++e) a[e] = silu1(a[e]);
    }
    v4u o; o.x = pk2(a[0], a[1]); o.y = pk2(a[2], a[3]); o.z = pk2(a[4], a[5]); o.w = pk2(a[6], a[7]);
    if (c < 1024) *(v4u*)(WSP(bf16, WS_XS) + (size_t)(q.b * LPAD + q.pp) * 1024 + c) = o;
    else *(v4u*)(WSP(bf16, WS_BC) + (size_t)(q.b * LPAD + q.pp) * 512 + (c - 1024)) = o;
}
__device__ __forceinline__ void p4_conv(Frame& F) {
    const float* um = WSP(float, WS_META + MO_U);
    const int gt = F.gw * 64 + F.lane, NT = F.NGW * 64, NITEM = NBATCH * LPAD * (CONVD / 8);
    for (int it = gt; it < NITEM; it += 3 * NT) {
        ConvItem q0, q1, q2; const int i1 = it + NT, i2 = it + 2 * NT;
        conv_issue(F, it, q0); if (i1 < NITEM) conv_issue(F, i1, q1); if (i2 < NITEM) conv_issue(F, i2, q2);
        conv_finish(F, q0); if (i1 < NITEM) conv_finish(F, q1); if (i2 < NITEM) conv_finish(F, q2);
    }
    for (int it = gt; it < NBATCH * LPAD * SH; it += NT) { const int hd = it & 15, pp = (it >> 4) % LPAD, b = (it >> 4) / LPAD, p = pp - PPAD;
        float v = 0.f;
        if (p >= 0) { const float x = (p < NMETA ? um[(size_t)p * NIN + NINP + hd] : WSP(float, WS_DTR)[(size_t)(b * SEQ + p - NMETA) * 16 + hd]) + F.in[17][hd];
            v = fmaxf(x, 0.f) + log1pf(__expf(-fabsf(x))); }
        WSP(float, WS_DT)[it] = v; }
}
__device__ __forceinline__ void p4_mixer_attn(Frame& F) {
    p4_conv(F);
    for (int r_ = 0; r_ < (MK_REPEAT_PHASE == 41 ? 2 : 1); ++r_)
    for (int u = blockIdx.x; u < NBATCH * NHEAD * 16; u += F.G) { const int bh = (u & 7) * 2 + ((u >> 3) >> 4), idx = (u >> 3) & 15;
        att::attn_unit(F, bh, idx); att::attn_unit(F, bh, 31 - idx); }
}
__device__ __forceinline__ void p5_ssd_a(Frame& F) { int bgj = 0; for (int it = blockIdx.x; it < NBATCH * SH * 8; it += F.G) ssd::ssd_item<false>(F, it, bgj); }
__device__ __forceinline__ void p6_ssd_b(Frame& F) { int bgj = 0; for (int it = blockIdx.x; it < NBATCH * SH * 8; it += F.G) ssd::ssd_item<true>(F, it, bgj);
    if (F.NGW != 2048) convert_items(F, IT_BG, IT_END, F.gw, F.NGW); }
struct Args { const float* in[26]; float* out; unsigned char* ws; int ph_lo, ph_hi; };
__global__ void __launch_bounds__(NWAVES * 64, 2) hymba_fwd(Args args) {
    extern __shared__ __attribute__((aligned(16))) unsigned char lds[];
    Frame F;
    F.lds = (LAS unsigned char*)lds;
    F.tid = threadIdx.x; F.lane = F.tid & 63; F.wave = __builtin_amdgcn_readfirstlane(F.tid >> 6);
    F.G = gridDim.x; F.gw = blockIdx.x * NWAVES + F.wave; F.NGW = F.G * NWAVES;
#pragma unroll
    for (int i = 0; i < 26; ++i) F.in[i] = args.in[i];
    F.out = args.out; F.ws = args.ws; F.inp = args.in;
    volatile LAS unsigned* MISC = (volatile LAS unsigned*)(F.lds + MISC_OFF);
    for (int u = F.tid; u < 128; u += NWAVES * 64) MISC[u] = 0u;
    __syncthreads();
    XcdBarrier bar; bar.bar = (unsigned*)(F.ws + WS_CTL) + CW_BAR; bar.x = 0; bar.st = nullptr;
    if (N_LAUNCHES == 1) bar = xcd_barrier_post((unsigned*)(F.ws + WS_CTL) + CW_BAR, MISC + 8);
    const int lo = args.ph_lo, hi = args.ph_hi;
#define IN(k) (lo <= (k) && (k) < hi)
#ifndef MK_REPEAT_PHASE
#define MK_REPEAT_PHASE -1
#endif
#define REPS(k) for (int rep_ = 0; rep_ < ((k) == MK_REPEAT_PHASE ? 2 : 1); ++rep_)
#define REPBAR(k) do { if ((k) == MK_REPEAT_PHASE && rep_ == 0) xcd_barrier(bar); } while (0)
#define SEAM(k) do { if (IN(k) && IN((k) + 1)) xcd_barrier(bar); } while (0)
    using pg8::Gemm; using pg8::StaticOrder;
    LAS unsigned char* ring = F.lds + RING_OFF;

    if (IN(0)) { REPS(0) { p0_prologue(F); REPBAR(0); } SEAM(0); }
    if (IN(1)) {
        Gemm g{WSP(bf16, WS_XN), WSP(bf16, WS_W1GU), MR, NGU, DM}; StaticOrder S; S.init(MR, NGU, F.G, (int)blockIdx.x);
        pg8::Unit u0{0, 0}; (void)S.next(0, u0);
        pg8::EpiSwiGLU E{WSP(bf16, WS_ACT), DFF, WSP(float, WS_SSQ0), 1, build_rs_table(F, WSP(float, WS_SSQ0), 1, 1.0f / 2048.0f, u0.pm)};
        REPS(1) { pg8::gemm_phase<pg8::EpiSwiGLU, StaticOrder, true, true>(ring, g, S, E); REPBAR(1); }
        { const int first = S.nwg % F.G, nsl = F.G - first;
          const int w0 = (int)blockIdx.x >= first ? ((int)blockIdx.x - first) * NWAVES + F.wave : -1;
          meta_gateup(F, w0, nsl * NWAVES);
          constexpr int NMW = DFF / 16;
          convert_items(F, IT_CUT0, IT_BG, w0 >= NMW ? w0 - NMW : -1, nsl * NWAVES - NMW); }
        SEAM(1);
    }
    if (IN(2)) {
        meta_down(F);
        Gemm g{WSP(bf16, WS_ACT), WSP(bf16, WS_W1D), MR, DM, DFF}; StaticOrder S; S.init(MR, DM, F.G, (int)blockIdx.x);
        pg8::EpiResT<false> E{F.in[0], nullptr, nullptr, WSP(bf16, WS_XN), WSP(float, WS_SSQ1), 0.5f, DM, nullptr, 0, pg8::RsTable{nullptr, -1, -1}};
        REPS(2) { pg8::gemm_phase<pg8::EpiResT<false>, StaticOrder, true, true>(ring, g, S, E); REPBAR(2); }
        SEAM(2);
    }
    if (IN(3)) {
        Gemm g{WSP(bf16, WS_XN), WSP(bf16, WS_WIN), MR, NINP, DM}; StaticOrder S; S.init(MR, NINP, F.G, (int)blockIdx.x);
        pg8::Unit u0{0, 0}; (void)S.next(0, u0);
        pg8::EpiInProj E{WSP(bf16, WS_ACT), NINP, WSP(float, WS_SSQ1), F.in[8], F.in[9], WSP(float, WS_ROPE), build_rs_table(F, WSP(float, WS_SSQ1), 32, 1.0f / 2048.0f, u0.pm)};
        REPS(3) { pg8::gemm_phase<pg8::EpiInProj, StaticOrder, true, true>(ring, g, S, E); REPBAR(3); }
        { const int first = S.nwg % F.G, nsl = F.G - first;
          meta_inproj_and_dt(F, (int)blockIdx.x >= first ? ((int)blockIdx.x - first) * NWAVES + F.wave : -1, NMETA_IT + NDT_IT, nsl * NWAVES); }
        SEAM(3);
    }
    if (IN(4)) { REPS(4) { p4_mixer_attn(F); REPBAR(4); } SEAM(4); }
    if (IN(5)) { REPS(5) { p5_ssd_a(F); REPBAR(5); } SEAM(5); }
    if (IN(6)) { REPS(6) { p6_ssd_b(F); REPBAR(6); } SEAM(6); }
    if (IN(7)) {
        Gemm g{WSP(bf16, WS_MIX), WSP(bf16, WS_WOUT), MR, DM, DM}; StaticOrder S; S.init(MR, DM, F.G, (int)blockIdx.x);
        pg8::Unit u0{0, 0}; (void)S.next(0, u0);
        pg8::EpiResT<true> E{nullptr, WSP(bf16, WS_XN), nullptr, WSP(bf16, WS_XN), WSP(float, WS_SSQ2), 1.0f, DM, WSP(float, WS_SSQS), 16, build_rs_table(F, WSP(float, WS_SSQS), 32, 1.0f / 1024.0f, u0.pm)};
        pg8::gemm_phase<pg8::EpiResT<true>, StaticOrder, true, true>(ring, g, S, E);
        SEAM(7);
    }
    if (IN(8)) {
        Gemm g{WSP(bf16, WS_XN), WSP(bf16, WS_W2GU), MR, NGU, DM}; StaticOrder S; S.init(MR, NGU, F.G, (int)blockIdx.x);
        pg8::Unit u0{0, 0}; (void)S.next(0, u0);
        pg8::EpiSwiGLU E{WSP(bf16, WS_ACT), DFF, WSP(float, WS_SSQ2), 32, build_rs_table(F, WSP(float, WS_SSQ2), 32, 1.0f / 2048.0f, u0.pm)};
        REPS(8) { pg8::gemm_phase<pg8::EpiSwiGLU, StaticOrder, true, true>(ring, g, S, E); REPBAR(8); }
        SEAM(8);
    }
    if (IN(9)) {
        Gemm g{WSP(bf16, WS_ACT), WSP(bf16, WS_W2D), MR, DM, DFF}; StaticOrder S; S.init(MR, DM, F.G, (int)blockIdx.x);
        pg8::EpiResT<false> E{nullptr, WSP(bf16, WS_XN), F.out, nullptr, nullptr, 0.5f, DM, nullptr, 0, pg8::RsTable{nullptr, -1, -1}};
        pg8::gemm_phase<pg8::EpiResT<false>, StaticOrder, true, true>(ring, g, S, E);
    }
#undef IN
#undef SEAM
}

extern "C" void kernel_launch(void* const* d_in, const int* in_sizes, int n_in, void* d_out, int out_size, void* d_ws, size_t ws_size, hipStream_t stream) {
    static int grid = 0;
    if (grid == 0) {
        if (n_in != 26 || in_sizes[0] != MR * DM || out_size != MR * DM || ws_size < WS_END) { fprintf(stderr, "kernel_launch: unexpected shapes (n_in %d, in0 %d, out %d, ws %zu)\n", n_in, n_in > 0 ? in_sizes[0] : -1, out_size, ws_size); grid = -1; return; }
        int dev = 0, cus = 0, per_cu = 0;
        if (hipGetDevice(&dev) != hipSuccess || hipDeviceGetAttribute(&cus, hipDeviceAttributeMultiprocessorCount, dev) != hipSuccess) { grid = -1; return; }
        if (hipFuncSetAttribute((const void*)hymba_fwd, hipFuncAttributeMaxDynamicSharedMemorySize, LDS_BYTES) != hipSuccess) { fprintf(stderr, "kernel_launch: hipFuncSetAttribute failed\n"); grid = -1; return; }
        if (hipOccupancyMaxActiveBlocksPerMultiprocessor(&per_cu, (const void*)hymba_fwd, NWAVES * 64, LDS_BYTES) != hipSuccess || per_cu < 1) { fprintf(stderr, "kernel_launch: occupancy query says %d blocks per CU\n", per_cu); (void)hipGetLastError(); grid = -1; return; }
        grid = cus;
    }
    if (grid < 0) return;
    (void)hipMemsetAsync((char*)d_ws + WS_CTL, 0, CTL_ZERO_BYTES, stream);
    Args a{};
    for (int i = 0; i < 26; ++i) a.in[i] = (const float*)d_in[i];
    a.out = (float*)d_out; a.ws = (unsigned char*)d_ws;
    for (int li = 0; li < N_LAUNCHES; ++li) {
        a.ph_lo = (N_LAUNCHES == 1) ? 0 : li; a.ph_hi = (N_LAUNCHES == 1) ? NPH : li + 1;
        hipLaunchKernelGGL(hymba_fwd, dim3(grid), dim3(NWAVES * 64), LDS_BYTES, stream, a);
    }
}
```

```cpp
#include <hip/hip_runtime.h>
#include <cstdio>
#include <cstdint>
#include <cmath>
#ifndef MK_AMP
#define MK_AMP 0
#endif
namespace pg8 {
#define PG8_LAS __attribute__((address_space(3)))
typedef unsigned short bf16_t;
typedef short bf16x8 __attribute__((ext_vector_type(8)));
typedef float f32x4 __attribute__((ext_vector_type(4)));
typedef unsigned u32x4 __attribute__((ext_vector_type(4)));
constexpr int BM = 256, BK = 64, HALF = 128, HTB = HALF * BK * 2  , STAGE_BYTES = 8 * HTB, NXCD = 8, WGM = 8;

__host__ __device__ __forceinline__ int lds_byte(int r, int c) { const int st = (r >> 4) * 2 + (c >> 5), rr = r & 15, cc = c & 31, ob = rr * 64 + cc * 2; return st * 1024 + (ob ^ (((ob >> 9) & 1) << 5)); }
__host__ __device__ __forceinline__ void stage_rc(int b, int& R, int& C) { const int st = b / 1024, sb = b % 1024, swz = sb ^ (((sb >> 9) & 1) << 5); R = (st >> 1) * 16 + swz / 64; C = (st & 1) * 32 + (swz % 64) / 2; }
__host__ __device__ __forceinline__ int perm32(int rho) { const int n = rho >> 4, i = rho & 15; return 8 * (i >> 2) + 4 * n + (i & 3); }

struct Unit { int pm, pn; };
struct Gemm { const bf16_t* A; const bf16_t* Bt; int M, N, K; };

struct StaticOrder {
    int nM, nN, nwg, G, c;
    __host__ __device__ void init(int M, int N, int G_, int c_) { nM = M / BM; nN = N / BM; nwg = nM * nN; G = G_; c = c_; }
    __host__ __device__ __forceinline__ bool next(int i, Unit& u) const {
        const long L = (long)i * G + c; if (L >= nwg) return false;
        int wgid = (int)L; { const int q = nwg / NXCD, r = nwg % NXCD, xcd = wgid % NXCD, off = wgid / NXCD; wgid = (xcd < r ? xcd * (q + 1) : r * (q + 1) + (xcd - r) * q) + off; }
        const int nig = WGM * nN, gid = wgid / nig, fm = gid * WGM, gsz = (nM - fm) < WGM ? (nM - fm) : WGM;
        u.pm = fm + ((wgid % nig) % gsz); u.pn = (wgid % nig) / gsz; return true;
    }
    __device__ __forceinline__ void a_ready(const Unit&) const {}
    __device__ __forceinline__ void done(const Unit&) const {}
};


__device__ __forceinline__ unsigned cvt_pk_bf16(float lo, float hi) { unsigned r; asm volatile("v_cvt_pk_bf16_f32 %0, %1, %2" : "=v"(r) : "v"(lo), "v"(hi)); return r; }
typedef unsigned u32x2 __attribute__((ext_vector_type(2)));
constexpr float RMS_EPS = 1e-6f;
__device__ __forceinline__ float row_rs(const float* ssq, int np, int row, float inv_n = 1.0f / 2048.0f) {
    float s;
    if (np == 1) s = ssq[row];
    else { const f32x4* p = (const f32x4*)(ssq + (size_t)row * 32); f32x4 a = p[0];
#pragma unroll
        for (int i = 1; i < 8; ++i) a += p[i];
        s = (a[0] + a[1]) + (a[2] + a[3]); }
    return __builtin_amdgcn_rsqf(s * inv_n + RMS_EPS);
}
struct RsTable { const PG8_LAS float* t; int tpm, tpm2; };
__device__ __forceinline__ float row_rs_t(const RsTable& T, const float* ssq, int np, float inv_n, int pm, int rin) { return (pm == T.tpm) ? T.t[rin] : (pm == T.tpm2) ? T.t[256 + rin] : row_rs(ssq, np, pm * BM + rin, inv_n); }
__device__ __forceinline__ float silu_f(float g) { return g * __builtin_amdgcn_rcpf(1.0f + __builtin_amdgcn_exp2f(-1.4426950408889634f * g)); }

struct EpiSwiGLU {
    static constexpr bool PERM = true, AFTER_DRAIN = false, HAS_MID = false, AMP = (MK_AMP == 11);
    bf16_t* O; int ldc; const float* ssq; int np; RsTable T;
    __device__ __forceinline__ void mid(f32x4 (&)[2][2][4][2], const Unit&, int, int, int, int) const {}
    __device__ __forceinline__ void operator()(const f32x4 (&acc)[2][2][4][2], const Unit& u, int wr, int wc, int fr, int fq) const {
        const int row0 = u.pm * BM + wr * 64 + fr, col0 = u.pn * HALF + wc * 32 + 8 * fq;
#pragma unroll
        for (int ai = 0; ai < 2; ++ai)
#pragma unroll
            for (int m = 0; m < 4; ++m) { const int row = row0 + ai * HALF + m * 16; const float rs = row_rs_t(T, ssq, np, 1.0f / 2048.0f, u.pm, wr * 64 + fr + ai * HALF + m * 16);
                float a[8];
#pragma unroll
                for (int n = 0; n < 2; ++n)
#pragma unroll
                    for (int i = 0; i < 4; ++i) { const float g = acc[ai][0][m][n][i] * rs, up = acc[ai][1][m][n][i] * rs; a[4 * n + i] = silu_f(g) * up; }
                u32x4 w; w.x = cvt_pk_bf16(a[0], a[1]); w.y = cvt_pk_bf16(a[2], a[3]); w.z = cvt_pk_bf16(a[4], a[5]); w.w = cvt_pk_bf16(a[6], a[7]);
                *(u32x4*)(O + (size_t)row * ldc + col0) = w; }
    }
};
template <bool MID> struct EpiResT {
    static constexpr bool PERM = false, AFTER_DRAIN = false, HAS_MID = MID, AMP = false;
    const float* basef; const bf16_t* baseh; float* out; bf16_t* xn; float* ssq; float scale; int ldc; const float* rsm; int kmid; RsTable T;
    __device__ __forceinline__ void mid(f32x4 (&acc)[2][2][4][2], const Unit& u, int wr, int wc, int fr, int fq) const {
        int fro = fr; asm volatile("" : "+v"(fro));
        const int rin0 = wr * 64 + fro;
#pragma unroll
        for (int ai = 0; ai < 2; ++ai)
#pragma unroll
            for (int m = 0; m < 4; ++m) { const float r = row_rs_t(T, rsm, 32, 1.0f / 1024.0f, u.pm, rin0 + ai * HALF + m * 16);
#pragma unroll
                for (int bj = 0; bj < 2; ++bj)
#pragma unroll
                    for (int n = 0; n < 2; ++n) acc[ai][bj][m][n] *= r; }
    }
    __device__ __forceinline__ void operator()(const f32x4 (&acc)[2][2][4][2], const Unit& u, int wr, int wc, int fr, int fq) const {
        const int row0 = u.pm * BM + wr * 64 + fr, col0 = u.pn * BM + wc * 32 + 4 * fq;
#pragma unroll
        for (int ai = 0; ai < 2; ++ai) {
            f32x4 bf[4][2][2]; u32x2 bh[4][2][2];
#pragma unroll
            for (int m = 0; m < 4; ++m)
#pragma unroll
                for (int bj = 0; bj < 2; ++bj)
#pragma unroll
                    for (int n = 0; n < 2; ++n) { const size_t o1 = (size_t)(row0 + ai * HALF + m * 16) * ldc + col0 + bj * HALF + n * 16;
                        if (basef) bf[m][bj][n] = *(const f32x4*)(basef + o1); else bh[m][bj][n] = *(const u32x2*)(baseh + o1); }
#pragma unroll
            for (int m = 0; m < 4; ++m) { const int row = row0 + ai * HALF + m * 16; const size_t off = (size_t)row * ldc + col0; float sq = 0.f;
#pragma unroll
                for (int bj = 0; bj < 2; ++bj)
#pragma unroll
                    for (int n = 0; n < 2; ++n) { const size_t o1 = off + bj * HALF + n * 16; f32x4 b;
                        if (basef) b = bf[m][bj][n];
                        else { const u32x2 h = bh[m][bj][n]; b[0] = __uint_as_float(h.x << 16); b[1] = __uint_as_float(h.x & 0xffff0000u); b[2] = __uint_as_float(h.y << 16); b[3] = __uint_as_float(h.y & 0xffff0000u); }
                        const f32x4 o = b + acc[ai][bj][m][n] * scale;
                        if (out) *(f32x4*)(out + o1) = o;
                        if (xn) { sq += (o[0] * o[0] + o[1] * o[1]) + (o[2] * o[2] + o[3] * o[3]); u32x2 w; w.x = cvt_pk_bf16(o[0], o[1]); w.y = cvt_pk_bf16(o[2], o[3]); *(u32x2*)(xn + o1) = w; } }
                if (xn) { sq += __shfl_xor(sq, 16); sq += __shfl_xor(sq, 32); if (fq == 0) ssq[(size_t)row * 32 + u.pn * 4 + wc] = sq; } }
        }
    }
};
struct EpiInProj {
    static constexpr bool PERM = true, AFTER_DRAIN = false, HAS_MID = false, AMP = (MK_AMP == 12);
    bf16_t* U; int ldc; const float* ssq; const float* qn; const float* kn; const float* rope; RsTable T;
    __device__ __forceinline__ void mid(f32x4 (&)[2][2][4][2], const Unit&, int, int, int, int) const {}
    __device__ __forceinline__ void operator()(const f32x4 (&acc)[2][2][4][2], const Unit& u, int wr, int wc, int fr, int fq) const {
        const int row0 = u.pm * BM + wr * 64 + fr, col0 = u.pn * BM + wc * 64 + 8 * fq;
        const bool isqk = u.pn < 8;
        f32x4 wv[2][2];
        if (isqk) { const float* wn = (u.pn < 4) ? qn : kn;
#pragma unroll
            for (int bj = 0; bj < 2; ++bj)
#pragma unroll
                for (int n = 0; n < 2; ++n) wv[bj][n] = *(const f32x4*)(wn + 32 * bj + 8 * fq + 4 * n); }
#pragma unroll
        for (int ai = 0; ai < 2; ++ai)
#pragma unroll
            for (int m = 0; m < 4; ++m) { const int row = row0 + ai * HALF + m * 16; const float rs = row_rs_t(T, ssq, 32, 1.0f / 2048.0f, u.pm, wr * 64 + fr + ai * HALF + m * 16);
                f32x4 v[2][2];
#pragma unroll
                for (int bj = 0; bj < 2; ++bj)
#pragma unroll
                    for (int n = 0; n < 2; ++n) v[bj][n] = acc[ai][bj][m][n] * rs;
                if (isqk) {
                    float sq = 0.f;
#pragma unroll
                    for (int bj = 0; bj < 2; ++bj)
#pragma unroll
                        for (int n = 0; n < 2; ++n) sq += (v[bj][n][0] * v[bj][n][0] + v[bj][n][1] * v[bj][n][1]) + (v[bj][n][2] * v[bj][n][2] + v[bj][n][3] * v[bj][n][3]);
                    sq += __shfl_xor(sq, 16); sq += __shfl_xor(sq, 32);
                    const float r = __builtin_amdgcn_rsqf(sq * (1.0f / 64.0f) + RMS_EPS);
#pragma unroll
                    for (int bj = 0; bj < 2; ++bj)
#pragma unroll
                        for (int n = 0; n < 2; ++n) v[bj][n] = v[bj][n] * r * wv[bj][n];
                    const int pos = (row & 4095) + 16;
                    const f32x4 c0 = *(const f32x4*)(rope + pos * 16), c1 = *(const f32x4*)(rope + pos * 16 + 4), s0 = *(const f32x4*)(rope + pos * 16 + 8), s1 = *(const f32x4*)(rope + pos * 16 + 12);
                    f32x4 p0, p1;
#pragma unroll
                    for (int i = 0; i < 4; ++i) { p0[i] = __shfl_xor(v[0][0][i], 16); p1[i] = __shfl_xor(v[0][1][i], 16); }
                    if (fq == 0) { v[0][0] = v[0][0] * c0 - p0 * s0; v[0][1] = v[0][1] * c1 - p1 * s1; }
                    else if (fq == 1) { v[0][0] = v[0][0] * c0 + p0 * s0; v[0][1] = v[0][1] * c1 + p1 * s1; }
                    if (u.pn < 4) { v[0][0] *= 0.18033688011112042f; v[0][1] *= 0.18033688011112042f; v[1][0] *= 0.18033688011112042f; v[1][1] *= 0.18033688011112042f; }
                }
#pragma unroll
                for (int bj = 0; bj < 2; ++bj) { u32x4 w; w.x = cvt_pk_bf16(v[bj][0][0], v[bj][0][1]); w.y = cvt_pk_bf16(v[bj][0][2], v[bj][0][3]); w.z = cvt_pk_bf16(v[bj][1][0], v[bj][1][1]); w.w = cvt_pk_bf16(v[bj][1][2], v[bj][1][3]);
                    *(u32x4*)(U + (size_t)row * ldc + col0 + 32 * bj) = w; } }
    }
};

template <class Epi, class Sched, bool ALIGN_EPI = false, bool SP2 = false>
__device__ __forceinline__ void gemm_phase(PG8_LAS unsigned char* lds, const Gemm g, const Sched& S, const Epi& E) {
    const int tid = threadIdx.x, wid = __builtin_amdgcn_readfirstlane(tid >> 6), lane = tid & 63, wr = wid >> 2, wc = wid & 3, fr = lane & 15, fq = lane >> 4;
    const int K = g.K, nt = K / BK;
    unsigned voffA[2], voffB[2];
#pragma unroll
    for (int i = 0; i < 2; ++i) { int R, C; stage_rc(tid * 16 + i * 8192, R, C); const int Rb = Epi::PERM ? ((R & ~31) + perm32(R & 31)) : R;
        voffA[i] = (unsigned)(R * K + C) * 2u; voffB[i] = (unsigned)(Rb * K + C) * 2u; }
    const size_t kstep = (size_t)(BK * 2);
    const size_t hstep = (size_t)HALF * K * 2;
    const size_t tstep = 2 * hstep;
    const unsigned ldsw = (unsigned)wid * 1024u;
    const int aoff = lds_byte(wr * 64 + fr, fq * 8), boff = lds_byte(wc * 32 + fr, fq * 8);
#define PG8_SA(b, h) (((b) * 2 + (h)) * HTB)
#define PG8_SB(b, h) ((4 + (b) * 2 + (h)) * HTB)
#define PG8_STAGE(bufoff, gbase, voff) do { _Pragma("unroll") for (int _i = 0; _i < 2; ++_i) \
        __builtin_amdgcn_global_load_lds((const unsigned*)((const char*)(gbase) + (voff)[_i]), (PG8_LAS unsigned*)(lds + (bufoff) + ldsw + _i * 8192), 16, 0, 0); } while (0)
#define PG8_LDA(dst, b, h) do { _Pragma("unroll") for (int m = 0; m < 4; ++m) _Pragma("unroll") for (int k = 0; k < 2; ++k) dst[m][k] = *(const PG8_LAS bf16x8*)(lds + PG8_SA(b, h) + aoff + m * 2048 + k * 1024); } while (0)
#define PG8_LDB(dst, b, h) do { _Pragma("unroll") for (int n = 0; n < 2; ++n) _Pragma("unroll") for (int k = 0; k < 2; ++k) dst[n][k] = *(const PG8_LAS bf16x8*)(lds + PG8_SB(b, h) + boff + n * 2048 + k * 1024); } while (0)
#define PG8_MMA(ai, bj, At, Bt) do { __builtin_amdgcn_s_setprio(1); _Pragma("unroll") for (int m = 0; m < 4; ++m) _Pragma("unroll") for (int n = 0; n < 2; ++n) _Pragma("unroll") for (int k = 0; k < 2; ++k) \
        acc[ai][bj][m][n] = __builtin_amdgcn_mfma_f32_16x16x32_bf16(Bt[n][k], At[m][k], acc[ai][bj][m][n], 0, 0, 0); __builtin_amdgcn_s_setprio(0); } while (0)
#define PG8_WAIT_V(n) asm volatile("s_waitcnt vmcnt(" #n ")" ::: "memory")
#define PG8_WAIT_L(n) asm volatile("s_waitcnt lgkmcnt(" #n ")" ::: "memory")
#define PG8_BAR __builtin_amdgcn_s_barrier()
#define PG8_SCHED __builtin_amdgcn_sched_barrier(0)
    Unit cur, nxt; int ui = 0;
    if (!S.next(0, cur)) return;
    f32x4 acc[2][2][4][2];
#pragma unroll
    for (int a = 0; a < 2; ++a)
#pragma unroll
        for (int b = 0; b < 2; ++b)
#pragma unroll
            for (int m = 0; m < 4; ++m)
#pragma unroll
                for (int n = 0; n < 2; ++n) acc[a][b][m][n] = (f32x4){0.f, 0.f, 0.f, 0.f};
    bf16x8 At[4][2], B0[2][2], B1[2][2];
    const char* cA = (const char*)g.A + (size_t)cur.pm * tstep; const char* cB = (const char*)g.Bt + (size_t)cur.pn * tstep;
    S.a_ready(cur);
    if constexpr (SP2) {
        PG8_STAGE(PG8_SB(0, 0), cB, voffB); PG8_STAGE(PG8_SB(0, 1), cB + hstep, voffB); PG8_STAGE(PG8_SA(0, 0), cA, voffA); PG8_STAGE(PG8_SA(0, 1), cA + hstep, voffA);
        if (wr == 1) PG8_BAR;
        PG8_WAIT_V(2); PG8_BAR;
        PG8_STAGE(PG8_SB(1, 0), cB + kstep, voffB); PG8_STAGE(PG8_SA(1, 0), cA + kstep, voffA); PG8_STAGE(PG8_SB(1, 1), cB + hstep + kstep, voffB);
        PG8_WAIT_V(6); PG8_BAR;
    } else {
        PG8_STAGE(PG8_SB(0, 0), cB, voffB); PG8_STAGE(PG8_SA(0, 0), cA, voffA); PG8_STAGE(PG8_SB(0, 1), cB + hstep, voffB); PG8_STAGE(PG8_SA(0, 1), cA + hstep, voffA);
        if (wr == 1) PG8_BAR;
        PG8_WAIT_V(4); PG8_BAR;
        PG8_STAGE(PG8_SB(1, 0), cB + kstep, voffB); PG8_STAGE(PG8_SA(1, 0), cA + kstep, voffA); PG8_STAGE(PG8_SB(1, 1), cB + hstep + kstep, voffB);
        PG8_WAIT_V(6); PG8_BAR;
    }
    for (;;) {
        const bool has_next = S.next(ui + 1, nxt);
        const char* nA = has_next ? (const char*)g.A + (size_t)nxt.pm * tstep : cA; const char* nB = has_next ? (const char*)g.Bt + (size_t)nxt.pn * tstep : cB;
        for (int t = 0; t < nt; t += 2) {
            const bool last = (t == nt - 2);
            if constexpr (Epi::HAS_MID) { if (t == E.kmid) E.mid(acc, cur, wr, wc, fr, fq); }
            const char* a1 = cA + (size_t)(t + 1) * kstep;
            const char* a2 = last ? nA : cA + (size_t)(t + 2) * kstep; const char* b2 = last ? nB : cB + (size_t)(t + 2) * kstep;
            const char* a3 = a2 + kstep; const char* b3 = b2 + kstep;
            if (last && has_next) S.a_ready(nxt);
            if constexpr (SP2) {
            PG8_LDB(B0, 0, 0); PG8_LDB(B1, 0, 1); PG8_SCHED; PG8_LDA(At, 0, 0); PG8_STAGE(PG8_SA(1, 1), a1 + hstep, voffA);
            PG8_WAIT_V(8); PG8_WAIT_L(0); PG8_BAR; PG8_MMA(0, 0, At, B0); PG8_MMA(0, 1, At, B1); PG8_BAR; PG8_SCHED;
            PG8_LDA(At, 0, 1); PG8_STAGE(PG8_SB(0, 0), b2, voffB); PG8_STAGE(PG8_SB(0, 1), b2 + hstep, voffB); PG8_STAGE(PG8_SA(0, 0), a2, voffA);
            PG8_WAIT_V(8); PG8_WAIT_L(0); PG8_BAR; PG8_MMA(1, 0, At, B0); PG8_MMA(1, 1, At, B1); PG8_BAR; PG8_SCHED;
            PG8_LDB(B0, 1, 0); PG8_LDB(B1, 1, 1); PG8_SCHED; PG8_LDA(At, 1, 0); PG8_STAGE(PG8_SA(0, 1), a2 + hstep, voffA);
            PG8_WAIT_V(8); PG8_WAIT_L(0); PG8_BAR; PG8_MMA(0, 0, At, B0); PG8_MMA(0, 1, At, B1); PG8_BAR; PG8_SCHED;
            PG8_LDA(At, 1, 1); PG8_STAGE(PG8_SB(1, 0), b3, voffB); PG8_STAGE(PG8_SB(1, 1), b3 + hstep, voffB); PG8_STAGE(PG8_SA(1, 0), a3, voffA);
            PG8_WAIT_V(8); PG8_WAIT_L(0); PG8_BAR; PG8_MMA(1, 0, At, B0); PG8_MMA(1, 1, At, B1); PG8_BAR; PG8_SCHED;
            } else {
            PG8_LDB(B0, 0, 0); PG8_SCHED; PG8_LDA(At, 0, 0); PG8_STAGE(PG8_SA(1, 1), a1 + hstep, voffA);
            PG8_WAIT_L(8); PG8_BAR; PG8_WAIT_L(0); PG8_MMA(0, 0, At, B0); PG8_BAR; PG8_SCHED;
            PG8_LDB(B1, 0, 1); PG8_STAGE(PG8_SB(0, 0), b2, voffB);
            PG8_BAR; PG8_WAIT_L(0); PG8_MMA(0, 1, At, B1); PG8_BAR;
            PG8_LDA(At, 0, 1); PG8_STAGE(PG8_SA(0, 0), a2, voffA);
            PG8_BAR; PG8_WAIT_L(0); PG8_MMA(1, 0, At, B0); PG8_BAR; PG8_SCHED;
            PG8_STAGE(PG8_SB(0, 1), b2 + hstep, voffB);
            PG8_WAIT_V(6); PG8_BAR; PG8_MMA(1, 1, At, B1); PG8_BAR;
            PG8_LDB(B0, 1, 0); PG8_SCHED; PG8_LDA(At, 1, 0); PG8_STAGE(PG8_SA(0, 1), a2 + hstep, voffA);
            PG8_WAIT_L(8); PG8_BAR; PG8_WAIT_L(0); PG8_MMA(0, 0, At, B0); PG8_BAR; PG8_SCHED;
            PG8_LDB(B1, 1, 1); PG8_STAGE(PG8_SB(1, 0), b3, voffB);
            PG8_BAR; PG8_WAIT_L(0); PG8_MMA(0, 1, At, B1); PG8_BAR;
            PG8_LDA(At, 1, 1); PG8_STAGE(PG8_SA(1, 0), a3, voffA);
            PG8_BAR; PG8_WAIT_L(0); PG8_MMA(1, 0, At, B0); PG8_BAR; PG8_SCHED;
            PG8_STAGE(PG8_SB(1, 1), b3 + hstep, voffB);
            PG8_WAIT_V(6); PG8_BAR; PG8_MMA(1, 1, At, B1); PG8_BAR;
            }
        }
        if constexpr (ALIGN_EPI) { if (wr == 0) PG8_BAR; }
        if constexpr (!Epi::AFTER_DRAIN) { for (int amp_ = 0; amp_ < (Epi::AMP ? 3 : 1); ++amp_) { E(acc, cur, wr, wc, fr, fq); asm volatile("" ::: "memory"); } S.done(cur); }
        if (!has_next) break;
#pragma unroll
        for (int a = 0; a < 2; ++a)
#pragma unroll
            for (int b = 0; b < 2; ++b)
#pragma unroll
                for (int m = 0; m < 4; ++m)
#pragma unroll
                    for (int n = 0; n < 2; ++n) acc[a][b][m][n] = (f32x4){0.f, 0.f, 0.f, 0.f};
        cur = nxt; cA = nA; cB = nB; ++ui;
        if constexpr (ALIGN_EPI) { if (wr == 1) PG8_BAR; }
    }
    PG8_WAIT_V(0);
    if constexpr (!ALIGN_EPI) { if (wr == 0) PG8_BAR; }
    PG8_BAR;
    if constexpr (Epi::AFTER_DRAIN) { E.fused(acc, cur, wr, wc, fr, fq, lds, wid, lane); S.done(cur); }
#undef PG8_SA
#undef PG8_SB
#undef PG8_STAGE
#undef PG8_LDA
#undef PG8_LDB
#undef PG8_MMA
#undef PG8_WAIT_V
#undef PG8_WAIT_L
#undef PG8_BAR
#undef PG8_SCHED
}
}

#ifndef PG8_SP2
#define PG8_SP2 true
#endif

constexpr int NWAVES = 8;
constexpr int DM = 2048, SEQ = 4096, NBATCH = 2, MR = NBATCH * SEQ, NMETA = 16, LPOS = SEQ + NMETA;
constexpr int DFF = 5632, NGU = 2 * DFF;
constexpr int NHEAD = 8, SH = 16, CONVD = 1536, NIN = 5648, NINP = 5632;
constexpr int PPAD = 48, LPAD = LPOS + PPAD;
constexpr float EPS = 1e-6f;
#ifndef MK_REPEAT_PHASE
#define MK_REPEAT_PHASE -1
#endif
#ifndef MK_N_LAUNCHES
#define MK_N_LAUNCHES 1
#endif
constexpr int NPH = 10;
constexpr int N_LAUNCHES = MK_N_LAUNCHES;

constexpr size_t MiB = 1u << 20;
constexpr size_t WS_CTL = 0, CTL_ZERO_BYTES = 1 * MiB;
constexpr size_t WS_W1GU = 2 * MiB, WS_W1D = 46 * MiB, WS_WIN = 68 * MiB, WS_WOUT = 91 * MiB, WS_W2GU = 99 * MiB, WS_W2D = 143 * MiB;
constexpr size_t WS_XN = 165 * MiB;
constexpr size_t WS_ACT = 197 * MiB;
constexpr size_t WS_MIX = 285 * MiB;
constexpr size_t WS_SSQ0 = 317 * MiB;
constexpr size_t WS_SSQ1 = 318 * MiB, WS_SSQ2 = 319 * MiB;
constexpr size_t WS_DTR = 320 * MiB;
constexpr size_t WS_ROPE = 321 * MiB;
constexpr size_t WS_META = 322 * MiB;
constexpr size_t MO_XN = 0, MO_SSQ0 = 65536, MO_ACT = 131072, MO_H1 = 327680, MO_XN1 = 458752, MO_U = 524288, MO_KM = 917504, MO_VM = 950272, MO_SSQ1 = 69632;
constexpr size_t WS_SST = 324 * MiB;
constexpr size_t WS_ATOT = 333 * MiB;
constexpr size_t WS_SSQS = 334 * MiB;
constexpr size_t WS_XS = 336 * MiB;
constexpr size_t WS_BC = 353 * MiB;
constexpr size_t WS_DT = 362 * MiB;
constexpr size_t WS_END = 363 * MiB;
constexpr int CW_BAR = 4096;

constexpr int RING_OFF = 0, RING_BYTES = 131072;
constexpr int LDS_BYTES = 147456, MISC_OFF = LDS_BYTES - 512;

#define GAS __attribute__((address_space(1)))
#define LAS __attribute__((address_space(3)))
typedef unsigned short bf16;
typedef unsigned v4u __attribute__((ext_vector_type(4)));
typedef float f32x4 __attribute__((ext_vector_type(4)));
typedef short bf16x8 __attribute__((ext_vector_type(8)));
typedef GAS unsigned gu32;
typedef GAS unsigned long long gu64;
#define RLX_AGENT __ATOMIC_RELAXED, __HIP_MEMORY_SCOPE_AGENT
#define LDS_WAIT() asm volatile("s_waitcnt lgkmcnt(0)" ::: "memory")
#define VM_WAIT() asm volatile("s_waitcnt vmcnt(0)" ::: "memory")
__device__ __forceinline__ unsigned long long rt() { return __builtin_amdgcn_s_memrealtime(); }
__device__ __forceinline__ unsigned f2bf(float f) { unsigned u = __builtin_bit_cast(unsigned, f); return (u + 0x7fffu + ((u >> 16) & 1u)) >> 16; }
__device__ __forceinline__ unsigned pk2(float lo, float hi) { return f2bf(lo) | (f2bf(hi) << 16); }

#define XB_TMO      128
#define XB_XCNT(j)  (256  + 64 * (j))
#define XB_XSUB(j)  (1280 + 64 * (j))
#define XB_XGEN(j)  (2304 + 64 * (j))
#define XB_TOP      3328
#define XB_TOPGEN   3392
#define XCD_BAR_WORDS 3456
#define XB_SPIN_CAP (1u << 18)

__device__ __forceinline__ unsigned xb_ld(unsigned* p)              { return __hip_atomic_load(p, __ATOMIC_RELAXED, __HIP_MEMORY_SCOPE_AGENT); }
__device__ __forceinline__ unsigned xb_add(unsigned* p, unsigned v) { return __hip_atomic_fetch_add(p, v, __ATOMIC_RELAXED, __HIP_MEMORY_SCOPE_AGENT); }
__device__ __forceinline__ unsigned xb_xcc_id() { return (unsigned)__builtin_amdgcn_s_getreg((3 << 11) | 20) & 0xFu; }
#define XB_SPIN(cond, bar) do { unsigned _sp = 0; while (cond) { __builtin_amdgcn_s_sleep(1); \
    if ((++_sp & 255u) == 0u) { if (xb_ld(&(bar)[XB_TMO])) break; if (_sp > XB_SPIN_CAP) { atomicAdd(&(bar)[XB_TMO], 1u); break; } } } } while (0)

struct XcdBarrier {
    unsigned* bar; unsigned x;
    volatile LAS unsigned* st;
};

__device__ __forceinline__ XcdBarrier xcd_barrier_post(unsigned* bar, volatile LAS unsigned* st) {
    XcdBarrier b; b.bar = bar; b.x = xb_xcc_id(); b.st = st;
    if (threadIdx.x == 0) (void)xb_add(&bar[XB_XCNT(b.x)], 1u);
    return b;
}
__device__ __forceinline__ void xcd_barrier_complete(unsigned* bar, unsigned x, unsigned& nloc, unsigned& nx) {
    const unsigned G = gridDim.x * gridDim.y * gridDim.z;
    unsigned sum, cnt, mine, sp = 0u;
    for (;;) {
        sum = 0u; cnt = 0u; mine = 0u;
#pragma unroll
        for (unsigned j = 0; j < 16; ++j) { const unsigned c = xb_ld(&bar[XB_XCNT(j)]); sum += c; cnt += (c > 0u) ? 1u : 0u; mine = (j == x) ? c : mine; }
        if (sum == G) break;
        __builtin_amdgcn_s_sleep(1);
        if ((++sp & 255u) == 0u) { if (xb_ld(&bar[XB_TMO])) break; if (sp > XB_SPIN_CAP) { atomicAdd(&bar[XB_TMO], 1u); break; } }
    }
    nloc = mine > 0u ? mine : 1u; nx = cnt > 0u ? cnt : 1u;
}

__device__ __forceinline__ void xcd_barrier(const XcdBarrier& b) {
    asm volatile("s_waitcnt vmcnt(0)" ::: "memory");
    __syncthreads();
    if (threadIdx.x == 0) {
        unsigned* bar = b.bar;
        __builtin_amdgcn_s_waitcnt(0);
        unsigned nloc = b.st[0], nx = b.st[1];
        if (nloc == 0u) { xcd_barrier_complete(bar, b.x, nloc, nx); b.st[0] = nloc; b.st[1] = nx; }
        const unsigned old = xb_add(&bar[XB_XSUB(b.x)], 1u);
        const unsigned gen = old / nloc;
        if (old + 1u == (gen + 1u) * nloc) {
            __builtin_amdgcn_fence(__ATOMIC_RELEASE, "agent");
            asm volatile("s_waitcnt vmcnt(0)" ::: "memory");
            const unsigned og = xb_add(&bar[XB_TOP], 1u);
            const unsigned tg = og / nx;
            if (og + 1u == (tg + 1u) * nx) xb_add(&bar[XB_TOPGEN], 1u);
            else XB_SPIN(xb_ld(&bar[XB_TOPGEN]) == tg, bar);
            __builtin_amdgcn_fence(__ATOMIC_ACQUIRE, "agent");
            xb_add(&bar[XB_XGEN(b.x)], 1u);
            asm volatile("s_waitcnt vmcnt(0)" ::: "memory");
        } else {
            XB_SPIN(xb_ld(&bar[XB_XGEN(b.x)]) == gen, bar);
            __builtin_amdgcn_fence(__ATOMIC_ACQUIRE, "agent");
            asm volatile("s_waitcnt vmcnt(0)" ::: "memory");
        }
    }
    __syncthreads();
}


typedef unsigned u32x2v __attribute__((ext_vector_type(2)));
__device__ __forceinline__ float bf2f(unsigned b) { return __uint_as_float(b << 16); }
__device__ __forceinline__ float wave_sum(float v) {
#pragma unroll
    for (int o = 1; o < 64; o <<= 1) v += __shfl_xor(v, o);
    return v;
}
__device__ __forceinline__ float wave_max(float v) {
#pragma unroll
    for (int o = 1; o < 64; o <<= 1) v = fmaxf(v, __shfl_xor(v, o));
    return v;
}
__device__ __forceinline__ float silu1(float g) { return g * __builtin_amdgcn_rcpf(1.0f + __builtin_amdgcn_exp2f(-1.4426950408889634f * g)); }

struct Frame {
    LAS unsigned char* lds;
    int tid, lane, wave, G, gw, NGW;
    const float* in[26]; float* out; unsigned char* ws; const float* const* inp;
};
#define WSP(T, off) ((T*)(F.ws + (off)))

constexpr int RST_OFF = RING_BYTES;
__device__ __forceinline__ pg8::RsTable build_rs_table(Frame& F, const float* ssq, int np, float inv_n, int pm, int pm2 = -1) {
    LAS float* t = (LAS float*)(F.lds + RST_OFF);
    if (F.tid < 256) t[F.tid] = pg8::row_rs(ssq, np, pm * 256 + F.tid, inv_n);
    else if (pm2 >= 0) t[F.tid] = pg8::row_rs(ssq, np, pm2 * 256 + F.tid - 256, inv_n);
    __syncthreads();
    return pg8::RsTable{t, pm, pm2};
}
__device__ __forceinline__ int rowmap(int kind, int n) {
    if (kind == 1) return 256 * (n >> 7) + (n & 127);
    if (kind == 2) return 256 * (n >> 7) + 128 + (n & 127);
    if (kind == 3) { if (n >= NINP) return n; const int pn = n >> 8, rem = n & 255, wc = rem >> 6, bj = (rem >> 5) & 1, j = rem & 31; return 256 * pn + 128 * bj + 32 * wc + j; }
    return n;
}
struct TItem { const float* W; int K, N; const float* kscale; bf16* WT; int kind, item, ks_off, krot; };
__device__ __forceinline__ void transpose_load(const TItem& t, int lane, f32x4 (&v)[16]) {
    const int nblk = (t.N + 63) >> 6, kb = t.item / nblk, nb = t.item - kb * nblk, k0 = 64 * kb, n0 = 64 * nb;
    const float* src = t.W + (size_t)(k0 + 8 * (lane >> 3)) * t.N;
#pragma unroll
    for (int h = 0; h < 2; ++h) { int nl = n0 + 32 * h + 4 * (lane & 7); nl = nl < t.N ? nl : t.N - 4;
#pragma unroll
        for (int i = 0; i < 8; ++i) v[8 * h + i] = __builtin_nontemporal_load((const f32x4*)(src + (size_t)i * t.N + nl)); }
}
__device__ __forceinline__ void transpose_finish(const TItem& t, int lane, f32x4 (&v)[16]) {
    const int nblk = (t.N + 63) >> 6, kb = t.item / nblk, nb = t.item - kb * nblk, k0 = 64 * kb, n0 = 64 * nb, r = lane >> 3;
    float sc[8];
    if (t.kscale && k0 >= t.ks_off) { const f32x4 s0 = *(const f32x4*)(t.kscale + k0 + 8 * r - t.ks_off), s1 = *(const f32x4*)(t.kscale + k0 + 8 * r - t.ks_off + 4);
        sc[0] = s0[0]; sc[1] = s0[1]; sc[2] = s0[2]; sc[3] = s0[3]; sc[4] = s1[0]; sc[5] = s1[1]; sc[6] = s1[2]; sc[7] = s1[3]; }
    else {
#pragma unroll
        for (int i = 0; i < 8; ++i) sc[i] = 1.0f; }
    int kd = k0 + t.krot; if (kd >= t.K) kd -= t.K;
#pragma unroll
    for (int h = 0; h < 2; ++h)
#pragma unroll
        for (int j = 0; j < 4; ++j) { const int n = n0 + 32 * h + 4 * (lane & 7) + j;
            v4u o; o.x = pg8::cvt_pk_bf16(v[8 * h + 0][j] * sc[0], v[8 * h + 1][j] * sc[1]); o.y = pg8::cvt_pk_bf16(v[8 * h + 2][j] * sc[2], v[8 * h + 3][j] * sc[3]);
            o.z = pg8::cvt_pk_bf16(v[8 * h + 4][j] * sc[4], v[8 * h + 5][j] * sc[5]); o.w = pg8::cvt_pk_bf16(v[8 * h + 6][j] * sc[6], v[8 * h + 7][j] * sc[7]);
            if (n < t.N) *(v4u*)(t.WT + (size_t)rowmap(t.kind, n) * t.K + kd + 8 * r) = o; }
}
__device__ __forceinline__ void row_to_bf16(const float* xrow, bf16* orow, float* ssq, int lane) {
    const f32x4* xr = (const f32x4*)xrow + lane; float s = 0.f; f32x4 v[8];
#pragma unroll
    for (int j = 0; j < 8; ++j) { v[j] = __builtin_nontemporal_load(xr + 64 * j); s += (v[j][0] * v[j][0] + v[j][1] * v[j][1]) + (v[j][2] * v[j][2] + v[j][3] * v[j][3]); }
    s = wave_sum(s);
    u32x2v* o8 = (u32x2v*)orow + lane;
#pragma unroll
    for (int j = 0; j < 8; ++j) { u32x2v w; w.x = pk2(v[j][0], v[j][1]); w.y = pk2(v[j][2], v[j][3]); o8[64 * j] = w; }
    if (lane == 0) *ssq = s;
}
__constant__ float ROPE_INV[8] = {1.0f, 0.1939227432012558f, 0.03760603070259094f, 0.007292664609849453f, 0.0014142135623842478f, 0.00027424818836152554f, 5.318296098266728e-05f, 1.0313386155758053e-05f};
constexpr int I_G = 32 * 88, I_D = 88 * 32, I_IN = 32 * 89, I_O = 32 * 32;
constexpr int IT_W1G = 0, IT_W1U = IT_W1G + I_G, IT_WOUT = IT_W1U + I_G, IT_W1D = IT_WOUT + I_O, IT_WIN = IT_W1D + I_D, IT_W2U = IT_WIN + I_IN, IT_W2G = IT_W2U + I_G, IT_W2D = IT_W2G + I_G, IT_END = IT_W2D + I_D;
#ifndef MK_N1
#define MK_N1 6688
#endif
constexpr int IT_BG = IT_W2U, BG_P = (IT_END - IT_BG + 7) / 8;
constexpr int IT_CUT0 = IT_BG - MK_N1;
static_assert(IT_CUT0 >= IT_WOUT, "W1 gate/up are needed by P1");
__device__ __forceinline__ TItem mk_item(Frame& F, int it) {
    const int m = (it >= IT_W1U) + (it >= IT_WOUT) + (it >= IT_W1D) + (it >= IT_WIN) + (it >= IT_W2U) + (it >= IT_W2G) + (it >= IT_W2D);
    const int start = m == 0 ? IT_W1G : m == 1 ? IT_W1U : m == 2 ? IT_WOUT : m == 3 ? IT_W1D : m == 4 ? IT_WIN : m == 5 ? IT_W2U : m == 6 ? IT_W2G : IT_W2D;
    const unsigned long long WI = 0x1917180705150403ull, SI = 0xff161606ff140202ull;
    const int wi = (int)((WI >> (8 * m)) & 0xffu), si = (int)((SI >> (8 * m)) & 0xffu);
    const bool down = (m == 3 || m == 7);
    const size_t wto = m < 2 ? WS_W1GU : m == 2 ? WS_WOUT : m == 3 ? WS_W1D : m == 4 ? WS_WIN : m < 7 ? WS_W2GU : WS_W2D;
    const int kind = (m == 0 || m == 6) ? 1 : (m == 1 || m == 5) ? 2 : m == 4 ? 3 : 0;
    TItem t; t.W = F.inp[wi]; t.K = down ? DFF : DM; t.N = down ? DM : m == 2 ? DM : m == 4 ? NIN : DFF; t.kscale = si == 0xff ? nullptr : F.inp[si]; t.WT = WSP(bf16, wto); t.kind = kind; t.item = it - start;
    t.ks_off = m == 2 ? 1024 : 0; t.krot = m == 2 ? 1024 : 0;
    return t;
}
__device__ __forceinline__ void convert_items(Frame& F, int lo, int hi, int w, int nw) {
    if (w < 0) return;
    f32x4 va[16], vb[16]; int it = lo + w;
    if (it < hi) { TItem ta = mk_item(F, it); transpose_load(ta, F.lane, va);
        for (;;) {
            const int itb = it + nw; TItem tb = mk_item(F, itb < hi ? itb : it);
            if (itb < hi) transpose_load(tb, F.lane, vb);
            transpose_finish(ta, F.lane, va);
            if (itb >= hi) break;
            const int itc = itb + nw; ta = mk_item(F, itc < hi ? itc : itb);
            if (itc < hi) transpose_load(ta, F.lane, va);
            transpose_finish(tb, F.lane, vb);
            if (itc >= hi) break;
            it = itc;
        } }
}
__device__ __forceinline__ void p0_prologue(Frame& F) {
    convert_items(F, 0, IT_CUT0, F.gw, F.NGW);
    for (int m = F.gw; m < MR; m += 2 * F.NGW) {
        const int m2 = m + F.NGW;
        const f32x4* xa = (const f32x4*)(F.in[0] + (size_t)m * DM) + F.lane; const f32x4* xb = (const f32x4*)(F.in[0] + (size_t)(m2 < MR ? m2 : m) * DM) + F.lane;
        f32x4 va[8], vb[8]; float sa = 0.f, sb = 0.f;
#pragma unroll
        for (int j = 0; j < 8; ++j) { va[j] = __builtin_nontemporal_load(xa + 64 * j); vb[j] = __builtin_nontemporal_load(xb + 64 * j); }
#pragma unroll
        for (int j = 0; j < 8; ++j) { sa += (va[j][0] * va[j][0] + va[j][1] * va[j][1]) + (va[j][2] * va[j][2] + va[j][3] * va[j][3]); sb += (vb[j][0] * vb[j][0] + vb[j][1] * vb[j][1]) + (vb[j][2] * vb[j][2] + vb[j][3] * vb[j][3]); }
        sa = wave_sum(sa); sb = wave_sum(sb);
        u32x2v* oa = (u32x2v*)(WSP(bf16, WS_XN) + (size_t)m * DM) + F.lane; u32x2v* ob = (u32x2v*)(WSP(bf16, WS_XN) + (size_t)m2 * DM) + F.lane;
#pragma unroll
        for (int j = 0; j < 8; ++j) { u32x2v w; w.x = pk2(va[j][0], va[j][1]); w.y = pk2(va[j][2], va[j][3]); oa[64 * j] = w; }
        if (F.lane == 0) WSP(float, WS_SSQ0)[m] = sa;
        if (m2 < MR) {
#pragma unroll
            for (int j = 0; j < 8; ++j) { u32x2v w; w.x = pk2(vb[j][0], vb[j][1]); w.y = pk2(vb[j][2], vb[j][3]); ob[64 * j] = w; }
            if (F.lane == 0) WSP(float, WS_SSQ0)[m2] = sb; }
    }
    for (int p = F.gw; p < NMETA; p += F.NGW) row_to_bf16(F.in[1] + (size_t)p * DM, WSP(bf16, WS_META + MO_XN) + (size_t)p * DM, WSP(float, WS_META + MO_SSQ0) + p, F.lane);
    for (int e = F.gw * 64 + F.lane; e < LPOS * 8; e += F.NGW * 64) { const int pos = e >> 3, i = e & 7;
        const float ang = (float)pos * ROPE_INV[i];
        double tr = (double)ang * 0.15915494309189535; tr -= __builtin_rint(tr);
        const float tf = (float)tr;
        WSP(float, WS_ROPE)[pos * 16 + i] = __builtin_amdgcn_cosf(tf); WSP(float, WS_ROPE)[pos * 16 + 8 + i] = __builtin_amdgcn_sinf(tf); }
}

__device__ __forceinline__ f32x4 skinny16(const bf16* A, int lda, const bf16* Bt, int ldb, int k0, int k1, int lane, f32x4 acc) {
    const bf16* ap = A + (size_t)(lane & 15) * lda + 8 * (lane >> 4);
    const bf16* bp = Bt + (size_t)(lane & 15) * ldb + 8 * (lane >> 4);
#pragma unroll 16
    for (int k = k0; k < k1; k += 32) { const bf16x8 a = *(const bf16x8*)(ap + k), b = *(const bf16x8*)(bp + k);
        acc = __builtin_amdgcn_mfma_f32_16x16x32_bf16(a, b, acc, 0, 0, 0); }
    asm volatile("s_nop 15\n\ts_nop 3" : "+v"(acc));
    return acc;
}
__device__ __forceinline__ void meta_gateup(Frame& F, int w0, int wstride) {
    const bf16* A = WSP(bf16, WS_META + MO_XN); const float* ssq = WSP(float, WS_META + MO_SSQ0); bf16* act = WSP(bf16, WS_META + MO_ACT);
    if (w0 < 0) return;
    for (int it = w0; it < DFF / 16; it += wstride) { const int c0 = 16 * it, rg = 256 * (c0 >> 7) + (c0 & 127);
        f32x4 g = (f32x4){0.f, 0.f, 0.f, 0.f}, u = g;
        g = skinny16(A, DM, WSP(bf16, WS_W1GU) + (size_t)rg * DM, DM, 0, DM, F.lane, g);
        u = skinny16(A, DM, WSP(bf16, WS_W1GU) + (size_t)(rg + 128) * DM, DM, 0, DM, F.lane, u);
#pragma unroll
        for (int i = 0; i < 4; ++i) { const int row = 4 * (F.lane >> 4) + i; const float rs = __builtin_amdgcn_rsqf(ssq[row] * (1.0f / 2048.0f) + EPS);
            act[row * DFF + c0 + (F.lane & 15)] = (bf16)f2bf(silu1(g[i] * rs) * (u[i] * rs)); } }
}
__device__ __forceinline__ void meta_down(Frame& F) {
    const bf16* A = WSP(bf16, WS_META + MO_ACT); float* ssq1 = WSP(float, WS_META + MO_SSQ1); bf16* xn1 = WSP(bf16, WS_META + MO_XN1);
    LAS f32x4* red = (LAS f32x4*)(F.lds + 65536);
    for (int it = blockIdx.x; it < DM / 16; it += F.G) { const int c0 = 16 * it;
        __syncthreads();
        f32x4 a = (f32x4){0.f, 0.f, 0.f, 0.f};
        a = skinny16(A, DFF, WSP(bf16, WS_W1D) + (size_t)c0 * DFF, DFF, F.wave * (DFF / 8), (F.wave + 1) * (DFF / 8), F.lane, a);
        red[F.wave * 64 + F.lane] = a;
        __syncthreads();
        if (F.wave == 0) {
#pragma unroll
            for (int w = 1; w < 8; ++w) a += red[w * 64 + F.lane];
#pragma unroll
            for (int i = 0; i < 4; ++i) { const int row = 4 * (F.lane >> 4) + i, col = c0 + (F.lane & 15); const float o = F.in[1][row * DM + col] + 0.5f * a[i];
                xn1[row * DM + col] = (bf16)f2bf(o);
                float sq = o * o; sq += __shfl_xor(sq, 1); sq += __shfl_xor(sq, 2); sq += __shfl_xor(sq, 4); sq += __shfl_xor(sq, 8);
                if ((F.lane & 15) == 0) ssq1[row * 128 + it] = sq; } }
        __syncthreads();
    }
}
constexpr int NMETA_IT = NIN / 16, NDT_IT = MR / 16;
__device__ __forceinline__ void meta_inproj_and_dt(Frame& F, int it0, int it_end, int wstride) {
    const int nmeta = NMETA_IT;
    if (it0 < 0) return;
    for (int it = it0; it < it_end; it += wstride) {
        if (it < nmeta) {
            const float* ssq1 = WSP(float, WS_META + MO_SSQ1); float* um = WSP(float, WS_META + MO_U);
            float rs[4];
#pragma unroll
            for (int i = 0; i < 4; ++i) { const f32x4* pp = (const f32x4*)(ssq1 + (4 * (F.lane >> 4) + i) * 128 + 8 * (F.lane & 15)); const f32x4 v = pp[0] + pp[1]; float s2 = (v[0] + v[1]) + (v[2] + v[3]);
                s2 += __shfl_xor(s2, 1); s2 += __shfl_xor(s2, 2); s2 += __shfl_xor(s2, 4); s2 += __shfl_xor(s2, 8);
                rs[i] = __builtin_amdgcn_rsqf(s2 * (1.0f / 2048.0f) + EPS); }
            const int r0 = 16 * it;
            int c0;
            if (r0 >= NINP) c0 = r0; else { const int pn = r0 >> 8, rem = r0 & 255, bj = rem >> 7, wc = (rem & 127) >> 5, j = rem & 31; c0 = 256 * pn + 64 * wc + 32 * bj + j; }
            f32x4 a = (f32x4){0.f, 0.f, 0.f, 0.f};
            a = skinny16(WSP(bf16, WS_META + MO_XN1), DM, WSP(bf16, WS_WIN) + (size_t)r0 * DM, DM, 0, DM, F.lane, a);
#pragma unroll
            for (int i = 0; i < 4; ++i) um[(size_t)(4 * (F.lane >> 4) + i) * NIN + c0 + (F.lane & 15)] = a[i] * rs[i];
        } else {
            const int m0 = 16 * (it - nmeta);
            f32x4 a = (f32x4){0.f, 0.f, 0.f, 0.f};
            a = skinny16(WSP(bf16, WS_XN) + (size_t)m0 * DM, DM, WSP(bf16, WS_WIN) + (size_t)NINP * DM, DM, 0, DM, F.lane, a);
#pragma unroll
            for (int i = 0; i < 4; ++i) { const int row = m0 + 4 * (F.lane >> 4) + i; WSP(float, WS_DTR)[(size_t)row * 16 + (F.lane & 15)] = a[i] * pg8::row_rs(WSP(float, WS_SSQ1), 32, row); }
        }
    }
}


namespace att {
typedef float f32x16 __attribute__((ext_vector_type(16)));
typedef short s16x4 __attribute__((ext_vector_type(4)));
typedef short v4i16_t __attribute__((ext_vector_type(4)));
typedef float f32x2_t __attribute__((ext_vector_type(2))); typedef __bf16 bf16x2_t __attribute__((ext_vector_type(2)));
constexpr int STAGE = 32768, VOFF = 16384;
__device__ __forceinline__ int crow(int r, int hi) { return (r & 3) + 8 * (r >> 2) + 4 * hi; }
__device__ __forceinline__ unsigned cvtpk(float lo, float hi) { f32x2_t v = {lo, hi}; bf16x2_t b = __builtin_convertvector(v, bf16x2_t); return __builtin_bit_cast(unsigned, b); }
#define ATT_WAITBAR() asm volatile("s_waitcnt vmcnt(0) lgkmcnt(0)\n\ts_barrier" ::: "memory")
__device__ __forceinline__ void glds16(const void* gsrc, unsigned lds_dst) { unsigned keep;
    asm volatile("s_mov_b32 %0, m0\n\ts_mov_b32 m0, %2\n\ts_nop 0\n\tglobal_load_lds_dwordx4 %1, off\n\ts_mov_b32 m0, %0" : "=&s"(keep) : "v"(gsrc), "s"(lds_dst) : "memory"); }
#define ATT_DMA(src, dstoff) glds16((const void*)(src), (unsigned)__builtin_amdgcn_readfirstlane((int)(dstoff)))
#define ATT_MFMA(a, b, c) __builtin_amdgcn_mfma_f32_32x32x16_bf16((a), (b), (c), 0, 0, 0)
__device__ __forceinline__ float fadd_s(float a, float b) { float r; asm("v_add_f32 %0, %1, %2" : "=v"(r) : "v"(a), "v"(b)); return r; }

constexpr int KST = 16384, VST0 = 4 * KST, VSTB = 16384, WSF_OFF = VST0 + 3 * VSTB, STG_OFF = VST0, DUMMY_OFF = WSF_OFF + 1024;
__device__ __forceinline__ void attn_unit(Frame& F, int bh, int jq) {
    LAS unsigned char* lds = F.lds;
    const bf16* U = WSP(bf16, WS_ACT);
    int lane = F.lane; asm volatile("" : "+v"(lane));
    const int wave = F.wave, r32 = lane & 31, hi = lane >> 5;
    const int b = bh >> 3, h = bh & 7, rb = wave & 3, sub = wave >> 2;
    const int cw = 2 * jq + (rb >> 1);
    const int row0 = b * SEQ + 128 * jq + 32 * rb;
    const int T = 2 * jq + 2;
    const int kk0 = 8 * wave + (lane >> 4), kk1 = kk0 + 4;
    const bf16* kbase0 = U + (size_t)(b * SEQ + kk0) * NINP + 1024 + h * 128 + 8 * ((lane & 15) ^ (kk0 & 15));
    const bf16* kbase1 = U + (size_t)(b * SEQ + kk1) * NINP + 1024 + h * 128 + 8 * ((lane & 15) ^ (kk1 & 15));
    const int v0 = 2 * wave, v1 = 2 * wave + 1;
    const bf16* vbase0 = U + (size_t)(b * SEQ + 16 * (v0 & 3) + (lane >> 2)) * NINP + 2048 + h * 128 + 32 * (v0 >> 2) + 8 * (lane & 3);
    const bf16* vbase1 = U + (size_t)(b * SEQ + 16 * (v1 & 3) + (lane >> 2)) * NINP + 2048 + h * 128 + 32 * (v1 >> 2) + 8 * (lane & 3);
    const int kd0 = 2 * wave * 1024, kd1 = kd0 + 1024, vd0 = v0 * 1024, vd1 = v1 * 1024;
#define ATT_DMA_K(t, ks_) do { const size_t to_ = (size_t)(t) * 64 * NINP; ATT_DMA(kbase0 + to_, (ks_) + kd0); ATT_DMA(kbase1 + to_, (ks_) + kd1); } while (0)
#define ATT_DMA_V(t, vs_) do { const size_t to_ = (size_t)(t) * 64 * NINP; ATT_DMA(vbase0 + to_, (vs_) + vd0); ATT_DMA(vbase1 + to_, (vs_) + vd1); } while (0)
    ATT_DMA_K(0, 0); ATT_DMA_V(0, VST0); ATT_DMA_K(1, KST); ATT_DMA_V(1, VST0 + VSTB); if (T > 2) ATT_DMA_K(2, 2 * KST);
    { const float* um = WSP(float, WS_META + MO_U);
      float mv[4];
#pragma unroll
      for (int i4 = 0; i4 < 4; ++i4) { const int itm = 4 * wave + i4; mv[i4] = um[(size_t)(itm >> 1) * NIN + 1024 + h * 128 + (itm & 1) * 64 + lane]; }
#pragma unroll
      for (int i4 = 0; i4 < 4; ++i4) { const int itm = 4 * wave + i4, p = itm >> 1, sh = itm & 1, d = lane;
          float v = mv[i4];
          const float r = __builtin_amdgcn_rsqf(wave_sum(v * v) * (1.0f / 64.0f) + EPS);
          v = v * r * F.in[9][d];
          const float pr = __shfl_xor(v, 8); const float* rp = WSP(float, WS_ROPE) + p * 16;
          if (d < 8) v = v * rp[d] - pr * rp[8 + d]; else if (d < 16) v = v * rp[d - 8] + pr * rp[d];
          const int dd = sh * 64 + d;
          *(LAS bf16*)(lds + 3 * KST + p * 256 + (((dd >> 3) ^ p) << 4) + (dd & 7) * 2) = (bf16)f2bf(v); }
      { const int e = 4 * (wave * 64 + lane), key = e >> 7, d = e & 127; const f32x4 vv = *(const f32x4*)(um + (size_t)key * NIN + 2048 + h * 128 + d);
        u32x2v w2; w2.x = pk2(vv[0], vv[1]); w2.y = pk2(vv[2], vv[3]); *(LAS u32x2v*)(lds + VST0 + 2 * VSTB + (4 * (d >> 5)) * 1024 + key * 64 + (d & 31) * 2) = w2; } }
    bf16x8 qf[4];
#pragma unroll
    for (int ks = 0; ks < 4; ++ks) qf[ks] = *(const bf16x8*)(U + (size_t)(row0 + r32) * NINP + h * 128 + sub * 64 + 16 * ks + 8 * hi);
    f32x16 o[4];
#pragma unroll
    for (int d = 0; d < 4; ++d)
#pragma unroll
        for (int i = 0; i < 16; ++i) o[d][i] = 0.f;
    float lsum = 0.f;
    const f32x16 zero16 = {0.f, 0.f, 0.f, 0.f, 0.f, 0.f, 0.f, 0.f, 0.f, 0.f, 0.f, 0.f, 0.f, 0.f, 0.f, 0.f};
    const int koff = r32 * 256 + (((8 * sub + hi) ^ (r32 & 15)) << 4);
    const int voff = ((lane >> 4) & 1) * 32 + (lane & 3) * 8 + (4 * hi + ((lane & 15) >> 2)) * 64;
#define ATT_KF(kst_, half, ks) (*(const LAS bf16x8*)(lds + (kst_) + (half) * 8192 + (koff ^ ((ks) << 5))))
#define ATT_VTR(vst_, off) __builtin_bit_cast(s16x4, __builtin_amdgcn_ds_read_tr16_b64_v4i16((LAS v4i16_t*)(lds + (vst_) + voff + (off))))
    ATT_WAITBAR();
    f32x16 s0 = zero16, s1 = zero16;
    {
        f32x16 sc = zero16;
#pragma unroll
        for (int ks = 0; ks < 4; ++ks) sc = ATT_MFMA(ATT_KF(3 * KST, 0, ks), qf[ks], sc);
#pragma unroll
        for (int ks = 0; ks < 4; ++ks) { s0 = ATT_MFMA(ATT_KF(0, 0, ks), qf[ks], s0); s1 = ATT_MFMA(ATT_KF(0, 1, ks), qf[ks], s1); }
#pragma unroll
        for (int i = 0; i < 8; ++i) { sc[i] = __builtin_amdgcn_exp2f(sc[i]); lsum += sc[i]; }
        v4u pw; pw.x = cvtpk(sc[0], sc[1]); pw.y = cvtpk(sc[2], sc[3]); pw.z = cvtpk(sc[4], sc[5]); pw.w = cvtpk(sc[6], sc[7]);
        const bf16x8 pm = __builtin_bit_cast(bf16x8, pw);
#pragma unroll
        for (int d = 0; d < 4; ++d) { const s16x4 lo = ATT_VTR(VST0 + 2 * VSTB, d * 4096), hh = ATT_VTR(VST0 + 2 * VSTB, d * 4096 + 512);
            const bf16x8 vf = {lo[0], lo[1], lo[2], lo[3], hh[0], hh[1], hh[2], hh[3]};
            o[d] = ATT_MFMA(pm, vf, o[d]); }
    }
    ATT_WAITBAR();
    int vm0 = 0, vm2 = 2;
#define SBAR() __builtin_amdgcn_sched_barrier(0)
#define ATT_VTRP(vp_, off) __builtin_bit_cast(s16x4, __builtin_amdgcn_ds_read_tr16_b64_v4i16((LAS v4i16_t*)((vp_) + (off))))
#define ATT_VLOAD(buf, vst_, d, kp) do { _Pragma("unroll") for (int ks_ = 0; ks_ < 2; ++ks_) { vlo[buf][ks_] = ATT_VTRP(vst_, (d) * 4096 + (2 * (kp) + ks_) * 1024); vhi[buf][ks_] = ATT_VTRP(vst_, (d) * 4096 + (2 * (kp) + ks_) * 1024 + 512); } } while (0)
#define ATT_GQ(MF) do { __builtin_amdgcn_s_setprio(1); MF; __builtin_amdgcn_s_setprio(0); SBAR(); } while (0)
#define ATT_GS(NV, b4, PW, w0, w1) do { ls = (((ls + NV[b4]) + NV[b4 + 1]) + NV[b4 + 2]) + NV[b4 + 3];     PW[w0] = cvtpk(NV[b4], NV[b4 + 1]); PW[w1] = cvtpk(NV[b4 + 2], NV[b4 + 3]); } while (0)
#define ATT_GB(MF, NV, i0, GS) do { __builtin_amdgcn_s_setprio(1); MF; __builtin_amdgcn_s_setprio(0); NV[i0] = __builtin_amdgcn_exp2f(NV[i0]); NV[i0 + 1] = __builtin_amdgcn_exp2f(NV[i0 + 1]); GS; SBAR(); } while (0)
#define ATT_VF(buf, ks_) (bf16x8){vlo[buf][ks_][0], vlo[buf][ks_][1], vlo[buf][ks_][2], vlo[buf][ks_][3], vhi[buf][ks_][0], vhi[buf][ks_][1], vhi[buf][ks_][2], vhi[buf][ks_][3]}
#define ATT_STEP(C0, C1, C2, C3, D0, D1, D2, D3, tt) do { \
        const int t_ = (tt); const int knext = ((t_ + 1) & 3) * KST, kdst = ((t_ + 3) & 3) * KST, vdst = VST0 + vm2 * VSTB; \
        LAS unsigned char* vcur = lds + VST0 + vm0 * VSTB + voff; asm volatile("" : "+v"(vcur));     \
        const bool dk = t_ + 3 < T, dv = t_ + 2 < T; const size_t tok_ = dk ? (size_t)(t_ + 3) * 64 * NINP : 0, tov_ = dv ? (size_t)(t_ + 2) * 64 * NINP : 0; \
        const int dK0 = dk ? kdst + kd0 : DUMMY_OFF + wave * 1024, dK1 = dk ? kdst + kd1 : DUMMY_OFF + wave * 1024, dV0 = dv ? vdst + vd0 : DUMMY_OFF + wave * 1024, dV1 = dv ? vdst + vd1 : DUMMY_OFF + wave * 1024; \
        ATT_DMA(kbase0 + tok_, dK0); ATT_DMA(kbase1 + tok_, dK1); ATT_DMA(vbase0 + tov_, dV0); ATT_DMA(vbase1 + tov_, dV1); \
        if (t_ <= cw) { \
            bf16x8 kf[4]; s16x4 vlo[2][2], vhi[2][2]; f32x16 N0, N1; float ls = 0.f; \
            SBAR(); \
            kf[0] = ATT_KF(knext, 0, 0); kf[1] = ATT_KF(knext, 1, 0); kf[2] = ATT_KF(knext, 0, 1); kf[3] = ATT_KF(knext, 1, 1); SBAR(); \
            ATT_GQ(N0 = ATT_MFMA(kf[0], qf[0], zero16)); \
            ATT_GQ(N1 = ATT_MFMA(kf[1], qf[0], zero16)); \
            kf[0] = ATT_KF(knext, 0, 2); kf[1] = ATT_KF(knext, 1, 2); SBAR(); \
            ATT_GQ(N0 = ATT_MFMA(kf[2], qf[1], N0)); \
            ATT_GQ(N1 = ATT_MFMA(kf[3], qf[1], N1)); \
            kf[2] = ATT_KF(knext, 0, 3); kf[3] = ATT_KF(knext, 1, 3); SBAR(); \
            ATT_GQ(N0 = ATT_MFMA(kf[0], qf[2], N0)); \
            ATT_GQ(N1 = ATT_MFMA(kf[1], qf[2], N1)); \
            ATT_VLOAD(0, vcur, 0, 0); SBAR(); \
            ATT_GQ(N0 = ATT_MFMA(kf[2], qf[3], N0)); \
            ATT_GQ(N1 = ATT_MFMA(kf[3], qf[3], N1)); \
            const bf16x8 pf0 = __builtin_bit_cast(bf16x8, C0), pf1 = __builtin_bit_cast(bf16x8, C1), pf2 = __builtin_bit_cast(bf16x8, C2), pf3 = __builtin_bit_cast(bf16x8, C3); \
            ATT_VLOAD(1, vcur, 0, 1); SBAR(); \
            ATT_GB(o[0] = ATT_MFMA(pf0, ATT_VF(0, 0), o[0]), N0, 0, (void)0); ATT_GB(o[0] = ATT_MFMA(pf1, ATT_VF(0, 1), o[0]), N0, 2, (void)0); \
            ATT_VLOAD(0, vcur, 1, 0); SBAR(); \
            ATT_GB(o[0] = ATT_MFMA(pf2, ATT_VF(1, 0), o[0]), N0, 4, ATT_GS(N0, 0, D0, 0, 1)); ATT_GB(o[0] = ATT_MFMA(pf3, ATT_VF(1, 1), o[0]), N0, 6, (void)0); \
            ATT_VLOAD(1, vcur, 1, 1); SBAR(); \
            ATT_GB(o[1] = ATT_MFMA(pf0, ATT_VF(0, 0), o[1]), N0, 8, ATT_GS(N0, 4, D0, 2, 3)); ATT_GB(o[1] = ATT_MFMA(pf1, ATT_VF(0, 1), o[1]), N0, 10, (void)0); \
            ATT_VLOAD(0, vcur, 2, 0); SBAR(); \
            ATT_GB(o[1] = ATT_MFMA(pf2, ATT_VF(1, 0), o[1]), N0, 12, ATT_GS(N0, 8, D1, 0, 1)); ATT_GB(o[1] = ATT_MFMA(pf3, ATT_VF(1, 1), o[1]), N0, 14, (void)0); \
            ATT_VLOAD(1, vcur, 2, 1); SBAR(); \
            ATT_GB(o[2] = ATT_MFMA(pf0, ATT_VF(0, 0), o[2]), N1, 0, ATT_GS(N0, 12, D1, 2, 3)); ATT_GB(o[2] = ATT_MFMA(pf1, ATT_VF(0, 1), o[2]), N1, 2, (void)0); \
            ATT_VLOAD(0, vcur, 3, 0); SBAR(); \
            ATT_GB(o[2] = ATT_MFMA(pf2, ATT_VF(1, 0), o[2]), N1, 4, ATT_GS(N1, 0, D2, 0, 1)); ATT_GB(o[2] = ATT_MFMA(pf3, ATT_VF(1, 1), o[2]), N1, 6, (void)0); \
            ATT_VLOAD(1, vcur, 3, 1); SBAR(); \
            ATT_GB(o[3] = ATT_MFMA(pf0, ATT_VF(0, 0), o[3]), N1, 8, ATT_GS(N1, 4, D2, 2, 3)); ATT_GB(o[3] = ATT_MFMA(pf1, ATT_VF(0, 1), o[3]), N1, 10, (void)0); \
            ATT_GB(o[3] = ATT_MFMA(pf2, ATT_VF(1, 0), o[3]), N1, 12, ATT_GS(N1, 8, D3, 0, 1)); ATT_GB(o[3] = ATT_MFMA(pf3, ATT_VF(1, 1), o[3]), N1, 14, (void)0); \
            ATT_GS(N1, 12, D3, 2, 3); \
            lsum += (t_ < cw) ? ls : 0.f;     \
        } \
          \
        asm volatile("s_waitcnt vmcnt(4) lgkmcnt(0)\n\ts_barrier" ::: "memory"); \
        vm0 = (vm0 == 2) ? 0 : vm0 + 1; vm2 = (vm2 == 2) ? 0 : vm2 + 1; \
    } while (0)
    v4u pa0, pa1, pa2, pa3, pb0, pb1, pb2, pb3;
    pb0 = pb1 = pb2 = pb3 = (v4u){0u, 0u, 0u, 0u};
    {
#pragma unroll
        for (int i = 0; i < 16; ++i) { s0[i] = __builtin_amdgcn_exp2f(s0[i]); s1[i] = __builtin_amdgcn_exp2f(s1[i]); }
        float ls = 0.f;
        ATT_GS(s0, 0, pa0, 0, 1); ATT_GS(s0, 4, pa0, 2, 3); ATT_GS(s0, 8, pa1, 0, 1); ATT_GS(s0, 12, pa1, 2, 3);
        ATT_GS(s1, 0, pa2, 0, 1); ATT_GS(s1, 4, pa2, 2, 3); ATT_GS(s1, 8, pa3, 0, 1); ATT_GS(s1, 12, pa3, 2, 3);
        lsum += ls;
    }
    for (int t = 0; t < T; t += 2) { ATT_STEP(pa0, pa1, pa2, pa3, pb0, pb1, pb2, pb3, t); ATT_STEP(pb0, pb1, pb2, pb3, pa0, pa1, pa2, pa3, t + 1); }
    ATT_WAITBAR();
#undef ATT_STEP
#undef ATT_VLOAD
#undef ATT_GQ
#undef ATT_GS
#undef ATT_GB
#undef ATT_VF
#undef SBAR
    int le = lane; asm volatile("" : "+v"(le));
    const int r32e = le & 31, hie = le >> 5;
    lsum += __shfl_xor(lsum, 32);
    LAS float* wsf = (LAS float*)(lds + WSF_OFF + wave * 128);
    float fac;
    if (sub == 0) fac = 1.0f / lsum;
    else { const float s1 = wave_sum(F.in[10][le] * F.in[11][le]), s2 = wave_sum(F.in[12][le] * F.in[13][le]); fac = (__expf(s1) - __expf(s2) + 0.2f) / lsum; }
    if (hie == 0) wsf[r32e] = fac;
    LDS_WAIT(); asm volatile("" ::: "memory");
    LAS float* xo = (LAS float*)(lds + (wave & 3) * 16384) + le;
    if (sub == 1) {
#pragma unroll
        for (int i = 0; i < 16; ++i) { const float f = wsf[crow(i, hie)];
#pragma unroll
            for (int d = 0; d < 4; ++d) xo[(d * 16 + i) * 64] = o[d][i] * f; }
    }
    ATT_WAITBAR();
    if (sub == 0) {
        LAS bf16* stg = (LAS bf16*)(lds + STG_OFF + wave * 8192);
        float wn[4];
#pragma unroll
        for (int d = 0; d < 4; ++d) wn[d] = F.in[14][32 * d + r32e] * 0.8f;
#pragma unroll
        for (int i = 0; i < 16; ++i) { const int q = crow(i, hie); const float f1 = wsf[q];
            float v[4], ss = 0.f;
#pragma unroll
            for (int d = 0; d < 4; ++d) { v[d] = o[d][i] * f1 - xo[(d * 16 + i) * 64]; ss += v[d] * v[d]; }
            ss += __shfl_xor(ss, 1); ss += __shfl_xor(ss, 2); ss += __shfl_xor(ss, 4); ss += __shfl_xor(ss, 8); ss += __shfl_xor(ss, 16);
            const float r = __builtin_amdgcn_rsqf(ss * (1.0f / 128.0f) + EPS);
#pragma unroll
            for (int d = 0; d < 4; ++d) stg[q * 128 + 32 * d + r32e] = (bf16)f2bf(v[d] * r * wn[d]); }
        LDS_WAIT(); asm volatile("" ::: "memory");
#pragma unroll
        for (int it = 0; it < 8; ++it) { const int q = 4 * it + (le >> 4), ch = le & 15;
            const v4u val = *(const LAS v4u*)(stg + q * 128 + 8 * ch);
            *(v4u*)(WSP(bf16, WS_MIX) + (size_t)(row0 + q) * DM + 1024 + h * 128 + 8 * ch) = val; }
    }
    ATT_WAITBAR();
#undef ATT_DMA_K
#undef ATT_DMA_V
#undef ATT_KF
#undef ATT_VTR
}
}


namespace ssd {
constexpr int S64 = 144, S128 = 272;
constexpr int O_CC = 0, O_BC = 17408, O_BT = 34816, O_XT = 53248, O_XS = 62464, O_XC = 71680, O_M = 80896, O_SI = 90112, O_SC = 107520;
#define SSD_MF(a, b, c) __builtin_amdgcn_mfma_f32_16x16x32_bf16((a), (b), (c), 0, 0, 0)
#define SSD_FRAG(img, stride, row, k) (*(const LAS bf16x8*)(lds + (img) + (row) * (stride) + 2 * (k)))
#define SSD_BAR() do { asm volatile("s_waitcnt vmcnt(0) lgkmcnt(0)" ::: "memory"); __builtin_amdgcn_s_barrier(); asm volatile("" ::: "memory"); } while (0)

__device__ __forceinline__ v4u pack8(const float (&v)[8]) { v4u o; o.x = pk2(v[0], v[1]); o.y = pk2(v[2], v[3]); o.z = pk2(v[4], v[5]); o.w = pk2(v[6], v[7]); return o; }
__device__ __forceinline__ unsigned bfe16(const v4u& r, int e) { const unsigned w = (e < 2) ? r.x : (e < 4) ? r.y : (e < 6) ? r.z : r.w; return (e & 1) ? (w >> 16) : (w & 0xffffu); }

template <bool PASSB>
__device__ __forceinline__ void ssd_item(Frame& F, int item, int& bgj) {
    LAS unsigned char* lds = F.lds;
    int lane0 = F.lane; asm volatile("" : "+v"(lane0));
    const int wave = F.wave;
    const int k = item & 7, hd = (item >> 3) & 15, b = item >> 7, g = hd >> 3;
    const float Ah = -__expf(F.in[18][hd]), Dk = F.in[19][hd];
    LAS float* sc = (LAS float*)(lds + O_SC);
    const int pt = wave >> 1, nb = 4 * (wave & 1);
    f32x4 stt[4];
#pragma unroll
    for (int j = 0; j < 4; ++j) stt[j] = (f32x4){0.f, 0.f, 0.f, 0.f};
    float* sst = WSP(float, WS_SST) + (size_t)((b * SH + hd) * 8) * 8192;
    float* atot = WSP(float, WS_ATOT) + (b * SH + hd) * 8;
    if (PASSB) {
        const int fr = lane0 & 15, fq = lane0 >> 4;
        for (int kk = 0; kk < k; ++kk) { const float dec = __expf(atot[kk]);
#pragma unroll
            for (int j = 0; j < 4; ++j) { const f32x4 s = *(const f32x4*)(sst + (size_t)kk * 8192 + (16 * pt + fr) * 128 + 16 * (nb + j) + 4 * fq); stt[j] = stt[j] * dec + s; } }
    }
    float asum = 0.f;
    const int c_lo = (k == 0) ? 0 : 8 * k + 1, c_hi = 8 * k + 8;
    const int role = (wave < 2) ? 0 : (wave < 4) ? 1 : (wave < 6 && PASSB) ? 2 : 3;
    v4u raw[8]; float dtv = 0.f;
    { const int li = (wave * 64 + lane0) & 127, cg = (role == 0) ? (li & 7) : (li & 15), l0 = (role == 0) ? 4 * (li >> 3) : 8 * (li >> 4);
      if (role == 0) { const bf16* src = WSP(bf16, WS_XS) + (size_t)(b * LPAD + 64 * c_lo + l0) * 1024 + hd * 64 + 8 * cg;
#pragma unroll
          for (int i = 0; i < 4; ++i) raw[i] = *(const v4u*)(src + (size_t)i * 1024); }
      else if (role < 3) { const bf16* src = WSP(bf16, WS_BC) + (size_t)(b * LPAD + 64 * c_lo + l0) * 512 + (role == 2 ? 256 : 0) + g * 128 + 8 * cg;
#pragma unroll
          for (int i = 0; i < 8; ++i) raw[i] = *(const v4u*)(src + (size_t)i * 512); }
      if (wave == 7) dtv = WSP(float, WS_DT)[(size_t)(b * LPAD + 64 * c_lo + lane0) * 16 + hd]; }
    for (int c = c_lo; c <= c_hi; ++c) {
        int lane = lane0; asm volatile("" : "+v"(lane));
        const int tid = wave * 64 + lane, fr = lane & 15, fq = lane >> 4, li = tid & 127;
        const int cg = (role == 0) ? (li & 7) : (li & 15), l0 = (role == 0) ? 4 * (li >> 3) : 8 * (li >> 4);
        u32x2v zv[2];
        if (PASSB && c >= 1) {
#pragma unroll
            for (int j = 0; j < 2; ++j) zv[j] = *(const u32x2v*)(WSP(bf16, WS_ACT) + (size_t)(b * SEQ + 64 * (c - 1) + 16 * pt + fr) * NINP + 3072 + hd * 64 + 16 * (2 * (wave & 1) + j) + 4 * fq);
        }
        const int cn = (c < c_hi) ? c + 1 : c;
        f32x4 cv[16]; TItem ct; bool chave = false;
        if (role == 0) {
            if (PASSB) {
#pragma unroll
                for (int i = 0; i < 4; ++i) *(LAS v4u*)(lds + O_XC + (l0 + i) * S64 + 16 * cg) = raw[i]; }
#pragma unroll
            for (int e = 0; e < 8; ++e) { u32x2v w2; w2.x = bfe16(raw[0], e) | (bfe16(raw[1], e) << 16); w2.y = bfe16(raw[2], e) | (bfe16(raw[3], e) << 16); *(LAS u32x2v*)(lds + O_XT + (8 * cg + e) * S64 + 2 * l0) = w2; }
            const bf16* src = WSP(bf16, WS_XS) + (size_t)(b * LPAD + 64 * cn + l0) * 1024 + hd * 64 + 8 * cg;
#pragma unroll
            for (int i = 0; i < 4; ++i) raw[i] = *(const v4u*)(src + (size_t)i * 1024);
        } else if (role == 1) {
            if (PASSB) {
#pragma unroll
                for (int i = 0; i < 8; ++i) *(LAS v4u*)(lds + O_BC + (l0 + i) * S128 + 16 * cg) = raw[i]; }
#pragma unroll
            for (int e = 0; e < 8; ++e) { v4u w4; w4.x = bfe16(raw[0], e) | (bfe16(raw[1], e) << 16); w4.y = bfe16(raw[2], e) | (bfe16(raw[3], e) << 16); w4.z = bfe16(raw[4], e) | (bfe16(raw[5], e) << 16); w4.w = bfe16(raw[6], e) | (bfe16(raw[7], e) << 16);
                *(LAS v4u*)(lds + O_BT + (8 * cg + e) * S64 + 2 * l0) = w4; }
            const bf16* src = WSP(bf16, WS_BC) + (size_t)(b * LPAD + 64 * cn + l0) * 512 + g * 128 + 8 * cg;
#pragma unroll
            for (int i = 0; i < 8; ++i) raw[i] = *(const v4u*)(src + (size_t)i * 512);
        } else if (role == 2) {
#pragma unroll
            for (int i = 0; i < 8; ++i) *(LAS v4u*)(lds + O_CC + (l0 + i) * S128 + 16 * cg) = raw[i];
            const bf16* src = WSP(bf16, WS_BC) + (size_t)(b * LPAD + 64 * cn + l0) * 512 + 256 + g * 128 + 8 * cg;
#pragma unroll
            for (int i = 0; i < 8; ++i) raw[i] = *(const v4u*)(src + (size_t)i * 512);
        }
        if (wave == 7) {
            const float dt = dtv;
            dtv = WSP(float, WS_DT)[(size_t)(b * LPAD + 64 * cn + lane) * 16 + hd];
            float a = dt * Ah;
#pragma unroll
            for (int o2 = 1; o2 < 64; o2 <<= 1) { const float t = __shfl_up(a, o2); if (lane >= o2) a += t; }
            const float aend = __shfl(a, 63);
            sc[lane] = dt; sc[64 + lane] = a; sc[128 + lane] = dt * __expf(aend - a);
            if (lane == 0) sc[192] = aend;
        }
        if (PASSB && F.NGW == 2048) { const int slot = (F.gw + bgj * BG_P) & 2047, cit = IT_BG + bgj * BG_P + slot; chave = bgj < 8 && slot < BG_P && cit < IT_END; ++bgj;
            if (chave) { ct = mk_item(F, cit); transpose_load(ct, lane, cv); } }
        asm volatile("s_waitcnt lgkmcnt(0)" ::: "memory"); __builtin_amdgcn_s_barrier(); asm volatile("" ::: "memory");
        const float aend = sc[192];
        for (int amp2_ = 0; amp2_ < (MK_AMP == 2 ? 3 : 1); ++amp2_) {
        { const int p = tid >> 3, lg = (tid & 7) * 8;
          const v4u xv = *(const LAS v4u*)(lds + O_XT + p * S64 + 2 * lg); const unsigned xw[4] = {xv.x, xv.y, xv.z, xv.w}; float v[8];
#pragma unroll
          for (int e = 0; e < 4; ++e) { v[2 * e] = bf2f(xw[e] & 0xffffu) * sc[128 + lg + 2 * e]; v[2 * e + 1] = bf2f(xw[e] >> 16) * sc[128 + lg + 2 * e + 1]; }
          *(LAS v4u*)(lds + O_XS + p * S64 + 2 * lg) = pack8(v); }
        if (PASSB) {
#pragma unroll
            for (int j = 0; j < 4; ++j) { u32x2v w2; w2.x = pk2(stt[j][0], stt[j][1]); w2.y = pk2(stt[j][2], stt[j][3]); *(LAS u32x2v*)(lds + O_SI + (16 * pt + fr) * S128 + 2 * (16 * (nb + j) + 4 * fq)) = w2; }
            const int l = 16 * pt + fr; const float al = sc[64 + l];
#pragma unroll
            for (int j = 0; j < 2; ++j) { const int st = 2 * (wave & 1) + j; f32x4 acc = (f32x4){0.f, 0.f, 0.f, 0.f};
                if (st <= pt) {
#pragma unroll
                    for (int ks = 0; ks < 4; ++ks) acc = SSD_MF(SSD_FRAG(O_BC, S128, 16 * st + fr, 32 * ks + 8 * fq), SSD_FRAG(O_CC, S128, l, 32 * ks + 8 * fq), acc);
                    asm volatile("s_nop 15\n\ts_nop 3" : "+v"(acc)); }
                float m[4];
#pragma unroll
                for (int i = 0; i < 4; ++i) { const int s = 16 * st + 4 * fq + i; m[i] = (s <= l) ? acc[i] * __expf(al - sc[64 + s]) * sc[s] : 0.f; }
                u32x2v w2; w2.x = pk2(m[0], m[1]); w2.y = pk2(m[2], m[3]); *(LAS u32x2v*)(lds + O_M + l * S64 + 2 * (16 * st + 4 * fq)) = w2; }
        }
        }
        asm volatile("s_waitcnt lgkmcnt(0)" ::: "memory"); __builtin_amdgcn_s_barrier(); asm volatile("" ::: "memory");
        for (int amp3_ = 0; amp3_ < (MK_AMP == 3 ? 3 : 1); ++amp3_) {
        if (PASSB && c >= 1) {
            const int l = 16 * pt + fr, row = b * SEQ + 64 * (c - 1) + l; const float el = __expf(sc[64 + l]);
            float sq = 0.f;
#pragma unroll
            for (int j = 0; j < 2; ++j) { const int ptile = 2 * (wave & 1) + j; f32x4 acc = (f32x4){0.f, 0.f, 0.f, 0.f};
#pragma unroll
                for (int ks = 0; ks < 4; ++ks) acc = SSD_MF(SSD_FRAG(O_SI, S128, 16 * ptile + fr, 32 * ks + 8 * fq), SSD_FRAG(O_CC, S128, l, 32 * ks + 8 * fq), acc);
                acc = acc * el;
#pragma unroll
                for (int ks = 0; ks < 2; ++ks) acc = SSD_MF(SSD_FRAG(O_XT, S64, 16 * ptile + fr, 32 * ks + 8 * fq), SSD_FRAG(O_M, S64, l, 32 * ks + 8 * fq), acc);
                const int pc = 16 * ptile + 4 * fq;
                const u32x2v xv = *(const LAS u32x2v*)(lds + O_XC + l * S64 + 2 * pc);
                float y[4];
                y[0] = (acc[0] + Dk * bf2f(xv.x & 0xffffu)) * silu1(bf2f(zv[j].x & 0xffffu)); y[1] = (acc[1] + Dk * bf2f(xv.x >> 16)) * silu1(bf2f(zv[j].x >> 16));
                y[2] = (acc[2] + Dk * bf2f(xv.y & 0xffffu)) * silu1(bf2f(zv[j].y & 0xffffu)); y[3] = (acc[3] + Dk * bf2f(xv.y >> 16)) * silu1(bf2f(zv[j].y >> 16));
                sq += (y[0] * y[0] + y[1] * y[1]) + (y[2] * y[2] + y[3] * y[3]);
                u32x2v w2; w2.x = pk2(y[0], y[1]); w2.y = pk2(y[2], y[3]);
                *(u32x2v*)(WSP(bf16, WS_MIX) + (size_t)row * DM + hd * 64 + pc) = w2; }
            sq += __shfl_xor(sq, 16); sq += __shfl_xor(sq, 32);
            if (fq == 0) WSP(float, WS_SSQS)[(size_t)row * 32 + 2 * hd + (wave & 1)] = sq;
        }
        }
        { const float dec = __expf(aend);
#pragma unroll
          for (int j = 0; j < 4; ++j) { f32x4 acc = stt[j] * dec;
#pragma unroll
              for (int ks = 0; ks < 2; ++ks) acc = SSD_MF(SSD_FRAG(O_BT, S64, 16 * (nb + j) + fr, 32 * ks + 8 * fq), SSD_FRAG(O_XS, S64, 16 * pt + fr, 32 * ks + 8 * fq), acc);
              stt[j] = acc; } }
        asum += aend;
        if (PASSB) { if (chave) transpose_finish(ct, lane, cv); }
        asm volatile("s_waitcnt lgkmcnt(0)" ::: "memory"); __builtin_amdgcn_s_barrier(); asm volatile("" ::: "memory");
    }
    if (!PASSB) { const int fr = lane0 & 15, fq = lane0 >> 4;
#pragma unroll
        for (int j = 0; j < 4; ++j) *(f32x4*)(sst + (size_t)k * 8192 + (16 * pt + fr) * 128 + 16 * (nb + j) + 4 * fq) = stt[j];
        if (wave == 0 && lane0 == 0) atot[k] = asum;
    }
}
}

struct ConvItem { int c, pp, b, p; v4u rv[4]; bool fast; };
__device__ __forceinline__ void conv_issue(Frame& F, int it, ConvItem& q) {
    const bf16* U = WSP(bf16, WS_ACT); const float* um = WSP(float, WS_META + MO_U);
    const int cg = it % (CONVD / 8); q.pp = (it / (CONVD / 8)) % LPAD; q.b = it / ((CONVD / 8) * LPAD); q.c = 8 * cg; q.p = q.pp - PPAD;
#pragma unroll
    for (int w = 0; w < 4; ++w) q.rv[w] = (v4u){0u, 0u, 0u, 0u};
    if (q.p >= 0) {
        if (q.p - 3 >= NMETA) { const bf16* src = U + (size_t)(q.b * SEQ + q.p - 3 - NMETA) * NINP + 4096 + q.c;
#pragma unroll
            for (int w = 0; w < 4; ++w) q.rv[w] = *(const v4u*)(src + (size_t)w * NINP); }
        else {
#pragma unroll
            for (int w = 0; w < 4; ++w) { const int ps = q.p - 3 + w; v4u v = (v4u){0u, 0u, 0u, 0u};
                if (ps >= NMETA) v = *(const v4u*)(U + (size_t)(q.b * SEQ + ps - NMETA) * NINP + 4096 + q.c);
                else if (ps >= 0) { const f32x4 r0 = *(const f32x4*)(um + (size_t)ps * NIN + 4096 + q.c), r1 = *(const f32x4*)(um + (size_t)ps * NIN + 4096 + q.c + 4);
                    v.x = pk2(r0[0], r0[1]); v.y = pk2(r0[2], r0[3]); v.z = pk2(r1[0], r1[1]); v.w = pk2(r1[2], r1[3]); }
                q.rv[w] = v; } }
    }
}
__device__ __forceinline__ void conv_finish(Frame& F, const ConvItem& q) {
    const float* cw = F.in[15]; const float* cb = F.in[16]; const int c = q.c;
    float a[8];
#pragma unroll
    for (int e = 0; e < 8; ++e) a[e] = 0.f;
    if (q.p >= 0) {
        const f32x4 b0 = *(const f32x4*)(cb + c), b1 = *(const f32x4*)(cb + c + 4);
        a[0] = b0[0]; a[1] = b0[1]; a[2] = b0[2]; a[3] = b0[3]; a[4] = b1[0]; a[5] = b1[1]; a[6] = b1[2]; a[7] = b1[3];
#pragma unroll
        for (int w = 0; w < 4; ++w) { const f32x4 w0 = *(const f32x4*)(cw + w * CONVD + c), w1 = *(const f32x4*)(cw + w * CONVD + c + 4);
            a[0] += bf2f(q.rv[w].x & 0xffffu) * w0[0]; a[1] += bf2f(q.rv[w].x >> 16) * w0[1]; a[2] += bf2f(q.rv[w].y & 0xffffu) * w0[2]; a[3] += bf2f(q.rv[w].y >> 16) * w0[3];
            a[4] += bf2f(q.rv[w].z & 0xffffu) * w1[0]; a[5] += bf2f(q.rv[w].z >> 16) * w1[1]; a[6] += bf2f(q.rv[w].w & 0xffffu) * w1[2]; a[7] += bf2f(q.rv[w].w >> 16) * w1[3]; }
#pragma unroll
        for (int e = 0; e < 8; ++e) a[e] = silu1(a[e]);
    }
    v4u o; o.x = pk2(a[0], a[1]); o.y = pk2(a[2], a[3]); o.z = pk2(a[4], a[5]); o.w = pk2(a[6], a[7]);
    if (c < 1024) *(v4u*)(WSP(bf16, WS_XS) + (size_t)(q.b * LPAD + q.pp) * 1024 + c) = o;
    else *(v4u*)(WSP(bf16, WS_BC) + (size_t)(q.b * LPAD + q.pp) * 512 + (c - 1024)) = o;
}
__device__ __forceinline__ void p4_conv(Frame& F) {
    const float* um = WSP(float, WS_META + MO_U);
    const int gt = F.gw * 64 + F.lane, NT = F.NGW * 64, NITEM = NBATCH * LPAD * (CONVD / 8);
    for (int it = gt; it < NITEM; it += 3 * NT) {
        ConvItem q0, q1, q2; const int i1 = it + NT, i2 = it + 2 * NT;
        conv_issue(F, it, q0); if (i1 < NITEM) conv_issue(F, i1, q1); if (i2 < NITEM) conv_issue(F, i2, q2);
        conv_finish(F, q0); if (i1 < NITEM) conv_finish(F, q1); if (i2 < NITEM) conv_finish(F, q2);
    }
    for (int it = gt; it < NBATCH * LPAD * SH; it += NT) { const int hd = it & 15, pp = (it >> 4) % LPAD, b = (it >> 4) / LPAD, p = pp - PPAD;
        float v = 0.f;
        if (p >= 0) { const float x = (p < NMETA ? um[(size_t)p * NIN + NINP + hd] : WSP(float, WS_DTR)[(size_t)(b * SEQ + p - NMETA) * 16 + hd]) + F.in[17][hd];
            v = fmaxf(x, 0.f) + log1pf(__expf(-fabsf(x))); }
        WSP(float, WS_DT)[it] = v; }
}
__device__ __forceinline__ void p4_mixer_attn(Frame& F) {
    p4_conv(F);
    for (int r_ = 0; r_ < (MK_REPEAT_PHASE == 41 ? 2 : 1); ++r_)
    for (int u = blockIdx.x; u < NBATCH * NHEAD * 16; u += F.G) { const int bh = (u & 7) * 2 + ((u >> 3) >> 4), idx = (u >> 3) & 15;
        att::attn_unit(F, bh, idx); att::attn_unit(F, bh, 31 - idx); }
}
__device__ __forceinline__ void p5_ssd_a(Frame& F) { int bgj = 0; for (int it = blockIdx.x; it < NBATCH * SH * 8; it += F.G) ssd::ssd_item<false>(F, it, bgj); }
__device__ __forceinline__ void p6_ssd_b(Frame& F) { int bgj = 0; for (int it = blockIdx.x; it < NBATCH * SH * 8; it += F.G) ssd::ssd_item<true>(F, it, bgj);
    if (F.NGW != 2048) convert_items(F, IT_BG, IT_END, F.gw, F.NGW); }
struct Args { const float* in[26]; float* out; unsigned char* ws; int ph_lo, ph_hi; };
__global__ void __launch_bounds__(NWAVES * 64, 2) hymba_fwd(Args args) {
    extern __shared__ __attribute__((aligned(16))) unsigned char lds[];
    Frame F;
    F.lds = (LAS unsigned char*)lds;
    F.tid = threadIdx.x; F.lane = F.tid & 63; F.wave = __builtin_amdgcn_readfirstlane(F.tid >> 6);
    F.G = gridDim.x; F.gw = blockIdx.x * NWAVES + F.wave; F.NGW = F.G * NWAVES;
#pragma unroll
    for (int i = 0; i < 26; ++i) F.in[i] = args.in[i];
    F.out = args.out; F.ws = args.ws; F.inp = args.in;
    volatile LAS unsigned* MISC = (volatile LAS unsigned*)(F.lds + MISC_OFF);
    for (int u = F.tid; u < 128; u += NWAVES * 64) MISC[u] = 0u;
    __syncthreads();
    XcdBarrier bar; bar.bar = (unsigned*)(F.ws + WS_CTL) + CW_BAR; bar.x = 0; bar.st = nullptr;
    if (N_LAUNCHES == 1) bar = xcd_barrier_post((unsigned*)(F.ws + WS_CTL) + CW_BAR, MISC + 8);
    const int lo = args.ph_lo, hi = args.ph_hi;
#define IN(k) (lo <= (k) && (k) < hi)
#ifndef MK_REPEAT_PHASE
#define MK_REPEAT_PHASE -1
#endif
#define REPS(k) for (int rep_ = 0; rep_ < ((k) == MK_REPEAT_PHASE ? 2 : 1); ++rep_)
#define REPBAR(k) do { if ((k) == MK_REPEAT_PHASE && rep_ == 0) xcd_barrier(bar); } while (0)
#define SEAM(k) do { if (IN(k) && IN((k) + 1)) xcd_barrier(bar); } while (0)
    using pg8::Gemm; using pg8::StaticOrder;
    LAS unsigned char* ring = F.lds + RING_OFF;

    if (IN(0)) { REPS(0) { p0_prologue(F); REPBAR(0); } SEAM(0); }
    if (IN(1)) {
        Gemm g{WSP(bf16, WS_XN), WSP(bf16, WS_W1GU), MR, NGU, DM}; StaticOrder S; S.init(MR, NGU, F.G, (int)blockIdx.x);
        pg8::Unit u0{0, 0}; (void)S.next(0, u0);
        pg8::EpiSwiGLU E{WSP(bf16, WS_ACT), DFF, WSP(float, WS_SSQ0), 1, build_rs_table(F, WSP(float, WS_SSQ0), 1, 1.0f / 2048.0f, u0.pm)};
        REPS(1) { pg8::gemm_phase<pg8::EpiSwiGLU, StaticOrder, true, true>(ring, g, S, E); REPBAR(1); }
        { const int first = S.nwg % F.G, nsl = F.G - first;
          const int w0 = (int)blockIdx.x >= first ? ((int)blockIdx.x - first) * NWAVES + F.wave : -1;
          meta_gateup(F, w0, nsl * NWAVES);
          constexpr int NMW = DFF / 16;
          convert_items(F, IT_CUT0, IT_BG, w0 >= NMW ? w0 - NMW : -1, nsl * NWAVES - NMW); }
        SEAM(1);
    }
    if (IN(2)) {
        meta_down(F);
        Gemm g{WSP(bf16, WS_ACT), WSP(bf16, WS_W1D), MR, DM, DFF}; StaticOrder S; S.init(MR, DM, F.G, (int)blockIdx.x);
        pg8::EpiResT<false> E{F.in[0], nullptr, nullptr, WSP(bf16, WS_XN), WSP(float, WS_SSQ1), 0.5f, DM, nullptr, 0, pg8::RsTable{nullptr, -1, -1}};
        REPS(2) { pg8::gemm_phase<pg8::EpiResT<false>, StaticOrder, true, true>(ring, g, S, E); REPBAR(2); }
        SEAM(2);
    }
    if (IN(3)) {
        Gemm g{WSP(bf16, WS_XN), WSP(bf16, WS_WIN), MR, NINP, DM}; StaticOrder S; S.init(MR, NINP, F.G, (int)blockIdx.x);
        pg8::Unit u0{0, 0}; (void)S.next(0, u0);
        pg8::EpiInProj E{WSP(bf16, WS_ACT), NINP, WSP(float, WS_SSQ1), F.in[8], F.in[9], WSP(float, WS_ROPE), build_rs_table(F, WSP(float, WS_SSQ1), 32, 1.0f / 2048.0f, u0.pm)};
        REPS(3) { pg8::gemm_phase<pg8::EpiInProj, StaticOrder, true, true>(ring, g, S, E); REPBAR(3); }
        { const int first = S.nwg % F.G, nsl = F.G - first;
          meta_inproj_and_dt(F, (int)blockIdx.x >= first ? ((int)blockIdx.x - first) * NWAVES + F.wave : -1, NMETA_IT + NDT_IT, nsl * NWAVES); }
        SEAM(3);
    }
    if (IN(4)) { REPS(4) { p4_mixer_attn(F); REPBAR(4); } SEAM(4); }
    if (IN(5)) { REPS(5) { p5_ssd_a(F); REPBAR(5); } SEAM(5); }
    if (IN(6)) { REPS(6) { p6_ssd_b(F); REPBAR(6); } SEAM(6); }
    if (IN(7)) {
        Gemm g{WSP(bf16, WS_MIX), WSP(bf16, WS_WOUT), MR, DM, DM}; StaticOrder S; S.init(MR, DM, F.G, (int)blockIdx.x);
        pg8::Unit u0{0, 0}; (void)S.next(0, u0);
        pg8::EpiResT<true> E{nullptr, WSP(bf16, WS_XN), nullptr, WSP(bf16, WS_XN), WSP(float, WS_SSQ2), 1.0f, DM, WSP(float, WS_SSQS), 16, build_rs_table(F, WSP(float, WS_SSQS), 32, 1.0f / 1024.0f, u0.pm)};
        pg8::gemm_phase<pg8::EpiResT<true>, StaticOrder, true, true>(ring, g, S, E);
        SEAM(7);
    }
    if (IN(8)) {
        Gemm g{WSP(bf16, WS_XN), WSP(bf16, WS_W2GU), MR, NGU, DM}; StaticOrder S; S.init(MR, NGU, F.G, (int)blockIdx.x);
        pg8::Unit u0{0, 0}; (void)S.next(0, u0);
        pg8::EpiSwiGLU E{WSP(bf16, WS_ACT), DFF, WSP(float, WS_SSQ2), 32, build_rs_table(F, WSP(float, WS_SSQ2), 32, 1.0f / 2048.0f, u0.pm)};
        REPS(8) { pg8::gemm_phase<pg8::EpiSwiGLU, StaticOrder, true, true>(ring, g, S, E); REPBAR(8); }
        SEAM(8);
    }
    if (IN(9)) {
        Gemm g{WSP(bf16, WS_ACT), WSP(bf16, WS_W2D), MR, DM, DFF}; StaticOrder S; S.init(MR, DM, F.G, (int)blockIdx.x);
        pg8::EpiResT<false> E{nullptr, WSP(bf16, WS_XN), F.out, nullptr, nullptr, 0.5f, DM, nullptr, 0, pg8::RsTable{nullptr, -1, -1}};
        pg8::gemm_phase<pg8::EpiResT<false>, StaticOrder, true, true>(ring, g, S, E);
    }
#undef IN
#undef SEAM
}

extern "C" void kernel_launch(void* const* d_in, const int* in_sizes, int n_in, void* d_out, int out_size, void* d_ws, size_t ws_size, hipStream_t stream) {
    static int grid = 0;
    if (grid == 0) {
        if (n_in != 26 || in_sizes[0] != MR * DM || out_size != MR * DM || ws_size < WS_END) { fprintf(stderr, "kernel_launch: unexpected shapes (n_in %d, in0 %d, out %d, ws %zu)\n", n_in, n_in > 0 ? in_sizes[0] : -1, out_size, ws_size); grid = -1; return; }
        int dev = 0, cus = 0, per_cu = 0;
        if (hipGetDevice(&dev) != hipSuccess || hipDeviceGetAttribute(&cus, hipDeviceAttributeMultiprocessorCount, dev) != hipSuccess) { grid = -1; return; }
        if (hipFuncSetAttribute((const void*)hymba_fwd, hipFuncAttributeMaxDynamicSharedMemorySize, LDS_BYTES) != hipSuccess) { fprintf(stderr, "kernel_launch: hipFuncSetAttribute failed\n"); grid = -1; return; }
        if (hipOccupancyMaxActiveBlocksPerMultiprocessor(&per_cu, (const void*)hymba_fwd, NWAVES * 64, LDS_BYTES) != hipSuccess || per_cu < 1) { fprintf(stderr, "kernel_launch: occupancy query says %d blocks per CU\n", per_cu); (void)hipGetLastError(); grid = -1; return; }
        grid = cus;
    }
    if (grid < 0) return;
    (void)hipMemsetAsync((char*)d_ws + WS_CTL, 0, CTL_ZERO_BYTES, stream);
    Args a{};
    for (int i = 0; i < 26; ++i) a.in[i] = (const float*)d_in[i];
    a.out = (float*)d_out; a.ws = (unsigned char*)d_ws;
    for (int li = 0; li < N_LAUNCHES; ++li) {
        a.ph_lo = (N_LAUNCHES == 1) ? 0 : li; a.ph_hi = (N_LAUNCHES == 1) ? NPH : li + 1;
        hipLaunchKernelGGL(hymba_fwd, dim3(grid), dim3(NWAVES * 64), LDS_BYTES, stream, a);
    }
}
```

```cpp
#include <hip/hip_runtime.h>
#include <cstdio>
#include <cstdint>
#include <cmath>
#ifndef MK_AMP
#define MK_AMP 0
#endif
namespace pg8 {
#define PG8_LAS __attribute__((address_space(3)))
typedef unsigned short bf16_t;
typedef short bf16x8 __attribute__((ext_vector_type(8)));
typedef float f32x4 __attribute__((ext_vector_type(4)));
typedef unsigned u32x4 __attribute__((ext_vector_type(4)));
constexpr int BM = 256, BK = 64, HALF = 128, HTB = HALF * BK * 2  , STAGE_BYTES = 8 * HTB, NXCD = 8, WGM = 8;

__host__ __device__ __forceinline__ int lds_byte(int r, int c) { const int st = (r >> 4) * 2 + (c >> 5), rr = r & 15, cc = c & 31, ob = rr * 64 + cc * 2; return st * 1024 + (ob ^ (((ob >> 9) & 1) << 5)); }
__host__ __device__ __forceinline__ void stage_rc(int b, int& R, int& C) { const int st = b / 1024, sb = b % 1024, swz = sb ^ (((sb >> 9) & 1) << 5); R = (st >> 1) * 16 + swz / 64; C = (st & 1) * 32 + (swz % 64) / 2; }
__host__ __device__ __forceinline__ int perm32(int rho) { const int n = rho >> 4, i = rho & 15; return 8 * (i >> 2) + 4 * n + (i & 3); }

struct Unit { int pm, pn; };
struct Gemm { const bf16_t* A; const bf16_t* Bt; int M, N, K; };

struct StaticOrder {
    int nM, nN, nwg, G, c;
    __host__ __device__ void init(int M, int N, int G_, int c_) { nM = M / BM; nN = N / BM; nwg = nM * nN; G = G_; c = c_; }
    __host__ __device__ __forceinline__ bool next(int i, Unit& u) const {
        const long L = (long)i * G + c; if (L >= nwg) return false;
        int wgid = (int)L; { const int q = nwg / NXCD, r = nwg % NXCD, xcd = wgid % NXCD, off = wgid / NXCD; wgid = (xcd < r ? xcd * (q + 1) : r * (q + 1) + (xcd - r) * q) + off; }
        const int nig = WGM * nN, gid = wgid / nig, fm = gid * WGM, gsz = (nM - fm) < WGM ? (nM - fm) : WGM;
        u.pm = fm + ((wgid % nig) % gsz); u.pn = (wgid % nig) / gsz; return true;
    }
    __device__ __forceinline__ void a_ready(const Unit&) const {}
    __device__ __forceinline__ void done(const Unit&) const {}
};


__device__ __forceinline__ unsigned cvt_pk_bf16(float lo, float hi) { unsigned r; asm volatile("v_cvt_pk_bf16_f32 %0, %1, %2" : "=v"(r) : "v"(lo), "v"(hi)); return r; }
typedef unsigned u32x2 __attribute__((ext_vector_type(2)));
constexpr float RMS_EPS = 1e-6f;
__device__ __forceinline__ float row_rs(const float* ssq, int np, int row, float inv_n = 1.0f / 2048.0f) {
    float s;
    if (np == 1) s = ssq[row];
    else { const f32x4* p = (const f32x4*)(ssq + (size_t)row * 32); f32x4 a = p[0];
#pragma unroll
        for (int i = 1; i < 8; ++i) a += p[i];
        s = (a[0] + a[1]) + (a[2] + a[3]); }
    return __builtin_amdgcn_rsqf(s * inv_n + RMS_EPS);
}
struct RsTable { const PG8_LAS float* t; int tpm, tpm2; };
__device__ __forceinline__ float row_rs_t(const RsTable& T, const float* ssq, int np, float inv_n, int pm, int rin) { return (pm == T.tpm) ? T.t[rin] : (pm == T.tpm2) ? T.t[256 + rin] : row_rs(ssq, np, pm * BM + rin, inv_n); }
__device__ __forceinline__ float silu_f(float g) { return g * __builtin_amdgcn_rcpf(1.0f + __builtin_amdgcn_exp2f(-1.4426950408889634f * g)); }

struct EpiSwiGLU {
    static constexpr bool PERM = true, AFTER_DRAIN = false, HAS_MID = false, AMP = (MK_AMP == 11);
    bf16_t* O; int ldc; const float* ssq; int np; RsTable T;
    __device__ __forceinline__ void mid(f32x4 (&)[2][2][4][2], const Unit&, int, int, int, int) const {}
    __device__ __forceinline__ void operator()(const f32x4 (&acc)[2][2][4][2], const Unit& u, int wr, int wc, int fr, int fq) const {
        const int row0 = u.pm * BM + wr * 64 + fr, col0 = u.pn * HALF + wc * 32 + 8 * fq;
#pragma unroll
        for (int ai = 0; ai < 2; ++ai)
#pragma unroll
            for (int m = 0; m < 4; ++m) { const int row = row0 + ai * HALF + m * 16; const float rs = row_rs_t(T, ssq, np, 1.0f / 2048.0f, u.pm, wr * 64 + fr + ai * HALF + m * 16);
                float a[8];
#pragma unroll
                for (int n = 0; n < 2; ++n)
#pragma unroll
                    for (int i = 0; i < 4; ++i) { const float g = acc[ai][0][m][n][i] * rs, up = acc[ai][1][m][n][i] * rs; a[4 * n + i] = silu_f(g) * up; }
                u32x4 w; w.x = cvt_pk_bf16(a[0], a[1]); w.y = cvt_pk_bf16(a[2], a[3]); w.z = cvt_pk_bf16(a[4], a[5]); w.w = cvt_pk_bf16(a[6], a[7]);
                *(u32x4*)(O + (size_t)row * ldc + col0) = w; }
    }
};
template <bool MID> struct EpiResT {
    static constexpr bool PERM = false, AFTER_DRAIN = false, HAS_MID = MID, AMP = false;
    const float* basef; const bf16_t* baseh; float* out; bf16_t* xn; float* ssq; float scale; int ldc; const float* rsm; int kmid; RsTable T;
    __device__ __forceinline__ void mid(f32x4 (&acc)[2][2][4][2], const Unit& u, int wr, int wc, int fr, int fq) const {
        int fro = fr; asm volatile("" : "+v"(fro));
        const int rin0 = wr * 64 + fro;
#pragma unroll
        for (int ai = 0; ai < 2; ++ai)
#pragma unroll
            for (int m = 0; m < 4; ++m) { const float r = row_rs_t(T, rsm, 32, 1.0f / 1024.0f, u.pm, rin0 + ai * HALF + m * 16);
#pragma unroll
                for (int bj = 0; bj < 2; ++bj)
#pragma unroll
                    for (int n = 0; n < 2; ++n) acc[ai][bj][m][n] *= r; }
    }
    __device__ __forceinline__ void operator()(const f32x4 (&acc)[2][2][4][2], const Unit& u, int wr, int wc, int fr, int fq) const {
        const int row0 = u.pm * BM + wr * 64 + fr, col0 = u.pn * BM + wc * 32 + 4 * fq;
#pragma unroll
        for (int ai = 0; ai < 2; ++ai) {
            f32x4 bf[4][2][2]; u32x2 bh[4][2][2];
#pragma unroll
            for (int m = 0; m < 4; ++m)
#pragma unroll
                for (int bj = 0; bj < 2; ++bj)
#pragma unroll
                    for (int n = 0; n < 2; ++n) { const size_t o1 = (size_t)(row0 + ai * HALF + m * 16) * ldc + col0 + bj * HALF + n * 16;
                        if (basef) bf[m][bj][n] = *(const f32x4*)(basef + o1); else bh[m][bj][n] = *(const u32x2*)(baseh + o1); }
#pragma unroll
            for (int m = 0; m < 4; ++m) { const int row = row0 + ai * HALF + m * 16; const size_t off = (size_t)row * ldc + col0; float sq = 0.f;
#pragma unroll
                for (int bj = 0; bj < 2; ++bj)
#pragma unroll
                    for (int n = 0; n < 2; ++n) { const size_t o1 = off + bj * HALF + n * 16; f32x4 b;
                        if (basef) b = bf[m][bj][n];
                        else { const u32x2 h = bh[m][bj][n]; b[0] = __uint_as_float(h.x << 16); b[1] = __uint_as_float(h.x & 0xffff0000u); b[2] = __uint_as_float(h.y << 16); b[3] = __uint_as_float(h.y & 0xffff0000u); }
                        const f32x4 o = b + acc[ai][bj][m][n] * scale;
                        if (out) *(f32x4*)(out + o1) = o;
                        if (xn) { sq += (o[0] * o[0] + o[1] * o[1]) + (o[2] * o[2] + o[3] * o[3]); u32x2 w; w.x = cvt_pk_bf16(o[0], o[1]); w.y = cvt_pk_bf16(o[2], o[3]); *(u32x2*)(xn + o1) = w; } }
                if (xn) { sq += __shfl_xor(sq, 16); sq += __shfl_xor(sq, 32); if (fq == 0) ssq[(size_t)row * 32 + u.pn * 4 + wc] = sq; } }
        }
    }
};
struct EpiInProj {
    static constexpr bool PERM = true, AFTER_DRAIN = false, HAS_MID = false, AMP = (MK_AMP == 12);
    bf16_t* U; int ldc; const float* ssq; const float* qn; const float* kn; const float* rope; RsTable T;
    __device__ __forceinline__ void mid(f32x4 (&)[2][2][4][2], const Unit&, int, int, int, int) const {}
    __device__ __forceinline__ void operator()(const f32x4 (&acc)[2][2][4][2], const Unit& u, int wr, int wc, int fr, int fq) const {
        const int row0 = u.pm * BM + wr * 64 + fr, col0 = u.pn * BM + wc * 64 + 8 * fq;
        const bool isqk = u.pn < 8;
        f32x4 wv[2][2];
        if (isqk) { const float* wn = (u.pn < 4) ? qn : kn;
#pragma unroll
            for (int bj = 0; bj < 2; ++bj)
#pragma unroll
                for (int n = 0; n < 2; ++n) wv[bj][n] = *(const f32x4*)(wn + 32 * bj + 8 * fq + 4 * n); }
#pragma unroll
        for (int ai = 0; ai < 2; ++ai)
#pragma unroll
            for (int m = 0; m < 4; ++m) { const int row = row0 + ai * HALF + m * 16; const float rs = row_rs_t(T, ssq, 32, 1.0f / 2048.0f, u.pm, wr * 64 + fr + ai * HALF + m * 16);
                f32x4 v[2][2];
#pragma unroll
                for (int bj = 0; bj < 2; ++bj)
#pragma unroll
                    for (int n = 0; n < 2; ++n) v[bj][n] = acc[ai][bj][m][n] * rs;
                if (isqk) {
                    float sq = 0.f;
#pragma unroll
                    for (int bj = 0; bj < 2; ++bj)
#pragma unroll
                        for (int n = 0; n < 2; ++n) sq += (v[bj][n][0] * v[bj][n][0] + v[bj][n][1] * v[bj][n][1]) + (v[bj][n][2] * v[bj][n][2] + v[bj][n][3] * v[bj][n][3]);
                    sq += __shfl_xor(sq, 16); sq += __shfl_xor(sq, 32);
                    const float r = __builtin_amdgcn_rsqf(sq * (1.0f / 64.0f) + RMS_EPS);
#pragma unroll
                    for (int bj = 0; bj < 2; ++bj)
#pragma unroll
                        for (int n = 0; n < 2; ++n) v[bj][n] = v[bj][n] * r * wv[bj][n];
                    const int pos = (row & 4095) + 16;
                    const f32x4 c0 = *(const f32x4*)(rope + pos * 16), c1 = *(const f32x4*)(rope + pos * 16 + 4), s0 = *(const f32x4*)(rope + pos * 16 + 8), s1 = *(const f32x4*)(rope + pos * 16 + 12);
                    f32x4 p0, p1;
#pragma unroll
                    for (int i = 0; i < 4; ++i) { p0[i] = __shfl_xor(v[0][0][i], 16); p1[i] = __shfl_xor(v[0][1][i], 16); }
                    if (fq == 0) { v[0][0] = v[0][0] * c0 - p0 * s0; v[0][1] = v[0][1] * c1 - p1 * s1; }
                    else if (fq == 1) { v[0][0] = v[0][0] * c0 + p0 * s0; v[0][1] = v[0][1] * c1 + p1 * s1; }
                    if (u.pn < 4) { v[0][0] *= 0.18033688011112042f; v[0][1] *= 0.18033688011112042f; v[1][0] *= 0.18033688011112042f; v[1][1] *= 0.18033688011112042f; }
                }
#pragma unroll
                for (int bj = 0; bj < 2; ++bj) { u32x4 w; w.x = cvt_pk_bf16(v[bj][0][0], v[bj][0][1]); w.y = cvt_pk_bf16(v[bj][0][2], v[bj][0][3]); w.z = cvt_pk_bf16(v[bj][1][0], v[bj][1][1]); w.w = cvt_pk_bf16(v[bj][1][2], v[bj][1][3]);
                    *(u32x4*)(U + (size_t)row * ldc + col0 + 32 * bj) = w; } }
    }
};

template <class Epi, class Sched, bool ALIGN_EPI = false, bool SP2 = false>
__device__ __forceinline__ void gemm_phase(PG8_LAS unsigned char* lds, const Gemm g, const Sched& S, const Epi& E) {
    const int tid = threadIdx.x, wid = __builtin_amdgcn_readfirstlane(tid >> 6), lane = tid & 63, wr = wid >> 2, wc = wid & 3, fr = lane & 15, fq = lane >> 4;
    const int K = g.K, nt = K / BK;
    unsigned voffA[2], voffB[2];
#pragma unroll
    for (int i = 0; i < 2; ++i) { int R, C; stage_rc(tid * 16 + i * 8192, R, C); const int Rb = Epi::PERM ? ((R & ~31) + perm32(R & 31)) : R;
        voffA[i] = (unsigned)(R * K + C) * 2u; voffB[i] = (unsigned)(Rb * K + C) * 2u; }
    const size_t kstep = (size_t)(BK * 2);
    const size_t hstep = (size_t)HALF * K * 2;
    const size_t tstep = 2 * hstep;
    const unsigned ldsw = (unsigned)wid * 1024u;
    const int aoff = lds_byte(wr * 64 + fr, fq * 8), boff = lds_byte(wc * 32 + fr, fq * 8);
#define PG8_SA(b, h) (((b) * 2 + (h)) * HTB)
#define PG8_SB(b, h) ((4 + (b) * 2 + (h)) * HTB)
#define PG8_STAGE(bufoff, gbase, voff) do { _Pragma("unroll") for (int _i = 0; _i < 2; ++_i) \
        __builtin_amdgcn_global_load_lds((const unsigned*)((const char*)(gbase) + (voff)[_i]), (PG8_LAS unsigned*)(lds + (bufoff) + ldsw + _i * 8192), 16, 0, 0); } while (0)
#define PG8_LDA(dst, b, h) do { _Pragma("unroll") for (int m = 0; m < 4; ++m) _Pragma("unroll") for (int k = 0; k < 2; ++k) dst[m][k] = *(const PG8_LAS bf16x8*)(lds + PG8_SA(b, h) + aoff + m * 2048 + k * 1024); } while (0)
#define PG8_LDB(dst, b, h) do { _Pragma("unroll") for (int n = 0; n < 2; ++n) _Pragma("unroll") for (int k = 0; k < 2; ++k) dst[n][k] = *(const PG8_LAS bf16x8*)(lds + PG8_SB(b, h) + boff + n * 2048 + k * 1024); } while (0)
#define PG8_MMA(ai, bj, At, Bt) do { __builtin_amdgcn_s_setprio(1); _Pragma("unroll") for (int m = 0; m < 4; ++m) _Pragma("unroll") for (int n = 0; n < 2; ++n) _Pragma("unroll") for (int k = 0; k < 2; ++k) \
        acc[ai][bj][m][n] = __builtin_amdgcn_mfma_f32_16x16x32_bf16(Bt[n][k], At[m][k], acc[ai][bj][m][n], 0, 0, 0); __builtin_amdgcn_s_setprio(0); } while (0)
#define PG8_WAIT_V(n) asm volatile("s_waitcnt vmcnt(" #n ")" ::: "memory")
#define PG8_WAIT_L(n) asm volatile("s_waitcnt lgkmcnt(" #n ")" ::: "memory")
#define PG8_BAR __builtin_amdgcn_s_barrier()
#define PG8_SCHED __builtin_amdgcn_sched_barrier(0)
    Unit cur, nxt; int ui = 0;
    if (!S.next(0, cur)) return;
    f32x4 acc[2][2][4][2];
#pragma unroll
    for (int a = 0; a < 2; ++a)
#pragma unroll
        for (int b = 0; b < 2; ++b)
#pragma unroll
            for (int m = 0; m < 4; ++m)
#pragma unroll
                for (int n = 0; n < 2; ++n) acc[a][b][m][n] = (f32x4){0.f, 0.f, 0.f, 0.f};
    bf16x8 At[4][2], B0[2][2], B1[2][2];
    const char* cA = (const char*)g.A + (size_t)cur.pm * tstep; const char* cB = (const char*)g.Bt + (size_t)cur.pn * tstep;
    S.a_ready(cur);
    if constexpr (SP2) {
        PG8_STAGE(PG8_SB(0, 0), cB, voffB); PG8_STAGE(PG8_SB(0, 1), cB + hstep, voffB); PG8_STAGE(PG8_SA(0, 0), cA, voffA); PG8_STAGE(PG8_SA(0, 1), cA + hstep, voffA);
        if (wr == 1) PG8_BAR;
        PG8_WAIT_V(2); PG8_BAR;
        PG8_STAGE(PG8_SB(1, 0), cB + kstep, voffB); PG8_STAGE(PG8_SA(1, 0), cA + kstep, voffA); PG8_STAGE(PG8_SB(1, 1), cB + hstep + kstep, voffB);
        PG8_WAIT_V(6); PG8_BAR;
    } else {
        PG8_STAGE(PG8_SB(0, 0), cB, voffB); PG8_STAGE(PG8_SA(0, 0), cA, voffA); PG8_STAGE(PG8_SB(0, 1), cB + hstep, voffB); PG8_STAGE(PG8_SA(0, 1), cA + hstep, voffA);
        if (wr == 1) PG8_BAR;
        PG8_WAIT_V(4); PG8_BAR;
        PG8_STAGE(PG8_SB(1, 0), cB + kstep, voffB); PG8_STAGE(PG8_SA(1, 0), cA + kstep, voffA); PG8_STAGE(PG8_SB(1, 1), cB + hstep + kstep, voffB);
        PG8_WAIT_V(6); PG8_BAR;
    }
    for (;;) {
        const bool has_next = S.next(ui + 1, nxt);
        const char* nA = has_next ? (const char*)g.A + (size_t)nxt.pm * tstep : cA; const char* nB = has_next ? (const char*)g.Bt + (size_t)nxt.pn * tstep : cB;
        for (int t = 0; t < nt; t += 2) {
            const bool last = (t == nt - 2);
            if constexpr (Epi::HAS_MID) { if (t == E.kmid) E.mid(acc, cur, wr, wc, fr, fq); }
            const char* a1 = cA + (size_t)(t + 1) * kstep;
            const char* a2 = last ? nA : cA + (size_t)(t + 2) * kstep; const char* b2 = last ? nB : cB + (size_t)(t + 2) * kstep;
            const char* a3 = a2 + kstep; const char* b3 = b2 + kstep;
            if (last && has_next) S.a_ready(nxt);
            if constexpr (SP2) {
            PG8_LDB(B0, 0, 0); PG8_LDB(B1, 0, 1); PG8_SCHED; PG8_LDA(At, 0, 0); PG8_STAGE(PG8_SA(1, 1), a1 + hstep, voffA);
            PG8_WAIT_V(8); PG8_WAIT_L(0); PG8_BAR; PG8_MMA(0, 0, At, B0); PG8_MMA(0, 1, At, B1); PG8_BAR; PG8_SCHED;
            PG8_LDA(At, 0, 1); PG8_STAGE(PG8_SB(0, 0), b2, voffB); PG8_STAGE(PG8_SB(0, 1), b2 + hstep, voffB); PG8_STAGE(PG8_SA(0, 0), a2, voffA);
            PG8_WAIT_V(8); PG8_WAIT_L(0); PG8_BAR; PG8_MMA(1, 0, At, B0); PG8_MMA(1, 1, At, B1); PG8_BAR; PG8_SCHED;
            PG8_LDB(B0, 1, 0); PG8_LDB(B1, 1, 1); PG8_SCHED; PG8_LDA(At, 1, 0); PG8_STAGE(PG8_SA(0, 1), a2 + hstep, voffA);
            PG8_WAIT_V(8); PG8_WAIT_L(0); PG8_BAR; PG8_MMA(0, 0, At, B0); PG8_MMA(0, 1, At, B1); PG8_BAR; PG8_SCHED;
            PG8_LDA(At, 1, 1); PG8_STAGE(PG8_SB(1, 0), b3, voffB); PG8_STAGE(PG8_SB(1, 1), b3 + hstep, voffB); PG8_STAGE(PG8_SA(1, 0), a3, voffA);
            PG8_WAIT_V(8); PG8_WAIT_L(0); PG8_BAR; PG8_MMA(1, 0, At, B0); PG8_MMA(1, 1, At, B1); PG8_BAR; PG8_SCHED;
            } else {
            PG8_LDB(B0, 0, 0); PG8_SCHED; PG8_LDA(At, 0, 0); PG8_STAGE(PG8_SA(1, 1), a1 + hstep, voffA);
            PG8_WAIT_L(8); PG8_BAR; PG8_WAIT_L(0); PG8_MMA(0, 0, At, B0); PG8_BAR; PG8_SCHED;
            PG8_LDB(B1, 0, 1); PG8_STAGE(PG8_SB(0, 0), b2, voffB);
            PG8_BAR; PG8_WAIT_L(0); PG8_MMA(0, 1, At, B1); PG8_BAR;
            PG8_LDA(At, 0, 1); PG8_STAGE(PG8_SA(0, 0), a2, voffA);
            PG8_BAR; PG8_WAIT_L(0); PG8_MMA(1, 0, At, B0); PG8_BAR; PG8_SCHED;
            PG8_STAGE(PG8_SB(0, 1), b2 + hstep, voffB);
            PG8_WAIT_V(6); PG8_BAR; PG8_MMA(1, 1, At, B1); PG8_BAR;
            PG8_LDB(B0, 1, 0); PG8_SCHED; PG8_LDA(At, 1, 0); PG8_STAGE(PG8_SA(0, 1), a2 + hstep, voffA);
            PG8_WAIT_L(8); PG8_BAR; PG8_WAIT_L(0); PG8_MMA(0, 0, At, B0); PG8_BAR; PG8_SCHED;
            PG8_LDB(B1, 1, 1); PG8_STAGE(PG8_SB(1, 0), b3, voffB);
            PG8_BAR; PG8_WAIT_L(0); PG8_MMA(0, 1, At, B1); PG8_BAR;
            PG8_LDA(At, 1, 1); PG8_STAGE(PG8_SA(1, 0), a3, voffA);
            PG8_BAR; PG8_WAIT_L(0); PG8_MMA(1, 0, At, B0); PG8_BAR; PG8_SCHED;
            PG8_STAGE(PG8_SB(1, 1), b3 + hstep, voffB);
            PG8_WAIT_V(6); PG8_BAR; PG8_MMA(1, 1, At, B1); PG8_BAR;
            }
        }
        if constexpr (ALIGN_EPI) { if (wr == 0) PG8_BAR; }
        if constexpr (!Epi::AFTER_DRAIN) { for (int amp_ = 0; amp_ < (Epi::AMP ? 3 : 1); ++amp_) { E(acc, cur, wr, wc, fr, fq); asm volatile("" ::: "memory"); } S.done(cur); }
        if (!has_next) break;
#pragma unroll
        for (int a = 0; a < 2; ++a)
#pragma unroll
            for (int b = 0; b < 2; ++b)
#pragma unroll
                for (int m = 0; m < 4; ++m)
#pragma unroll
                    for (int n = 0; n < 2; ++n) acc[a][b][m][n] = (f32x4){0.f, 0.f, 0.f, 0.f};
        cur = nxt; cA = nA; cB = nB; ++ui;
        if constexpr (ALIGN_EPI) { if (wr == 1) PG8_BAR; }
    }
    PG8_WAIT_V(0);
    if constexpr (!ALIGN_EPI) { if (wr == 0) PG8_BAR; }
    PG8_BAR;
    if constexpr (Epi::AFTER_DRAIN) { E.fused(acc, cur, wr, wc, fr, fq, lds, wid, lane); S.done(cur); }
#undef PG8_SA
#undef PG8_SB
#undef PG8_STAGE
#undef PG8_LDA
#undef PG8_LDB
#undef PG8_MMA
#undef PG8_WAIT_V
#undef PG8_WAIT_L
#undef PG8_BAR
#undef PG8_SCHED
}
}

#ifndef PG8_SP2
#define PG8_SP2 true
#endif

constexpr int NWAVES = 8;
constexpr int DM = 2048, SEQ = 4096, NBATCH = 2, MR = NBATCH * SEQ, NMETA = 16, LPOS = SEQ + NMETA;
constexpr int DFF = 5632, NGU = 2 * DFF;
constexpr int NHEAD = 8, SH = 16, CONVD = 1536, NIN = 5648, NINP = 5632;
constexpr int PPAD = 48, LPAD = LPOS + PPAD;
constexpr float EPS = 1e-6f;
#ifndef MK_REPEAT_PHASE
#define MK_REPEAT_PHASE -1
#endif
#ifndef MK_N_LAUNCHES
#define MK_N_LAUNCHES 1
#endif
constexpr int NPH = 10;
constexpr int N_LAUNCHES = MK_N_LAUNCHES;

constexpr size_t MiB = 1u << 20;
constexpr size_t WS_CTL = 0, CTL_ZERO_BYTES = 1 * MiB;
constexpr size_t WS_W1GU = 2 * MiB, WS_W1D = 46 * MiB, WS_WIN = 68 * MiB, WS_WOUT = 91 * MiB, WS_W2GU = 99 * MiB, WS_W2D = 143 * MiB;
constexpr size_t WS_XN = 165 * MiB;
constexpr size_t WS_ACT = 197 * MiB;
constexpr size_t WS_MIX = 285 * MiB;
constexpr size_t WS_SSQ0 = 317 * MiB;
constexpr size_t WS_SSQ1 = 318 * MiB, WS_SSQ2 = 319 * MiB;
constexpr size_t WS_DTR = 320 * MiB;
constexpr size_t WS_ROPE = 321 * MiB;
constexpr size_t WS_META = 322 * MiB;
constexpr size_t MO_XN = 0, MO_SSQ0 = 65536, MO_ACT = 131072, MO_H1 = 327680, MO_XN1 = 458752, MO_U = 524288, MO_KM = 917504, MO_VM = 950272, MO_SSQ1 = 69632;
constexpr size_t WS_SST = 324 * MiB;
constexpr size_t WS_ATOT = 333 * MiB;
constexpr size_t WS_SSQS = 334 * MiB;
constexpr size_t WS_XS = 336 * MiB;
constexpr size_t WS_BC = 353 * MiB;
constexpr size_t WS_DT = 362 * MiB;
constexpr size_t WS_END = 363 * MiB;
constexpr int CW_BAR = 4096;

constexpr int RING_OFF = 0, RING_BYTES = 131072;
constexpr int LDS_BYTES = 147456, MISC_OFF = LDS_BYTES - 512;

#define GAS __attribute__((address_space(1)))
#define LAS __attribute__((address_space(3)))
typedef unsigned short bf16;
typedef unsigned v4u __attribute__((ext_vector_type(4)));
typedef float f32x4 __attribute__((ext_vector_type(4)));
typedef short bf16x8 __attribute__((ext_vector_type(8)));
typedef GAS unsigned gu32;
typedef GAS unsigned long long gu64;
#define RLX_AGENT __ATOMIC_RELAXED, __HIP_MEMORY_SCOPE_AGENT
#define LDS_WAIT() asm volatile("s_waitcnt lgkmcnt(0)" ::: "memory")
#define VM_WAIT() asm volatile("s_waitcnt vmcnt(0)" ::: "memory")
__device__ __forceinline__ unsigned long long rt() { return __builtin_amdgcn_s_memrealtime(); }
__device__ __forceinline__ unsigned f2bf(float f) { unsigned u = __builtin_bit_cast(unsigned, f); return (u + 0x7fffu + ((u >> 16) & 1u)) >> 16; }
__device__ __forceinline__ unsigned pk2(float lo, float hi) { return f2bf(lo) | (f2bf(hi) << 16); }

#define XB_TMO      128
#define XB_XCNT(j)  (256  + 64 * (j))
#define XB_XSUB(j)  (1280 + 64 * (j))
#define XB_XGEN(j)  (2304 + 64 * (j))
#define XB_TOP      3328
#define XB_TOPGEN   3392
#define XCD_BAR_WORDS 3456
#define XB_SPIN_CAP (1u << 18)

__device__ __forceinline__ unsigned xb_ld(unsigned* p)              { return __hip_atomic_load(p, __ATOMIC_RELAXED, __HIP_MEMORY_SCOPE_AGENT); }
__device__ __forceinline__ unsigned xb_add(unsigned* p, unsigned v) { return __hip_atomic_fetch_add(p, v, __ATOMIC_RELAXED, __HIP_MEMORY_SCOPE_AGENT); }
__device__ __forceinline__ unsigned xb_xcc_id() { return (unsigned)__builtin_amdgcn_s_getreg((3 << 11) | 20) & 0xFu; }
#define XB_SPIN(cond, bar) do { unsigned _sp = 0; while (cond) { __builtin_amdgcn_s_sleep(1); \
    if ((++_sp & 255u) == 0u) { if (xb_ld(&(bar)[XB_TMO])) break; if (_sp > XB_SPIN_CAP) { atomicAdd(&(bar)[XB_TMO], 1u); break; } } } } while (0)

struct XcdBarrier {
    unsigned* bar; unsigned x;
    volatile LAS unsigned* st;
};

__device__ __forceinline__ XcdBarrier xcd_barrier_post(unsigned* bar, volatile LAS unsigned* st) {
    XcdBarrier b; b.bar = bar; b.x = xb_xcc_id(); b.st = st;
    if (threadIdx.x == 0) (void)xb_add(&bar[XB_XCNT(b.x)], 1u);
    return b;
}
__device__ __forceinline__ void xcd_barrier_complete(unsigned* bar, unsigned x, unsigned& nloc, unsigned& nx) {
    const unsigned G = gridDim.x * gridDim.y * gridDim.z;
    unsigned sum, cnt, mine, sp = 0u;
    for (;;) {
        sum = 0u; cnt = 0u; mine = 0u;
#pragma unroll
        for (unsigned j = 0; j < 16; ++j) { const unsigned c = xb_ld(&bar[XB_XCNT(j)]); sum += c; cnt += (c > 0u) ? 1u : 0u; mine = (j == x) ? c : mine; }
        if (sum == G) break;
        __builtin_amdgcn_s_sleep(1);
        if ((++sp & 255u) == 0u) { if (xb_ld(&bar[XB_TMO])) break; if (sp > XB_SPIN_CAP) { atomicAdd(&bar[XB_TMO], 1u); break; } }
    }
    nloc = mine > 0u ? mine : 1u; nx = cnt > 0u ? cnt : 1u;
}

__device__ __forceinline__ void xcd_barrier(const XcdBarrier& b) {
    asm volatile("s_waitcnt vmcnt(0)" ::: "memory");
    __syncthreads();
    if (threadIdx.x == 0) {
        unsigned* bar = b.bar;
        __builtin_amdgcn_s_waitcnt(0);
        unsigned nloc = b.st[0], nx = b.st[1];
        if (nloc == 0u) { xcd_barrier_complete(bar, b.x, nloc, nx); b.st[0] = nloc; b.st[1] = nx; }
        const unsigned old = xb_add(&bar[XB_XSUB(b.x)], 1u);
        const unsigned gen = old / nloc;
        if (old + 1u == (gen + 1u) * nloc) {
            __builtin_amdgcn_fence(__ATOMIC_RELEASE, "agent");
            asm volatile("s_waitcnt vmcnt(0)" ::: "memory");
            const unsigned og = xb_add(&bar[XB_TOP], 1u);
            const unsigned tg = og / nx;
            if (og + 1u == (tg + 1u) * nx) xb_add(&bar[XB_TOPGEN], 1u);
            else XB_SPIN(xb_ld(&bar[XB_TOPGEN]) == tg, bar);
            __builtin_amdgcn_fence(__ATOMIC_ACQUIRE, "agent");
            xb_add(&bar[XB_XGEN(b.x)], 1u);
            asm volatile("s_waitcnt vmcnt(0)" ::: "memory");
        } else {
            XB_SPIN(xb_ld(&bar[XB_XGEN(b.x)]) == gen, bar);
            __builtin_amdgcn_fence(__ATOMIC_ACQUIRE, "agent");
            asm volatile("s_waitcnt vmcnt(0)" ::: "memory");
        }
    }
    __syncthreads();
}


typedef unsigned u32x2v __attribute__((ext_vector_type(2)));
__device__ __forceinline__ float bf2f(unsigned b) { return __uint_as_float(b << 16); }
__device__ __forceinline__ float wave_sum(float v) {
#pragma unroll
    for (int o = 1; o < 64; o <<= 1) v += __shfl_xor(v, o);
    return v;
}
__device__ __forceinline__ float wave_max(float v) {
#pragma unroll
    for (int o = 1; o < 64; o <<= 1) v = fmaxf(v, __shfl_xor(v, o));
    return v;
}
__device__ __forceinline__ float silu1(float g) { return g * __builtin_amdgcn_rcpf(1.0f + __builtin_amdgcn_exp2f(-1.4426950408889634f * g)); }

struct Frame {
    LAS unsigned char* lds;
    int tid, lane, wave, G, gw, NGW;
    const float* in[26]; float* out; unsigned char* ws; const float* const* inp;
};
#define WSP(T, off) ((T*)(F.ws + (off)))

constexpr int RST_OFF = RING_BYTES;
__device__ __forceinline__ pg8::RsTable build_rs_table(Frame& F, const float* ssq, int np, float inv_n, int pm, int pm2 = -1) {
    LAS float* t = (LAS float*)(F.lds + RST_OFF);
    if (F.tid < 256) t[F.tid] = pg8::row_rs(ssq, np, pm * 256 + F.tid, inv_n);
    else if (pm2 >= 0) t[F.tid] = pg8::row_rs(ssq, np, pm2 * 256 + F.tid - 256, inv_n);
    __syncthreads();
    return pg8::RsTable{t, pm, pm2};
}
__device__ __forceinline__ int rowmap(int kind, int n) {
    if (kind == 1) return 256 * (n >> 7) + (n & 127);
    if (kind == 2) return 256 * (n >> 7) + 128 + (n & 127);
    if (kind == 3) { if (n >= NINP) return n; const int pn = n >> 8, rem = n & 255, wc = rem >> 6, bj = (rem >> 5) & 1, j = rem & 31; return 256 * pn + 128 * bj + 32 * wc + j; }
    return n;
}
struct TItem { const float* W; int K, N; const float* kscale; bf16* WT; int kind, item, ks_off, krot; };
__device__ __forceinline__ void transpose_load(const TItem& t, int lane, f32x4 (&v)[16]) {
    const int nblk = (t.N + 63) >> 6, kb = t.item / nblk, nb = t.item - kb * nblk, k0 = 64 * kb, n0 = 64 * nb;
    const float* src = t.W + (size_t)(k0 + 8 * (lane >> 3)) * t.N;
#pragma unroll
    for (int h = 0; h < 2; ++h) { int nl = n0 + 32 * h + 4 * (lane & 7); nl = nl < t.N ? nl : t.N - 4;
#pragma unroll
        for (int i = 0; i < 8; ++i) v[8 * h + i] = __builtin_nontemporal_load((const f32x4*)(src + (size_t)i * t.N + nl)); }
}
__device__ __forceinline__ void transpose_finish(const TItem& t, int lane, f32x4 (&v)[16]) {
    const int nblk = (t.N + 63) >> 6, kb = t.item / nblk, nb = t.item - kb * nblk, k0 = 64 * kb, n0 = 64 * nb, r = lane >> 3;
    float sc[8];
    if (t.kscale && k0 >= t.ks_off) { const f32x4 s0 = *(const f32x4*)(t.kscale + k0 + 8 * r - t.ks_off), s1 = *(const f32x4*)(t.kscale + k0 + 8 * r - t.ks_off + 4);
        sc[0] = s0[0]; sc[1] = s0[1]; sc[2] = s0[2]; sc[3] = s0[3]; sc[4] = s1[0]; sc[5] = s1[1]; sc[6] = s1[2]; sc[7] = s1[3]; }
    else {
#pragma unroll
        for (int i = 0; i < 8; ++i) sc[i] = 1.0f; }
    int kd = k0 + t.krot; if (kd >= t.K) kd -= t.K;
#pragma unroll
    for (int h = 0; h < 2; ++h)
#pragma unroll
        for (int j = 0; j < 4; ++j) { const int n = n0 + 32 * h + 4 * (lane & 7) + j;
            v4u o; o.x = pg8::cvt_pk_bf16(v[8 * h + 0][j] * sc[0], v[8 * h + 1][j] * sc[1]); o.y = pg8::cvt_pk_bf16(v[8 * h + 2][j] * sc[2], v[8 * h + 3][j] * sc[3]);
            o.z = pg8::cvt_pk_bf16(v[8 * h + 4][j] * sc[4], v[8 * h + 5][j] * sc[5]); o.w = pg8::cvt_pk_bf16(v[8 * h + 6][j] * sc[6], v[8 * h + 7][j] * sc[7]);
            if (n < t.N) *(v4u*)(t.WT + (size_t)rowmap(t.kind, n) * t.K + kd + 8 * r) = o; }
}
__device__ __forceinline__ void transpose_load_h(const TItem& t, int lane, int h, f32x4 (&v)[8]) {
    const int nblk = (t.N + 63) >> 6, kb = t.item / nblk, nb = t.item - kb * nblk, k0 = 64 * kb, n0 = 64 * nb;
    const float* src = t.W + (size_t)(k0 + 8 * (lane >> 3)) * t.N;
    int nl = n0 + 32 * h + 4 * (lane & 7); nl = nl < t.N ? nl : t.N - 4;
#pragma unroll
    for (int i = 0; i < 8; ++i) v[i] = __builtin_nontemporal_load((const f32x4*)(src + (size_t)i * t.N + nl));
}
__device__ __forceinline__ void transpose_finish_h(const TItem& t, int lane, int h, f32x4 (&v)[8]) {
    const int nblk = (t.N + 63) >> 6, kb = t.item / nblk, nb = t.item - kb * nblk, k0 = 64 * kb, n0 = 64 * nb, r = lane >> 3;
    float sc[8];
    if (t.kscale && k0 >= t.ks_off) { const f32x4 s0 = *(const f32x4*)(t.kscale + k0 + 8 * r - t.ks_off), s1 = *(const f32x4*)(t.kscale + k0 + 8 * r - t.ks_off + 4);
        sc[0] = s0[0]; sc[1] = s0[1]; sc[2] = s0[2]; sc[3] = s0[3]; sc[4] = s1[0]; sc[5] = s1[1]; sc[6] = s1[2]; sc[7] = s1[3]; }
    else {
#pragma unroll
        for (int i = 0; i < 8; ++i) sc[i] = 1.0f; }
    int kd = k0 + t.krot; if (kd >= t.K) kd -= t.K;
#pragma unroll
    for (int j = 0; j < 4; ++j) { const int n = n0 + 32 * h + 4 * (lane & 7) + j;
        v4u o; o.x = pg8::cvt_pk_bf16(v[0][j] * sc[0], v[1][j] * sc[1]); o.y = pg8::cvt_pk_bf16(v[2][j] * sc[2], v[3][j] * sc[3]);
        o.z = pg8::cvt_pk_bf16(v[4][j] * sc[4], v[5][j] * sc[5]); o.w = pg8::cvt_pk_bf16(v[6][j] * sc[6], v[7][j] * sc[7]);
        if (n < t.N) *(v4u*)(t.WT + (size_t)rowmap(t.kind, n) * t.K + kd + 8 * r) = o; }
}
__device__ __forceinline__ void row_to_bf16(const float* xrow, bf16* orow, float* ssq, int lane) {
    const f32x4* xr = (const f32x4*)xrow + lane; float s = 0.f; f32x4 v[8];
#pragma unroll
    for (int j = 0; j < 8; ++j) { v[j] = __builtin_nontemporal_load(xr + 64 * j); s += (v[j][0] * v[j][0] + v[j][1] * v[j][1]) + (v[j][2] * v[j][2] + v[j][3] * v[j][3]); }
    s = wave_sum(s);
    u32x2v* o8 = (u32x2v*)orow + lane;
#pragma unroll
    for (int j = 0; j < 8; ++j) { u32x2v w; w.x = pk2(v[j][0], v[j][1]); w.y = pk2(v[j][2], v[j][3]); o8[64 * j] = w; }
    if (lane == 0) *ssq = s;
}
__constant__ float ROPE_INV[8] = {1.0f, 0.1939227432012558f, 0.03760603070259094f, 0.007292664609849453f, 0.0014142135623842478f, 0.00027424818836152554f, 5.318296098266728e-05f, 1.0313386155758053e-05f};
constexpr int I_G = 32 * 88, I_D = 88 * 32, I_IN = 32 * 89, I_O = 32 * 32;
constexpr int IT_W1G = 0, IT_W1U = IT_W1G + I_G, IT_WOUT = IT_W1U + I_G, IT_W1D = IT_WOUT + I_O, IT_WIN = IT_W1D + I_D, IT_W2U = IT_WIN + I_IN, IT_W2G = IT_W2U + I_G, IT_W2D = IT_W2G + I_G, IT_END = IT_W2D + I_D;
#ifndef MK_N1
#define MK_N1 6944
#endif
constexpr int IT_BG = IT_END - 8192;
constexpr int IT_CUT0 = IT_BG - MK_N1;
static_assert(IT_CUT0 >= IT_WOUT, "W1 gate/up are needed by P1");
__device__ __forceinline__ TItem mk_item(Frame& F, int it) {
    const int m = (it >= IT_W1U) + (it >= IT_WOUT) + (it >= IT_W1D) + (it >= IT_WIN) + (it >= IT_W2U) + (it >= IT_W2G) + (it >= IT_W2D);
    const int start = m == 0 ? IT_W1G : m == 1 ? IT_W1U : m == 2 ? IT_WOUT : m == 3 ? IT_W1D : m == 4 ? IT_WIN : m == 5 ? IT_W2U : m == 6 ? IT_W2G : IT_W2D;
    const unsigned long long WI = 0x1917180705150403ull, SI = 0xff161606ff140202ull;
    const int wi = (int)((WI >> (8 * m)) & 0xffu), si = (int)((SI >> (8 * m)) & 0xffu);
    const bool down = (m == 3 || m == 7);
    const size_t wto = m < 2 ? WS_W1GU : m == 2 ? WS_WOUT : m == 3 ? WS_W1D : m == 4 ? WS_WIN : m < 7 ? WS_W2GU : WS_W2D;
    const int kind = (m == 0 || m == 6) ? 1 : (m == 1 || m == 5) ? 2 : m == 4 ? 3 : 0;
    TItem t; t.W = F.inp[wi]; t.K = down ? DFF : DM; t.N = down ? DM : m == 2 ? DM : m == 4 ? NIN : DFF; t.kscale = si == 0xff ? nullptr : F.inp[si]; t.WT = WSP(bf16, wto); t.kind = kind; t.item = it - start;
    t.ks_off = m == 2 ? 1024 : 0; t.krot = m == 2 ? 1024 : 0;
    return t;
}
__device__ __forceinline__ void convert_items(Frame& F, int lo, int hi, int w, int nw) {
    if (w < 0) return;
    f32x4 va[16], vb[16]; int it = lo + w;
    if (it < hi) { TItem ta = mk_item(F, it); transpose_load(ta, F.lane, va);
        for (;;) {
            const int itb = it + nw; TItem tb = mk_item(F, itb < hi ? itb : it);
            if (itb < hi) transpose_load(tb, F.lane, vb);
            transpose_finish(ta, F.lane, va);
            if (itb >= hi) break;
            const int itc = itb + nw; ta = mk_item(F, itc < hi ? itc : itb);
            if (itc < hi) transpose_load(ta, F.lane, va);
            transpose_finish(tb, F.lane, vb);
            if (itc >= hi) break;
            it = itc;
        } }
}
__device__ __forceinline__ void p0_prologue(Frame& F) {
    convert_items(F, 0, IT_CUT0, F.gw, F.NGW);
    for (int m = F.gw; m < MR; m += 2 * F.NGW) {
        const int m2 = m + F.NGW;
        const f32x4* xa = (const f32x4*)(F.in[0] + (size_t)m * DM) + F.lane; const f32x4* xb = (const f32x4*)(F.in[0] + (size_t)(m2 < MR ? m2 : m) * DM) + F.lane;
        f32x4 va[8], vb[8]; float sa = 0.f, sb = 0.f;
#pragma unroll
        for (int j = 0; j < 8; ++j) { va[j] = __builtin_nontemporal_load(xa + 64 * j); vb[j] = __builtin_nontemporal_load(xb + 64 * j); }
#pragma unroll
        for (int j = 0; j < 8; ++j) { sa += (va[j][0] * va[j][0] + va[j][1] * va[j][1]) + (va[j][2] * va[j][2] + va[j][3] * va[j][3]); sb += (vb[j][0] * vb[j][0] + vb[j][1] * vb[j][1]) + (vb[j][2] * vb[j][2] + vb[j][3] * vb[j][3]); }
        sa = wave_sum(sa); sb = wave_sum(sb);
        u32x2v* oa = (u32x2v*)(WSP(bf16, WS_XN) + (size_t)m * DM) + F.lane; u32x2v* ob = (u32x2v*)(WSP(bf16, WS_XN) + (size_t)m2 * DM) + F.lane;
#pragma unroll
        for (int j = 0; j < 8; ++j) { u32x2v w; w.x = pk2(va[j][0], va[j][1]); w.y = pk2(va[j][2], va[j][3]); oa[64 * j] = w; }
        if (F.lane == 0) WSP(float, WS_SSQ0)[m] = sa;
        if (m2 < MR) {
#pragma unroll
            for (int j = 0; j < 8; ++j) { u32x2v w; w.x = pk2(vb[j][0], vb[j][1]); w.y = pk2(vb[j][2], vb[j][3]); ob[64 * j] = w; }
            if (F.lane == 0) WSP(float, WS_SSQ0)[m2] = sb; }
    }
    for (int p = F.gw; p < NMETA; p += F.NGW) row_to_bf16(F.in[1] + (size_t)p * DM, WSP(bf16, WS_META + MO_XN) + (size_t)p * DM, WSP(float, WS_META + MO_SSQ0) + p, F.lane);
    for (int e = F.gw * 64 + F.lane; e < LPOS * 8; e += F.NGW * 64) { const int pos = e >> 3, i = e & 7;
        const float ang = (float)pos * ROPE_INV[i];
        double tr = (double)ang * 0.15915494309189535; tr -= __builtin_rint(tr);
        const float tf = (float)tr;
        WSP(float, WS_ROPE)[pos * 16 + i] = __builtin_amdgcn_cosf(tf); WSP(float, WS_ROPE)[pos * 16 + 8 + i] = __builtin_amdgcn_sinf(tf); }
}

__device__ __forceinline__ f32x4 skinny16(const bf16* A, int lda, const bf16* Bt, int ldb, int k0, int k1, int lane, f32x4 acc) {
    const bf16* ap = A + (size_t)(lane & 15) * lda + 8 * (lane >> 4);
    const bf16* bp = Bt + (size_t)(lane & 15) * ldb + 8 * (lane >> 4);
#pragma unroll 16
    for (int k = k0; k < k1; k += 32) { const bf16x8 a = *(const bf16x8*)(ap + k), b = *(const bf16x8*)(bp + k);
        acc = __builtin_amdgcn_mfma_f32_16x16x32_bf16(a, b, acc, 0, 0, 0); }
    asm volatile("s_nop 15\n\ts_nop 3" : "+v"(acc));
    return acc;
}
__device__ __forceinline__ void meta_gateup(Frame& F, int w0, int wstride) {
    const bf16* A = WSP(bf16, WS_META + MO_XN); const float* ssq = WSP(float, WS_META + MO_SSQ0); bf16* act = WSP(bf16, WS_META + MO_ACT);
    if (w0 < 0) return;
    for (int it = w0; it < DFF / 16; it += wstride) { const int c0 = 16 * it, rg = 256 * (c0 >> 7) + (c0 & 127);
        f32x4 g = (f32x4){0.f, 0.f, 0.f, 0.f}, u = g;
        g = skinny16(A, DM, WSP(bf16, WS_W1GU) + (size_t)rg * DM, DM, 0, DM, F.lane, g);
        u = skinny16(A, DM, WSP(bf16, WS_W1GU) + (size_t)(rg + 128) * DM, DM, 0, DM, F.lane, u);
#pragma unroll
        for (int i = 0; i < 4; ++i) { const int row = 4 * (F.lane >> 4) + i; const float rs = __builtin_amdgcn_rsqf(ssq[row] * (1.0f / 2048.0f) + EPS);
            act[row * DFF + c0 + (F.lane & 15)] = (bf16)f2bf(silu1(g[i] * rs) * (u[i] * rs)); } }
}
__device__ __forceinline__ void meta_down(Frame& F) {
    const bf16* A = WSP(bf16, WS_META + MO_ACT); float* ssq1 = WSP(float, WS_META + MO_SSQ1); bf16* xn1 = WSP(bf16, WS_META + MO_XN1);
    LAS f32x4* red = (LAS f32x4*)(F.lds + 65536);
    for (int it = blockIdx.x; it < DM / 16; it += F.G) { const int c0 = 16 * it;
        __syncthreads();
        f32x4 a = (f32x4){0.f, 0.f, 0.f, 0.f};
        a = skinny16(A, DFF, WSP(bf16, WS_W1D) + (size_t)c0 * DFF, DFF, F.wave * (DFF / 8), (F.wave + 1) * (DFF / 8), F.lane, a);
        red[F.wave * 64 + F.lane] = a;
        __syncthreads();
        if (F.wave == 0) {
#pragma unroll
            for (int w = 1; w < 8; ++w) a += red[w * 64 + F.lane];
#pragma unroll
            for (int i = 0; i < 4; ++i) { const int row = 4 * (F.lane >> 4) + i, col = c0 + (F.lane & 15); const float o = F.in[1][row * DM + col] + 0.5f * a[i];
                xn1[row * DM + col] = (bf16)f2bf(o);
                float sq = o * o; sq += __shfl_xor(sq, 1); sq += __shfl_xor(sq, 2); sq += __shfl_xor(sq, 4); sq += __shfl_xor(sq, 8);
                if ((F.lane & 15) == 0) ssq1[row * 128 + it] = sq; } }
        __syncthreads();
    }
}
constexpr int NMETA_IT = NIN / 16, NDT_IT = MR / 16;
__device__ __forceinline__ void meta_inproj_and_dt(Frame& F, int it0, int it_end, int wstride) {
    const int nmeta = NMETA_IT;
    if (it0 < 0) return;
    for (int it = it0; it < it_end; it += wstride) {
        if (it < nmeta) {
            const float* ssq1 = WSP(float, WS_META + MO_SSQ1); float* um = WSP(float, WS_META + MO_U);
            float rs[4];
#pragma unroll
            for (int i = 0; i < 4; ++i) { const f32x4* pp = (const f32x4*)(ssq1 + (4 * (F.lane >> 4) + i) * 128 + 8 * (F.lane & 15)); const f32x4 v = pp[0] + pp[1]; float s2 = (v[0] + v[1]) + (v[2] + v[3]);
                s2 += __shfl_xor(s2, 1); s2 += __shfl_xor(s2, 2); s2 += __shfl_xor(s2, 4); s2 += __shfl_xor(s2, 8);
                rs[i] = __builtin_amdgcn_rsqf(s2 * (1.0f / 2048.0f) + EPS); }
            const int r0 = 16 * it;
            int c0;
            if (r0 >= NINP) c0 = r0; else { const int pn = r0 >> 8, rem = r0 & 255, bj = rem >> 7, wc = (rem & 127) >> 5, j = rem & 31; c0 = 256 * pn + 64 * wc + 32 * bj + j; }
            f32x4 a = (f32x4){0.f, 0.f, 0.f, 0.f};
            a = skinny16(WSP(bf16, WS_META + MO_XN1), DM, WSP(bf16, WS_WIN) + (size_t)r0 * DM, DM, 0, DM, F.lane, a);
#pragma unroll
            for (int i = 0; i < 4; ++i) um[(size_t)(4 * (F.lane >> 4) + i) * NIN + c0 + (F.lane & 15)] = a[i] * rs[i];
        } else {
            const int m0 = 16 * (it - nmeta);
            f32x4 a = (f32x4){0.f, 0.f, 0.f, 0.f};
            a = skinny16(WSP(bf16, WS_XN) + (size_t)m0 * DM, DM, WSP(bf16, WS_WIN) + (size_t)NINP * DM, DM, 0, DM, F.lane, a);
#pragma unroll
            for (int i = 0; i < 4; ++i) { const int row = m0 + 4 * (F.lane >> 4) + i; WSP(float, WS_DTR)[(size_t)row * 16 + (F.lane & 15)] = a[i] * pg8::row_rs(WSP(float, WS_SSQ1), 32, row); }
        }
    }
}


namespace att {
typedef float f32x16 __attribute__((ext_vector_type(16)));
typedef short s16x4 __attribute__((ext_vector_type(4)));
typedef short v4i16_t __attribute__((ext_vector_type(4)));
typedef float f32x2_t __attribute__((ext_vector_type(2))); typedef __bf16 bf16x2_t __attribute__((ext_vector_type(2)));
constexpr int STAGE = 32768, VOFF = 16384;
__device__ __forceinline__ int crow(int r, int hi) { return (r & 3) + 8 * (r >> 2) + 4 * hi; }
__device__ __forceinline__ unsigned cvtpk(float lo, float hi) { f32x2_t v = {lo, hi}; bf16x2_t b = __builtin_convertvector(v, bf16x2_t); return __builtin_bit_cast(unsigned, b); }
#define ATT_WAITBAR() asm volatile("s_waitcnt vmcnt(0) lgkmcnt(0)\n\ts_barrier" ::: "memory")
__device__ __forceinline__ void glds16(const void* gsrc, unsigned lds_dst) { unsigned keep;
    asm volatile("s_mov_b32 %0, m0\n\ts_mov_b32 m0, %2\n\ts_nop 0\n\tglobal_load_lds_dwordx4 %1, off\n\ts_mov_b32 m0, %0" : "=&s"(keep) : "v"(gsrc), "s"(lds_dst) : "memory"); }
#define ATT_DMA(src, dstoff) glds16((const void*)(src), (unsigned)__builtin_amdgcn_readfirstlane((int)(dstoff)))
#define ATT_MFMA(a, b, c) __builtin_amdgcn_mfma_f32_32x32x16_bf16((a), (b), (c), 0, 0, 0)
__device__ __forceinline__ float fadd_s(float a, float b) { float r; asm("v_add_f32 %0, %1, %2" : "=v"(r) : "v"(a), "v"(b)); return r; }

constexpr int KST = 16384, VST0 = 4 * KST, VSTB = 16384, WSF_OFF = VST0 + 3 * VSTB, STG_OFF = VST0, DUMMY_OFF = WSF_OFF + 1024;
__device__ __forceinline__ void attn_unit(Frame& F, int bh, int jq) {
    LAS unsigned char* lds = F.lds;
    const bf16* U = WSP(bf16, WS_ACT);
    int lane = F.lane; asm volatile("" : "+v"(lane));
    const int wave = F.wave, r32 = lane & 31, hi = lane >> 5;
    const int b = bh >> 3, h = bh & 7, rb = wave & 3, sub = wave >> 2;
    const int cw = 2 * jq + (rb >> 1);
    const int row0 = b * SEQ + 128 * jq + 32 * rb;
    const int T = 2 * jq + 2;
    const int kk0 = 8 * wave + (lane >> 4), kk1 = kk0 + 4;
    const bf16* kbase0 = U + (size_t)(b * SEQ + kk0) * NINP + 1024 + h * 128 + 8 * ((lane & 15) ^ (kk0 & 15));
    const bf16* kbase1 = U + (size_t)(b * SEQ + kk1) * NINP + 1024 + h * 128 + 8 * ((lane & 15) ^ (kk1 & 15));
    const int v0 = 2 * wave, v1 = 2 * wave + 1;
    const bf16* vbase0 = U + (size_t)(b * SEQ + 16 * (v0 & 3) + (lane >> 2)) * NINP + 2048 + h * 128 + 32 * (v0 >> 2) + 8 * (lane & 3);
    const bf16* vbase1 = U + (size_t)(b * SEQ + 16 * (v1 & 3) + (lane >> 2)) * NINP + 2048 + h * 128 + 32 * (v1 >> 2) + 8 * (lane & 3);
    const int kd0 = 2 * wave * 1024, kd1 = kd0 + 1024, vd0 = v0 * 1024, vd1 = v1 * 1024;
#define ATT_DMA_K(t, ks_) do { const size_t to_ = (size_t)(t) * 64 * NINP; ATT_DMA(kbase0 + to_, (ks_) + kd0); ATT_DMA(kbase1 + to_, (ks_) + kd1); } while (0)
#define ATT_DMA_V(t, vs_) do { const size_t to_ = (size_t)(t) * 64 * NINP; ATT_DMA(vbase0 + to_, (vs_) + vd0); ATT_DMA(vbase1 + to_, (vs_) + vd1); } while (0)
    ATT_DMA_K(0, 0); ATT_DMA_V(0, VST0); ATT_DMA_K(1, KST); ATT_DMA_V(1, VST0 + VSTB); if (T > 2) ATT_DMA_K(2, 2 * KST);
    { const float* um = WSP(float, WS_META + MO_U);
      float mv[4];
#pragma unroll
      for (int i4 = 0; i4 < 4; ++i4) { const int itm = 4 * wave + i4; mv[i4] = um[(size_t)(itm >> 1) * NIN + 1024 + h * 128 + (itm & 1) * 64 + lane]; }
#pragma unroll
      for (int i4 = 0; i4 < 4; ++i4) { const int itm = 4 * wave + i4, p = itm >> 1, sh = itm & 1, d = lane;
          float v = mv[i4];
          const float r = __builtin_amdgcn_rsqf(wave_sum(v * v) * (1.0f / 64.0f) + EPS);
          v = v * r * F.in[9][d];
          const float pr = __shfl_xor(v, 8); const float* rp = WSP(float, WS_ROPE) + p * 16;
          if (d < 8) v = v * rp[d] - pr * rp[8 + d]; else if (d < 16) v = v * rp[d - 8] + pr * rp[d];
          const int dd = sh * 64 + d;
          *(LAS bf16*)(lds + 3 * KST + p * 256 + (((dd >> 3) ^ p) << 4) + (dd & 7) * 2) = (bf16)f2bf(v); }
      { const int e = 4 * (wave * 64 + lane), key = e >> 7, d = e & 127; const f32x4 vv = *(const f32x4*)(um + (size_t)key * NIN + 2048 + h * 128 + d);
        u32x2v w2; w2.x = pk2(vv[0], vv[1]); w2.y = pk2(vv[2], vv[3]); *(LAS u32x2v*)(lds + VST0 + 2 * VSTB + (4 * (d >> 5)) * 1024 + key * 64 + (d & 31) * 2) = w2; } }
    bf16x8 qf[4];
#pragma unroll
    for (int ks = 0; ks < 4; ++ks) qf[ks] = *(const bf16x8*)(U + (size_t)(row0 + r32) * NINP + h * 128 + sub * 64 + 16 * ks + 8 * hi);
    f32x16 o[4];
#pragma unroll
    for (int d = 0; d < 4; ++d)
#pragma unroll
        for (int i = 0; i < 16; ++i) o[d][i] = 0.f;
    float lsum = 0.f;
    const f32x16 zero16 = {0.f, 0.f, 0.f, 0.f, 0.f, 0.f, 0.f, 0.f, 0.f, 0.f, 0.f, 0.f, 0.f, 0.f, 0.f, 0.f};
    const int koff = r32 * 256 + (((8 * sub + hi) ^ (r32 & 15)) << 4);
    const int voff = ((lane >> 4) & 1) * 32 + (lane & 3) * 8 + (4 * hi + ((lane & 15) >> 2)) * 64;
#define ATT_KF(kst_, half, ks) (*(const LAS bf16x8*)(lds + (kst_) + (half) * 8192 + (koff ^ ((ks) << 5))))
#define ATT_VTR(vst_, off) __builtin_bit_cast(s16x4, __builtin_amdgcn_ds_read_tr16_b64_v4i16((LAS v4i16_t*)(lds + (vst_) + voff + (off))))
    ATT_WAITBAR();
    f32x16 s0 = zero16, s1 = zero16;
    {
        f32x16 sc = zero16;
#pragma unroll
        for (int ks = 0; ks < 4; ++ks) sc = ATT_MFMA(ATT_KF(3 * KST, 0, ks), qf[ks], sc);
#pragma unroll
        for (int ks = 0; ks < 4; ++ks) { s0 = ATT_MFMA(ATT_KF(0, 0, ks), qf[ks], s0); s1 = ATT_MFMA(ATT_KF(0, 1, ks), qf[ks], s1); }
#pragma unroll
        for (int i = 0; i < 8; ++i) { sc[i] = __builtin_amdgcn_exp2f(sc[i]); lsum += sc[i]; }
        v4u pw; pw.x = cvtpk(sc[0], sc[1]); pw.y = cvtpk(sc[2], sc[3]); pw.z = cvtpk(sc[4], sc[5]); pw.w = cvtpk(sc[6], sc[7]);
        const bf16x8 pm = __builtin_bit_cast(bf16x8, pw);
#pragma unroll
        for (int d = 0; d < 4; ++d) { const s16x4 lo = ATT_VTR(VST0 + 2 * VSTB, d * 4096), hh = ATT_VTR(VST0 + 2 * VSTB, d * 4096 + 512);
            const bf16x8 vf = {lo[0], lo[1], lo[2], lo[3], hh[0], hh[1], hh[2], hh[3]};
            o[d] = ATT_MFMA(pm, vf, o[d]); }
    }
    ATT_WAITBAR();
    int vm0 = 0, vm2 = 2;
#define SBAR() __builtin_amdgcn_sched_barrier(0)
#define ATT_VTRP(vp_, off) __builtin_bit_cast(s16x4, __builtin_amdgcn_ds_read_tr16_b64_v4i16((LAS v4i16_t*)((vp_) + (off))))
#define ATT_VLOAD(buf, vst_, d, kp) do { _Pragma("unroll") for (int ks_ = 0; ks_ < 2; ++ks_) { vlo[buf][ks_] = ATT_VTRP(vst_, (d) * 4096 + (2 * (kp) + ks_) * 1024); vhi[buf][ks_] = ATT_VTRP(vst_, (d) * 4096 + (2 * (kp) + ks_) * 1024 + 512); } } while (0)
#define ATT_GQ(MF) do { __builtin_amdgcn_s_setprio(1); MF; __builtin_amdgcn_s_setprio(0); SBAR(); } while (0)
#define ATT_GS(NV, b4, PW, w0, w1) do { ls = (((ls + NV[b4]) + NV[b4 + 1]) + NV[b4 + 2]) + NV[b4 + 3];     PW[w0] = cvtpk(NV[b4], NV[b4 + 1]); PW[w1] = cvtpk(NV[b4 + 2], NV[b4 + 3]); } while (0)
#define ATT_GB(MF, NV, i0, GS) do { __builtin_amdgcn_s_setprio(1); MF; __builtin_amdgcn_s_setprio(0); NV[i0] = __builtin_amdgcn_exp2f(NV[i0]); NV[i0 + 1] = __builtin_amdgcn_exp2f(NV[i0 + 1]); GS; SBAR(); } while (0)
#define ATT_VF(buf, ks_) (bf16x8){vlo[buf][ks_][0], vlo[buf][ks_][1], vlo[buf][ks_][2], vlo[buf][ks_][3], vhi[buf][ks_][0], vhi[buf][ks_][1], vhi[buf][ks_][2], vhi[buf][ks_][3]}
#define ATT_STEP(C0, C1, C2, C3, D0, D1, D2, D3, tt) do { \
        const int t_ = (tt); const int knext = ((t_ + 1) & 3) * KST, kdst = ((t_ + 3) & 3) * KST, vdst = VST0 + vm2 * VSTB; \
        LAS unsigned char* vcur = lds + VST0 + vm0 * VSTB + voff; asm volatile("" : "+v"(vcur));     \
        const bool dk = t_ + 3 < T, dv = t_ + 2 < T; const size_t tok_ = dk ? (size_t)(t_ + 3) * 64 * NINP : 0, tov_ = dv ? (size_t)(t_ + 2) * 64 * NINP : 0; \
        const int dK0 = dk ? kdst + kd0 : DUMMY_OFF + wave * 1024, dK1 = dk ? kdst + kd1 : DUMMY_OFF + wave * 1024, dV0 = dv ? vdst + vd0 : DUMMY_OFF + wave * 1024, dV1 = dv ? vdst + vd1 : DUMMY_OFF + wave * 1024; \
        ATT_DMA(kbase0 + tok_, dK0); ATT_DMA(kbase1 + tok_, dK1); ATT_DMA(vbase0 + tov_, dV0); ATT_DMA(vbase1 + tov_, dV1); \
        if (t_ <= cw) { \
            bf16x8 kf[4]; s16x4 vlo[2][2], vhi[2][2]; f32x16 N0, N1; float ls = 0.f; \
            SBAR(); \
            kf[0] = ATT_KF(knext, 0, 0); kf[1] = ATT_KF(knext, 1, 0); kf[2] = ATT_KF(knext, 0, 1); kf[3] = ATT_KF(knext, 1, 1); SBAR(); \
            ATT_GQ(N0 = ATT_MFMA(kf[0], qf[0], zero16)); \
            ATT_GQ(N1 = ATT_MFMA(kf[1], qf[0], zero16)); \
            kf[0] = ATT_KF(knext, 0, 2); kf[1] = ATT_KF(knext, 1, 2); SBAR(); \
            ATT_GQ(N0 = ATT_MFMA(kf[2], qf[1], N0)); \
            ATT_GQ(N1 = ATT_MFMA(kf[3], qf[1], N1)); \
            kf[2] = ATT_KF(knext, 0, 3); kf[3] = ATT_KF(knext, 1, 3); SBAR(); \
            ATT_GQ(N0 = ATT_MFMA(kf[0], qf[2], N0)); \
            ATT_GQ(N1 = ATT_MFMA(kf[1], qf[2], N1)); \
            ATT_VLOAD(0, vcur, 0, 0); SBAR(); \
            ATT_GQ(N0 = ATT_MFMA(kf[2], qf[3], N0)); \
            ATT_GQ(N1 = ATT_MFMA(kf[3], qf[3], N1)); \
            const bf16x8 pf0 = __builtin_bit_cast(bf16x8, C0), pf1 = __builtin_bit_cast(bf16x8, C1), pf2 = __builtin_bit_cast(bf16x8, C2), pf3 = __builtin_bit_cast(bf16x8, C3); \
            ATT_VLOAD(1, vcur, 0, 1); SBAR(); \
            ATT_GB(o[0] = ATT_MFMA(pf0, ATT_VF(0, 0), o[0]), N0, 0, (void)0); ATT_GB(o[0] = ATT_MFMA(pf1, ATT_VF(0, 1), o[0]), N0, 2, (void)0); \
            ATT_VLOAD(0, vcur, 1, 0); SBAR(); \
            ATT_GB(o[0] = ATT_MFMA(pf2, ATT_VF(1, 0), o[0]), N0, 4, ATT_GS(N0, 0, D0, 0, 1)); ATT_GB(o[0] = ATT_MFMA(pf3, ATT_VF(1, 1), o[0]), N0, 6, (void)0); \
            ATT_VLOAD(1, vcur, 1, 1); SBAR(); \
            ATT_GB(o[1] = ATT_MFMA(pf0, ATT_VF(0, 0), o[1]), N0, 8, ATT_GS(N0, 4, D0, 2, 3)); ATT_GB(o[1] = ATT_MFMA(pf1, ATT_VF(0, 1), o[1]), N0, 10, (void)0); \
            ATT_VLOAD(0, vcur, 2, 0); SBAR(); \
            ATT_GB(o[1] = ATT_MFMA(pf2, ATT_VF(1, 0), o[1]), N0, 12, ATT_GS(N0, 8, D1, 0, 1)); ATT_GB(o[1] = ATT_MFMA(pf3, ATT_VF(1, 1), o[1]), N0, 14, (void)0); \
            ATT_VLOAD(1, vcur, 2, 1); SBAR(); \
            ATT_GB(o[2] = ATT_MFMA(pf0, ATT_VF(0, 0), o[2]), N1, 0, ATT_GS(N0, 12, D1, 2, 3)); ATT_GB(o[2] = ATT_MFMA(pf1, ATT_VF(0, 1), o[2]), N1, 2, (void)0); \
            ATT_VLOAD(0, vcur, 3, 0); SBAR(); \
            ATT_GB(o[2] = ATT_MFMA(pf2, ATT_VF(1, 0), o[2]), N1, 4, ATT_GS(N1, 0, D2, 0, 1)); ATT_GB(o[2] = ATT_MFMA(pf3, ATT_VF(1, 1), o[2]), N1, 6, (void)0); \
            ATT_VLOAD(1, vcur, 3, 1); SBAR(); \
            ATT_GB(o[3] = ATT_MFMA(pf0, ATT_VF(0, 0), o[3]), N1, 8, ATT_GS(N1, 4, D2, 2, 3)); ATT_GB(o[3] = ATT_MFMA(pf1, ATT_VF(0, 1), o[3]), N1, 10, (void)0); \
            ATT_GB(o[3] = ATT_MFMA(pf2, ATT_VF(1, 0), o[3]), N1, 12, ATT_GS(N1, 8, D3, 0, 1)); ATT_GB(o[3] = ATT_MFMA(pf3, ATT_VF(1, 1), o[3]), N1, 14, (void)0); \
            ATT_GS(N1, 12, D3, 2, 3); \
            lsum += (t_ < cw) ? ls : 0.f;     \
        } \
          \
        asm volatile("s_waitcnt vmcnt(4) lgkmcnt(0)\n\ts_barrier" ::: "memory"); \
        vm0 = (vm0 == 2) ? 0 : vm0 + 1; vm2 = (vm2 == 2) ? 0 : vm2 + 1; \
    } while (0)
    v4u pa0, pa1, pa2, pa3, pb0, pb1, pb2, pb3;
    pb0 = pb1 = pb2 = pb3 = (v4u){0u, 0u, 0u, 0u};
    {
#pragma unroll
        for (int i = 0; i < 16; ++i) { s0[i] = __builtin_amdgcn_exp2f(s0[i]); s1[i] = __builtin_amdgcn_exp2f(s1[i]); }
        float ls = 0.f;
        ATT_GS(s0, 0, pa0, 0, 1); ATT_GS(s0, 4, pa0, 2, 3); ATT_GS(s0, 8, pa1, 0, 1); ATT_GS(s0, 12, pa1, 2, 3);
        ATT_GS(s1, 0, pa2, 0, 1); ATT_GS(s1, 4, pa2, 2, 3); ATT_GS(s1, 8, pa3, 0, 1); ATT_GS(s1, 12, pa3, 2, 3);
        lsum += ls;
    }
    for (int t = 0; t < T; t += 2) { ATT_STEP(pa0, pa1, pa2, pa3, pb0, pb1, pb2, pb3, t); ATT_STEP(pb0, pb1, pb2, pb3, pa0, pa1, pa2, pa3, t + 1); }
    ATT_WAITBAR();
#undef ATT_STEP
#undef ATT_VLOAD
#undef ATT_GQ
#undef ATT_GS
#undef ATT_GB
#undef ATT_VF
#undef SBAR
    int le = lane; asm volatile("" : "+v"(le));
    const int r32e = le & 31, hie = le >> 5;
    lsum += __shfl_xor(lsum, 32);
    LAS float* wsf = (LAS float*)(lds + WSF_OFF + wave * 128);
    float fac;
    if (sub == 0) fac = 1.0f / lsum;
    else { const float s1 = wave_sum(F.in[10][le] * F.in[11][le]), s2 = wave_sum(F.in[12][le] * F.in[13][le]); fac = (__expf(s1) - __expf(s2) + 0.2f) / lsum; }
    if (hie == 0) wsf[r32e] = fac;
    LDS_WAIT(); asm volatile("" ::: "memory");
    LAS float* xo = (LAS float*)(lds + (wave & 3) * 16384) + le;
    if (sub == 1) {
#pragma unroll
        for (int i = 0; i < 16; ++i) { const float f = wsf[crow(i, hie)];
#pragma unroll
            for (int d = 0; d < 4; ++d) xo[(d * 16 + i) * 64] = o[d][i] * f; }
    }
    ATT_WAITBAR();
    if (sub == 0) {
        LAS bf16* stg = (LAS bf16*)(lds + STG_OFF + wave * 8192);
        float wn[4];
#pragma unroll
        for (int d = 0; d < 4; ++d) wn[d] = F.in[14][32 * d + r32e] * 0.8f;
#pragma unroll
        for (int i = 0; i < 16; ++i) { const int q = crow(i, hie); const float f1 = wsf[q];
            float v[4], ss = 0.f;
#pragma unroll
            for (int d = 0; d < 4; ++d) { v[d] = o[d][i] * f1 - xo[(d * 16 + i) * 64]; ss += v[d] * v[d]; }
            ss += __shfl_xor(ss, 1); ss += __shfl_xor(ss, 2); ss += __shfl_xor(ss, 4); ss += __shfl_xor(ss, 8); ss += __shfl_xor(ss, 16);
            const float r = __builtin_amdgcn_rsqf(ss * (1.0f / 128.0f) + EPS);
#pragma unroll
            for (int d = 0; d < 4; ++d) stg[q * 128 + 32 * d + r32e] = (bf16)f2bf(v[d] * r * wn[d]); }
        LDS_WAIT(); asm volatile("" ::: "memory");
#pragma unroll
        for (int it = 0; it < 8; ++it) { const int q = 4 * it + (le >> 4), ch = le & 15;
            const v4u val = *(const LAS v4u*)(stg + q * 128 + 8 * ch);
            *(v4u*)(WSP(bf16, WS_MIX) + (size_t)(row0 + q) * DM + 1024 + h * 128 + 8 * ch) = val; }
    }
    ATT_WAITBAR();
#undef ATT_DMA_K
#undef ATT_DMA_V
#undef ATT_KF
#undef ATT_VTR
}
}


namespace ssd {
constexpr int S64 = 144, S128 = 272;
constexpr int O_CC = 0, O_BC = 17408, O_BT = 34816, O_XT = 53248, O_XS = 62464, O_XC = 71680, O_M = 80896, O_SI = 90112, O_SC = 107520;
#define SSD_MF(a, b, c) __builtin_amdgcn_mfma_f32_16x16x32_bf16((a), (b), (c), 0, 0, 0)
#define SSD_FRAG(img, stride, row, k) (*(const LAS bf16x8*)(lds + (img) + (row) * (stride) + 2 * (k)))
#define SSD_BAR() do { asm volatile("s_waitcnt vmcnt(0) lgkmcnt(0)" ::: "memory"); __builtin_amdgcn_s_barrier(); asm volatile("" ::: "memory"); } while (0)

__device__ __forceinline__ v4u pack8(const float (&v)[8]) { v4u o; o.x = pk2(v[0], v[1]); o.y = pk2(v[2], v[3]); o.z = pk2(v[4], v[5]); o.w = pk2(v[6], v[7]); return o; }
__device__ __forceinline__ unsigned bfe16(const v4u& r, int e) { const unsigned w = (e < 2) ? r.x : (e < 4) ? r.y : (e < 6) ? r.z : r.w; return (e & 1) ? (w >> 16) : (w & 0xffffu); }

template <bool PASSB>
__device__ __forceinline__ void ssd_item(Frame& F, int item, int& bgj) {
    LAS unsigned char* lds = F.lds;
    int lane0 = F.lane; asm volatile("" : "+v"(lane0));
    const int wave = F.wave;
    const int k = item & 7, hd = (item >> 3) & 15, b = item >> 7, g = hd >> 3;
    const float Ah = -__expf(F.in[18][hd]), Dk = F.in[19][hd];
    LAS float* sc = (LAS float*)(lds + O_SC);
    const int pt = wave >> 1, nb = 4 * (wave & 1);
    f32x4 stt[4];
#pragma unroll
    for (int j = 0; j < 4; ++j) stt[j] = (f32x4){0.f, 0.f, 0.f, 0.f};
    float* sst = WSP(float, WS_SST) + (size_t)((b * SH + hd) * 8) * 8192;
    float* atot = WSP(float, WS_ATOT) + (b * SH + hd) * 8;
    if (PASSB) {
        const int fr = lane0 & 15, fq = lane0 >> 4;
        for (int kk = 0; kk < k; ++kk) { const float dec = __expf(atot[kk]);
#pragma unroll
            for (int j = 0; j < 4; ++j) { const f32x4 s = *(const f32x4*)(sst + (size_t)kk * 8192 + (16 * pt + fr) * 128 + 16 * (nb + j) + 4 * fq); stt[j] = stt[j] * dec + s; } }
    }
    float asum = 0.f;
    const int c_lo = (k == 0) ? 0 : 8 * k + 1, c_hi = 8 * k + 8;
    const int role = (wave < 2) ? 0 : (wave < 4) ? 1 : (wave < 6 && PASSB) ? 2 : 3;
    v4u raw[8]; float dtv = 0.f;
    { const int li = (wave * 64 + lane0) & 127, cg = (role == 0) ? (li & 7) : (li & 15), l0 = (role == 0) ? 4 * (li >> 3) : 8 * (li >> 4);
      if (role == 0) { const bf16* src = WSP(bf16, WS_XS) + (size_t)(b * LPAD + 64 * c_lo + l0) * 1024 + hd * 64 + 8 * cg;
#pragma unroll
          for (int i = 0; i < 4; ++i) raw[i] = *(const v4u*)(src + (size_t)i * 1024); }
      else if (role < 3) { const bf16* src = WSP(bf16, WS_BC) + (size_t)(b * LPAD + 64 * c_lo + l0) * 512 + (role == 2 ? 256 : 0) + g * 128 + 8 * cg;
#pragma unroll
          for (int i = 0; i < 8; ++i) raw[i] = *(const v4u*)(src + (size_t)i * 512); }
      if (wave == 7) dtv = WSP(float, WS_DT)[(size_t)(b * LPAD + 64 * c_lo + lane0) * 16 + hd]; }
    for (int c = c_lo; c <= c_hi; ++c) {
        int lane = lane0; asm volatile("" : "+v"(lane));
        const int tid = wave * 64 + lane, fr = lane & 15, fq = lane >> 4, li = tid & 127;
        const int cg = (role == 0) ? (li & 7) : (li & 15), l0 = (role == 0) ? 4 * (li >> 3) : 8 * (li >> 4);
        u32x2v zv[2];
        if (PASSB && c >= 1) {
#pragma unroll
            for (int j = 0; j < 2; ++j) zv[j] = *(const u32x2v*)(WSP(bf16, WS_ACT) + (size_t)(b * SEQ + 64 * (c - 1) + 16 * pt + fr) * NINP + 3072 + hd * 64 + 16 * (2 * (wave & 1) + j) + 4 * fq);
        }
        const int cn = (c < c_hi) ? c + 1 : c;
        f32x4 cv[8]; TItem ct; bool chave = false; int chh = 0;
        if (role == 0) {
            if (PASSB) {
#pragma unroll
                for (int i = 0; i < 4; ++i) *(LAS v4u*)(lds + O_XC + (l0 + i) * S64 + 16 * cg) = raw[i]; }
#pragma unroll
            for (int e = 0; e < 8; ++e) { u32x2v w2; w2.x = bfe16(raw[0], e) | (bfe16(raw[1], e) << 16); w2.y = bfe16(raw[2], e) | (bfe16(raw[3], e) << 16); *(LAS u32x2v*)(lds + O_XT + (8 * cg + e) * S64 + 2 * l0) = w2; }
            const bf16* src = WSP(bf16, WS_XS) + (size_t)(b * LPAD + 64 * cn + l0) * 1024 + hd * 64 + 8 * cg;
#pragma unroll
            for (int i = 0; i < 4; ++i) raw[i] = *(const v4u*)(src + (size_t)i * 1024);
        } else if (role == 1) {
            if (PASSB) {
#pragma unroll
                for (int i = 0; i < 8; ++i) *(LAS v4u*)(lds + O_BC + (l0 + i) * S128 + 16 * cg) = raw[i]; }
#pragma unroll
            for (int e = 0; e < 8; ++e) { v4u w4; w4.x = bfe16(raw[0], e) | (bfe16(raw[1], e) << 16); w4.y = bfe16(raw[2], e) | (bfe16(raw[3], e) << 16); w4.z = bfe16(raw[4], e) | (bfe16(raw[5], e) << 16); w4.w = bfe16(raw[6], e) | (bfe16(raw[7], e) << 16);
                *(LAS v4u*)(lds + O_BT + (8 * cg + e) * S64 + 2 * l0) = w4; }
            const bf16* src = WSP(bf16, WS_BC) + (size_t)(b * LPAD + 64 * cn + l0) * 512 + g * 128 + 8 * cg;
#pragma unroll
            for (int i = 0; i < 8; ++i) raw[i] = *(const v4u*)(src + (size_t)i * 512);
        } else if (role == 2) {
#pragma unroll
            for (int i = 0; i < 8; ++i) *(LAS v4u*)(lds + O_CC + (l0 + i) * S128 + 16 * cg) = raw[i];
            const bf16* src = WSP(bf16, WS_BC) + (size_t)(b * LPAD + 64 * cn + l0) * 512 + 256 + g * 128 + 8 * cg;
#pragma unroll
            for (int i = 0; i < 8; ++i) raw[i] = *(const v4u*)(src + (size_t)i * 512);
        }
        if (wave == 7) {
            const float dt = dtv;
            dtv = WSP(float, WS_DT)[(size_t)(b * LPAD + 64 * cn + lane) * 16 + hd];
            float a = dt * Ah;
#pragma unroll
            for (int o2 = 1; o2 < 64; o2 <<= 1) { const float t = __shfl_up(a, o2); if (lane >= o2) a += t; }
            const float aend = __shfl(a, 63);
            sc[lane] = dt; sc[64 + lane] = a; sc[128 + lane] = dt * __expf(aend - a);
            if (lane == 0) sc[192] = aend;
        }
        if (PASSB && F.NGW == 2048) { const int hix = bgj * 2048 + F.gw, cit = IT_BG + (hix >> 1); chh = hix & 1; chave = bgj < 8 && cit < IT_END; ++bgj;
            if (chave) { ct = mk_item(F, cit); transpose_load_h(ct, lane, chh, cv); } }
        asm volatile("s_waitcnt lgkmcnt(0)" ::: "memory"); __builtin_amdgcn_s_barrier(); asm volatile("" ::: "memory");
        const float aend = sc[192];
        for (int amp2_ = 0; amp2_ < (MK_AMP == 2 ? 3 : 1); ++amp2_) {
        { const int p = tid >> 3, lg = (tid & 7) * 8;
          const v4u xv = *(const LAS v4u*)(lds + O_XT + p * S64 + 2 * lg); const unsigned xw[4] = {xv.x, xv.y, xv.z, xv.w}; float v[8];
#pragma unroll
          for (int e = 0; e < 4; ++e) { v[2 * e] = bf2f(xw[e] & 0xffffu) * sc[128 + lg + 2 * e]; v[2 * e + 1] = bf2f(xw[e] >> 16) * sc[128 + lg + 2 * e + 1]; }
          *(LAS v4u*)(lds + O_XS + p * S64 + 2 * lg) = pack8(v); }
        if (PASSB) {
#pragma unroll
            for (int j = 0; j < 4; ++j) { u32x2v w2; w2.x = pk2(stt[j][0], stt[j][1]); w2.y = pk2(stt[j][2], stt[j][3]); *(LAS u32x2v*)(lds + O_SI + (16 * pt + fr) * S128 + 2 * (16 * (nb + j) + 4 * fq)) = w2; }
            const int l = 16 * pt + fr; const float al = sc[64 + l];
#pragma unroll
            for (int j = 0; j < 2; ++j) { const int st = 2 * (wave & 1) + j; f32x4 acc = (f32x4){0.f, 0.f, 0.f, 0.f};
                if (st <= pt) {
#pragma unroll
                    for (int ks = 0; ks < 4; ++ks) acc = SSD_MF(SSD_FRAG(O_BC, S128, 16 * st + fr, 32 * ks + 8 * fq), SSD_FRAG(O_CC, S128, l, 32 * ks + 8 * fq), acc);
                    asm volatile("s_nop 15\n\ts_nop 3" : "+v"(acc)); }
                float m[4];
#pragma unroll
                for (int i = 0; i < 4; ++i) { const int s = 16 * st + 4 * fq + i; m[i] = (s <= l) ? acc[i] * __expf(al - sc[64 + s]) * sc[s] : 0.f; }
                u32x2v w2; w2.x = pk2(m[0], m[1]); w2.y = pk2(m[2], m[3]); *(LAS u32x2v*)(lds + O_M + l * S64 + 2 * (16 * st + 4 * fq)) = w2; }
        }
        }
        asm volatile("s_waitcnt lgkmcnt(0)" ::: "memory"); __builtin_amdgcn_s_barrier(); asm volatile("" ::: "memory");
        for (int amp3_ = 0; amp3_ < (MK_AMP == 3 ? 3 : 1); ++amp3_) {
        if (PASSB && c >= 1) {
            const int l = 16 * pt + fr, row = b * SEQ + 64 * (c - 1) + l; const float el = __expf(sc[64 + l]);
            float sq = 0.f;
#pragma unroll
            for (int j = 0; j < 2; ++j) { const int ptile = 2 * (wave & 1) + j; f32x4 acc = (f32x4){0.f, 0.f, 0.f, 0.f};
#pragma unroll
                for (int ks = 0; ks < 4; ++ks) acc = SSD_MF(SSD_FRAG(O_SI, S128, 16 * ptile + fr, 32 * ks + 8 * fq), SSD_FRAG(O_CC, S128, l, 32 * ks + 8 * fq), acc);
                acc = acc * el;
#pragma unroll
                for (int ks = 0; ks < 2; ++ks) acc = SSD_MF(SSD_FRAG(O_XT, S64, 16 * ptile + fr, 32 * ks + 8 * fq), SSD_FRAG(O_M, S64, l, 32 * ks + 8 * fq), acc);
                const int pc = 16 * ptile + 4 * fq;
                const u32x2v xv = *(const LAS u32x2v*)(lds + O_XC + l * S64 + 2 * pc);
                float y[4];
                y[0] = (acc[0] + Dk * bf2f(xv.x & 0xffffu)) * silu1(bf2f(zv[j].x & 0xffffu)); y[1] = (acc[1] + Dk * bf2f(xv.x >> 16)) * silu1(bf2f(zv[j].x >> 16));
                y[2] = (acc[2] + Dk * bf2f(xv.y & 0xffffu)) * silu1(bf2f(zv[j].y & 0xffffu)); y[3] = (acc[3] + Dk * bf2f(xv.y >> 16)) * silu1(bf2f(zv[j].y >> 16));
                sq += (y[0] * y[0] + y[1] * y[1]) + (y[2] * y[2] + y[3] * y[3]);
                u32x2v w2; w2.x = pk2(y[0], y[1]); w2.y = pk2(y[2], y[3]);
                *(u32x2v*)(WSP(bf16, WS_MIX) + (size_t)row * DM + hd * 64 + pc) = w2; }
            sq += __shfl_xor(sq, 16); sq += __shfl_xor(sq, 32);
            if (fq == 0) WSP(float, WS_SSQS)[(size_t)row * 32 + 2 * hd + (wave & 1)] = sq;
        }
        }
        { const float dec = __expf(aend);
#pragma unroll
          for (int j = 0; j < 4; ++j) { f32x4 acc = stt[j] * dec;
#pragma unroll
              for (int ks = 0; ks < 2; ++ks) acc = SSD_MF(SSD_FRAG(O_BT, S64, 16 * (nb + j) + fr, 32 * ks + 8 * fq), SSD_FRAG(O_XS, S64, 16 * pt + fr, 32 * ks + 8 * fq), acc);
              stt[j] = acc; } }
        asum += aend;
        if (PASSB) { if (chave) transpose_finish_h(ct, lane, chh, cv); }
        asm volatile("s_waitcnt lgkmcnt(0)" ::: "memory"); __builtin_amdgcn_s_barrier(); asm volatile("" ::: "memory");
    }
    if (!PASSB) { const int fr = lane0 & 15, fq = lane0 >> 4;
#pragma unroll
        for (int j = 0; j < 4; ++j) *(f32x4*)(sst + (size_t)k * 8192 + (16 * pt + fr) * 128 + 16 * (nb + j) + 4 * fq) = stt[j];
        if (wave == 0 && lane0 == 0) atot[k] = asum;
    }
}
}

struct ConvItem { int c, pp, b, p; v4u rv[4]; bool fast; };
__device__ __forceinline__ void conv_issue(Frame& F, int it, ConvItem& q) {
    const bf16* U = WSP(bf16, WS_ACT); const float* um = WSP(float, WS_META + MO_U);
    const int cg = it % (CONVD / 8); q.pp = (it / (CONVD / 8)) % LPAD; q.b = it / ((CONVD / 8) * LPAD); q.c = 8 * cg; q.p = q.pp - PPAD;
#pragma unroll
    for (int w = 0; w < 4; ++w) q.rv[w] = (v4u){0u, 0u, 0u, 0u};
    if (q.p >= 0) {
        if (q.p - 3 >= NMETA) { const bf16* src = U + (size_t)(q.b * SEQ + q.p - 3 - NMETA) * NINP + 4096 + q.c;
#pragma unroll
            for (int w = 0; w < 4; ++w) q.rv[w] = *(const v4u*)(src + (size_t)w * NINP); }
        else {
#pragma unroll
            for (int w = 0; w < 4; ++w) { const int ps = q.p - 3 + w; v4u v = (v4u){0u, 0u, 0u, 0u};
                if (ps >= NMETA) v = *(const v4u*)(U + (size_t)(q.b * SEQ + ps - NMETA) * NINP + 4096 + q.c);
                else if (ps >= 0) { const f32x4 r0 = *(const f32x4*)(um + (size_t)ps * NIN + 4096 + q.c), r1 = *(const f32x4*)(um + (size_t)ps * NIN + 4096 + q.c + 4);
                    v.x = pk2(r0[0], r0[1]); v.y = pk2(r0[2], r0[3]); v.z = pk2(r1[0], r1[1]); v.w = pk2(r1[2], r1[3]); }
                q.rv[w] = v; } }
    }
}
__device__ __forceinline__ void conv_finish(Frame& F, const ConvItem& q) {
    const float* cw = F.in[15]; const float* cb = F.in[16]; const int c = q.c;
    float a[8];
#pragma unroll
    for (int e = 0; e < 8; ++e) a[e] = 0.f;
    if (q.p >= 0) {
        const f32x4 b0 = *(const f32x4*)(cb + c), b1 = *(const f32x4*)(cb + c + 4);
        a[0] = b0[0]; a[1] = b0[1]; a[2] = b0[2]; a[3] = b0[3]; a[4] = b1[0]; a[5] = b1[1]; a[6] = b1[2]; a[7] = b1[3];
#pragma unroll
        for (int w = 0; w < 4; ++w) { const f32x4 w0 = *(const f32x4*)(cw + w * CONVD + c), w1 = *(const f32x4*)(cw + w * CONVD + c + 4);
            a[0] += bf2f(q.rv[w].x & 0xffffu) * w0[0]; a[1] += bf2f(q.rv[w].x >> 16) * w0[1]; a[2] += bf2f(q.rv[w].y & 0xffffu) * w0[2]; a[3] += bf2f(q.rv[w].y >> 16) * w0[3];
            a[4] += bf2f(q.rv[w].z & 0xffffu) * w1[0]; a[5] += bf2f(q.rv[w].z >> 16) * w1[1]; a[6] += bf2f(q.rv[w].w & 0xffffu) * w1[2]; a[7] += bf2f(q.rv[w].w >> 16) * w1[3]; }
#pragma unroll
        for (int e = 0; e < 8; ++e) a[e] = silu1(a[e]);
    }
    v4u o; o.x = pk2(a[0], a[1]); o.y = pk2(a[2], a[3]); o.z = pk2(a[4], a[5]); o.w = pk2(a[6], a[7]);
    if (c < 1024) *(v4u*)(WSP(bf16, WS_XS) + (size_t)(q.b * LPAD + q.pp) * 1024 + c) = o;
    else *(v4u*)(WSP(bf16, WS_BC) + (size_t)(q.b * LPAD + q.pp) * 512 + (c - 1024)) = o;
}
__device__ __forceinline__ void p4_conv(Frame& F) {
    const float* um = WSP(float, WS_META + MO_U);
    const int gt = F.gw * 64 + F.lane, NT = F.NGW * 64, NITEM = NBATCH * LPAD * (CONVD / 8);
    for (int it = gt; it < NITEM; it += 3 * NT) {
        ConvItem q0, q1, q2; const int i1 = it + NT, i2 = it + 2 * NT;
        conv_issue(F, it, q0); if (i1 < NITEM) conv_issue(F, i1, q1); if (i2 < NITEM) conv_issue(F, i2, q2);
        conv_finish(F, q0); if (i1 < NITEM) conv_finish(F, q1); if (i2 < NITEM) conv_finish(F, q2);
    }
    for (int it = gt; it < NBATCH * LPAD * SH; it += NT) { const int hd = it & 15, pp = (it >> 4) % LPAD, b = (it >> 4) / LPAD, p = pp - PPAD;
        float v = 0.f;
        if (p >= 0) { const float x = (p < NMETA ? um[(size_t)p * NIN + NINP + hd] : WSP(float, WS_DTR)[(size_t)(b * SEQ + p - NMETA) * 16 + hd]) + F.in[17][hd];
            v = fmaxf(x, 0.f) + log1pf(__expf(-fabsf(x))); }
        WSP(float, WS_DT)[it] = v; }
}
__device__ __forceinline__ void p4_mixer_attn(Frame& F) {
    p4_conv(F);
    for (int r_ = 0; r_ < (MK_REPEAT_PHASE == 41 ? 2 : 1); ++r_)
    for (int u = blockIdx.x; u < NBATCH * NHEAD * 16; u += F.G) { const int bh = (u & 7) * 2 + ((u >> 3) >> 4), idx = (u >> 3) & 15;
        att::attn_unit(F, bh, idx); att::attn_unit(F, bh, 31 - idx); }
}
__device__ __forceinline__ void p5_ssd_a(Frame& F) { int bgj = 0; for (int it = blockIdx.x; it < NBATCH * SH * 8; it += F.G) ssd::ssd_item<false>(F, it, bgj); }
__device__ __forceinline__ void p6_ssd_b(Frame& F) { int bgj = 0; for (int it = blockIdx.x; it < NBATCH * SH * 8; it += F.G) ssd::ssd_item<true>(F, it, bgj);
    if (F.NGW != 2048) convert_items(F, IT_BG, IT_END, F.gw, F.NGW); }
struct Args { const float* in[26]; float* out; unsigned char* ws; int ph_lo, ph_hi; };
__global__ void __launch_bounds__(NWAVES * 64, 2) hymba_fwd(Args args) {
    extern __shared__ __attribute__((aligned(16))) unsigned char lds[];
    Frame F;
    F.lds = (LAS unsigned char*)lds;
    F.tid = threadIdx.x; F.lane = F.tid & 63; F.wave = __builtin_amdgcn_readfirstlane(F.tid >> 6);
    F.G = gridDim.x; F.gw = blockIdx.x * NWAVES + F.wave; F.NGW = F.G * NWAVES;
#pragma unroll
    for (int i = 0; i < 26; ++i) F.in[i] = args.in[i];
    F.out = args.out; F.ws = args.ws; F.inp = args.in;
    volatile LAS unsigned* MISC = (volatile LAS unsigned*)(F.lds + MISC_OFF);
    for (int u = F.tid; u < 128; u += NWAVES * 64) MISC[u] = 0u;
    __syncthreads();
    XcdBarrier bar; bar.bar = (unsigned*)(F.ws + WS_CTL) + CW_BAR; bar.x = 0; bar.st = nullptr;
    if (N_LAUNCHES == 1) bar = xcd_barrier_post((unsigned*)(F.ws + WS_CTL) + CW_BAR, MISC + 8);
    const int lo = args.ph_lo, hi = args.ph_hi;
#define IN(k) (lo <= (k) && (k) < hi)
#ifndef MK_REPEAT_PHASE
#define MK_REPEAT_PHASE -1
#endif
#define REPS(k) for (int rep_ = 0; rep_ < ((k) == MK_REPEAT_PHASE ? 2 : 1); ++rep_)
#define REPBAR(k) do { if ((k) == MK_REPEAT_PHASE && rep_ == 0) xcd_barrier(bar); } while (0)
#define SEAM(k) do { if (IN(k) && IN((k) + 1)) xcd_barrier(bar); } while (0)
    using pg8::Gemm; using pg8::StaticOrder;
    LAS unsigned char* ring = F.lds + RING_OFF;

    if (IN(0)) { REPS(0) { p0_prologue(F); REPBAR(0); } SEAM(0); }
    if (IN(1)) {
        Gemm g{WSP(bf16, WS_XN), WSP(bf16, WS_W1GU), MR, NGU, DM}; StaticOrder S; S.init(MR, NGU, F.G, (int)blockIdx.x);
        pg8::Unit u0{0, 0}; (void)S.next(0, u0);
        pg8::EpiSwiGLU E{WSP(bf16, WS_ACT), DFF, WSP(float, WS_SSQ0), 1, build_rs_table(F, WSP(float, WS_SSQ0), 1, 1.0f / 2048.0f, u0.pm)};
        REPS(1) { pg8::gemm_phase<pg8::EpiSwiGLU, StaticOrder, true, true>(ring, g, S, E); REPBAR(1); }
        { const int first = S.nwg % F.G, nsl = F.G - first;
          const int w0 = (int)blockIdx.x >= first ? ((int)blockIdx.x - first) * NWAVES + F.wave : -1;
          meta_gateup(F, w0, nsl * NWAVES);
          constexpr int NMW = DFF / 16;
          convert_items(F, IT_CUT0, IT_BG, w0 >= NMW ? w0 - NMW : -1, nsl * NWAVES - NMW); }
        SEAM(1);
    }
    if (IN(2)) {
        meta_down(F);
        Gemm g{WSP(bf16, WS_ACT), WSP(bf16, WS_W1D), MR, DM, DFF}; StaticOrder S; S.init(MR, DM, F.G, (int)blockIdx.x);
        pg8::EpiResT<false> E{F.in[0], nullptr, nullptr, WSP(bf16, WS_XN), WSP(float, WS_SSQ1), 0.5f, DM, nullptr, 0, pg8::RsTable{nullptr, -1, -1}};
        REPS(2) { pg8::gemm_phase<pg8::EpiResT<false>, StaticOrder, true, true>(ring, g, S, E); REPBAR(2); }
        SEAM(2);
    }
    if (IN(3)) {
        Gemm g{WSP(bf16, WS_XN), WSP(bf16, WS_WIN), MR, NINP, DM}; StaticOrder S; S.init(MR, NINP, F.G, (int)blockIdx.x);
        pg8::Unit u0{0, 0}; (void)S.next(0, u0);
        pg8::EpiInProj E{WSP(bf16, WS_ACT), NINP, WSP(float, WS_SSQ1), F.in[8], F.in[9], WSP(float, WS_ROPE), build_rs_table(F, WSP(float, WS_SSQ1), 32, 1.0f / 2048.0f, u0.pm)};
        REPS(3) { pg8::gemm_phase<pg8::EpiInProj, StaticOrder, true, true>(ring, g, S, E); REPBAR(3); }
        { const int first = S.nwg % F.G, nsl = F.G - first;
          meta_inproj_and_dt(F, (int)blockIdx.x >= first ? ((int)blockIdx.x - first) * NWAVES + F.wave : -1, NMETA_IT + NDT_IT, nsl * NWAVES); }
        SEAM(3);
    }
    if (IN(4)) { REPS(4) { p4_mixer_attn(F); REPBAR(4); } SEAM(4); }
    if (IN(5)) { REPS(5) { p5_ssd_a(F); REPBAR(5); } SEAM(5); }
    if (IN(6)) { REPS(6) { p6_ssd_b(F); REPBAR(6); } SEAM(6); }
    if (IN(7)) {
        Gemm g{WSP(bf16, WS_MIX), WSP(bf16, WS_WOUT), MR, DM, DM}; StaticOrder S; S.init(MR, DM, F.G, (int)blockIdx.x);
        pg8::Unit u0{0, 0}; (void)S.next(0, u0);
        pg8::EpiResT<true> E{nullptr, WSP(bf16, WS_XN), nullptr, WSP(bf16, WS_XN), WSP(float, WS_SSQ2), 1.0f, DM, WSP(float, WS_SSQS), 16, build_rs_table(F, WSP(float, WS_SSQS), 32, 1.0f / 1024.0f, u0.pm)};
        pg8::gemm_phase<pg8::EpiResT<true>, StaticOrder, true, true>(ring, g, S, E);
        SEAM(7);
    }
    if (IN(8)) {
        Gemm g{WSP(bf16, WS_XN), WSP(bf16, WS_W2GU), MR, NGU, DM}; StaticOrder S; S.init(MR, NGU, F.G, (int)blockIdx.x);
        pg8::Unit u0{0, 0}; (void)S.next(0, u0);
        pg8::EpiSwiGLU E{WSP(bf16, WS_ACT), DFF, WSP(float, WS_SSQ2), 32, build_rs_table(F, WSP(float, WS_SSQ2), 32, 1.0f / 2048.0f, u0.pm)};
        REPS(8) { pg8::gemm_phase<pg8::EpiSwiGLU, StaticOrder, true, true>(ring, g, S, E); REPBAR(8); }
        SEAM(8);
    }
    if (IN(9)) {
        Gemm g{WSP(bf16, WS_ACT), WSP(bf16, WS_W2D), MR, DM, DFF}; StaticOrder S; S.init(MR, DM, F.G, (int)blockIdx.x);
        pg8::EpiResT<false> E{nullptr, WSP(bf16, WS_XN), F.out, nullptr, nullptr, 0.5f, DM, nullptr, 0, pg8::RsTable{nullptr, -1, -1}};
        pg8::gemm_phase<pg8::EpiResT<false>, StaticOrder, true, true>(ring, g, S, E);
    }
#undef IN
#undef SEAM
}

extern "C" void kernel_launch(void* const* d_in, const int* in_sizes, int n_in, void* d_out, int out_size, void* d_ws, size_t ws_size, hipStream_t stream) {
    static int grid = 0;
    if (grid == 0) {
        if (n_in != 26 || in_sizes[0] != MR * DM || out_size != MR * DM || ws_size < WS_END) { fprintf(stderr, "kernel_launch: unexpected shapes (n_in %d, in0 %d, out %d, ws %zu)\n", n_in, n_in > 0 ? in_sizes[0] : -1, out_size, ws_size); grid = -1; return; }
        int dev = 0, cus = 0, per_cu = 0;
        if (hipGetDevice(&dev) != hipSuccess || hipDeviceGetAttribute(&cus, hipDeviceAttributeMultiprocessorCount, dev) != hipSuccess) { grid = -1; return; }
        if (hipFuncSetAttribute((const void*)hymba_fwd, hipFuncAttributeMaxDynamicSharedMemorySize, LDS_BYTES) != hipSuccess) { fprintf(stderr, "kernel_launch: hipFuncSetAttribute failed\n"); grid = -1; return; }
        if (hipOccupancyMaxActiveBlocksPerMultiprocessor(&per_cu, (const void*)hymba_fwd, NWAVES * 64, LDS_BYTES) != hipSuccess || per_cu < 1) { fprintf(stderr, "kernel_launch: occupancy query says %d blocks per CU\n", per_cu); (void)hipGetLastError(); grid = -1; return; }
        grid = cus;
    }
    if (grid < 0) return;
    (void)hipMemsetAsync((char*)d_ws + WS_CTL, 0, CTL_ZERO_BYTES, stream);
    Args a{};
    for (int i = 0; i < 26; ++i) a.in[i] = (const float*)d_in[i];
    a.out = (float*)d_out; a.ws = (unsigned char*)d_ws;
    for (int li = 0; li < N_LAUNCHES; ++li) {
        a.ph_lo = (N_LAUNCHES == 1) ? 0 : li; a.ph_hi = (N_LAUNCHES == 1) ? NPH : li + 1;
        hipLaunchKernelGGL(hymba_fwd, dim3(grid), dim3(NWAVES * 64), LDS_BYTES, stream, a);
    }
}
```

```cpp
#include <hip/hip_runtime.h>
#include <cstdio>
#include <cstdint>
#include <cmath>
#ifndef MK_AMP
#define MK_AMP 0
#endif
namespace pg8 {
#define PG8_LAS __attribute__((address_space(3)))
typedef unsigned short bf16_t;
typedef short bf16x8 __attribute__((ext_vector_type(8)));
typedef float f32x4 __attribute__((ext_vector_type(4)));
typedef unsigned u32x4 __attribute__((ext_vector_type(4)));
constexpr int BM = 256, BK = 64, HALF = 128, HTB = HALF * BK * 2  , STAGE_BYTES = 8 * HTB, NXCD = 8, WGM = 8;

__host__ __device__ __forceinline__ int lds_byte(int r, int c) { const int st = (r >> 4) * 2 + (c >> 5), rr = r & 15, cc = c & 31, ob = rr * 64 + cc * 2; return st * 1024 + (ob ^ (((ob >> 9) & 1) << 5)); }
__host__ __device__ __forceinline__ void stage_rc(int b, int& R, int& C) { const int st = b / 1024, sb = b % 1024, swz = sb ^ (((sb >> 9) & 1) << 5); R = (st >> 1) * 16 + swz / 64; C = (st & 1) * 32 + (swz % 64) / 2; }
__host__ __device__ __forceinline__ int perm32(int rho) { const int n = rho >> 4, i = rho & 15; return 8 * (i >> 2) + 4 * n + (i & 3); }

struct Unit { int pm, pn; };
struct Gemm { const bf16_t* A; const bf16_t* Bt; int M, N, K; };

struct StaticOrder {
    int nM, nN, nwg, G, c;
    __host__ __device__ void init(int M, int N, int G_, int c_) { nM = M / BM; nN = N / BM; nwg = nM * nN; G = G_; c = c_; }
    __host__ __device__ __forceinline__ bool next(int i, Unit& u) const {
        const long L = (long)i * G + c; if (L >= nwg) return false;
        int wgid = (int)L; { const int q = nwg / NXCD, r = nwg % NXCD, xcd = wgid % NXCD, off = wgid / NXCD; wgid = (xcd < r ? xcd * (q + 1) : r * (q + 1) + (xcd - r) * q) + off; }
        const int nig = WGM * nN, gid = wgid / nig, fm = gid * WGM, gsz = (nM - fm) < WGM ? (nM - fm) : WGM;
        u.pm = fm + ((wgid % nig) % gsz); u.pn = (wgid % nig) / gsz; return true;
    }
    __device__ __forceinline__ void a_ready(const Unit&) const {}
    __device__ __forceinline__ void done(const Unit&) const {}
};


__device__ __forceinline__ unsigned cvt_pk_bf16(float lo, float hi) { unsigned r; asm volatile("v_cvt_pk_bf16_f32 %0, %1, %2" : "=v"(r) : "v"(lo), "v"(hi)); return r; }
typedef unsigned u32x2 __attribute__((ext_vector_type(2)));
constexpr float RMS_EPS = 1e-6f;
__device__ __forceinline__ float row_rs(const float* ssq, int np, int row, float inv_n = 1.0f / 2048.0f) {
    float s;
    if (np == 1) s = ssq[row];
    else { const f32x4* p = (const f32x4*)(ssq + (size_t)row * 32); f32x4 a = p[0];
#pragma unroll
        for (int i = 1; i < 8; ++i) a += p[i];
        s = (a[0] + a[1]) + (a[2] + a[3]); }
    return __builtin_amdgcn_rsqf(s * inv_n + RMS_EPS);
}
struct RsTable { const PG8_LAS float* t; int tpm, tpm2; };
__device__ __forceinline__ float row_rs_t(const RsTable& T, const float* ssq, int np, float inv_n, int pm, int rin) { return (pm == T.tpm) ? T.t[rin] : (pm == T.tpm2) ? T.t[256 + rin] : row_rs(ssq, np, pm * BM + rin, inv_n); }
__device__ __forceinline__ float silu_f(float g) { return g * __builtin_amdgcn_rcpf(1.0f + __builtin_amdgcn_exp2f(-1.4426950408889634f * g)); }

struct EpiSwiGLU {
    static constexpr bool PERM = true, AFTER_DRAIN = false, HAS_MID = false, AMP = (MK_AMP == 11);
    bf16_t* O; int ldc; const float* ssq; int np; RsTable T;
    __device__ __forceinline__ void mid(f32x4 (&)[2][2][4][2], const Unit&, int, int, int, int) const {}
    __device__ __forceinline__ void operator()(const f32x4 (&acc)[2][2][4][2], const Unit& u, int wr, int wc, int fr, int fq) const {
        const int row0 = u.pm * BM + wr * 64 + fr, col0 = u.pn * HALF + wc * 32 + 8 * fq;
#pragma unroll
        for (int ai = 0; ai < 2; ++ai)
#pragma unroll
            for (int m = 0; m < 4; ++m) { const int row = row0 + ai * HALF + m * 16; const float rs = row_rs_t(T, ssq, np, 1.0f / 2048.0f, u.pm, wr * 64 + fr + ai * HALF + m * 16);
                float a[8];
#pragma unroll
                for (int n = 0; n < 2; ++n)
#pragma unroll
                    for (int i = 0; i < 4; ++i) { const float g = acc[ai][0][m][n][i] * rs, up = acc[ai][1][m][n][i] * rs; a[4 * n + i] = silu_f(g) * up; }
                u32x4 w; w.x = cvt_pk_bf16(a[0], a[1]); w.y = cvt_pk_bf16(a[2], a[3]); w.z = cvt_pk_bf16(a[4], a[5]); w.w = cvt_pk_bf16(a[6], a[7]);
                *(u32x4*)(O + (size_t)row * ldc + col0) = w; }
    }
};
template <bool MID> struct EpiResT {
    static constexpr bool PERM = false, AFTER_DRAIN = false, HAS_MID = MID, AMP = false;
    const float* basef; const bf16_t* baseh; float* out; bf16_t* xn; float* ssq; float scale; int ldc; const float* rsm; int kmid; RsTable T;
    __device__ __forceinline__ void mid(f32x4 (&acc)[2][2][4][2], const Unit& u, int wr, int wc, int fr, int fq) const {
        int fro = fr; asm volatile("" : "+v"(fro));
        const int rin0 = wr * 64 + fro;
#pragma unroll
        for (int ai = 0; ai < 2; ++ai)
#pragma unroll
            for (int m = 0; m < 4; ++m) { const float r = row_rs_t(T, rsm, 32, 1.0f / 1024.0f, u.pm, rin0 + ai * HALF + m * 16);
#pragma unroll
                for (int bj = 0; bj < 2; ++bj)
#pragma unroll
                    for (int n = 0; n < 2; ++n) acc[ai][bj][m][n] *= r; }
    }
    __device__ __forceinline__ void operator()(const f32x4 (&acc)[2][2][4][2], const Unit& u, int wr, int wc, int fr, int fq) const {
        const int row0 = u.pm * BM + wr * 64 + fr, col0 = u.pn * BM + wc * 32 + 4 * fq;
#pragma unroll
        for (int ai = 0; ai < 2; ++ai) {
            f32x4 bf[4][2][2]; u32x2 bh[4][2][2];
#pragma unroll
            for (int m = 0; m < 4; ++m)
#pragma unroll
                for (int bj = 0; bj < 2; ++bj)
#pragma unroll
                    for (int n = 0; n < 2; ++n) { const size_t o1 = (size_t)(row0 + ai * HALF + m * 16) * ldc + col0 + bj * HALF + n * 16;
                        if (basef) bf[m][bj][n] = *(const f32x4*)(basef + o1); else bh[m][bj][n] = *(const u32x2*)(baseh + o1); }
#pragma unroll
            for (int m = 0; m < 4; ++m) { const int row = row0 + ai * HALF + m * 16; const size_t off = (size_t)row * ldc + col0; float sq = 0.f;
#pragma unroll
                for (int bj = 0; bj < 2; ++bj)
#pragma unroll
                    for (int n = 0; n < 2; ++n) { const size_t o1 = off + bj * HALF + n * 16; f32x4 b;
                        if (basef) b = bf[m][bj][n];
                        else { const u32x2 h = bh[m][bj][n]; b[0] = __uint_as_float(h.x << 16); b[1] = __uint_as_float(h.x & 0xffff0000u); b[2] = __uint_as_float(h.y << 16); b[3] = __uint_as_float(h.y & 0xffff0000u); }
                        const f32x4 o = b + acc[ai][bj][m][n] * scale;
                        if (out) *(f32x4*)(out + o1) = o;
                        if (xn) { sq += (o[0] * o[0] + o[1] * o[1]) + (o[2] * o[2] + o[3] * o[3]); u32x2 w; w.x = cvt_pk_bf16(o[0], o[1]); w.y = cvt_pk_bf16(o[2], o[3]); *(u32x2*)(xn + o1) = w; } }
                if (xn) { sq += __shfl_xor(sq, 16); sq += __shfl_xor(sq, 32); if (fq == 0) ssq[(size_t)row * 32 + u.pn * 4 + wc] = sq; } }
        }
    }
};
struct EpiInProj {
    static constexpr bool PERM = true, AFTER_DRAIN = false, HAS_MID = false, AMP = (MK_AMP == 12);
    bf16_t* U; int ldc; const float* ssq; const float* qn; const float* kn; const float* rope; RsTable T;
    __device__ __forceinline__ void mid(f32x4 (&)[2][2][4][2], const Unit&, int, int, int, int) const {}
    __device__ __forceinline__ void operator()(const f32x4 (&acc)[2][2][4][2], const Unit& u, int wr, int wc, int fr, int fq) const {
        const int row0 = u.pm * BM + wr * 64 + fr, col0 = u.pn * BM + wc * 64 + 8 * fq;
        const bool isqk = u.pn < 8;
        f32x4 wv[2][2];
        if (isqk) { const float* wn = (u.pn < 4) ? qn : kn;
#pragma unroll
            for (int bj = 0; bj < 2; ++bj)
#pragma unroll
                for (int n = 0; n < 2; ++n) wv[bj][n] = *(const f32x4*)(wn + 32 * bj + 8 * fq + 4 * n); }
#pragma unroll
        for (int ai = 0; ai < 2; ++ai)
#pragma unroll
            for (int m = 0; m < 4; ++m) { const int row = row0 + ai * HALF + m * 16; const float rs = row_rs_t(T, ssq, 32, 1.0f / 2048.0f, u.pm, wr * 64 + fr + ai * HALF + m * 16);
                f32x4 v[2][2];
#pragma unroll
                for (int bj = 0; bj < 2; ++bj)
#pragma unroll
                    for (int n = 0; n < 2; ++n) v[bj][n] = acc[ai][bj][m][n] * rs;
                if (isqk) {
                    float sq = 0.f;
#pragma unroll
                    for (int bj = 0; bj < 2; ++bj)
#pragma unroll
                        for (int n = 0; n < 2; ++n) sq += (v[bj][n][0] * v[bj][n][0] + v[bj][n][1] * v[bj][n][1]) + (v[bj][n][2] * v[bj][n][2] + v[bj][n][3] * v[bj][n][3]);
                    sq += __shfl_xor(sq, 16); sq += __shfl_xor(sq, 32);
                    const float r = __builtin_amdgcn_rsqf(sq * (1.0f / 64.0f) + RMS_EPS);
#pragma unroll
                    for (int bj = 0; bj < 2; ++bj)
#pragma unroll
                        for (int n = 0; n < 2; ++n) v[bj][n] = v[bj][n] * r * wv[bj][n];
                    const int pos = (row & 4095) + 16;
                    const f32x4 c0 = *(const f32x4*)(rope + pos * 16), c1 = *(const f32x4*)(rope + pos * 16 + 4), s0 = *(const f32x4*)(rope + pos * 16 + 8), s1 = *(const f32x4*)(rope + pos * 16 + 12);
                    f32x4 p0, p1;
#pragma unroll
                    for (int i = 0; i < 4; ++i) { p0[i] = __shfl_xor(v[0][0][i], 16); p1[i] = __shfl_xor(v[0][1][i], 16); }
                    if (fq == 0) { v[0][0] = v[0][0] * c0 - p0 * s0; v[0][1] = v[0][1] * c1 - p1 * s1; }
                    else if (fq == 1) { v[0][0] = v[0][0] * c0 + p0 * s0; v[0][1] = v[0][1] * c1 + p1 * s1; }
                    if (u.pn < 4) { v[0][0] *= 0.18033688011112042f; v[0][1] *= 0.18033688011112042f; v[1][0] *= 0.18033688011112042f; v[1][1] *= 0.18033688011112042f; }
                }
#pragma unroll
                for (int bj = 0; bj < 2; ++bj) { u32x4 w; w.x = cvt_pk_bf16(v[bj][0][0], v[bj][0][1]); w.y = cvt_pk_bf16(v[bj][0][2], v[bj][0][3]); w.z = cvt_pk_bf16(v[bj][1][0], v[bj][1][1]); w.w = cvt_pk_bf16(v[bj][1][2], v[bj][1][3]);
                    *(u32x4*)(U + (size_t)row * ldc + col0 + 32 * bj) = w; } }
    }
};

template <class Epi, class Sched, bool ALIGN_EPI = false, bool SP2 = false>
__device__ __forceinline__ void gemm_phase(PG8_LAS unsigned char* lds, const Gemm g, const Sched& S, const Epi& E) {
    const int tid = threadIdx.x, wid = __builtin_amdgcn_readfirstlane(tid >> 6), lane = tid & 63, wr = wid >> 2, wc = wid & 3, fr = lane & 15, fq = lane >> 4;
    const int K = g.K, nt = K / BK;
    unsigned voffA[2], voffB[2];
#pragma unroll
    for (int i = 0; i < 2; ++i) { int R, C; stage_rc(tid * 16 + i * 8192, R, C); const int Rb = Epi::PERM ? ((R & ~31) + perm32(R & 31)) : R;
        voffA[i] = (unsigned)(R * K + C) * 2u; voffB[i] = (unsigned)(Rb * K + C) * 2u; }
    const size_t kstep = (size_t)(BK * 2);
    const size_t hstep = (size_t)HALF * K * 2;
    const size_t tstep = 2 * hstep;
    const unsigned ldsw = (unsigned)wid * 1024u;
    const int aoff = lds_byte(wr * 64 + fr, fq * 8), boff = lds_byte(wc * 32 + fr, fq * 8);
#define PG8_SA(b, h) (((b) * 2 + (h)) * HTB)
#define PG8_SB(b, h) ((4 + (b) * 2 + (h)) * HTB)
#define PG8_STAGE(bufoff, gbase, voff) do { _Pragma("unroll") for (int _i = 0; _i < 2; ++_i) \
        __builtin_amdgcn_global_load_lds((const unsigned*)((const char*)(gbase) + (voff)[_i]), (PG8_LAS unsigned*)(lds + (bufoff) + ldsw + _i * 8192), 16, 0, 0); } while (0)
#define PG8_LDA(dst, b, h) do { _Pragma("unroll") for (int m = 0; m < 4; ++m) _Pragma("unroll") for (int k = 0; k < 2; ++k) dst[m][k] = *(const PG8_LAS bf16x8*)(lds + PG8_SA(b, h) + aoff + m * 2048 + k * 1024); } while (0)
#define PG8_LDB(dst, b, h) do { _Pragma("unroll") for (int n = 0; n < 2; ++n) _Pragma("unroll") for (int k = 0; k < 2; ++k) dst[n][k] = *(const PG8_LAS bf16x8*)(lds + PG8_SB(b, h) + boff + n * 2048 + k * 1024); } while (0)
#define PG8_MMA(ai, bj, At, Bt) do { __builtin_amdgcn_s_setprio(1); _Pragma("unroll") for (int m = 0; m < 4; ++m) _Pragma("unroll") for (int n = 0; n < 2; ++n) _Pragma("unroll") for (int k = 0; k < 2; ++k) \
        acc[ai][bj][m][n] = __builtin_amdgcn_mfma_f32_16x16x32_bf16(Bt[n][k], At[m][k], acc[ai][bj][m][n], 0, 0, 0); __builtin_amdgcn_s_setprio(0); } while (0)
#define PG8_WAIT_V(n) asm volatile("s_waitcnt vmcnt(" #n ")" ::: "memory")
#define PG8_WAIT_L(n) asm volatile("s_waitcnt lgkmcnt(" #n ")" ::: "memory")
#define PG8_BAR __builtin_amdgcn_s_barrier()
#define PG8_SCHED __builtin_amdgcn_sched_barrier(0)
    Unit cur, nxt; int ui = 0;
    if (!S.next(0, cur)) return;
    f32x4 acc[2][2][4][2];
#pragma unroll
    for (int a = 0; a < 2; ++a)
#pragma unroll
        for (int b = 0; b < 2; ++b)
#pragma unroll
            for (int m = 0; m < 4; ++m)
#pragma unroll
                for (int n = 0; n < 2; ++n) acc[a][b][m][n] = (f32x4){0.f, 0.f, 0.f, 0.f};
    bf16x8 At[4][2], B0[2][2], B1[2][2];
    const char* cA = (const char*)g.A + (size_t)cur.pm * tstep; const char* cB = (const char*)g.Bt + (size_t)cur.pn * tstep;
    S.a_ready(cur);
    if constexpr (SP2) {
        PG8_STAGE(PG8_SB(0, 0), cB, voffB); PG8_STAGE(PG8_SB(0, 1), cB + hstep, voffB); PG8_STAGE(PG8_SA(0, 0), cA, voffA); PG8_STAGE(PG8_SA(0, 1), cA + hstep, voffA);
        if (wr == 1) PG8_BAR;
        PG8_WAIT_V(2); PG8_BAR;
        PG8_STAGE(PG8_SB(1, 0), cB + kstep, voffB); PG8_STAGE(PG8_SA(1, 0), cA + kstep, voffA); PG8_STAGE(PG8_SB(1, 1), cB + hstep + kstep, voffB);
        PG8_WAIT_V(6); PG8_BAR;
    } else {
        PG8_STAGE(PG8_SB(0, 0), cB, voffB); PG8_STAGE(PG8_SA(0, 0), cA, voffA); PG8_STAGE(PG8_SB(0, 1), cB + hstep, voffB); PG8_STAGE(PG8_SA(0, 1), cA + hstep, voffA);
        if (wr == 1) PG8_BAR;
        PG8_WAIT_V(4); PG8_BAR;
        PG8_STAGE(PG8_SB(1, 0), cB + kstep, voffB); PG8_STAGE(PG8_SA(1, 0), cA + kstep, voffA); PG8_STAGE(PG8_SB(1, 1), cB + hstep + kstep, voffB);
        PG8_WAIT_V(6); PG8_BAR;
    }
    for (;;) {
        const bool has_next = S.next(ui + 1, nxt);
        const char* nA = has_next ? (const char*)g.A + (size_t)nxt.pm * tstep : cA; const char* nB = has_next ? (const char*)g.Bt + (size_t)nxt.pn * tstep : cB;
        for (int t = 0; t < nt; t += 2) {
            const bool last = (t == nt - 2);
            if constexpr (Epi::HAS_MID) { if (t == E.kmid) E.mid(acc, cur, wr, wc, fr, fq); }
            const char* a1 = cA + (size_t)(t + 1) * kstep;
            const char* a2 = last ? nA : cA + (size_t)(t + 2) * kstep; const char* b2 = last ? nB : cB + (size_t)(t + 2) * kstep;
            const char* a3 = a2 + kstep; const char* b3 = b2 + kstep;
            if (last && has_next) S.a_ready(nxt);
            if constexpr (SP2) {
            PG8_LDB(B0, 0, 0); PG8_LDB(B1, 0, 1); PG8_SCHED; PG8_LDA(At, 0, 0); PG8_STAGE(PG8_SA(1, 1), a1 + hstep, voffA);
            PG8_WAIT_V(8); PG8_WAIT_L(0); PG8_BAR; PG8_MMA(0, 0, At, B0); PG8_MMA(0, 1, At, B1); PG8_BAR; PG8_SCHED;
            PG8_LDA(At, 0, 1); PG8_STAGE(PG8_SB(0, 0), b2, voffB); PG8_STAGE(PG8_SB(0, 1), b2 + hstep, voffB); PG8_STAGE(PG8_SA(0, 0), a2, voffA);
            PG8_WAIT_V(8); PG8_WAIT_L(0); PG8_BAR; PG8_MMA(1, 0, At, B0); PG8_MMA(1, 1, At, B1); PG8_BAR; PG8_SCHED;
            PG8_LDB(B0, 1, 0); PG8_LDB(B1, 1, 1); PG8_SCHED; PG8_LDA(At, 1, 0); PG8_STAGE(PG8_SA(0, 1), a2 + hstep, voffA);
            PG8_WAIT_V(8); PG8_WAIT_L(0); PG8_BAR; PG8_MMA(0, 0, At, B0); PG8_MMA(0, 1, At, B1); PG8_BAR; PG8_SCHED;
            PG8_LDA(At, 1, 1); PG8_STAGE(PG8_SB(1, 0), b3, voffB); PG8_STAGE(PG8_SB(1, 1), b3 + hstep, voffB); PG8_STAGE(PG8_SA(1, 0), a3, voffA);
            PG8_WAIT_V(8); PG8_WAIT_L(0); PG8_BAR; PG8_MMA(1, 0, At, B0); PG8_MMA(1, 1, At, B1); PG8_BAR; PG8_SCHED;
            } else {
            PG8_LDB(B0, 0, 0); PG8_SCHED; PG8_LDA(At, 0, 0); PG8_STAGE(PG8_SA(1, 1), a1 + hstep, voffA);
            PG8_WAIT_L(8); PG8_BAR; PG8_WAIT_L(0); PG8_MMA(0, 0, At, B0); PG8_BAR; PG8_SCHED;
            PG8_LDB(B1, 0, 1); PG8_STAGE(PG8_SB(0, 0), b2, voffB);
            PG8_BAR; PG8_WAIT_L(0); PG8_MMA(0, 1, At, B1); PG8_BAR;
            PG8_LDA(At, 0, 1); PG8_STAGE(PG8_SA(0, 0), a2, voffA);
            PG8_BAR; PG8_WAIT_L(0); PG8_MMA(1, 0, At, B0); PG8_BAR; PG8_SCHED;
            PG8_STAGE(PG8_SB(0, 1), b2 + hstep, voffB);
            PG8_WAIT_V(6); PG8_BAR; PG8_MMA(1, 1, At, B1); PG8_BAR;
            PG8_LDB(B0, 1, 0); PG8_SCHED; PG8_LDA(At, 1, 0); PG8_STAGE(PG8_SA(0, 1), a2 + hstep, voffA);
            PG8_WAIT_L(8); PG8_BAR; PG8_WAIT_L(0); PG8_MMA(0, 0, At, B0); PG8_BAR; PG8_SCHED;
            PG8_LDB(B1, 1, 1); PG8_STAGE(PG8_SB(1, 0), b3, voffB);
            PG8_BAR; PG8_WAIT_L(0); PG8_MMA(0, 1, At, B1); PG8_BAR;
            PG8_LDA(At, 1, 1); PG8_STAGE(PG8_SA(1, 0), a3, voffA);
            PG8_BAR; PG8_WAIT_L(0); PG8_MMA(1, 0, At, B0); PG8_BAR; PG8_SCHED;
            PG8_STAGE(PG8_SB(1, 1), b3 + hstep, voffB);
            PG8_WAIT_V(6); PG8_BAR; PG8_MMA(1, 1, At, B1); PG8_BAR;
            }
        }
        if constexpr (ALIGN_EPI) { if (wr == 0) PG8_BAR; }
        if constexpr (!Epi::AFTER_DRAIN) { for (int amp_ = 0; amp_ < (Epi::AMP ? 3 : 1); ++amp_) { E(acc, cur, wr, wc, fr, fq); asm volatile("" ::: "memory"); } S.done(cur); }
        if (!has_next) break;
#pragma unroll
        for (int a = 0; a < 2; ++a)
#pragma unroll
            for (int b = 0; b < 2; ++b)
#pragma unroll
                for (int m = 0; m < 4; ++m)
#pragma unroll
                    for (int n = 0; n < 2; ++n) acc[a][b][m][n] = (f32x4){0.f, 0.f, 0.f, 0.f};
        cur = nxt; cA = nA; cB = nB; ++ui;
        if constexpr (ALIGN_EPI) { if (wr == 1) PG8_BAR; }
    }
    PG8_WAIT_V(0);
    if constexpr (!ALIGN_EPI) { if (wr == 0) PG8_BAR; }
    PG8_BAR;
    if constexpr (Epi::AFTER_DRAIN) { E.fused(acc, cur, wr, wc, fr, fq, lds, wid, lane); S.done(cur); }
#undef PG8_SA
#undef PG8_SB
#undef PG8_STAGE
#undef PG8_LDA
#undef PG8_LDB
#undef PG8_MMA
#undef PG8_WAIT_V
#undef PG8_WAIT_L
#undef PG8_BAR
#undef PG8_SCHED
}
}

#ifndef PG8_SP2
#define PG8_SP2 true
#endif

constexpr int NWAVES = 8;
constexpr int DM = 2048, SEQ = 4096, NBATCH = 2, MR = NBATCH * SEQ, NMETA = 16, LPOS = SEQ + NMETA;
constexpr int DFF = 5632, NGU = 2 * DFF;
constexpr int NHEAD = 8, SH = 16, CONVD = 1536, NIN = 5648, NINP = 5632;
constexpr int PPAD = 48, LPAD = LPOS + PPAD;
constexpr float EPS = 1e-6f;
#ifndef MK_REPEAT_PHASE
#define MK_REPEAT_PHASE -1
#endif
#ifndef MK_N_LAUNCHES
#define MK_N_LAUNCHES 1
#endif
constexpr int NPH = 10;
constexpr int N_LAUNCHES = MK_N_LAUNCHES;

constexpr size_t MiB = 1u << 20;
constexpr size_t WS_CTL = 0, CTL_ZERO_BYTES = 1 * MiB;
constexpr size_t WS_W1GU = 2 * MiB, WS_W1D = 46 * MiB, WS_WIN = 68 * MiB, WS_WOUT = 91 * MiB, WS_W2GU = 99 * MiB, WS_W2D = 143 * MiB;
constexpr size_t WS_XN = 165 * MiB;
constexpr size_t WS_ACT = 197 * MiB;
constexpr size_t WS_MIX = 285 * MiB;
constexpr size_t WS_SSQ0 = 317 * MiB;
constexpr size_t WS_SSQ1 = 318 * MiB, WS_SSQ2 = 319 * MiB;
constexpr size_t WS_DTR = 320 * MiB;
constexpr size_t WS_ROPE = 321 * MiB;
constexpr size_t WS_META = 322 * MiB;
constexpr size_t MO_XN = 0, MO_SSQ0 = 65536, MO_ACT = 131072, MO_H1 = 327680, MO_XN1 = 458752, MO_U = 524288, MO_KM = 917504, MO_VM = 950272, MO_SSQ1 = 69632;
constexpr size_t WS_SST = 324 * MiB;
constexpr size_t WS_ATOT = 333 * MiB;
constexpr size_t WS_SSQS = 334 * MiB;
constexpr size_t WS_XS = 336 * MiB;
constexpr size_t WS_BC = 353 * MiB;
constexpr size_t WS_DT = 362 * MiB;
constexpr size_t WS_END = 363 * MiB;
constexpr int CW_BAR = 4096;

constexpr int RING_OFF = 0, RING_BYTES = 131072;
constexpr int LDS_BYTES = 147456, MISC_OFF = LDS_BYTES - 512;

#define GAS __attribute__((address_space(1)))
#define LAS __attribute__((address_space(3)))
typedef unsigned short bf16;
typedef unsigned v4u __attribute__((ext_vector_type(4)));
typedef float f32x4 __attribute__((ext_vector_type(4)));
typedef short bf16x8 __attribute__((ext_vector_type(8)));
typedef GAS unsigned gu32;
typedef GAS unsigned long long gu64;
#define RLX_AGENT __ATOMIC_RELAXED, __HIP_MEMORY_SCOPE_AGENT
#define LDS_WAIT() asm volatile("s_waitcnt lgkmcnt(0)" ::: "memory")
#define VM_WAIT() asm volatile("s_waitcnt vmcnt(0)" ::: "memory")
__device__ __forceinline__ unsigned long long rt() { return __builtin_amdgcn_s_memrealtime(); }
__device__ __forceinline__ unsigned f2bf(float f) { unsigned u = __builtin_bit_cast(unsigned, f); return (u + 0x7fffu + ((u >> 16) & 1u)) >> 16; }
__device__ __forceinline__ unsigned pk2(float lo, float hi) { return f2bf(lo) | (f2bf(hi) << 16); }

#define XB_TMO      128
#define XB_XCNT(j)  (256  + 64 * (j))
#define XB_XSUB(j)  (1280 + 64 * (j))
#define XB_XGEN(j)  (2304 + 64 * (j))
#define XB_TOP      3328
#define XB_TOPGEN   3392
#define XCD_BAR_WORDS 3456
#define XB_SPIN_CAP (1u << 18)

__device__ __forceinline__ unsigned xb_ld(unsigned* p)              { return __hip_atomic_load(p, __ATOMIC_RELAXED, __HIP_MEMORY_SCOPE_AGENT); }
__device__ __forceinline__ unsigned xb_add(unsigned* p, unsigned v) { return __hip_atomic_fetch_add(p, v, __ATOMIC_RELAXED, __HIP_MEMORY_SCOPE_AGENT); }
__device__ __forceinline__ unsigned xb_xcc_id() { return (unsigned)__builtin_amdgcn_s_getreg((3 << 11) | 20) & 0xFu; }
#define XB_SPIN(cond, bar) do { unsigned _sp = 0; while (cond) { __builtin_amdgcn_s_sleep(1); \
    if ((++_sp & 255u) == 0u) { if (xb_ld(&(bar)[XB_TMO])) break; if (_sp > XB_SPIN_CAP) { atomicAdd(&(bar)[XB_TMO], 1u); break; } } } } while (0)

struct XcdBarrier {
    unsigned* bar; unsigned x;
    volatile LAS unsigned* st;
};

__device__ __forceinline__ XcdBarrier xcd_barrier_post(unsigned* bar, volatile LAS unsigned* st) {
    XcdBarrier b; b.bar = bar; b.x = xb_xcc_id(); b.st = st;
    if (threadIdx.x == 0) (void)xb_add(&bar[XB_XCNT(b.x)], 1u);
    return b;
}
__device__ __forceinline__ void xcd_barrier_complete(unsigned* bar, unsigned x, unsigned& nloc, unsigned& nx) {
    const unsigned G = gridDim.x * gridDim.y * gridDim.z;
    unsigned sum, cnt, mine, sp = 0u;
    for (;;) {
        sum = 0u; cnt = 0u; mine = 0u;
#pragma unroll
        for (unsigned j = 0; j < 16; ++j) { const unsigned c = xb_ld(&bar[XB_XCNT(j)]); sum += c; cnt += (c > 0u) ? 1u : 0u; mine = (j == x) ? c : mine; }
        if (sum == G) break;
        __builtin_amdgcn_s_sleep(1);
        if ((++sp & 255u) == 0u) { if (xb_ld(&bar[XB_TMO])) break; if (sp > XB_SPIN_CAP) { atomicAdd(&bar[XB_TMO], 1u); break; } }
    }
    nloc = mine > 0u ? mine : 1u; nx = cnt > 0u ? cnt : 1u;
}

__device__ __forceinline__ void xcd_barrier(const XcdBarrier& b) {
    asm volatile("s_waitcnt vmcnt(0)" ::: "memory");
    __syncthreads();
    if (threadIdx.x == 0) {
        unsigned* bar = b.bar;
        __builtin_amdgcn_s_waitcnt(0);
        unsigned nloc = b.st[0], nx = b.st[1];
        if (nloc == 0u) { xcd_barrier_complete(bar, b.x, nloc, nx); b.st[0] = nloc; b.st[1] = nx; }
        const unsigned old = xb_add(&bar[XB_XSUB(b.x)], 1u);
        const unsigned gen = old / nloc;
        if (old + 1u == (gen + 1u) * nloc) {
            __builtin_amdgcn_fence(__ATOMIC_RELEASE, "agent");
            asm volatile("s_waitcnt vmcnt(0)" ::: "memory");
            const unsigned og = xb_add(&bar[XB_TOP], 1u);
            const unsigned tg = og / nx;
            if (og + 1u == (tg + 1u) * nx) xb_add(&bar[XB_TOPGEN], 1u);
            else XB_SPIN(xb_ld(&bar[XB_TOPGEN]) == tg, bar);
            __builtin_amdgcn_fence(__ATOMIC_ACQUIRE, "agent");
            xb_add(&bar[XB_XGEN(b.x)], 1u);
            asm volatile("s_waitcnt vmcnt(0)" ::: "memory");
        } else {
            XB_SPIN(xb_ld(&bar[XB_XGEN(b.x)]) == gen, bar);
            __builtin_amdgcn_fence(__ATOMIC_ACQUIRE, "agent");
            asm volatile("s_waitcnt vmcnt(0)" ::: "memory");
        }
    }
    __syncthreads();
}


typedef unsigned u32x2v __attribute__((ext_vector_type(2)));
__device__ __forceinline__ float bf2f(unsigned b) { return __uint_as_float(b << 16); }
__device__ __forceinline__ float wave_sum(float v) {
#pragma unroll
    for (int o = 1; o < 64; o <<= 1) v += __shfl_xor(v, o);
    return v;
}
__device__ __forceinline__ float wave_max(float v) {
#pragma unroll
    for (int o = 1; o < 64; o <<= 1) v = fmaxf(v, __shfl_xor(v, o));
    return v;
}
__device__ __forceinline__ float silu1(float g) { return g * __builtin_amdgcn_rcpf(1.0f + __builtin_amdgcn_exp2f(-1.4426950408889634f * g)); }

struct Frame {
    LAS unsigned char* lds;
    int tid, lane, wave, G, gw, NGW;
    const float* in[26]; float* out; unsigned char* ws; const float* const* inp;
};
#define WSP(T, off) ((T*)(F.ws + (off)))

constexpr int RST_OFF = RING_BYTES;
__device__ __forceinline__ pg8::RsTable build_rs_table(Frame& F, const float* ssq, int np, float inv_n, int pm, int pm2 = -1) {
    LAS float* t = (LAS float*)(F.lds + RST_OFF);
    if (F.tid < 256) t[F.tid] = pg8::row_rs(ssq, np, pm * 256 + F.tid, inv_n);
    else if (pm2 >= 0) t[F.tid] = pg8::row_rs(ssq, np, pm2 * 256 + F.tid - 256, inv_n);
    __syncthreads();
    return pg8::RsTable{t, pm, pm2};
}
__device__ __forceinline__ int rowmap(int kind, int n) {
    if (kind == 1) return 256 * (n >> 7) + (n & 127);
    if (kind == 2) return 256 * (n >> 7) + 128 + (n & 127);
    if (kind == 3) { if (n >= NINP) return n; const int pn = n >> 8, rem = n & 255, wc = rem >> 6, bj = (rem >> 5) & 1, j = rem & 31; return 256 * pn + 128 * bj + 32 * wc + j; }
    return n;
}
struct TItem { const float* W; int K, N; const float* kscale; bf16* WT; int kind, item, ks_off, krot; };
__device__ __forceinline__ void transpose_load(const TItem& t, int lane, f32x4 (&v)[16]) {
    const int nblk = (t.N + 63) >> 6, kb = t.item / nblk, nb = t.item - kb * nblk, k0 = 64 * kb, n0 = 64 * nb;
    const float* src = t.W + (size_t)(k0 + 8 * (lane >> 3)) * t.N;
#pragma unroll
    for (int h = 0; h < 2; ++h) { int nl = n0 + 32 * h + 4 * (lane & 7); nl = nl < t.N ? nl : t.N - 4;
#pragma unroll
        for (int i = 0; i < 8; ++i) v[8 * h + i] = __builtin_nontemporal_load((const f32x4*)(src + (size_t)i * t.N + nl)); }
}
__device__ __forceinline__ void transpose_finish(const TItem& t, int lane, f32x4 (&v)[16]) {
    const int nblk = (t.N + 63) >> 6, kb = t.item / nblk, nb = t.item - kb * nblk, k0 = 64 * kb, n0 = 64 * nb, r = lane >> 3;
    float sc[8];
    if (t.kscale && k0 >= t.ks_off) { const f32x4 s0 = *(const f32x4*)(t.kscale + k0 + 8 * r - t.ks_off), s1 = *(const f32x4*)(t.kscale + k0 + 8 * r - t.ks_off + 4);
        sc[0] = s0[0]; sc[1] = s0[1]; sc[2] = s0[2]; sc[3] = s0[3]; sc[4] = s1[0]; sc[5] = s1[1]; sc[6] = s1[2]; sc[7] = s1[3]; }
    else {
#pragma unroll
        for (int i = 0; i < 8; ++i) sc[i] = 1.0f; }
    int kd = k0 + t.krot; if (kd >= t.K) kd -= t.K;
#pragma unroll
    for (int h = 0; h < 2; ++h)
#pragma unroll
        for (int j = 0; j < 4; ++j) { const int n = n0 + 32 * h + 4 * (lane & 7) + j;
            v4u o; o.x = pg8::cvt_pk_bf16(v[8 * h + 0][j] * sc[0], v[8 * h + 1][j] * sc[1]); o.y = pg8::cvt_pk_bf16(v[8 * h + 2][j] * sc[2], v[8 * h + 3][j] * sc[3]);
            o.z = pg8::cvt_pk_bf16(v[8 * h + 4][j] * sc[4], v[8 * h + 5][j] * sc[5]); o.w = pg8::cvt_pk_bf16(v[8 * h + 6][j] * sc[6], v[8 * h + 7][j] * sc[7]);
            if (n < t.N) *(v4u*)(t.WT + (size_t)rowmap(t.kind, n) * t.K + kd + 8 * r) = o; }
}
__device__ __forceinline__ void transpose_load_h(const TItem& t, int lane, int h, f32x4 (&v)[8]) {
    const int nblk = (t.N + 63) >> 6, kb = t.item / nblk, nb = t.item - kb * nblk, k0 = 64 * kb, n0 = 64 * nb;
    const float* src = t.W + (size_t)(k0 + 8 * (lane >> 3)) * t.N;
    int nl = n0 + 32 * h + 4 * (lane & 7); nl = nl < t.N ? nl : t.N - 4;
#pragma unroll
    for (int i = 0; i < 8; ++i) v[i] = __builtin_nontemporal_load((const f32x4*)(src + (size_t)i * t.N + nl));
}
__device__ __forceinline__ void transpose_finish_h(const TItem& t, int lane, int h, f32x4 (&v)[8]) {
    const int nblk = (t.N + 63) >> 6, kb = t.item / nblk, nb = t.item - kb * nblk, k0 = 64 * kb, n0 = 64 * nb, r = lane >> 3;
    float sc[8];
    if (t.kscale && k0 >= t.ks_off) { const f32x4 s0 = *(const f32x4*)(t.kscale + k0 + 8 * r - t.ks_off), s1 = *(const f32x4*)(t.kscale + k0 + 8 * r - t.ks_off + 4);
        sc[0] = s0[0]; sc[1] = s0[1]; sc[2] = s0[2]; sc[3] = s0[3]; sc[4] = s1[0]; sc[5] = s1[1]; sc[6] = s1[2]; sc[7] = s1[3]; }
    else {
#pragma unroll
        for (int i = 0; i < 8; ++i) sc[i] = 1.0f; }
    int kd = k0 + t.krot; if (kd >= t.K) kd -= t.K;
#pragma unroll
    for (int j = 0; j < 4; ++j) { const int n = n0 + 32 * h + 4 * (lane & 7) + j;
        v4u o; o.x = pg8::cvt_pk_bf16(v[0][j] * sc[0], v[1][j] * sc[1]); o.y = pg8::cvt_pk_bf16(v[2][j] * sc[2], v[3][j] * sc[3]);
        o.z = pg8::cvt_pk_bf16(v[4][j] * sc[4], v[5][j] * sc[5]); o.w = pg8::cvt_pk_bf16(v[6][j] * sc[6], v[7][j] * sc[7]);
        if (n < t.N) *(v4u*)(t.WT + (size_t)rowmap(t.kind, n) * t.K + kd + 8 * r) = o; }
}
__device__ __forceinline__ void row_to_bf16(const float* xrow, bf16* orow, float* ssq, int lane) {
    const f32x4* xr = (const f32x4*)xrow + lane; float s = 0.f; f32x4 v[8];
#pragma unroll
    for (int j = 0; j < 8; ++j) { v[j] = __builtin_nontemporal_load(xr + 64 * j); s += (v[j][0] * v[j][0] + v[j][1] * v[j][1]) + (v[j][2] * v[j][2] + v[j][3] * v[j][3]); }
    s = wave_sum(s);
    u32x2v* o8 = (u32x2v*)orow + lane;
#pragma unroll
    for (int j = 0; j < 8; ++j) { u32x2v w; w.x = pk2(v[j][0], v[j][1]); w.y = pk2(v[j][2], v[j][3]); o8[64 * j] = w; }
    if (lane == 0) *ssq = s;
}
__constant__ float ROPE_INV[8] = {1.0f, 0.1939227432012558f, 0.03760603070259094f, 0.007292664609849453f, 0.0014142135623842478f, 0.00027424818836152554f, 5.318296098266728e-05f, 1.0313386155758053e-05f};
constexpr int I_G = 32 * 88, I_D = 88 * 32, I_IN = 32 * 89, I_O = 32 * 32;
constexpr int IT_W1G = 0, IT_W1U = IT_W1G + I_G, IT_WOUT = IT_W1U + I_G, IT_W1D = IT_WOUT + I_O, IT_WIN = IT_W1D + I_D, IT_W2U = IT_WIN + I_IN, IT_W2G = IT_W2U + I_G, IT_W2D = IT_W2G + I_G, IT_END = IT_W2D + I_D;
#ifndef MK_N1
#define MK_N1 6944
#endif
constexpr int IT_BG = IT_END - 8192;
constexpr int IT_CUT0 = IT_BG - MK_N1;
static_assert(IT_CUT0 >= IT_WOUT, "W1 gate/up are needed by P1");
__device__ __forceinline__ TItem mk_item(Frame& F, int it) {
    const int m = (it >= IT_W1U) + (it >= IT_WOUT) + (it >= IT_W1D) + (it >= IT_WIN) + (it >= IT_W2U) + (it >= IT_W2G) + (it >= IT_W2D);
    const int start = m == 0 ? IT_W1G : m == 1 ? IT_W1U : m == 2 ? IT_WOUT : m == 3 ? IT_W1D : m == 4 ? IT_WIN : m == 5 ? IT_W2U : m == 6 ? IT_W2G : IT_W2D;
    const unsigned long long WI = 0x1917180705150403ull, SI = 0xff161606ff140202ull;
    const int wi = (int)((WI >> (8 * m)) & 0xffu), si = (int)((SI >> (8 * m)) & 0xffu);
    const bool down = (m == 3 || m == 7);
    const size_t wto = m < 2 ? WS_W1GU : m == 2 ? WS_WOUT : m == 3 ? WS_W1D : m == 4 ? WS_WIN : m < 7 ? WS_W2GU : WS_W2D;
    const int kind = (m == 0 || m == 6) ? 1 : (m == 1 || m == 5) ? 2 : m == 4 ? 3 : 0;
    TItem t; t.W = F.inp[wi]; t.K = down ? DFF : DM; t.N = down ? DM : m == 2 ? DM : m == 4 ? NIN : DFF; t.kscale = si == 0xff ? nullptr : F.inp[si]; t.WT = WSP(bf16, wto); t.kind = kind; t.item = it - start;
    t.ks_off = m == 2 ? 1024 : 0; t.krot = m == 2 ? 1024 : 0;
    return t;
}
__device__ __forceinline__ void convert_items(Frame& F, int lo, int hi, int w, int nw) {
    if (w < 0) return;
    f32x4 va[16], vb[16]; int it = lo + w;
    if (it < hi) { TItem ta = mk_item(F, it); transpose_load(ta, F.lane, va);
        for (;;) {
            const int itb = it + nw; TItem tb = mk_item(F, itb < hi ? itb : it);
            if (itb < hi) transpose_load(tb, F.lane, vb);
            transpose_finish(ta, F.lane, va);
            if (itb >= hi) break;
            const int itc = itb + nw; ta = mk_item(F, itc < hi ? itc : itb);
            if (itc < hi) transpose_load(ta, F.lane, va);
            transpose_finish(tb, F.lane, vb);
            if (itc >= hi) break;
            it = itc;
        } }
}
__device__ __forceinline__ void p0_prologue(Frame& F) {
    convert_items(F, 0, IT_CUT0, F.gw, F.NGW);
    for (int m = F.gw; m < MR; m += 2 * F.NGW) {
        const int m2 = m + F.NGW;
        const f32x4* xa = (const f32x4*)(F.in[0] + (size_t)m * DM) + F.lane; const f32x4* xb = (const f32x4*)(F.in[0] + (size_t)(m2 < MR ? m2 : m) * DM) + F.lane;
        f32x4 va[8], vb[8]; float sa = 0.f, sb = 0.f;
#pragma unroll
        for (int j = 0; j < 8; ++j) { va[j] = __builtin_nontemporal_load(xa + 64 * j); vb[j] = __builtin_nontemporal_load(xb + 64 * j); }
#pragma unroll
        for (int j = 0; j < 8; ++j) { sa += (va[j][0] * va[j][0] + va[j][1] * va[j][1]) + (va[j][2] * va[j][2] + va[j][3] * va[j][3]); sb += (vb[j][0] * vb[j][0] + vb[j][1] * vb[j][1]) + (vb[j][2] * vb[j][2] + vb[j][3] * vb[j][3]); }
        sa = wave_sum(sa); sb = wave_sum(sb);
        u32x2v* oa = (u32x2v*)(WSP(bf16, WS_XN) + (size_t)m * DM) + F.lane; u32x2v* ob = (u32x2v*)(WSP(bf16, WS_XN) + (size_t)m2 * DM) + F.lane;
#pragma unroll
        for (int j = 0; j < 8; ++j) { u32x2v w; w.x = pk2(va[j][0], va[j][1]); w.y = pk2(va[j][2], va[j][3]); oa[64 * j] = w; }
        if (F.lane == 0) WSP(float, WS_SSQ0)[m] = sa;
        if (m2 < MR) {
#pragma unroll
            for (int j = 0; j < 8; ++j) { u32x2v w; w.x = pk2(vb[j][0], vb[j][1]); w.y = pk2(vb[j][2], vb[j][3]); ob[64 * j] = w; }
            if (F.lane == 0) WSP(float, WS_SSQ0)[m2] = sb; }
    }
    for (int p = F.gw; p < NMETA; p += F.NGW) row_to_bf16(F.in[1] + (size_t)p * DM, WSP(bf16, WS_META + MO_XN) + (size_t)p * DM, WSP(float, WS_META + MO_SSQ0) + p, F.lane);
    for (int e = F.gw * 64 + F.lane; e < LPOS * 8; e += F.NGW * 64) { const int pos = e >> 3, i = e & 7;
        const float ang = (float)pos * ROPE_INV[i];
        double tr = (double)ang * 0.15915494309189535; tr -= __builtin_rint(tr);
        const float tf = (float)tr;
        WSP(float, WS_ROPE)[pos * 16 + i] = __builtin_amdgcn_cosf(tf); WSP(float, WS_ROPE)[pos * 16 + 8 + i] = __builtin_amdgcn_sinf(tf); }
}

__device__ __forceinline__ f32x4 skinny16(const bf16* A, int lda, const bf16* Bt, int ldb, int k0, int k1, int lane, f32x4 acc) {
    const bf16* ap = A + (size_t)(lane & 15) * lda + 8 * (lane >> 4);
    const bf16* bp = Bt + (size_t)(lane & 15) * ldb + 8 * (lane >> 4);
#pragma unroll 16
    for (int k = k0; k < k1; k += 32) { const bf16x8 a = *(const bf16x8*)(ap + k), b = *(const bf16x8*)(bp + k);
        acc = __builtin_amdgcn_mfma_f32_16x16x32_bf16(a, b, acc, 0, 0, 0); }
    asm volatile("s_nop 15\n\ts_nop 3" : "+v"(acc));
    return acc;
}
__device__ __forceinline__ void meta_gateup(Frame& F, int w0, int wstride) {
    const bf16* A = WSP(bf16, WS_META + MO_XN); const float* ssq = WSP(float, WS_META + MO_SSQ0); bf16* act = WSP(bf16, WS_META + MO_ACT);
    if (w0 < 0) return;
    for (int it = w0; it < DFF / 16; it += wstride) { const int c0 = 16 * it, rg = 256 * (c0 >> 7) + (c0 & 127);
        f32x4 g = (f32x4){0.f, 0.f, 0.f, 0.f}, u = g;
        g = skinny16(A, DM, WSP(bf16, WS_W1GU) + (size_t)rg * DM, DM, 0, DM, F.lane, g);
        u = skinny16(A, DM, WSP(bf16, WS_W1GU) + (size_t)(rg + 128) * DM, DM, 0, DM, F.lane, u);
#pragma unroll
        for (int i = 0; i < 4; ++i) { const int row = 4 * (F.lane >> 4) + i; const float rs = __builtin_amdgcn_rsqf(ssq[row] * (1.0f / 2048.0f) + EPS);
            act[row * DFF + c0 + (F.lane & 15)] = (bf16)f2bf(silu1(g[i] * rs) * (u[i] * rs)); } }
}
__device__ __forceinline__ void meta_down(Frame& F) {
    const bf16* A = WSP(bf16, WS_META + MO_ACT); float* ssq1 = WSP(float, WS_META + MO_SSQ1); bf16* xn1 = WSP(bf16, WS_META + MO_XN1);
    LAS f32x4* red = (LAS f32x4*)(F.lds + 65536);
    for (int it = blockIdx.x; it < DM / 16; it += F.G) { const int c0 = 16 * it;
        __syncthreads();
        f32x4 a = (f32x4){0.f, 0.f, 0.f, 0.f};
        a = skinny16(A, DFF, WSP(bf16, WS_W1D) + (size_t)c0 * DFF, DFF, F.wave * (DFF / 8), (F.wave + 1) * (DFF / 8), F.lane, a);
        red[F.wave * 64 + F.lane] = a;
        __syncthreads();
        if (F.wave == 0) {
#pragma unroll
            for (int w = 1; w < 8; ++w) a += red[w * 64 + F.lane];
#pragma unroll
            for (int i = 0; i < 4; ++i) { const int row = 4 * (F.lane >> 4) + i, col = c0 + (F.lane & 15); const float o = F.in[1][row * DM + col] + 0.5f * a[i];
                xn1[row * DM + col] = (bf16)f2bf(o);
                float sq = o * o; sq += __shfl_xor(sq, 1); sq += __shfl_xor(sq, 2); sq += __shfl_xor(sq, 4); sq += __shfl_xor(sq, 8);
                if ((F.lane & 15) == 0) ssq1[row * 128 + it] = sq; } }
        __syncthreads();
    }
}
constexpr int NMETA_IT = NIN / 16, NDT_IT = MR / 16;
__device__ __forceinline__ void meta_inproj_and_dt(Frame& F, int it0, int it_end, int wstride) {
    const int nmeta = NMETA_IT;
    if (it0 < 0) return;
    for (int it = it0; it < it_end; it += wstride) {
        if (it < nmeta) {
            const float* ssq1 = WSP(float, WS_META + MO_SSQ1); float* um = WSP(float, WS_META + MO_U);
            float rs[4];
#pragma unroll
            for (int i = 0; i < 4; ++i) { const f32x4* pp = (const f32x4*)(ssq1 + (4 * (F.lane >> 4) + i) * 128 + 8 * (F.lane & 15)); const f32x4 v = pp[0] + pp[1]; float s2 = (v[0] + v[1]) + (v[2] + v[3]);
                s2 += __shfl_xor(s2, 1); s2 += __shfl_xor(s2, 2); s2 += __shfl_xor(s2, 4); s2 += __shfl_xor(s2, 8);
                rs[i] = __builtin_amdgcn_rsqf(s2 * (1.0f / 2048.0f) + EPS); }
            const int r0 = 16 * it;
            int c0;
            if (r0 >= NINP) c0 = r0; else { const int pn = r0 >> 8, rem = r0 & 255, bj = rem >> 7, wc = (rem & 127) >> 5, j = rem & 31; c0 = 256 * pn + 64 * wc + 32 * bj + j; }
            f32x4 a = (f32x4){0.f, 0.f, 0.f, 0.f};
            a = skinny16(WSP(bf16, WS_META + MO_XN1), DM, WSP(bf16, WS_WIN) + (size_t)r0 * DM, DM, 0, DM, F.lane, a);
#pragma unroll
            for (int i = 0; i < 4; ++i) um[(size_t)(4 * (F.lane >> 4) + i) * NIN + c0 + (F.lane & 15)] = a[i] * rs[i];
        } else {
            const int m0 = 16 * (it - nmeta);
            f32x4 a = (f32x4){0.f, 0.f, 0.f, 0.f};
            a = skinny16(WSP(bf16, WS_XN) + (size_t)m0 * DM, DM, WSP(bf16, WS_WIN) + (size_t)NINP * DM, DM, 0, DM, F.lane, a);
#pragma unroll
            for (int i = 0; i < 4; ++i) { const int row = m0 + 4 * (F.lane >> 4) + i; WSP(float, WS_DTR)[(size_t)row * 16 + (F.lane & 15)] = a[i] * pg8::row_rs(WSP(float, WS_SSQ1), 32, row); }
        }
    }
}


namespace att {
typedef float f32x16 __attribute__((ext_vector_type(16)));
typedef short s16x4 __attribute__((ext_vector_type(4)));
typedef short v4i16_t __attribute__((ext_vector_type(4)));
typedef float f32x2_t __attribute__((ext_vector_type(2))); typedef __bf16 bf16x2_t __attribute__((ext_vector_type(2)));
constexpr int STAGE = 32768, VOFF = 16384;
__device__ __forceinline__ int crow(int r, int hi) { return (r & 3) + 8 * (r >> 2) + 4 * hi; }
__device__ __forceinline__ unsigned cvtpk(float lo, float hi) { f32x2_t v = {lo, hi}; bf16x2_t b = __builtin_convertvector(v, bf16x2_t); return __builtin_bit_cast(unsigned, b); }
#define ATT_WAITBAR() asm volatile("s_waitcnt vmcnt(0) lgkmcnt(0)\n\ts_barrier" ::: "memory")
__device__ __forceinline__ void glds16(const void* gsrc, unsigned lds_dst) { unsigned keep;
    asm volatile("s_mov_b32 %0, m0\n\ts_mov_b32 m0, %2\n\ts_nop 0\n\tglobal_load_lds_dwordx4 %1, off\n\ts_mov_b32 m0, %0" : "=&s"(keep) : "v"(gsrc), "s"(lds_dst) : "memory"); }
#define ATT_DMA(src, dstoff) glds16((const void*)(src), (unsigned)__builtin_amdgcn_readfirstlane((int)(dstoff)))
#define ATT_MFMA(a, b, c) __builtin_amdgcn_mfma_f32_32x32x16_bf16((a), (b), (c), 0, 0, 0)
__device__ __forceinline__ float fadd_s(float a, float b) { float r; asm("v_add_f32 %0, %1, %2" : "=v"(r) : "v"(a), "v"(b)); return r; }

constexpr int KST = 16384, VST0 = 4 * KST, VSTB = 16384, WSF_OFF = VST0 + 3 * VSTB, STG_OFF = VST0, DUMMY_OFF = WSF_OFF + 1024;
constexpr int META_K_OFF = 126976, META_V_OFF = 135168;
__device__ __forceinline__ void attn_meta_tile(Frame& F, int bh) {
    LAS unsigned char* lds = F.lds; const int wave = F.wave, lane = F.lane, h = bh & 7;
    { const float* um = WSP(float, WS_META + MO_U);
      float mv[4];
#pragma unroll
      for (int i4 = 0; i4 < 4; ++i4) { const int itm = 4 * wave + i4; mv[i4] = um[(size_t)(itm >> 1) * NIN + 1024 + h * 128 + (itm & 1) * 64 + lane]; }
#pragma unroll
      for (int i4 = 0; i4 < 4; ++i4) { const int itm = 4 * wave + i4, p = itm >> 1, sh = itm & 1, d = lane;
          float v = mv[i4];
          const float r = __builtin_amdgcn_rsqf(wave_sum(v * v) * (1.0f / 64.0f) + EPS);
          v = v * r * F.in[9][d];
          const float pr = __shfl_xor(v, 8); const float* rp = WSP(float, WS_ROPE) + p * 16;
          if (d < 8) v = v * rp[d] - pr * rp[8 + d]; else if (d < 16) v = v * rp[d - 8] + pr * rp[d];
          const int dd = sh * 64 + d;
          *(LAS bf16*)(lds + META_K_OFF + p * 256 + (((dd >> 3) ^ p) << 4) + (dd & 7) * 2) = (bf16)f2bf(v); }
      { const int e = 4 * (wave * 64 + lane), key = e >> 7, d = e & 127; const f32x4 vv = *(const f32x4*)(um + (size_t)key * NIN + 2048 + h * 128 + d);
        u32x2v w2; w2.x = pk2(vv[0], vv[1]); w2.y = pk2(vv[2], vv[3]); *(LAS u32x2v*)(lds + META_V_OFF + (d >> 5) * 1024 + key * 64 + (d & 31) * 2) = w2; } }
}
__device__ __forceinline__ void attn_unit(Frame& F, int bh, int jq, float lam) {
    LAS unsigned char* lds = F.lds;
    const bf16* U = WSP(bf16, WS_ACT);
    int lane = F.lane; asm volatile("" : "+v"(lane));
    const int wave = F.wave, r32 = lane & 31, hi = lane >> 5;
    const int b = bh >> 3, h = bh & 7, rb = wave & 3, sub = wave >> 2;
    const int cw = 2 * jq + (rb >> 1);
    const int row0 = b * SEQ + 128 * jq + 32 * rb;
    const int T = 2 * jq + 2;
    const int kk0 = 8 * wave + (lane >> 4), kk1 = kk0 + 4;
    const bf16* kbase0 = U + (size_t)(b * SEQ + kk0) * NINP + 1024 + h * 128 + 8 * ((lane & 15) ^ (kk0 & 15));
    const bf16* kbase1 = U + (size_t)(b * SEQ + kk1) * NINP + 1024 + h * 128 + 8 * ((lane & 15) ^ (kk1 & 15));
    const int v0 = 2 * wave, v1 = 2 * wave + 1;
    const bf16* vbase0 = U + (size_t)(b * SEQ + 16 * (v0 & 3) + (lane >> 2)) * NINP + 2048 + h * 128 + 32 * (v0 >> 2) + 8 * (lane & 3);
    const bf16* vbase1 = U + (size_t)(b * SEQ + 16 * (v1 & 3) + (lane >> 2)) * NINP + 2048 + h * 128 + 32 * (v1 >> 2) + 8 * (lane & 3);
    const int kd0 = 2 * wave * 1024, kd1 = kd0 + 1024, vd0 = v0 * 1024, vd1 = v1 * 1024;
#define ATT_DMA_K(t, ks_) do { const size_t to_ = (size_t)(t) * 64 * NINP; ATT_DMA(kbase0 + to_, (ks_) + kd0); ATT_DMA(kbase1 + to_, (ks_) + kd1); } while (0)
#define ATT_DMA_V(t, vs_) do { const size_t to_ = (size_t)(t) * 64 * NINP; ATT_DMA(vbase0 + to_, (vs_) + vd0); ATT_DMA(vbase1 + to_, (vs_) + vd1); } while (0)
    ATT_DMA_K(0, 0); ATT_DMA_V(0, VST0); ATT_DMA_K(1, KST); ATT_DMA_V(1, VST0 + VSTB); if (T > 2) ATT_DMA_K(2, 2 * KST);
    bf16x8 qf[4];
#pragma unroll
    for (int ks = 0; ks < 4; ++ks) qf[ks] = *(const bf16x8*)(U + (size_t)(row0 + r32) * NINP + h * 128 + sub * 64 + 16 * ks + 8 * hi);
    f32x16 o[4];
#pragma unroll
    for (int d = 0; d < 4; ++d)
#pragma unroll
        for (int i = 0; i < 16; ++i) o[d][i] = 0.f;
    float lsum = 0.f;
    const f32x16 zero16 = {0.f, 0.f, 0.f, 0.f, 0.f, 0.f, 0.f, 0.f, 0.f, 0.f, 0.f, 0.f, 0.f, 0.f, 0.f, 0.f};
    const int koff = r32 * 256 + (((8 * sub + hi) ^ (r32 & 15)) << 4);
    const int voff = ((lane >> 4) & 1) * 32 + (lane & 3) * 8 + (4 * hi + ((lane & 15) >> 2)) * 64;
#define ATT_KF(kst_, half, ks) (*(const LAS bf16x8*)(lds + (kst_) + (half) * 8192 + (koff ^ ((ks) << 5))))
#define ATT_VTR(vst_, off) __builtin_bit_cast(s16x4, __builtin_amdgcn_ds_read_tr16_b64_v4i16((LAS v4i16_t*)(lds + (vst_) + voff + (off))))
    ATT_WAITBAR();
    f32x16 s0 = zero16, s1 = zero16;
    {
        f32x16 sc = zero16;
#pragma unroll
        for (int ks = 0; ks < 4; ++ks) sc = ATT_MFMA(ATT_KF(META_K_OFF, 0, ks), qf[ks], sc);
#pragma unroll
        for (int ks = 0; ks < 4; ++ks) { s0 = ATT_MFMA(ATT_KF(0, 0, ks), qf[ks], s0); s1 = ATT_MFMA(ATT_KF(0, 1, ks), qf[ks], s1); }
#pragma unroll
        for (int i = 0; i < 8; ++i) { sc[i] = __builtin_amdgcn_exp2f(sc[i]); lsum += sc[i]; }
        v4u pw; pw.x = cvtpk(sc[0], sc[1]); pw.y = cvtpk(sc[2], sc[3]); pw.z = cvtpk(sc[4], sc[5]); pw.w = cvtpk(sc[6], sc[7]);
        const bf16x8 pm = __builtin_bit_cast(bf16x8, pw);
#pragma unroll
        for (int d = 0; d < 4; ++d) { const s16x4 lo = ATT_VTR(META_V_OFF, d * 1024), hh = ATT_VTR(META_V_OFF, d * 1024 + 512);
            const bf16x8 vf = {lo[0], lo[1], lo[2], lo[3], hh[0], hh[1], hh[2], hh[3]};
            o[d] = ATT_MFMA(pm, vf, o[d]); }
    }
    ATT_WAITBAR();
    int vm0 = 0, vm2 = 2;
#define SBAR() __builtin_amdgcn_sched_barrier(0)
#define ATT_VTRP(vp_, off) __builtin_bit_cast(s16x4, __builtin_amdgcn_ds_read_tr16_b64_v4i16((LAS v4i16_t*)((vp_) + (off))))
#define ATT_VLOAD(buf, vst_, d, kp) do { _Pragma("unroll") for (int ks_ = 0; ks_ < 2; ++ks_) { vlo[buf][ks_] = ATT_VTRP(vst_, (d) * 4096 + (2 * (kp) + ks_) * 1024); vhi[buf][ks_] = ATT_VTRP(vst_, (d) * 4096 + (2 * (kp) + ks_) * 1024 + 512); } } while (0)
#define ATT_GQ(MF) do { MF; SBAR(); } while (0)
#define ATT_GS(NV, b4, PW, w0, w1) do { ls = (((ls + NV[b4]) + NV[b4 + 1]) + NV[b4 + 2]) + NV[b4 + 3];     PW[w0] = cvtpk(NV[b4], NV[b4 + 1]); PW[w1] = cvtpk(NV[b4 + 2], NV[b4 + 3]); } while (0)
#define ATT_GB(MF, NV, i0, GS) do { MF; NV[i0] = __builtin_amdgcn_exp2f(NV[i0]); NV[i0 + 1] = __builtin_amdgcn_exp2f(NV[i0 + 1]); GS; SBAR(); } while (0)
#define ATT_VF(buf, ks_) (bf16x8){vlo[buf][ks_][0], vlo[buf][ks_][1], vlo[buf][ks_][2], vlo[buf][ks_][3], vhi[buf][ks_][0], vhi[buf][ks_][1], vhi[buf][ks_][2], vhi[buf][ks_][3]}
#define ATT_STEP(C0, C1, C2, C3, D0, D1, D2, D3, tt) do { \
        const int t_ = (tt); const int knext = ((t_ + 1) & 3) * KST, kdst = ((t_ + 3) & 3) * KST, vdst = VST0 + vm2 * VSTB; \
        LAS unsigned char* vcur = lds + VST0 + vm0 * VSTB + voff; asm volatile("" : "+v"(vcur));     \
        const bool dk = t_ + 3 < T, dv = t_ + 2 < T; const size_t tok_ = dk ? (size_t)(t_ + 3) * 64 * NINP : 0, tov_ = dv ? (size_t)(t_ + 2) * 64 * NINP : 0; \
        const int dK0 = dk ? kdst + kd0 : DUMMY_OFF + wave * 1024, dK1 = dk ? kdst + kd1 : DUMMY_OFF + wave * 1024, dV0 = dv ? vdst + vd0 : DUMMY_OFF + wave * 1024, dV1 = dv ? vdst + vd1 : DUMMY_OFF + wave * 1024; \
        ATT_DMA(kbase0 + tok_, dK0); ATT_DMA(kbase1 + tok_, dK1); ATT_DMA(vbase0 + tov_, dV0); ATT_DMA(vbase1 + tov_, dV1); \
        if (t_ <= cw) { \
            bf16x8 kf[4]; s16x4 vlo[2][2], vhi[2][2]; f32x16 N0, N1; float ls = 0.f; \
            SBAR(); \
            kf[0] = ATT_KF(knext, 0, 0); kf[1] = ATT_KF(knext, 1, 0); kf[2] = ATT_KF(knext, 0, 1); kf[3] = ATT_KF(knext, 1, 1); SBAR(); \
            ATT_GQ(N0 = ATT_MFMA(kf[0], qf[0], zero16)); \
            ATT_GQ(N1 = ATT_MFMA(kf[1], qf[0], zero16)); \
            kf[0] = ATT_KF(knext, 0, 2); kf[1] = ATT_KF(knext, 1, 2); SBAR(); \
            ATT_GQ(N0 = ATT_MFMA(kf[2], qf[1], N0)); \
            ATT_GQ(N1 = ATT_MFMA(kf[3], qf[1], N1)); \
            kf[2] = ATT_KF(knext, 0, 3); kf[3] = ATT_KF(knext, 1, 3); SBAR(); \
            ATT_GQ(N0 = ATT_MFMA(kf[0], qf[2], N0)); \
            ATT_GQ(N1 = ATT_MFMA(kf[1], qf[2], N1)); \
            ATT_VLOAD(0, vcur, 0, 0); SBAR(); \
            ATT_GQ(N0 = ATT_MFMA(kf[2], qf[3], N0)); \
            ATT_GQ(N1 = ATT_MFMA(kf[3], qf[3], N1)); \
            const bf16x8 pf0 = __builtin_bit_cast(bf16x8, C0), pf1 = __builtin_bit_cast(bf16x8, C1), pf2 = __builtin_bit_cast(bf16x8, C2), pf3 = __builtin_bit_cast(bf16x8, C3); \
            ATT_VLOAD(1, vcur, 0, 1); SBAR(); \
            ATT_GB(o[0] = ATT_MFMA(pf0, ATT_VF(0, 0), o[0]), N0, 0, (void)0); ATT_GB(o[0] = ATT_MFMA(pf1, ATT_VF(0, 1), o[0]), N0, 2, (void)0); \
            ATT_VLOAD(0, vcur, 1, 0); SBAR(); \
            ATT_GB(o[0] = ATT_MFMA(pf2, ATT_VF(1, 0), o[0]), N0, 4, ATT_GS(N0, 0, D0, 0, 1)); ATT_GB(o[0] = ATT_MFMA(pf3, ATT_VF(1, 1), o[0]), N0, 6, (void)0); \
            ATT_VLOAD(1, vcur, 1, 1); SBAR(); \
            ATT_GB(o[1] = ATT_MFMA(pf0, ATT_VF(0, 0), o[1]), N0, 8, ATT_GS(N0, 4, D0, 2, 3)); ATT_GB(o[1] = ATT_MFMA(pf1, ATT_VF(0, 1), o[1]), N0, 10, (void)0); \
            ATT_VLOAD(0, vcur, 2, 0); SBAR(); \
            ATT_GB(o[1] = ATT_MFMA(pf2, ATT_VF(1, 0), o[1]), N0, 12, ATT_GS(N0, 8, D1, 0, 1)); ATT_GB(o[1] = ATT_MFMA(pf3, ATT_VF(1, 1), o[1]), N0, 14, (void)0); \
            ATT_VLOAD(1, vcur, 2, 1); SBAR(); \
            ATT_GB(o[2] = ATT_MFMA(pf0, ATT_VF(0, 0), o[2]), N1, 0, ATT_GS(N0, 12, D1, 2, 3)); ATT_GB(o[2] = ATT_MFMA(pf1, ATT_VF(0, 1), o[2]), N1, 2, (void)0); \
            ATT_VLOAD(0, vcur, 3, 0); SBAR(); \
            ATT_GB(o[2] = ATT_MFMA(pf2, ATT_VF(1, 0), o[2]), N1, 4, ATT_GS(N1, 0, D2, 0, 1)); ATT_GB(o[2] = ATT_MFMA(pf3, ATT_VF(1, 1), o[2]), N1, 6, (void)0); \
            ATT_VLOAD(1, vcur, 3, 1); SBAR(); \
            ATT_GB(o[3] = ATT_MFMA(pf0, ATT_VF(0, 0), o[3]), N1, 8, ATT_GS(N1, 4, D2, 2, 3)); ATT_GB(o[3] = ATT_MFMA(pf1, ATT_VF(0, 1), o[3]), N1, 10, (void)0); \
            ATT_GB(o[3] = ATT_MFMA(pf2, ATT_VF(1, 0), o[3]), N1, 12, ATT_GS(N1, 8, D3, 0, 1)); ATT_GB(o[3] = ATT_MFMA(pf3, ATT_VF(1, 1), o[3]), N1, 14, (void)0); \
            ATT_GS(N1, 12, D3, 2, 3); \
            lsum += (t_ < cw) ? ls : 0.f;     \
        } \
          \
        asm volatile("s_waitcnt vmcnt(4) lgkmcnt(0)\n\ts_barrier" ::: "memory"); \
        vm0 = (vm0 == 2) ? 0 : vm0 + 1; vm2 = (vm2 == 2) ? 0 : vm2 + 1; \
    } while (0)
    v4u pa0, pa1, pa2, pa3, pb0, pb1, pb2, pb3;
    pb0 = pb1 = pb2 = pb3 = (v4u){0u, 0u, 0u, 0u};
    {
#pragma unroll
        for (int i = 0; i < 16; ++i) { s0[i] = __builtin_amdgcn_exp2f(s0[i]); s1[i] = __builtin_amdgcn_exp2f(s1[i]); }
        float ls = 0.f;
        ATT_GS(s0, 0, pa0, 0, 1); ATT_GS(s0, 4, pa0, 2, 3); ATT_GS(s0, 8, pa1, 0, 1); ATT_GS(s0, 12, pa1, 2, 3);
        ATT_GS(s1, 0, pa2, 0, 1); ATT_GS(s1, 4, pa2, 2, 3); ATT_GS(s1, 8, pa3, 0, 1); ATT_GS(s1, 12, pa3, 2, 3);
        lsum += ls;
    }
    for (int t = 0; t < T; t += 2) { ATT_STEP(pa0, pa1, pa2, pa3, pb0, pb1, pb2, pb3, t); ATT_STEP(pb0, pb1, pb2, pb3, pa0, pa1, pa2, pa3, t + 1); }
    ATT_WAITBAR();
#undef ATT_STEP
#undef ATT_VLOAD
#undef ATT_GQ
#undef ATT_GS
#undef ATT_GB
#undef ATT_VF
#undef SBAR
    int le = lane; asm volatile("" : "+v"(le));
    const int r32e = le & 31, hie = le >> 5;
    lsum += __shfl_xor(lsum, 32);
    LAS float* wsf = (LAS float*)(lds + WSF_OFF + wave * 128);
    float wn[4];
#pragma unroll
    for (int d = 0; d < 4; ++d) wn[d] = F.in[14][32 * d + r32e];
    const float fac = (sub == 0 ? 1.0f : lam) / lsum;
    if (hie == 0) wsf[r32e] = fac;
    LDS_WAIT(); asm volatile("" ::: "memory");
    LAS float* xo = (LAS float*)(lds + (wave & 3) * 16384) + le;
    if (sub == 1) {
#pragma unroll
        for (int i = 0; i < 16; ++i) { const float f = wsf[crow(i, hie)];
#pragma unroll
            for (int d = 0; d < 4; ++d) xo[(d * 16 + i) * 64] = o[d][i] * f; }
    }
    ATT_WAITBAR();
    if (sub == 0) {
        LAS bf16* stg = (LAS bf16*)(lds + STG_OFF + wave * 8192);
#pragma unroll
        for (int d = 0; d < 4; ++d) wn[d] *= 0.8f;
#pragma unroll
        for (int i = 0; i < 16; ++i) { const int q = crow(i, hie); const float f1 = wsf[q];
            float v[4], ss = 0.f;
#pragma unroll
            for (int d = 0; d < 4; ++d) { v[d] = o[d][i] * f1 - xo[(d * 16 + i) * 64]; ss += v[d] * v[d]; }
            ss += __shfl_xor(ss, 1); ss += __shfl_xor(ss, 2); ss += __shfl_xor(ss, 4); ss += __shfl_xor(ss, 8); ss += __shfl_xor(ss, 16);
            const float r = __builtin_amdgcn_rsqf(ss * (1.0f / 128.0f) + EPS);
#pragma unroll
            for (int d = 0; d < 4; ++d) stg[q * 128 + 32 * d + r32e] = (bf16)(cvtpk(v[d] * r * wn[d], 0.f) & 0xffffu); }
        LDS_WAIT(); asm volatile("" ::: "memory");
#pragma unroll
        for (int it = 0; it < 8; ++it) { const int q = 4 * it + (le >> 4), ch = le & 15;
            const v4u val = *(const LAS v4u*)(stg + q * 128 + 8 * ch);
            *(v4u*)(WSP(bf16, WS_MIX) + (size_t)(row0 + q) * DM + 1024 + h * 128 + 8 * ch) = val; }
    }
    ATT_WAITBAR();
#undef ATT_DMA_K
#undef ATT_DMA_V
#undef ATT_KF
#undef ATT_VTR
}
}


namespace ssd {
constexpr int S64 = 144, S128 = 272;
constexpr int O_CC = 0, O_BC = 17408, O_BT = 34816, O_XT = 53248, O_XS = 62464, O_XC = 71680, O_M = 80896, O_SI = 90112, O_SC = 107520;
#define SSD_MF(a, b, c) __builtin_amdgcn_mfma_f32_16x16x32_bf16((a), (b), (c), 0, 0, 0)
#define SSD_FRAG(img, stride, row, k) (*(const LAS bf16x8*)(lds + (img) + (row) * (stride) + 2 * (k)))
#define SSD_BAR() do { asm volatile("s_waitcnt vmcnt(0) lgkmcnt(0)" ::: "memory"); __builtin_amdgcn_s_barrier(); asm volatile("" ::: "memory"); } while (0)

__device__ __forceinline__ v4u pack8(const float (&v)[8]) { v4u o; o.x = pk2(v[0], v[1]); o.y = pk2(v[2], v[3]); o.z = pk2(v[4], v[5]); o.w = pk2(v[6], v[7]); return o; }
__device__ __forceinline__ unsigned bfe16(const v4u& r, int e) { const unsigned w = (e < 2) ? r.x : (e < 4) ? r.y : (e < 6) ? r.z : r.w; return (e & 1) ? (w >> 16) : (w & 0xffffu); }

template <bool PASSB>
__device__ __forceinline__ void ssd_item(Frame& F, int item, int& bgj) {
    LAS unsigned char* lds = F.lds;
    int lane0 = F.lane; asm volatile("" : "+v"(lane0));
    const int wave = F.wave;
    const int k = item & 7, hd = (item >> 3) & 15, b = item >> 7, g = hd >> 3;
    const float Ah = -__expf(F.in[18][hd]), Dk = F.in[19][hd];
    LAS float* sc = (LAS float*)(lds + O_SC);
    const int pt = wave >> 1, nb = 4 * (wave & 1);
    f32x4 stt[4];
#pragma unroll
    for (int j = 0; j < 4; ++j) stt[j] = (f32x4){0.f, 0.f, 0.f, 0.f};
    float* sst = WSP(float, WS_SST) + (size_t)((b * SH + hd) * 8) * 8192;
    float* atot = WSP(float, WS_ATOT) + (b * SH + hd) * 8;
    if (PASSB) {
        const int fr = lane0 & 15, fq = lane0 >> 4;
        for (int kk = 0; kk < k; ++kk) { const float dec = __expf(atot[kk]);
#pragma unroll
            for (int j = 0; j < 4; ++j) { const f32x4 s = *(const f32x4*)(sst + (size_t)kk * 8192 + (16 * pt + fr) * 128 + 16 * (nb + j) + 4 * fq); stt[j] = stt[j] * dec + s; } }
    }
    float asum = 0.f;
    const int c_lo = (k == 0) ? 0 : 8 * k + 1, c_hi = 8 * k + 8;
    const int role = (wave < 2) ? 0 : (wave < 4) ? 1 : (wave < 6 && PASSB) ? 2 : 3;
    v4u raw[8]; float dtv = 0.f;
    { const int li = (wave * 64 + lane0) & 127, cg = (role == 0) ? (li & 7) : (li & 15), l0 = (role == 0) ? 4 * (li >> 3) : 8 * (li >> 4);
      if (role == 0) { const bf16* src = WSP(bf16, WS_XS) + (size_t)(b * LPAD + 64 * c_lo + l0) * 1024 + hd * 64 + 8 * cg;
#pragma unroll
          for (int i = 0; i < 4; ++i) raw[i] = *(const v4u*)(src + (size_t)i * 1024); }
      else if (role < 3) { const bf16* src = WSP(bf16, WS_BC) + (size_t)(b * LPAD + 64 * c_lo + l0) * 512 + (role == 2 ? 256 : 0) + g * 128 + 8 * cg;
#pragma unroll
          for (int i = 0; i < 8; ++i) raw[i] = *(const v4u*)(src + (size_t)i * 512); }
      if (wave == 7) dtv = WSP(float, WS_DT)[(size_t)(b * LPAD + 64 * c_lo + lane0) * 16 + hd]; }
    for (int c = c_lo; c <= c_hi; ++c) {
        int lane = lane0; asm volatile("" : "+v"(lane));
        const int tid = wave * 64 + lane, fr = lane & 15, fq = lane >> 4, li = tid & 127;
        const int cg = (role == 0) ? (li & 7) : (li & 15), l0 = (role == 0) ? 4 * (li >> 3) : 8 * (li >> 4);
        u32x2v zv[2];
        if (PASSB && c >= 1) {
#pragma unroll
            for (int j = 0; j < 2; ++j) zv[j] = *(const u32x2v*)(WSP(bf16, WS_ACT) + (size_t)(b * SEQ + 64 * (c - 1) + 16 * pt + fr) * NINP + 3072 + hd * 64 + 16 * (2 * (wave & 1) + j) + 4 * fq);
        }
        const int cn = (c < c_hi) ? c + 1 : c;
        f32x4 cv[8]; TItem ct; bool chave = false; int chh = 0;
        if (role == 0) {
            if (PASSB) {
#pragma unroll
                for (int i = 0; i < 4; ++i) *(LAS v4u*)(lds + O_XC + (l0 + i) * S64 + 16 * cg) = raw[i]; }
#pragma unroll
            for (int e = 0; e < 8; ++e) { u32x2v w2; w2.x = bfe16(raw[0], e) | (bfe16(raw[1], e) << 16); w2.y = bfe16(raw[2], e) | (bfe16(raw[3], e) << 16); *(LAS u32x2v*)(lds + O_XT + (8 * cg + e) * S64 + 2 * l0) = w2; }
            const bf16* src = WSP(bf16, WS_XS) + (size_t)(b * LPAD + 64 * cn + l0) * 1024 + hd * 64 + 8 * cg;
#pragma unroll
            for (int i = 0; i < 4; ++i) raw[i] = *(const v4u*)(src + (size_t)i * 1024);
        } else if (role == 1) {
            if (PASSB) {
#pragma unroll
                for (int i = 0; i < 8; ++i) *(LAS v4u*)(lds + O_BC + (l0 + i) * S128 + 16 * cg) = raw[i]; }
#pragma unroll
            for (int e = 0; e < 8; ++e) { v4u w4; w4.x = bfe16(raw[0], e) | (bfe16(raw[1], e) << 16); w4.y = bfe16(raw[2], e) | (bfe16(raw[3], e) << 16); w4.z = bfe16(raw[4], e) | (bfe16(raw[5], e) << 16); w4.w = bfe16(raw[6], e) | (bfe16(raw[7], e) << 16);
                *(LAS v4u*)(lds + O_BT + (8 * cg + e) * S64 + 2 * l0) = w4; }
            const bf16* src = WSP(bf16, WS_BC) + (size_t)(b * LPAD + 64 * cn + l0) * 512 + g * 128 + 8 * cg;
#pragma unroll
            for (int i = 0; i < 8; ++i) raw[i] = *(const v4u*)(src + (size_t)i * 512);
        } else if (role == 2) {
#pragma unroll
            for (int i = 0; i < 8; ++i) *(LAS v4u*)(lds + O_CC + (l0 + i) * S128 + 16 * cg) = raw[i];
            const bf16* src = WSP(bf16, WS_BC) + (size_t)(b * LPAD + 64 * cn + l0) * 512 + 256 + g * 128 + 8 * cg;
#pragma unroll
            for (int i = 0; i < 8; ++i) raw[i] = *(const v4u*)(src + (size_t)i * 512);
        }
        if (wave == 7) {
            const float dt = dtv;
            dtv = WSP(float, WS_DT)[(size_t)(b * LPAD + 64 * cn + lane) * 16 + hd];
            float a = dt * Ah;
#pragma unroll
            for (int o2 = 1; o2 < 64; o2 <<= 1) { const float t = __shfl_up(a, o2); if (lane >= o2) a += t; }
            const float aend = __shfl(a, 63);
            sc[lane] = dt; sc[64 + lane] = a; sc[128 + lane] = dt * __expf(aend - a);
            if (lane == 0) sc[192] = aend;
        }
        if (PASSB && F.NGW == 2048) { const int hix = bgj * 2048 + F.gw, cit = IT_BG + (hix >> 1); chh = hix & 1; chave = bgj < 8 && cit < IT_END; ++bgj;
            if (chave) { ct = mk_item(F, cit); transpose_load_h(ct, lane, chh, cv); } }
        asm volatile("s_waitcnt lgkmcnt(0)" ::: "memory"); __builtin_amdgcn_s_barrier(); asm volatile("" ::: "memory");
        const float aend = sc[192];
        for (int amp2_ = 0; amp2_ < (MK_AMP == 2 ? 3 : 1); ++amp2_) {
        { const int p = tid >> 3, lg = (tid & 7) * 8;
          const v4u xv = *(const LAS v4u*)(lds + O_XT + p * S64 + 2 * lg); const unsigned xw[4] = {xv.x, xv.y, xv.z, xv.w}; float v[8];
#pragma unroll
          for (int e = 0; e < 4; ++e) { v[2 * e] = bf2f(xw[e] & 0xffffu) * sc[128 + lg + 2 * e]; v[2 * e + 1] = bf2f(xw[e] >> 16) * sc[128 + lg + 2 * e + 1]; }
          *(LAS v4u*)(lds + O_XS + p * S64 + 2 * lg) = pack8(v); }
        if (PASSB) {
#pragma unroll
            for (int j = 0; j < 4; ++j) { u32x2v w2; w2.x = pk2(stt[j][0], stt[j][1]); w2.y = pk2(stt[j][2], stt[j][3]); *(LAS u32x2v*)(lds + O_SI + (16 * pt + fr) * S128 + 2 * (16 * (nb + j) + 4 * fq)) = w2; }
            const int l = 16 * pt + fr; const float al = sc[64 + l];
#pragma unroll
            for (int j = 0; j < 2; ++j) { const int st = 2 * (wave & 1) + j; f32x4 acc = (f32x4){0.f, 0.f, 0.f, 0.f};
                if (st <= pt) {
#pragma unroll
                    for (int ks = 0; ks < 4; ++ks) acc = SSD_MF(SSD_FRAG(O_BC, S128, 16 * st + fr, 32 * ks + 8 * fq), SSD_FRAG(O_CC, S128, l, 32 * ks + 8 * fq), acc);
                    asm volatile("s_nop 15\n\ts_nop 3" : "+v"(acc)); }
                float m[4];
#pragma unroll
                for (int i = 0; i < 4; ++i) { const int s = 16 * st + 4 * fq + i; m[i] = (s <= l) ? acc[i] * __expf(al - sc[64 + s]) * sc[s] : 0.f; }
                u32x2v w2; w2.x = pk2(m[0], m[1]); w2.y = pk2(m[2], m[3]); *(LAS u32x2v*)(lds + O_M + l * S64 + 2 * (16 * st + 4 * fq)) = w2; }
        }
        }
        asm volatile("s_waitcnt lgkmcnt(0)" ::: "memory"); __builtin_amdgcn_s_barrier(); asm volatile("" ::: "memory");
        for (int amp3_ = 0; amp3_ < (MK_AMP == 3 ? 3 : 1); ++amp3_) {
        if (PASSB && c >= 1) {
            const int l = 16 * pt + fr, row = b * SEQ + 64 * (c - 1) + l; const float el = __expf(sc[64 + l]);
            float sq = 0.f;
#pragma unroll
            for (int j = 0; j < 2; ++j) { const int ptile = 2 * (wave & 1) + j; f32x4 acc = (f32x4){0.f, 0.f, 0.f, 0.f};
#pragma unroll
                for (int ks = 0; ks < 4; ++ks) acc = SSD_MF(SSD_FRAG(O_SI, S128, 16 * ptile + fr, 32 * ks + 8 * fq), SSD_FRAG(O_CC, S128, l, 32 * ks + 8 * fq), acc);
                acc = acc * el;
#pragma unroll
                for (int ks = 0; ks < 2; ++ks) acc = SSD_MF(SSD_FRAG(O_XT, S64, 16 * ptile + fr, 32 * ks + 8 * fq), SSD_FRAG(O_M, S64, l, 32 * ks + 8 * fq), acc);
                const int pc = 16 * ptile + 4 * fq;
                const u32x2v xv = *(const LAS u32x2v*)(lds + O_XC + l * S64 + 2 * pc);
                float y[4];
                y[0] = (acc[0] + Dk * bf2f(xv.x & 0xffffu)) * silu1(bf2f(zv[j].x & 0xffffu)); y[1] = (acc[1] + Dk * bf2f(xv.x >> 16)) * silu1(bf2f(zv[j].x >> 16));
                y[2] = (acc[2] + Dk * bf2f(xv.y & 0xffffu)) * silu1(bf2f(zv[j].y & 0xffffu)); y[3] = (acc[3] + Dk * bf2f(xv.y >> 16)) * silu1(bf2f(zv[j].y >> 16));
                sq += (y[0] * y[0] + y[1] * y[1]) + (y[2] * y[2] + y[3] * y[3]);
                u32x2v w2; w2.x = pk2(y[0], y[1]); w2.y = pk2(y[2], y[3]);
                *(u32x2v*)(WSP(bf16, WS_MIX) + (size_t)row * DM + hd * 64 + pc) = w2; }
            sq += __shfl_xor(sq, 16); sq += __shfl_xor(sq, 32);
            if (fq == 0) WSP(float, WS_SSQS)[(size_t)row * 32 + 2 * hd + (wave & 1)] = sq;
        }
        }
        { const float dec = __expf(aend);
#pragma unroll
          for (int j = 0; j < 4; ++j) { f32x4 acc = stt[j] * dec;
#pragma unroll
              for (int ks = 0; ks < 2; ++ks) acc = SSD_MF(SSD_FRAG(O_BT, S64, 16 * (nb + j) + fr, 32 * ks + 8 * fq), SSD_FRAG(O_XS, S64, 16 * pt + fr, 32 * ks + 8 * fq), acc);
              stt[j] = acc; } }
        asum += aend;
        if (PASSB) { if (chave) transpose_finish_h(ct, lane, chh, cv); }
        asm volatile("s_waitcnt lgkmcnt(0)" ::: "memory"); __builtin_amdgcn_s_barrier(); asm volatile("" ::: "memory");
    }
    if (!PASSB) { const int fr = lane0 & 15, fq = lane0 >> 4;
#pragma unroll
        for (int j = 0; j < 4; ++j) *(f32x4*)(sst + (size_t)k * 8192 + (16 * pt + fr) * 128 + 16 * (nb + j) + 4 * fq) = stt[j];
        if (wave == 0 && lane0 == 0) atot[k] = asum;
    }
}
}

struct ConvItem { int c, pp, b, p; v4u rv[4]; bool fast; };
__device__ __forceinline__ void conv_issue(Frame& F, int it, ConvItem& q) {
    const bf16* U = WSP(bf16, WS_ACT); const float* um = WSP(float, WS_META + MO_U);
    const int cg = it % (CONVD / 8); q.pp = (it / (CONVD / 8)) % LPAD; q.b = it / ((CONVD / 8) * LPAD); q.c = 8 * cg; q.p = q.pp - PPAD;
#pragma unroll
    for (int w = 0; w < 4; ++w) q.rv[w] = (v4u){0u, 0u, 0u, 0u};
    if (q.p >= 0) {
        if (q.p - 3 >= NMETA) { const bf16* src = U + (size_t)(q.b * SEQ + q.p - 3 - NMETA) * NINP + 4096 + q.c;
#pragma unroll
            for (int w = 0; w < 4; ++w) q.rv[w] = *(const v4u*)(src + (size_t)w * NINP); }
        else {
#pragma unroll
            for (int w = 0; w < 4; ++w) { const int ps = q.p - 3 + w; v4u v = (v4u){0u, 0u, 0u, 0u};
                if (ps >= NMETA) v = *(const v4u*)(U + (size_t)(q.b * SEQ + ps - NMETA) * NINP + 4096 + q.c);
                else if (ps >= 0) { const f32x4 r0 = *(const f32x4*)(um + (size_t)ps * NIN + 4096 + q.c), r1 = *(const f32x4*)(um + (size_t)ps * NIN + 4096 + q.c + 4);
                    v.x = pk2(r0[0], r0[1]); v.y = pk2(r0[2], r0[3]); v.z = pk2(r1[0], r1[1]); v.w = pk2(r1[2], r1[3]); }
                q.rv[w] = v; } }
    }
}
__device__ __forceinline__ void conv_finish(Frame& F, const ConvItem& q) {
    const float* cw = F.in[15]; const float* cb = F.in[16]; const int c = q.c;
    float a[8];
#pragma unroll
    for (int e = 0; e < 8; ++e) a[e] = 0.f;
    if (q.p >= 0) {
        const f32x4 b0 = *(const f32x4*)(cb + c), b1 = *(const f32x4*)(cb + c + 4);
        a[0] = b0[0]; a[1] = b0[1]; a[2] = b0[2]; a[3] = b0[3]; a[4] = b1[0]; a[5] = b1[1]; a[6] = b1[2]; a[7] = b1[3];
#pragma unroll
        for (int w = 0; w < 4; ++w) { const f32x4 w0 = *(const f32x4*)(cw + w * CONVD + c), w1 = *(const f32x4*)(cw + w * CONVD + c + 4);
            a[0] += bf2f(q.rv[w].x & 0xffffu) * w0[0]; a[1] += bf2f(q.rv[w].x >> 16) * w0[1]; a[2] += bf2f(q.rv[w].y & 0xffffu) * w0[2]; a[3] += bf2f(q.rv[w].y >> 16) * w0[3];
            a[4] += bf2f(q.rv[w].z & 0xffffu) * w1[0]; a[5] += bf2f(q.rv[w].z >> 16) * w1[1]; a[6] += bf2f(q.rv[w].w & 0xffffu) * w1[2]; a[7] += bf2f(q.rv[w].w >> 16) * w1[3]; }
#pragma unroll
        for (int e = 0; e < 8; ++e) a[e] = silu1(a[e]);
    }
    v4u o; o.x = pk2(a[0], a[1]); o.y = pk2(a[2], a[3]); o.z = pk2(a[4], a[5]); o.w = pk2(a[6], a[7]);
    if (c < 1024) *(v4u*)(WSP(bf16, WS_XS) + (size_t)(q.b * LPAD + q.pp) * 1024 + c) = o;
    else *(v4u*)(WSP(bf16, WS_BC) + (size_t)(q.b * LPAD + q.pp) * 512 + (c - 1024)) = o;
}
__device__ __forceinline__ void p4_conv(Frame& F) {
    const float* um = WSP(float, WS_META + MO_U);
    const int gt = F.gw * 64 + F.lane, NT = F.NGW * 64, NITEM = NBATCH * LPAD * (CONVD / 8);
    for (int it = gt; it < NITEM; it += 3 * NT) {
        ConvItem q0, q1, q2; const int i1 = it + NT, i2 = it + 2 * NT;
        conv_issue(F, it, q0); if (i1 < NITEM) conv_issue(F, i1, q1); if (i2 < NITEM) conv_issue(F, i2, q2);
        conv_finish(F, q0); if (i1 < NITEM) conv_finish(F, q1); if (i2 < NITEM) conv_finish(F, q2);
    }
    for (int it = gt; it < NBATCH * LPAD * SH; it += NT) { const int hd = it & 15, pp = (it >> 4) % LPAD, b = (it >> 4) / LPAD, p = pp - PPAD;
        float v = 0.f;
        if (p >= 0) { const float x = (p < NMETA ? um[(size_t)p * NIN + NINP + hd] : WSP(float, WS_DTR)[(size_t)(b * SEQ + p - NMETA) * 16 + hd]) + F.in[17][hd];
            v = fmaxf(x, 0.f) + log1pf(__expf(-fabsf(x))); }
        WSP(float, WS_DT)[it] = v; }
}
__device__ __forceinline__ void p4_mixer_attn(Frame& F) {
    p4_conv(F);
    float lam; { const float s1 = wave_sum(F.in[10][F.lane] * F.in[11][F.lane]), s2 = wave_sum(F.in[12][F.lane] * F.in[13][F.lane]); lam = __expf(s1) - __expf(s2) + 0.2f; }
    lam = __builtin_bit_cast(float, __builtin_amdgcn_readfirstlane(__builtin_bit_cast(int, lam)));
    for (int r_ = 0; r_ < (MK_REPEAT_PHASE == 41 ? 2 : 1); ++r_)
    for (int u = blockIdx.x; u < NBATCH * NHEAD * 16; u += F.G) { const int bh = (u & 7) * 2 + ((u >> 3) >> 4), idx = (u >> 3) & 15;
        att::attn_meta_tile(F, bh); att::attn_unit(F, bh, idx, lam); att::attn_unit(F, bh, 31 - idx, lam); }
}
__device__ __forceinline__ void p5_ssd_a(Frame& F) { int bgj = 0; for (int it = blockIdx.x; it < NBATCH * SH * 8; it += F.G) ssd::ssd_item<false>(F, it, bgj); }
__device__ __forceinline__ void p6_ssd_b(Frame& F) { int bgj = 0; for (int it = blockIdx.x; it < NBATCH * SH * 8; it += F.G) ssd::ssd_item<true>(F, it, bgj);
    if (F.NGW != 2048) convert_items(F, IT_BG, IT_END, F.gw, F.NGW); }
struct Args { const float* in[26]; float* out; unsigned char* ws; int ph_lo, ph_hi; };
__global__ void __launch_bounds__(NWAVES * 64, 2) hymba_fwd(Args args) {
    extern __shared__ __attribute__((aligned(16))) unsigned char lds[];
    Frame F;
    F.lds = (LAS unsigned char*)lds;
    F.tid = threadIdx.x; F.lane = F.tid & 63; F.wave = __builtin_amdgcn_readfirstlane(F.tid >> 6);
    F.G = gridDim.x; F.gw = blockIdx.x * NWAVES + F.wave; F.NGW = F.G * NWAVES;
#pragma unroll
    for (int i = 0; i < 26; ++i) F.in[i] = args.in[i];
    F.out = args.out; F.ws = args.ws; F.inp = args.in;
    volatile LAS unsigned* MISC = (volatile LAS unsigned*)(F.lds + MISC_OFF);
    for (int u = F.tid; u < 128; u += NWAVES * 64) MISC[u] = 0u;
    __syncthreads();
    XcdBarrier bar; bar.bar = (unsigned*)(F.ws + WS_CTL) + CW_BAR; bar.x = 0; bar.st = nullptr;
    if (N_LAUNCHES == 1) bar = xcd_barrier_post((unsigned*)(F.ws + WS_CTL) + CW_BAR, MISC + 8);
    const int lo = args.ph_lo, hi = args.ph_hi;
#define IN(k) (lo <= (k) && (k) < hi)
#ifndef MK_REPEAT_PHASE
#define MK_REPEAT_PHASE -1
#endif
#define REPS(k) for (int rep_ = 0; rep_ < ((k) == MK_REPEAT_PHASE ? 2 : 1); ++rep_)
#define REPBAR(k) do { if ((k) == MK_REPEAT_PHASE && rep_ == 0) xcd_barrier(bar); } while (0)
#define SEAM(k) do { if (IN(k) && IN((k) + 1)) xcd_barrier(bar); } while (0)
    using pg8::Gemm; using pg8::StaticOrder;
    LAS unsigned char* ring = F.lds + RING_OFF;

    if (IN(0)) { REPS(0) { p0_prologue(F); REPBAR(0); } SEAM(0); }
    if (IN(1)) {
        Gemm g{WSP(bf16, WS_XN), WSP(bf16, WS_W1GU), MR, NGU, DM}; StaticOrder S; S.init(MR, NGU, F.G, (int)blockIdx.x);
        pg8::Unit u0{0, 0}; (void)S.next(0, u0);
        pg8::EpiSwiGLU E{WSP(bf16, WS_ACT), DFF, WSP(float, WS_SSQ0), 1, build_rs_table(F, WSP(float, WS_SSQ0), 1, 1.0f / 2048.0f, u0.pm)};
        REPS(1) { pg8::gemm_phase<pg8::EpiSwiGLU, StaticOrder, true, true>(ring, g, S, E); REPBAR(1); }
        { const int first = S.nwg % F.G, nsl = F.G - first;
          const int w0 = (int)blockIdx.x >= first ? ((int)blockIdx.x - first) * NWAVES + F.wave : -1;
          meta_gateup(F, w0, nsl * NWAVES);
          constexpr int NMW = DFF / 16;
          convert_items(F, IT_CUT0, IT_BG, w0 >= NMW ? w0 - NMW : -1, nsl * NWAVES - NMW); }
        SEAM(1);
    }
    if (IN(2)) {
        meta_down(F);
        Gemm g{WSP(bf16, WS_ACT), WSP(bf16, WS_W1D), MR, DM, DFF}; StaticOrder S; S.init(MR, DM, F.G, (int)blockIdx.x);
        pg8::EpiResT<false> E{F.in[0], nullptr, nullptr, WSP(bf16, WS_XN), WSP(float, WS_SSQ1), 0.5f, DM, nullptr, 0, pg8::RsTable{nullptr, -1, -1}};
        REPS(2) { pg8::gemm_phase<pg8::EpiResT<false>, StaticOrder, true, true>(ring, g, S, E); REPBAR(2); }
        SEAM(2);
    }
    if (IN(3)) {
        Gemm g{WSP(bf16, WS_XN), WSP(bf16, WS_WIN), MR, NINP, DM}; StaticOrder S; S.init(MR, NINP, F.G, (int)blockIdx.x);
        pg8::Unit u0{0, 0}; (void)S.next(0, u0);
        pg8::EpiInProj E{WSP(bf16, WS_ACT), NINP, WSP(float, WS_SSQ1), F.in[8], F.in[9], WSP(float, WS_ROPE), build_rs_table(F, WSP(float, WS_SSQ1), 32, 1.0f / 2048.0f, u0.pm)};
        REPS(3) { pg8::gemm_phase<pg8::EpiInProj, StaticOrder, true, true>(ring, g, S, E); REPBAR(3); }
        { const int first = S.nwg % F.G, nsl = F.G - first;
          meta_inproj_and_dt(F, (int)blockIdx.x >= first ? ((int)blockIdx.x - first) * NWAVES + F.wave : -1, NMETA_IT + NDT_IT, nsl * NWAVES); }
        SEAM(3);
    }
    if (IN(4)) { REPS(4) { p4_mixer_attn(F); REPBAR(4); } SEAM(4); }
    if (IN(5)) { REPS(5) { p5_ssd_a(F); REPBAR(5); } SEAM(5); }
    if (IN(6)) { REPS(6) { p6_ssd_b(F); REPBAR(6); } SEAM(6); }
    if (IN(7)) {
        Gemm g{WSP(bf16, WS_MIX), WSP(bf16, WS_WOUT), MR, DM, DM}; StaticOrder S; S.init(MR, DM, F.G, (int)blockIdx.x);
        pg8::Unit u0{0, 0}; (void)S.next(0, u0);
        pg8::EpiResT<true> E{nullptr, WSP(bf16, WS_XN), nullptr, WSP(bf16, WS_XN), WSP(float, WS_SSQ2), 1.0f, DM, WSP(float, WS_SSQS), 16, build_rs_table(F, WSP(float, WS_SSQS), 32, 1.0f / 1024.0f, u0.pm)};
        pg8::gemm_phase<pg8::EpiResT<true>, StaticOrder, true, true>(ring, g, S, E);
        SEAM(7);
    }
    if (IN(8)) {
        Gemm g{WSP(bf16, WS_XN), WSP(bf16, WS_W2GU), MR, NGU, DM}; StaticOrder S; S.init(MR, NGU, F.G, (int)blockIdx.x);
        pg8::Unit u0{0, 0}; (void)S.next(0, u0);
        pg8::EpiSwiGLU E{WSP(bf16, WS_ACT), DFF, WSP(float, WS_SSQ2), 32, build_rs_table(F, WSP(float, WS_SSQ2), 32, 1.0f / 2048.0f, u0.pm)};
        REPS(8) { pg8::gemm_phase<pg8::EpiSwiGLU, StaticOrder, true, true>(ring, g, S, E); REPBAR(8); }
        SEAM(8);
    }
    if (IN(9)) {
        Gemm g{WSP(bf16, WS_ACT), WSP(bf16, WS_W2D), MR, DM, DFF}; StaticOrder S; S.init(MR, DM, F.G, (int)blockIdx.x);
        pg8::EpiResT<false> E{nullptr, WSP(bf16, WS_XN), F.out, nullptr, nullptr, 0.5f, DM, nullptr, 0, pg8::RsTable{nullptr, -1, -1}};
        pg8::gemm_phase<pg8::EpiResT<false>, StaticOrder, true, true>(ring, g, S, E);
    }
#undef IN
#undef SEAM
}

extern "C" void kernel_launch(void* const* d_in, const int* in_sizes, int n_in, void* d_out, int out_size, void* d_ws, size_t ws_size, hipStream_t stream) {
    static int grid = 0;
    if (grid == 0) {
        if (n_in != 26 || in_sizes[0] != MR * DM || out_size != MR * DM || ws_size < WS_END) { fprintf(stderr, "kernel_launch: unexpected shapes (n_in %d, in0 %d, out %d, ws %zu)\n", n_in, n_in > 0 ? in_sizes[0] : -1, out_size, ws_size); grid = -1; return; }
        int dev = 0, cus = 0, per_cu = 0;
        if (hipGetDevice(&dev) != hipSuccess || hipDeviceGetAttribute(&cus, hipDeviceAttributeMultiprocessorCount, dev) != hipSuccess) { grid = -1; return; }
        if (hipFuncSetAttribute((const void*)hymba_fwd, hipFuncAttributeMaxDynamicSharedMemorySize, LDS_BYTES) != hipSuccess) { fprintf(stderr, "kernel_launch: hipFuncSetAttribute failed\n"); grid = -1; return; }
        if (hipOccupancyMaxActiveBlocksPerMultiprocessor(&per_cu, (const void*)hymba_fwd, NWAVES * 64, LDS_BYTES) != hipSuccess || per_cu < 1) { fprintf(stderr, "kernel_launch: occupancy query says %d blocks per CU\n", per_cu); (void)hipGetLastError(); grid = -1; return; }
        grid = cus;
    }
    if (grid < 0) return;
    (void)hipMemsetAsync((char*)d_ws + WS_CTL, 0, CTL_ZERO_BYTES, stream);
    Args a{};
    for (int i = 0; i < 26; ++i) a.in[i] = (const float*)d_in[i];
    a.out = (float*)d_out; a.ws = (unsigned char*)d_ws;
    for (int li = 0; li < N_LAUNCHES; ++li) {
        a.ph_lo = (N_LAUNCHES == 1) ? 0 : li; a.ph_hi = (N_LAUNCHES == 1) ? NPH : li + 1;
        hipLaunchKernelGGL(hymba_fwd, dim3(grid), dim3(NWAVES * 64), LDS_BYTES, stream, a);
    }
}
```

```cpp
#include <hip/hip_runtime.h>
#include <cstdio>
#include <cstdint>
#include <cmath>
#ifndef MK_AMP
#define MK_AMP 0
#endif
namespace pg8 {
#define PG8_LAS __attribute__((address_space(3)))
typedef unsigned short bf16_t;
typedef short bf16x8 __attribute__((ext_vector_type(8)));
typedef float f32x4 __attribute__((ext_vector_type(4)));
typedef unsigned u32x4 __attribute__((ext_vector_type(4)));
constexpr int BM = 256, BK = 64, HALF = 128, HTB = HALF * BK * 2  , STAGE_BYTES = 8 * HTB, NXCD = 8, WGM = 8;

__host__ __device__ __forceinline__ int lds_byte(int r, int c) { const int st = (r >> 4) * 2 + (c >> 5), rr = r & 15, cc = c & 31, ob = rr * 64 + cc * 2; return st * 1024 + (ob ^ (((ob >> 9) & 1) << 5)); }
__host__ __device__ __forceinline__ void stage_rc(int b, int& R, int& C) { const int st = b / 1024, sb = b % 1024, swz = sb ^ (((sb >> 9) & 1) << 5); R = (st >> 1) * 16 + swz / 64; C = (st & 1) * 32 + (swz % 64) / 2; }
__host__ __device__ __forceinline__ int perm32(int rho) { const int n = rho >> 4, i = rho & 15; return 8 * (i >> 2) + 4 * n + (i & 3); }

struct Unit { int pm, pn; };
struct Gemm { const bf16_t* A; const bf16_t* Bt; int M, N, K; };

struct StaticOrder {
    int nM, nN, nwg, G, c;
    __host__ __device__ void init(int M, int N, int G_, int c_) { nM = M / BM; nN = N / BM; nwg = nM * nN; G = G_; c = c_; }
    __host__ __device__ __forceinline__ bool next(int i, Unit& u) const {
        const long L = (long)i * G + c; if (L >= nwg) return false;
        int wgid = (int)L; { const int q = nwg / NXCD, r = nwg % NXCD, xcd = wgid % NXCD, off = wgid / NXCD; wgid = (xcd < r ? xcd * (q + 1) : r * (q + 1) + (xcd - r) * q) + off; }
        const int nig = WGM * nN, gid = wgid / nig, fm = gid * WGM, gsz = (nM - fm) < WGM ? (nM - fm) : WGM;
        u.pm = fm + ((wgid % nig) % gsz); u.pn = (wgid % nig) / gsz; return true;
    }
    __device__ __forceinline__ void a_ready(const Unit&) const {}
    __device__ __forceinline__ void done(const Unit&) const {}
};


__device__ __forceinline__ unsigned cvt_pk_bf16(float lo, float hi) { unsigned r; asm volatile("v_cvt_pk_bf16_f32 %0, %1, %2" : "=v"(r) : "v"(lo), "v"(hi)); return r; }
typedef unsigned u32x2 __attribute__((ext_vector_type(2)));
constexpr float RMS_EPS = 1e-6f;
__device__ __forceinline__ float row_rs(const float* ssq, int np, int row, float inv_n = 1.0f / 2048.0f) {
    float s;
    if (np == 1) s = ssq[row];
    else { const f32x4* p = (const f32x4*)(ssq + (size_t)row * 32); f32x4 a = p[0];
#pragma unroll
        for (int i = 1; i < 8; ++i) a += p[i];
        s = (a[0] + a[1]) + (a[2] + a[3]); }
    return __builtin_amdgcn_rsqf(s * inv_n + RMS_EPS);
}
struct RsTable { const PG8_LAS float* t; int tpm, tpm2; };
__device__ __forceinline__ float row_rs_t(const RsTable& T, const float* ssq, int np, float inv_n, int pm, int rin) { return (pm == T.tpm) ? T.t[rin] : (pm == T.tpm2) ? T.t[256 + rin] : row_rs(ssq, np, pm * BM + rin, inv_n); }
__device__ __forceinline__ float silu_f(float g) { return g * __builtin_amdgcn_rcpf(1.0f + __builtin_amdgcn_exp2f(-1.4426950408889634f * g)); }

struct EpiSwiGLU {
    static constexpr bool PERM = true, AFTER_DRAIN = false, HAS_MID = false, AMP = (MK_AMP == 11);
    bf16_t* O; int ldc; const float* ssq; int np; RsTable T;
    __device__ __forceinline__ void mid(f32x4 (&)[2][2][4][2], const Unit&, int, int, int, int) const {}
    __device__ __forceinline__ void operator()(const f32x4 (&acc)[2][2][4][2], const Unit& u, int wr, int wc, int fr, int fq) const {
        const int row0 = u.pm * BM + wr * 64 + fr, col0 = u.pn * HALF + wc * 32 + 8 * fq;
#pragma unroll
        for (int ai = 0; ai < 2; ++ai)
#pragma unroll
            for (int m = 0; m < 4; ++m) { const int row = row0 + ai * HALF + m * 16; const float rs = row_rs_t(T, ssq, np, 1.0f / 2048.0f, u.pm, wr * 64 + fr + ai * HALF + m * 16);
                float a[8];
#pragma unroll
                for (int n = 0; n < 2; ++n)
#pragma unroll
                    for (int i = 0; i < 4; ++i) { const float g = acc[ai][0][m][n][i] * rs, up = acc[ai][1][m][n][i] * rs; a[4 * n + i] = silu_f(g) * up; }
                u32x4 w; w.x = cvt_pk_bf16(a[0], a[1]); w.y = cvt_pk_bf16(a[2], a[3]); w.z = cvt_pk_bf16(a[4], a[5]); w.w = cvt_pk_bf16(a[6], a[7]);
                *(u32x4*)(O + (size_t)row * ldc + col0) = w; }
    }
};
template <bool MID> struct EpiResT {
    static constexpr bool PERM = false, AFTER_DRAIN = false, HAS_MID = MID, AMP = false;
    const float* basef; const bf16_t* baseh; float* out; bf16_t* xn; float* ssq; float scale; int ldc; const float* rsm; int kmid; RsTable T;
    __device__ __forceinline__ void mid(f32x4 (&acc)[2][2][4][2], const Unit& u, int wr, int wc, int fr, int fq) const {
        int fro = fr; asm volatile("" : "+v"(fro));
        const int rin0 = wr * 64 + fro;
#pragma unroll
        for (int ai = 0; ai < 2; ++ai)
#pragma unroll
            for (int m = 0; m < 4; ++m) { const float r = row_rs_t(T, rsm, 32, 1.0f / 1024.0f, u.pm, rin0 + ai * HALF + m * 16);
#pragma unroll
                for (int bj = 0; bj < 2; ++bj)
#pragma unroll
                    for (int n = 0; n < 2; ++n) acc[ai][bj][m][n] *= r; }
    }
    __device__ __forceinline__ void operator()(const f32x4 (&acc)[2][2][4][2], const Unit& u, int wr, int wc, int fr, int fq) const {
        const int row0 = u.pm * BM + wr * 64 + fr, col0 = u.pn * BM + wc * 32 + 4 * fq;
#pragma unroll
        for (int ai = 0; ai < 2; ++ai) {
            f32x4 bf[4][2][2]; u32x2 bh[4][2][2];
#pragma unroll
            for (int m = 0; m < 4; ++m)
#pragma unroll
                for (int bj = 0; bj < 2; ++bj)
#pragma unroll
                    for (int n = 0; n < 2; ++n) { const size_t o1 = (size_t)(row0 + ai * HALF + m * 16) * ldc + col0 + bj * HALF + n * 16;
                        if (basef) bf[m][bj][n] = *(const f32x4*)(basef + o1); else bh[m][bj][n] = *(const u32x2*)(baseh + o1); }
#pragma unroll
            for (int m = 0; m < 4; ++m) { const int row = row0 + ai * HALF + m * 16; const size_t off = (size_t)row * ldc + col0; float sq = 0.f;
#pragma unroll
                for (int bj = 0; bj < 2; ++bj)
#pragma unroll
                    for (int n = 0; n < 2; ++n) { const size_t o1 = off + bj * HALF + n * 16; f32x4 b;
                        if (basef) b = bf[m][bj][n];
                        else { const u32x2 h = bh[m][bj][n]; b[0] = __uint_as_float(h.x << 16); b[1] = __uint_as_float(h.x & 0xffff0000u); b[2] = __uint_as_float(h.y << 16); b[3] = __uint_as_float(h.y & 0xffff0000u); }
                        const f32x4 o = b + acc[ai][bj][m][n] * scale;
                        if (out) *(f32x4*)(out + o1) = o;
                        if (xn) { sq += (o[0] * o[0] + o[1] * o[1]) + (o[2] * o[2] + o[3] * o[3]); u32x2 w; w.x = cvt_pk_bf16(o[0], o[1]); w.y = cvt_pk_bf16(o[2], o[3]); *(u32x2*)(xn + o1) = w; } }
                if (xn) { sq += __shfl_xor(sq, 16); sq += __shfl_xor(sq, 32); if (fq == 0) ssq[(size_t)row * 32 + u.pn * 4 + wc] = sq; } }
        }
    }
};
struct EpiInProj {
    static constexpr bool PERM = true, AFTER_DRAIN = false, HAS_MID = false, AMP = (MK_AMP == 12);
    bf16_t* U; int ldc; const float* ssq; const float* qn; const float* kn; const float* rope; RsTable T;
    __device__ __forceinline__ void mid(f32x4 (&)[2][2][4][2], const Unit&, int, int, int, int) const {}
    __device__ __forceinline__ void operator()(const f32x4 (&acc)[2][2][4][2], const Unit& u, int wr, int wc, int fr, int fq) const {
        const int row0 = u.pm * BM + wr * 64 + fr, col0 = u.pn * BM + wc * 64 + 8 * fq;
        const bool isqk = u.pn < 8;
        f32x4 wv[2][2];
        if (isqk) { const float* wn = (u.pn < 4) ? qn : kn;
#pragma unroll
            for (int bj = 0; bj < 2; ++bj)
#pragma unroll
                for (int n = 0; n < 2; ++n) wv[bj][n] = *(const f32x4*)(wn + 32 * bj + 8 * fq + 4 * n); }
#pragma unroll
        for (int ai = 0; ai < 2; ++ai)
#pragma unroll
            for (int m = 0; m < 4; ++m) { const int row = row0 + ai * HALF + m * 16; const float rs = row_rs_t(T, ssq, 32, 1.0f / 2048.0f, u.pm, wr * 64 + fr + ai * HALF + m * 16);
                f32x4 v[2][2];
#pragma unroll
                for (int bj = 0; bj < 2; ++bj)
#pragma unroll
                    for (int n = 0; n < 2; ++n) v[bj][n] = acc[ai][bj][m][n] * rs;
                if (isqk) {
                    float sq = 0.f;
#pragma unroll
                    for (int bj = 0; bj < 2; ++bj)
#pragma unroll
                        for (int n = 0; n < 2; ++n) sq += (v[bj][n][0] * v[bj][n][0] + v[bj][n][1] * v[bj][n][1]) + (v[bj][n][2] * v[bj][n][2] + v[bj][n][3] * v[bj][n][3]);
                    sq += __shfl_xor(sq, 16); sq += __shfl_xor(sq, 32);
                    const float r = __builtin_amdgcn_rsqf(sq * (1.0f / 64.0f) + RMS_EPS);
#pragma unroll
                    for (int bj = 0; bj < 2; ++bj)
#pragma unroll
                        for (int n = 0; n < 2; ++n) v[bj][n] = v[bj][n] * r * wv[bj][n];
                    const int pos = (row & 4095) + 16;
                    const f32x4 c0 = *(const f32x4*)(rope + pos * 16), c1 = *(const f32x4*)(rope + pos * 16 + 4), s0 = *(const f32x4*)(rope + pos * 16 + 8), s1 = *(const f32x4*)(rope + pos * 16 + 12);
                    f32x4 p0, p1;
#pragma unroll
                    for (int i = 0; i < 4; ++i) { p0[i] = __shfl_xor(v[0][0][i], 16); p1[i] = __shfl_xor(v[0][1][i], 16); }
                    if (fq == 0) { v[0][0] = v[0][0] * c0 - p0 * s0; v[0][1] = v[0][1] * c1 - p1 * s1; }
                    else if (fq == 1) { v[0][0] = v[0][0] * c0 + p0 * s0; v[0][1] = v[0][1] * c1 + p1 * s1; }
                    if (u.pn < 4) { v[0][0] *= 0.18033688011112042f; v[0][1] *= 0.18033688011112042f; v[1][0] *= 0.18033688011112042f; v[1][1] *= 0.18033688011112042f; }
                }
#pragma unroll
                for (int bj = 0; bj < 2; ++bj) { u32x4 w; w.x = cvt_pk_bf16(v[bj][0][0], v[bj][0][1]); w.y = cvt_pk_bf16(v[bj][0][2], v[bj][0][3]); w.z = cvt_pk_bf16(v[bj][1][0], v[bj][1][1]); w.w = cvt_pk_bf16(v[bj][1][2], v[bj][1][3]);
                    *(u32x4*)(U + (size_t)row * ldc + col0 + 32 * bj) = w; } }
    }
};

template <class Epi, class Sched, bool ALIGN_EPI = false, bool SP2 = false>
__device__ __forceinline__ void gemm_phase(PG8_LAS unsigned char* lds, const Gemm g, const Sched& S, const Epi& E) {
    const int tid = threadIdx.x, wid = __builtin_amdgcn_readfirstlane(tid >> 6), lane = tid & 63, wr = wid >> 2, wc = wid & 3, fr = lane & 15, fq = lane >> 4;
    const int K = g.K, nt = K / BK;
    unsigned voffA[2], voffB[2];
#pragma unroll
    for (int i = 0; i < 2; ++i) { int R, C; stage_rc(tid * 16 + i * 8192, R, C); const int Rb = Epi::PERM ? ((R & ~31) + perm32(R & 31)) : R;
        voffA[i] = (unsigned)(R * K + C) * 2u; voffB[i] = (unsigned)(Rb * K + C) * 2u; }
    const size_t kstep = (size_t)(BK * 2);
    const size_t hstep = (size_t)HALF * K * 2;
    const size_t tstep = 2 * hstep;
    const unsigned ldsw = (unsigned)wid * 1024u;
    const int aoff = lds_byte(wr * 64 + fr, fq * 8), boff = lds_byte(wc * 32 + fr, fq * 8);
#define PG8_SA(b, h) (((b) * 2 + (h)) * HTB)
#define PG8_SB(b, h) ((4 + (b) * 2 + (h)) * HTB)
#define PG8_STAGE(bufoff, gbase, voff) do { _Pragma("unroll") for (int _i = 0; _i < 2; ++_i) \
        __builtin_amdgcn_global_load_lds((const unsigned*)((const char*)(gbase) + (voff)[_i]), (PG8_LAS unsigned*)(lds + (bufoff) + ldsw + _i * 8192), 16, 0, 0); } while (0)
#define PG8_LDA(dst, b, h) do { _Pragma("unroll") for (int m = 0; m < 4; ++m) _Pragma("unroll") for (int k = 0; k < 2; ++k) dst[m][k] = *(const PG8_LAS bf16x8*)(lds + PG8_SA(b, h) + aoff + m * 2048 + k * 1024); } while (0)
#define PG8_LDB(dst, b, h) do { _Pragma("unroll") for (int n = 0; n < 2; ++n) _Pragma("unroll") for (int k = 0; k < 2; ++k) dst[n][k] = *(const PG8_LAS bf16x8*)(lds + PG8_SB(b, h) + boff + n * 2048 + k * 1024); } while (0)
#define PG8_MMA(ai, bj, At, Bt) do { __builtin_amdgcn_s_setprio(1); _Pragma("unroll") for (int m = 0; m < 4; ++m) _Pragma("unroll") for (int n = 0; n < 2; ++n) _Pragma("unroll") for (int k = 0; k < 2; ++k) \
        acc[ai][bj][m][n] = __builtin_amdgcn_mfma_f32_16x16x32_bf16(Bt[n][k], At[m][k], acc[ai][bj][m][n], 0, 0, 0); __builtin_amdgcn_s_setprio(0); } while (0)
#define PG8_WAIT_V(n) asm volatile("s_waitcnt vmcnt(" #n ")" ::: "memory")
#define PG8_WAIT_L(n) asm volatile("s_waitcnt lgkmcnt(" #n ")" ::: "memory")
#define PG8_BAR __builtin_amdgcn_s_barrier()
#define PG8_SCHED __builtin_amdgcn_sched_barrier(0)
    Unit cur, nxt; int ui = 0;
    if (!S.next(0, cur)) return;
    f32x4 acc[2][2][4][2];
#pragma unroll
    for (int a = 0; a < 2; ++a)
#pragma unroll
        for (int b = 0; b < 2; ++b)
#pragma unroll
            for (int m = 0; m < 4; ++m)
#pragma unroll
                for (int n = 0; n < 2; ++n) acc[a][b][m][n] = (f32x4){0.f, 0.f, 0.f, 0.f};
    bf16x8 At[4][2], B0[2][2], B1[2][2];
    const char* cA = (const char*)g.A + (size_t)cur.pm * tstep; const char* cB = (const char*)g.Bt + (size_t)cur.pn * tstep;
    S.a_ready(cur);
    if constexpr (SP2) {
        PG8_STAGE(PG8_SB(0, 0), cB, voffB); PG8_STAGE(PG8_SB(0, 1), cB + hstep, voffB); PG8_STAGE(PG8_SA(0, 0), cA, voffA); PG8_STAGE(PG8_SA(0, 1), cA + hstep, voffA);
        if (wr == 1) PG8_BAR;
        PG8_WAIT_V(2); PG8_BAR;
        PG8_STAGE(PG8_SB(1, 0), cB + kstep, voffB); PG8_STAGE(PG8_SA(1, 0), cA + kstep, voffA); PG8_STAGE(PG8_SB(1, 1), cB + hstep + kstep, voffB);
        PG8_WAIT_V(6); PG8_BAR;
    } else {
        PG8_STAGE(PG8_SB(0, 0), cB, voffB); PG8_STAGE(PG8_SA(0, 0), cA, voffA); PG8_STAGE(PG8_SB(0, 1), cB + hstep, voffB); PG8_STAGE(PG8_SA(0, 1), cA + hstep, voffA);
        if (wr == 1) PG8_BAR;
        PG8_WAIT_V(4); PG8_BAR;
        PG8_STAGE(PG8_SB(1, 0), cB + kstep, voffB); PG8_STAGE(PG8_SA(1, 0), cA + kstep, voffA); PG8_STAGE(PG8_SB(1, 1), cB + hstep + kstep, voffB);
        PG8_WAIT_V(6); PG8_BAR;
    }
    for (;;) {
        const bool has_next = S.next(ui + 1, nxt);
        const char* nA = has_next ? (const char*)g.A + (size_t)nxt.pm * tstep : cA; const char* nB = has_next ? (const char*)g.Bt + (size_t)nxt.pn * tstep : cB;
        for (int t = 0; t < nt; t += 2) {
            const bool last = (t == nt - 2);
            if constexpr (Epi::HAS_MID) { if (t == E.kmid) E.mid(acc, cur, wr, wc, fr, fq); }
            const char* a1 = cA + (size_t)(t + 1) * kstep;
            const char* a2 = last ? nA : cA + (size_t)(t + 2) * kstep; const char* b2 = last ? nB : cB + (size_t)(t + 2) * kstep;
            const char* a3 = a2 + kstep; const char* b3 = b2 + kstep;
            if (last && has_next) S.a_ready(nxt);
            if constexpr (SP2) {
            PG8_LDB(B0, 0, 0); PG8_LDB(B1, 0, 1); PG8_SCHED; PG8_LDA(At, 0, 0); PG8_STAGE(PG8_SA(1, 1), a1 + hstep, voffA);
            PG8_WAIT_V(8); PG8_WAIT_L(0); PG8_BAR; PG8_MMA(0, 0, At, B0); PG8_MMA(0, 1, At, B1); PG8_BAR; PG8_SCHED;
            PG8_LDA(At, 0, 1); PG8_STAGE(PG8_SB(0, 0), b2, voffB); PG8_STAGE(PG8_SB(0, 1), b2 + hstep, voffB); PG8_STAGE(PG8_SA(0, 0), a2, voffA);
            PG8_WAIT_V(8); PG8_WAIT_L(0); PG8_BAR; PG8_MMA(1, 0, At, B0); PG8_MMA(1, 1, At, B1); PG8_BAR; PG8_SCHED;
            PG8_LDB(B0, 1, 0); PG8_LDB(B1, 1, 1); PG8_SCHED; PG8_LDA(At, 1, 0); PG8_STAGE(PG8_SA(0, 1), a2 + hstep, voffA);
            PG8_WAIT_V(8); PG8_WAIT_L(0); PG8_BAR; PG8_MMA(0, 0, At, B0); PG8_MMA(0, 1, At, B1); PG8_BAR; PG8_SCHED;
            PG8_LDA(At, 1, 1); PG8_STAGE(PG8_SB(1, 0), b3, voffB); PG8_STAGE(PG8_SB(1, 1), b3 + hstep, voffB); PG8_STAGE(PG8_SA(1, 0), a3, voffA);
            PG8_WAIT_V(8); PG8_WAIT_L(0); PG8_BAR; PG8_MMA(1, 0, At, B0); PG8_MMA(1, 1, At, B1); PG8_BAR; PG8_SCHED;
            } else {
            PG8_LDB(B0, 0, 0); PG8_SCHED; PG8_LDA(At, 0, 0); PG8_STAGE(PG8_SA(1, 1), a1 + hstep, voffA);
            PG8_WAIT_L(8); PG8_BAR; PG8_WAIT_L(0); PG8_MMA(0, 0, At, B0); PG8_BAR; PG8_SCHED;
            PG8_LDB(B1, 0, 1); PG8_STAGE(PG8_SB(0, 0), b2, voffB);
            PG8_BAR; PG8_WAIT_L(0); PG8_MMA(0, 1, At, B1); PG8_BAR;
            PG8_LDA(At, 0, 1); PG8_STAGE(PG8_SA(0, 0), a2, voffA);
            PG8_BAR; PG8_WAIT_L(0); PG8_MMA(1, 0, At, B0); PG8_BAR; PG8_SCHED;
            PG8_STAGE(PG8_SB(0, 1), b2 + hstep, voffB);
            PG8_WAIT_V(6); PG8_BAR; PG8_MMA(1, 1, At, B1); PG8_BAR;
            PG8_LDB(B0, 1, 0); PG8_SCHED; PG8_LDA(At, 1, 0); PG8_STAGE(PG8_SA(0, 1), a2 + hstep, voffA);
            PG8_WAIT_L(8); PG8_BAR; PG8_WAIT_L(0); PG8_MMA(0, 0, At, B0); PG8_BAR; PG8_SCHED;
            PG8_LDB(B1, 1, 1); PG8_STAGE(PG8_SB(1, 0), b3, voffB);
            PG8_BAR; PG8_WAIT_L(0); PG8_MMA(0, 1, At, B1); PG8_BAR;
            PG8_LDA(At, 1, 1); PG8_STAGE(PG8_SA(1, 0), a3, voffA);
            PG8_BAR; PG8_WAIT_L(0); PG8_MMA(1, 0, At, B0); PG8_BAR; PG8_SCHED;
            PG8_STAGE(PG8_SB(1, 1), b3 + hstep, voffB);
            PG8_WAIT_V(6); PG8_BAR; PG8_MMA(1, 1, At, B1); PG8_BAR;
            }
        }
        if constexpr (ALIGN_EPI) { if (wr == 0) PG8_BAR; }
        if constexpr (!Epi::AFTER_DRAIN) { for (int amp_ = 0; amp_ < (Epi::AMP ? 3 : 1); ++amp_) { E(acc, cur, wr, wc, fr, fq); asm volatile("" ::: "memory"); } S.done(cur); }
        if (!has_next) break;
#pragma unroll
        for (int a = 0; a < 2; ++a)
#pragma unroll
            for (int b = 0; b < 2; ++b)
#pragma unroll
                for (int m = 0; m < 4; ++m)
#pragma unroll
                    for (int n = 0; n < 2; ++n) acc[a][b][m][n] = (f32x4){0.f, 0.f, 0.f, 0.f};
        cur = nxt; cA = nA; cB = nB; ++ui;
        if constexpr (ALIGN_EPI) { if (wr == 1) PG8_BAR; }
    }
    PG8_WAIT_V(0);
    if constexpr (!ALIGN_EPI) { if (wr == 0) PG8_BAR; }
    PG8_BAR;
    if constexpr (Epi::AFTER_DRAIN) { E.fused(acc, cur, wr, wc, fr, fq, lds, wid, lane); S.done(cur); }
#undef PG8_SA
#undef PG8_SB
#undef PG8_STAGE
#undef PG8_LDA
#undef PG8_LDB
#undef PG8_MMA
#undef PG8_WAIT_V
#undef PG8_WAIT_L
#undef PG8_BAR
#undef PG8_SCHED
}
}

#ifndef PG8_SP2
#define PG8_SP2 true
#endif

constexpr int NWAVES = 8;
constexpr int DM = 2048, SEQ = 4096, NBATCH = 2, MR = NBATCH * SEQ, NMETA = 16, LPOS = SEQ + NMETA;
constexpr int DFF = 5632, NGU = 2 * DFF;
constexpr int NHEAD = 8, SH = 16, CONVD = 1536, NIN = 5648, NINP = 5632;
constexpr int PPAD = 48, LPAD = LPOS + PPAD;
constexpr float EPS = 1e-6f;
#ifndef MK_REPEAT_PHASE
#define MK_REPEAT_PHASE -1
#endif
#ifndef MK_N_LAUNCHES
#define MK_N_LAUNCHES 1
#endif
constexpr int NPH = 10;
constexpr int N_LAUNCHES = MK_N_LAUNCHES;

constexpr size_t MiB = 1u << 20;
constexpr size_t WS_CTL = 0, CTL_ZERO_BYTES = 1 * MiB;
constexpr size_t WS_W1GU = 2 * MiB, WS_W1D = 46 * MiB, WS_WIN = 68 * MiB, WS_WOUT = 91 * MiB, WS_W2GU = 99 * MiB, WS_W2D = 143 * MiB;
constexpr size_t WS_XN = 165 * MiB;
constexpr size_t WS_ACT = 197 * MiB;
constexpr size_t WS_MIX = 285 * MiB;
constexpr size_t WS_SSQ0 = 317 * MiB;
constexpr size_t WS_SSQ1 = 318 * MiB, WS_SSQ2 = 319 * MiB;
constexpr size_t WS_DTR = 320 * MiB;
constexpr size_t WS_ROPE = 321 * MiB;
constexpr size_t WS_META = 322 * MiB;
constexpr size_t MO_XN = 0, MO_SSQ0 = 65536, MO_ACT = 131072, MO_H1 = 327680, MO_XN1 = 458752, MO_U = 524288, MO_KM = 917504, MO_VM = 950272, MO_SSQ1 = 69632;
constexpr size_t WS_SST = 324 * MiB;
constexpr size_t WS_ATOT = 333 * MiB;
constexpr size_t WS_SSQS = 334 * MiB;
constexpr size_t WS_XS = 336 * MiB;
constexpr size_t WS_BC = 353 * MiB;
constexpr size_t WS_DT = 362 * MiB;
constexpr size_t WS_END = 363 * MiB;
constexpr int CW_BAR = 4096;

constexpr int RING_OFF = 0, RING_BYTES = 131072;
constexpr int LDS_BYTES = 147456, MISC_OFF = LDS_BYTES - 512;

#define GAS __attribute__((address_space(1)))
#define LAS __attribute__((address_space(3)))
typedef unsigned short bf16;
typedef unsigned v4u __attribute__((ext_vector_type(4)));
typedef float f32x4 __attribute__((ext_vector_type(4)));
typedef short bf16x8 __attribute__((ext_vector_type(8)));
typedef GAS unsigned gu32;
typedef GAS unsigned long long gu64;
#define RLX_AGENT __ATOMIC_RELAXED, __HIP_MEMORY_SCOPE_AGENT
#define LDS_WAIT() asm volatile("s_waitcnt lgkmcnt(0)" ::: "memory")
#define VM_WAIT() asm volatile("s_waitcnt vmcnt(0)" ::: "memory")
__device__ __forceinline__ unsigned long long rt() { return __builtin_amdgcn_s_memrealtime(); }
__device__ __forceinline__ unsigned f2bf(float f) { unsigned u = __builtin_bit_cast(unsigned, f); return (u + 0x7fffu + ((u >> 16) & 1u)) >> 16; }
typedef float f32x2_pk __attribute__((ext_vector_type(2))); typedef __bf16 bf16x2_pk __attribute__((ext_vector_type(2)));
__device__ __forceinline__ unsigned pk2(float lo, float hi) { f32x2_pk v = {lo, hi}; bf16x2_pk b = __builtin_convertvector(v, bf16x2_pk); return __builtin_bit_cast(unsigned, b); }

#define XB_TMO      128
#define XB_XCNT(j)  (256  + 64 * (j))
#define XB_XSUB(j)  (1280 + 64 * (j))
#define XB_XGEN(j)  (2304 + 64 * (j))
#define XB_TOP      3328
#define XB_TOPGEN   3392
#define XCD_BAR_WORDS 3456
#define XB_SPIN_CAP (1u << 18)

__device__ __forceinline__ unsigned xb_ld(unsigned* p)              { return __hip_atomic_load(p, __ATOMIC_RELAXED, __HIP_MEMORY_SCOPE_AGENT); }
__device__ __forceinline__ unsigned xb_add(unsigned* p, unsigned v) { return __hip_atomic_fetch_add(p, v, __ATOMIC_RELAXED, __HIP_MEMORY_SCOPE_AGENT); }
__device__ __forceinline__ unsigned xb_xcc_id() { return (unsigned)__builtin_amdgcn_s_getreg((3 << 11) | 20) & 0xFu; }
#define XB_SPIN(cond, bar) do { unsigned _sp = 0; while (cond) { __builtin_amdgcn_s_sleep(1); \
    if ((++_sp & 255u) == 0u) { if (xb_ld(&(bar)[XB_TMO])) break; if (_sp > XB_SPIN_CAP) { atomicAdd(&(bar)[XB_TMO], 1u); break; } } } } while (0)

struct XcdBarrier {
    unsigned* bar; unsigned x;
    volatile LAS unsigned* st;
};

__device__ __forceinline__ XcdBarrier xcd_barrier_post(unsigned* bar, volatile LAS unsigned* st) {
    XcdBarrier b; b.bar = bar; b.x = xb_xcc_id(); b.st = st;
    if (threadIdx.x == 0) (void)xb_add(&bar[XB_XCNT(b.x)], 1u);
    return b;
}
__device__ __forceinline__ void xcd_barrier_complete(unsigned* bar, unsigned x, unsigned& nloc, unsigned& nx) {
    const unsigned G = gridDim.x * gridDim.y * gridDim.z;
    unsigned sum, cnt, mine, sp = 0u;
    for (;;) {
        sum = 0u; cnt = 0u; mine = 0u;
#pragma unroll
        for (unsigned j = 0; j < 16; ++j) { const unsigned c = xb_ld(&bar[XB_XCNT(j)]); sum += c; cnt += (c > 0u) ? 1u : 0u; mine = (j == x) ? c : mine; }
        if (sum == G) break;
        __builtin_amdgcn_s_sleep(1);
        if ((++sp & 255u) == 0u) { if (xb_ld(&bar[XB_TMO])) break; if (sp > XB_SPIN_CAP) { atomicAdd(&bar[XB_TMO], 1u); break; } }
    }
    nloc = mine > 0u ? mine : 1u; nx = cnt > 0u ? cnt : 1u;
}

__device__ __forceinline__ void xcd_barrier(const XcdBarrier& b) {
    asm volatile("s_waitcnt vmcnt(0)" ::: "memory");
    __syncthreads();
    if (threadIdx.x == 0) {
        unsigned* bar = b.bar;
        __builtin_amdgcn_s_waitcnt(0);
        unsigned nloc = b.st[0], nx = b.st[1];
        if (nloc == 0u) { xcd_barrier_complete(bar, b.x, nloc, nx); b.st[0] = nloc; b.st[1] = nx; }
        const unsigned old = xb_add(&bar[XB_XSUB(b.x)], 1u);
        const unsigned gen = old / nloc;
        if (old + 1u == (gen + 1u) * nloc) {
            __builtin_amdgcn_fence(__ATOMIC_RELEASE, "agent");
            asm volatile("s_waitcnt vmcnt(0)" ::: "memory");
            const unsigned og = xb_add(&bar[XB_TOP], 1u);
            const unsigned tg = og / nx;
            if (og + 1u == (tg + 1u) * nx) xb_add(&bar[XB_TOPGEN], 1u);
            else XB_SPIN(xb_ld(&bar[XB_TOPGEN]) == tg, bar);
            __builtin_amdgcn_fence(__ATOMIC_ACQUIRE, "agent");
            xb_add(&bar[XB_XGEN(b.x)], 1u);
            asm volatile("s_waitcnt vmcnt(0)" ::: "memory");
        } else {
            XB_SPIN(xb_ld(&bar[XB_XGEN(b.x)]) == gen, bar);
            __builtin_amdgcn_fence(__ATOMIC_ACQUIRE, "agent");
            asm volatile("s_waitcnt vmcnt(0)" ::: "memory");
        }
    }
    __syncthreads();
}


typedef unsigned u32x2v __attribute__((ext_vector_type(2)));
__device__ __forceinline__ float bf2f(unsigned b) { return __uint_as_float(b << 16); }
__device__ __forceinline__ float wave_sum(float v) {
#pragma unroll
    for (int o = 1; o < 64; o <<= 1) v += __shfl_xor(v, o);
    return v;
}
__device__ __forceinline__ float wave_max(float v) {
#pragma unroll
    for (int o = 1; o < 64; o <<= 1) v = fmaxf(v, __shfl_xor(v, o));
    return v;
}
__device__ __forceinline__ float silu1(float g) { return g * __builtin_amdgcn_rcpf(1.0f + __builtin_amdgcn_exp2f(-1.4426950408889634f * g)); }

struct Frame {
    LAS unsigned char* lds;
    int tid, lane, wave, G, gw, NGW;
    const float* in[26]; float* out; unsigned char* ws; const float* const* inp;
};
#define WSP(T, off) ((T*)(F.ws + (off)))

constexpr int RST_OFF = RING_BYTES;
__device__ __forceinline__ pg8::RsTable build_rs_table(Frame& F, const float* ssq, int np, float inv_n, int pm, int pm2 = -1) {
    LAS float* t = (LAS float*)(F.lds + RST_OFF);
    if (F.tid < 256) t[F.tid] = pg8::row_rs(ssq, np, pm * 256 + F.tid, inv_n);
    else if (pm2 >= 0) t[F.tid] = pg8::row_rs(ssq, np, pm2 * 256 + F.tid - 256, inv_n);
    __syncthreads();
    return pg8::RsTable{t, pm, pm2};
}
__device__ __forceinline__ int rowmap(int kind, int n) {
    if (kind == 1) return 256 * (n >> 7) + (n & 127);
    if (kind == 2) return 256 * (n >> 7) + 128 + (n & 127);
    if (kind == 3) { if (n >= NINP) return n; const int pn = n >> 8, rem = n & 255, wc = rem >> 6, bj = (rem >> 5) & 1, j = rem & 31; return 256 * pn + 128 * bj + 32 * wc + j; }
    return n;
}
struct TItem { const float* W; int K, N; const float* kscale; bf16* WT; int kind, item, ks_off, krot; };
__device__ __forceinline__ void transpose_load(const TItem& t, int lane, f32x4 (&v)[16]) {
    const int nblk = (t.N + 63) >> 6, kb = t.item / nblk, nb = t.item - kb * nblk, k0 = 64 * kb, n0 = 64 * nb;
    const float* src = t.W + (size_t)(k0 + 8 * (lane >> 3)) * t.N;
#pragma unroll
    for (int h = 0; h < 2; ++h) { int nl = n0 + 32 * h + 4 * (lane & 7); nl = nl < t.N ? nl : t.N - 4;
#pragma unroll
        for (int i = 0; i < 8; ++i) v[8 * h + i] = __builtin_nontemporal_load((const f32x4*)(src + (size_t)i * t.N + nl)); }
}
__device__ __forceinline__ void transpose_finish(const TItem& t, int lane, f32x4 (&v)[16]) {
    const int nblk = (t.N + 63) >> 6, kb = t.item / nblk, nb = t.item - kb * nblk, k0 = 64 * kb, n0 = 64 * nb, r = lane >> 3;
    float sc[8];
    if (t.kscale && k0 >= t.ks_off) { const f32x4 s0 = *(const f32x4*)(t.kscale + k0 + 8 * r - t.ks_off), s1 = *(const f32x4*)(t.kscale + k0 + 8 * r - t.ks_off + 4);
        sc[0] = s0[0]; sc[1] = s0[1]; sc[2] = s0[2]; sc[3] = s0[3]; sc[4] = s1[0]; sc[5] = s1[1]; sc[6] = s1[2]; sc[7] = s1[3]; }
    else {
#pragma unroll
        for (int i = 0; i < 8; ++i) sc[i] = 1.0f; }
    int kd = k0 + t.krot; if (kd >= t.K) kd -= t.K;
#pragma unroll
    for (int h = 0; h < 2; ++h)
#pragma unroll
        for (int j = 0; j < 4; ++j) { const int n = n0 + 32 * h + 4 * (lane & 7) + j;
            v4u o; o.x = pg8::cvt_pk_bf16(v[8 * h + 0][j] * sc[0], v[8 * h + 1][j] * sc[1]); o.y = pg8::cvt_pk_bf16(v[8 * h + 2][j] * sc[2], v[8 * h + 3][j] * sc[3]);
            o.z = pg8::cvt_pk_bf16(v[8 * h + 4][j] * sc[4], v[8 * h + 5][j] * sc[5]); o.w = pg8::cvt_pk_bf16(v[8 * h + 6][j] * sc[6], v[8 * h + 7][j] * sc[7]);
            if (n < t.N) *(v4u*)(t.WT + (size_t)rowmap(t.kind, n) * t.K + kd + 8 * r) = o; }
}
__device__ __forceinline__ void transpose_load_h(const TItem& t, int lane, int h, f32x4 (&v)[8]) {
    const int nblk = (t.N + 63) >> 6, kb = t.item / nblk, nb = t.item - kb * nblk, k0 = 64 * kb, n0 = 64 * nb;
    const float* src = t.W + (size_t)(k0 + 8 * (lane >> 3)) * t.N;
    int nl = n0 + 32 * h + 4 * (lane & 7); nl = nl < t.N ? nl : t.N - 4;
#pragma unroll
    for (int i = 0; i < 8; ++i) v[i] = __builtin_nontemporal_load((const f32x4*)(src + (size_t)i * t.N + nl));
}
__device__ __forceinline__ void transpose_finish_h(const TItem& t, int lane, int h, f32x4 (&v)[8]) {
    const int nblk = (t.N + 63) >> 6, kb = t.item / nblk, nb = t.item - kb * nblk, k0 = 64 * kb, n0 = 64 * nb, r = lane >> 3;
    float sc[8];
    if (t.kscale && k0 >= t.ks_off) { const f32x4 s0 = *(const f32x4*)(t.kscale + k0 + 8 * r - t.ks_off), s1 = *(const f32x4*)(t.kscale + k0 + 8 * r - t.ks_off + 4);
        sc[0] = s0[0]; sc[1] = s0[1]; sc[2] = s0[2]; sc[3] = s0[3]; sc[4] = s1[0]; sc[5] = s1[1]; sc[6] = s1[2]; sc[7] = s1[3]; }
    else {
#pragma unroll
        for (int i = 0; i < 8; ++i) sc[i] = 1.0f; }
    int kd = k0 + t.krot; if (kd >= t.K) kd -= t.K;
#pragma unroll
    for (int j = 0; j < 4; ++j) { const int n = n0 + 32 * h + 4 * (lane & 7) + j;
        v4u o; o.x = pg8::cvt_pk_bf16(v[0][j] * sc[0], v[1][j] * sc[1]); o.y = pg8::cvt_pk_bf16(v[2][j] * sc[2], v[3][j] * sc[3]);
        o.z = pg8::cvt_pk_bf16(v[4][j] * sc[4], v[5][j] * sc[5]); o.w = pg8::cvt_pk_bf16(v[6][j] * sc[6], v[7][j] * sc[7]);
        if (n < t.N) *(v4u*)(t.WT + (size_t)rowmap(t.kind, n) * t.K + kd + 8 * r) = o; }
}
__device__ __forceinline__ void row_to_bf16(const float* xrow, bf16* orow, float* ssq, int lane) {
    const f32x4* xr = (const f32x4*)xrow + lane; float s = 0.f; f32x4 v[8];
#pragma unroll
    for (int j = 0; j < 8; ++j) { v[j] = __builtin_nontemporal_load(xr + 64 * j); s += (v[j][0] * v[j][0] + v[j][1] * v[j][1]) + (v[j][2] * v[j][2] + v[j][3] * v[j][3]); }
    s = wave_sum(s);
    u32x2v* o8 = (u32x2v*)orow + lane;
#pragma unroll
    for (int j = 0; j < 8; ++j) { u32x2v w; w.x = pk2(v[j][0], v[j][1]); w.y = pk2(v[j][2], v[j][3]); o8[64 * j] = w; }
    if (lane == 0) *ssq = s;
}
__constant__ float ROPE_INV[8] = {1.0f, 0.1939227432012558f, 0.03760603070259094f, 0.007292664609849453f, 0.0014142135623842478f, 0.00027424818836152554f, 5.318296098266728e-05f, 1.0313386155758053e-05f};
constexpr int I_G = 32 * 88, I_D = 88 * 32, I_IN = 32 * 89, I_O = 32 * 32;
constexpr int IT_W1G = 0, IT_W1U = IT_W1G + I_G, IT_WOUT = IT_W1U + I_G, IT_W1D = IT_WOUT + I_O, IT_WIN = IT_W1D + I_D, IT_W2U = IT_WIN + I_IN, IT_W2G = IT_W2U + I_G, IT_W2D = IT_W2G + I_G, IT_END = IT_W2D + I_D;
#ifndef MK_N1
#define MK_N1 6944
#endif
constexpr int IT_BG = IT_END - 8192;
constexpr int IT_CUT0 = IT_BG - MK_N1;
static_assert(IT_CUT0 >= IT_WOUT, "W1 gate/up are needed by P1");
__device__ __forceinline__ TItem mk_item(Frame& F, int it) {
    const int m = (it >= IT_W1U) + (it >= IT_WOUT) + (it >= IT_W1D) + (it >= IT_WIN) + (it >= IT_W2U) + (it >= IT_W2G) + (it >= IT_W2D);
    const int start = m == 0 ? IT_W1G : m == 1 ? IT_W1U : m == 2 ? IT_WOUT : m == 3 ? IT_W1D : m == 4 ? IT_WIN : m == 5 ? IT_W2U : m == 6 ? IT_W2G : IT_W2D;
    const unsigned long long WI = 0x1917180705150403ull, SI = 0xff161606ff140202ull;
    const int wi = (int)((WI >> (8 * m)) & 0xffu), si = (int)((SI >> (8 * m)) & 0xffu);
    const bool down = (m == 3 || m == 7);
    const size_t wto = m < 2 ? WS_W1GU : m == 2 ? WS_WOUT : m == 3 ? WS_W1D : m == 4 ? WS_WIN : m < 7 ? WS_W2GU : WS_W2D;
    const int kind = (m == 0 || m == 6) ? 1 : (m == 1 || m == 5) ? 2 : m == 4 ? 3 : 0;
    TItem t; t.W = F.inp[wi]; t.K = down ? DFF : DM; t.N = down ? DM : m == 2 ? DM : m == 4 ? NIN : DFF; t.kscale = si == 0xff ? nullptr : F.inp[si]; t.WT = WSP(bf16, wto); t.kind = kind; t.item = it - start;
    t.ks_off = m == 2 ? 1024 : 0; t.krot = m == 2 ? 1024 : 0;
    return t;
}
__device__ __forceinline__ void convert_items(Frame& F, int lo, int hi, int w, int nw) {
    if (w < 0) return;
    f32x4 va[16], vb[16]; int it = lo + w;
    if (it < hi) { TItem ta = mk_item(F, it); transpose_load(ta, F.lane, va);
        for (;;) {
            const int itb = it + nw; TItem tb = mk_item(F, itb < hi ? itb : it);
            if (itb < hi) transpose_load(tb, F.lane, vb);
            transpose_finish(ta, F.lane, va);
            if (itb >= hi) break;
            const int itc = itb + nw; ta = mk_item(F, itc < hi ? itc : itb);
            if (itc < hi) transpose_load(ta, F.lane, va);
            transpose_finish(tb, F.lane, vb);
            if (itc >= hi) break;
            it = itc;
        } }
}
__device__ __forceinline__ void p0_prologue(Frame& F) {
    convert_items(F, 0, IT_CUT0, F.gw, F.NGW);
    for (int m = F.gw; m < MR; m += 2 * F.NGW) {
        const int m2 = m + F.NGW;
        const f32x4* xa = (const f32x4*)(F.in[0] + (size_t)m * DM) + F.lane; const f32x4* xb = (const f32x4*)(F.in[0] + (size_t)(m2 < MR ? m2 : m) * DM) + F.lane;
        f32x4 va[8], vb[8]; float sa = 0.f, sb = 0.f;
#pragma unroll
        for (int j = 0; j < 8; ++j) { va[j] = __builtin_nontemporal_load(xa + 64 * j); vb[j] = __builtin_nontemporal_load(xb + 64 * j); }
#pragma unroll
        for (int j = 0; j < 8; ++j) { sa += (va[j][0] * va[j][0] + va[j][1] * va[j][1]) + (va[j][2] * va[j][2] + va[j][3] * va[j][3]); sb += (vb[j][0] * vb[j][0] + vb[j][1] * vb[j][1]) + (vb[j][2] * vb[j][2] + vb[j][3] * vb[j][3]); }
        sa = wave_sum(sa); sb = wave_sum(sb);
        u32x2v* oa = (u32x2v*)(WSP(bf16, WS_XN) + (size_t)m * DM) + F.lane; u32x2v* ob = (u32x2v*)(WSP(bf16, WS_XN) + (size_t)m2 * DM) + F.lane;
#pragma unroll
        for (int j = 0; j < 8; ++j) { u32x2v w; w.x = pk2(va[j][0], va[j][1]); w.y = pk2(va[j][2], va[j][3]); oa[64 * j] = w; }
        if (F.lane == 0) WSP(float, WS_SSQ0)[m] = sa;
        if (m2 < MR) {
#pragma unroll
            for (int j = 0; j < 8; ++j) { u32x2v w; w.x = pk2(vb[j][0], vb[j][1]); w.y = pk2(vb[j][2], vb[j][3]); ob[64 * j] = w; }
            if (F.lane == 0) WSP(float, WS_SSQ0)[m2] = sb; }
    }
    for (int p = F.gw; p < NMETA; p += F.NGW) row_to_bf16(F.in[1] + (size_t)p * DM, WSP(bf16, WS_META + MO_XN) + (size_t)p * DM, WSP(float, WS_META + MO_SSQ0) + p, F.lane);
    for (int e = F.gw * 64 + F.lane; e < LPOS * 8; e += F.NGW * 64) { const int pos = e >> 3, i = e & 7;
        const float ang = (float)pos * ROPE_INV[i];
        double tr = (double)ang * 0.15915494309189535; tr -= __builtin_rint(tr);
        const float tf = (float)tr;
        WSP(float, WS_ROPE)[pos * 16 + i] = __builtin_amdgcn_cosf(tf); WSP(float, WS_ROPE)[pos * 16 + 8 + i] = __builtin_amdgcn_sinf(tf); }
}

__device__ __forceinline__ f32x4 skinny16(const bf16* A, int lda, const bf16* Bt, int ldb, int k0, int k1, int lane, f32x4 acc) {
    const bf16* ap = A + (size_t)(lane & 15) * lda + 8 * (lane >> 4);
    const bf16* bp = Bt + (size_t)(lane & 15) * ldb + 8 * (lane >> 4);
#pragma unroll 16
    for (int k = k0; k < k1; k += 32) { const bf16x8 a = *(const bf16x8*)(ap + k), b = *(const bf16x8*)(bp + k);
        acc = __builtin_amdgcn_mfma_f32_16x16x32_bf16(a, b, acc, 0, 0, 0); }
    asm volatile("s_nop 15\n\ts_nop 3" : "+v"(acc));
    return acc;
}
__device__ __forceinline__ void meta_gateup(Frame& F, int w0, int wstride) {
    const bf16* A = WSP(bf16, WS_META + MO_XN); const float* ssq = WSP(float, WS_META + MO_SSQ0); bf16* act = WSP(bf16, WS_META + MO_ACT);
    if (w0 < 0) return;
    for (int it = w0; it < DFF / 16; it += wstride) { const int c0 = 16 * it, rg = 256 * (c0 >> 7) + (c0 & 127);
        f32x4 g = (f32x4){0.f, 0.f, 0.f, 0.f}, u = g;
        g = skinny16(A, DM, WSP(bf16, WS_W1GU) + (size_t)rg * DM, DM, 0, DM, F.lane, g);
        u = skinny16(A, DM, WSP(bf16, WS_W1GU) + (size_t)(rg + 128) * DM, DM, 0, DM, F.lane, u);
#pragma unroll
        for (int i = 0; i < 4; ++i) { const int row = 4 * (F.lane >> 4) + i; const float rs = __builtin_amdgcn_rsqf(ssq[row] * (1.0f / 2048.0f) + EPS);
            act[row * DFF + c0 + (F.lane & 15)] = (bf16)f2bf(silu1(g[i] * rs) * (u[i] * rs)); } }
}
__device__ __forceinline__ void meta_down(Frame& F) {
    const bf16* A = WSP(bf16, WS_META + MO_ACT); float* ssq1 = WSP(float, WS_META + MO_SSQ1); bf16* xn1 = WSP(bf16, WS_META + MO_XN1);
    LAS f32x4* red = (LAS f32x4*)(F.lds + 65536);
    for (int it = blockIdx.x; it < DM / 16; it += F.G) { const int c0 = 16 * it;
        __syncthreads();
        f32x4 a = (f32x4){0.f, 0.f, 0.f, 0.f};
        a = skinny16(A, DFF, WSP(bf16, WS_W1D) + (size_t)c0 * DFF, DFF, F.wave * (DFF / 8), (F.wave + 1) * (DFF / 8), F.lane, a);
        red[F.wave * 64 + F.lane] = a;
        __syncthreads();
        if (F.wave == 0) {
#pragma unroll
            for (int w = 1; w < 8; ++w) a += red[w * 64 + F.lane];
#pragma unroll
            for (int i = 0; i < 4; ++i) { const int row = 4 * (F.lane >> 4) + i, col = c0 + (F.lane & 15); const float o = F.in[1][row * DM + col] + 0.5f * a[i];
                xn1[row * DM + col] = (bf16)f2bf(o);
                float sq = o * o; sq += __shfl_xor(sq, 1); sq += __shfl_xor(sq, 2); sq += __shfl_xor(sq, 4); sq += __shfl_xor(sq, 8);
                if ((F.lane & 15) == 0) ssq1[row * 128 + it] = sq; } }
        __syncthreads();
    }
}
constexpr int NMETA_IT = NIN / 16, NDT_IT = MR / 16;
__device__ __forceinline__ void meta_inproj_and_dt(Frame& F, int it0, int it_end, int wstride) {
    const int nmeta = NMETA_IT;
    if (it0 < 0) return;
    for (int it = it0; it < it_end; it += wstride) {
        if (it < nmeta) {
            const float* ssq1 = WSP(float, WS_META + MO_SSQ1); float* um = WSP(float, WS_META + MO_U);
            float rs[4];
#pragma unroll
            for (int i = 0; i < 4; ++i) { const f32x4* pp = (const f32x4*)(ssq1 + (4 * (F.lane >> 4) + i) * 128 + 8 * (F.lane & 15)); const f32x4 v = pp[0] + pp[1]; float s2 = (v[0] + v[1]) + (v[2] + v[3]);
                s2 += __shfl_xor(s2, 1); s2 += __shfl_xor(s2, 2); s2 += __shfl_xor(s2, 4); s2 += __shfl_xor(s2, 8);
                rs[i] = __builtin_amdgcn_rsqf(s2 * (1.0f / 2048.0f) + EPS); }
            const int r0 = 16 * it;
            int c0;
            if (r0 >= NINP) c0 = r0; else { const int pn = r0 >> 8, rem = r0 & 255, bj = rem >> 7, wc = (rem & 127) >> 5, j = rem & 31; c0 = 256 * pn + 64 * wc + 32 * bj + j; }
            f32x4 a = (f32x4){0.f, 0.f, 0.f, 0.f};
            a = skinny16(WSP(bf16, WS_META + MO_XN1), DM, WSP(bf16, WS_WIN) + (size_t)r0 * DM, DM, 0, DM, F.lane, a);
#pragma unroll
            for (int i = 0; i < 4; ++i) um[(size_t)(4 * (F.lane >> 4) + i) * NIN + c0 + (F.lane & 15)] = a[i] * rs[i];
        } else {
            const int m0 = 16 * (it - nmeta);
            f32x4 a = (f32x4){0.f, 0.f, 0.f, 0.f};
            a = skinny16(WSP(bf16, WS_XN) + (size_t)m0 * DM, DM, WSP(bf16, WS_WIN) + (size_t)NINP * DM, DM, 0, DM, F.lane, a);
#pragma unroll
            for (int i = 0; i < 4; ++i) { const int row = m0 + 4 * (F.lane >> 4) + i; WSP(float, WS_DTR)[(size_t)row * 16 + (F.lane & 15)] = a[i] * pg8::row_rs(WSP(float, WS_SSQ1), 32, row); }
        }
    }
}


namespace att {
typedef float f32x16 __attribute__((ext_vector_type(16)));
typedef short s16x4 __attribute__((ext_vector_type(4)));
typedef short v4i16_t __attribute__((ext_vector_type(4)));
typedef float f32x2_t __attribute__((ext_vector_type(2))); typedef __bf16 bf16x2_t __attribute__((ext_vector_type(2)));
constexpr int STAGE = 32768, VOFF = 16384;
__device__ __forceinline__ int crow(int r, int hi) { return (r & 3) + 8 * (r >> 2) + 4 * hi; }
__device__ __forceinline__ unsigned cvtpk(float lo, float hi) { f32x2_t v = {lo, hi}; bf16x2_t b = __builtin_convertvector(v, bf16x2_t); return __builtin_bit_cast(unsigned, b); }
#define ATT_WAITBAR() asm volatile("s_waitcnt vmcnt(0) lgkmcnt(0)\n\ts_barrier" ::: "memory")
__device__ __forceinline__ void glds16(const void* gsrc, unsigned lds_dst) { unsigned keep;
    asm volatile("s_mov_b32 %0, m0\n\ts_mov_b32 m0, %2\n\ts_nop 0\n\tglobal_load_lds_dwordx4 %1, off\n\ts_mov_b32 m0, %0" : "=&s"(keep) : "v"(gsrc), "s"(lds_dst) : "memory"); }
#define ATT_DMA(src, dstoff) glds16((const void*)(src), (unsigned)__builtin_amdgcn_readfirstlane((int)(dstoff)))
#define ATT_MFMA(a, b, c) __builtin_amdgcn_mfma_f32_32x32x16_bf16((a), (b), (c), 0, 0, 0)
__device__ __forceinline__ float fadd_s(float a, float b) { float r; asm("v_add_f32 %0, %1, %2" : "=v"(r) : "v"(a), "v"(b)); return r; }

constexpr int KST = 16384, VST0 = 4 * KST, VSTB = 16384, WSF_OFF = VST0 + 3 * VSTB, STG_OFF = VST0, DUMMY_OFF = WSF_OFF + 1024;
constexpr int META_K_OFF = 126976, META_V_OFF = 135168;
__device__ __forceinline__ void attn_meta_tile(Frame& F, int bh) {
    LAS unsigned char* lds = F.lds; const int wave = F.wave, lane = F.lane, h = bh & 7;
    { const float* um = WSP(float, WS_META + MO_U);
      float mv[4];
#pragma unroll
      for (int i4 = 0; i4 < 4; ++i4) { const int itm = 4 * wave + i4; mv[i4] = um[(size_t)(itm >> 1) * NIN + 1024 + h * 128 + (itm & 1) * 64 + lane]; }
#pragma unroll
      for (int i4 = 0; i4 < 4; ++i4) { const int itm = 4 * wave + i4, p = itm >> 1, sh = itm & 1, d = lane;
          float v = mv[i4];
          const float r = __builtin_amdgcn_rsqf(wave_sum(v * v) * (1.0f / 64.0f) + EPS);
          v = v * r * F.in[9][d];
          const float pr = __shfl_xor(v, 8); const float* rp = WSP(float, WS_ROPE) + p * 16;
          if (d < 8) v = v * rp[d] - pr * rp[8 + d]; else if (d < 16) v = v * rp[d - 8] + pr * rp[d];
          const int dd = sh * 64 + d;
          *(LAS bf16*)(lds + META_K_OFF + p * 256 + (((dd >> 3) ^ p) << 4) + (dd & 7) * 2) = (bf16)f2bf(v); }
      { const int e = 4 * (wave * 64 + lane), key = e >> 7, d = e & 127; const f32x4 vv = *(const f32x4*)(um + (size_t)key * NIN + 2048 + h * 128 + d);
        u32x2v w2; w2.x = pk2(vv[0], vv[1]); w2.y = pk2(vv[2], vv[3]); *(LAS u32x2v*)(lds + META_V_OFF + (d >> 5) * 1024 + key * 64 + (d & 31) * 2) = w2; } }
}
__device__ __forceinline__ void attn_unit(Frame& F, int bh, int jq, float lam) {
    LAS unsigned char* lds = F.lds;
    const bf16* U = WSP(bf16, WS_ACT);
    int lane = F.lane; asm volatile("" : "+v"(lane));
    const int wave = F.wave, r32 = lane & 31, hi = lane >> 5;
    const int b = bh >> 3, h = bh & 7, rb = wave & 3, sub = wave >> 2;
    const int cw = 2 * jq + (rb >> 1);
    const int row0 = b * SEQ + 128 * jq + 32 * rb;
    const int T = 2 * jq + 2;
    const int kk0 = 8 * wave + (lane >> 4), kk1 = kk0 + 4;
    const bf16* kbase0 = U + (size_t)(b * SEQ + kk0) * NINP + 1024 + h * 128 + 8 * ((lane & 15) ^ (kk0 & 15));
    const bf16* kbase1 = U + (size_t)(b * SEQ + kk1) * NINP + 1024 + h * 128 + 8 * ((lane & 15) ^ (kk1 & 15));
    const int v0 = 2 * wave, v1 = 2 * wave + 1;
    const bf16* vbase0 = U + (size_t)(b * SEQ + 16 * (v0 & 3) + (lane >> 2)) * NINP + 2048 + h * 128 + 32 * (v0 >> 2) + 8 * (lane & 3);
    const bf16* vbase1 = U + (size_t)(b * SEQ + 16 * (v1 & 3) + (lane >> 2)) * NINP + 2048 + h * 128 + 32 * (v1 >> 2) + 8 * (lane & 3);
    const int kd0 = 2 * wave * 1024, kd1 = kd0 + 1024, vd0 = v0 * 1024, vd1 = v1 * 1024;
#define ATT_DMA_K(t, ks_) do { const size_t to_ = (size_t)(t) * 64 * NINP; ATT_DMA(kbase0 + to_, (ks_) + kd0); ATT_DMA(kbase1 + to_, (ks_) + kd1); } while (0)
#define ATT_DMA_V(t, vs_) do { const size_t to_ = (size_t)(t) * 64 * NINP; ATT_DMA(vbase0 + to_, (vs_) + vd0); ATT_DMA(vbase1 + to_, (vs_) + vd1); } while (0)
    ATT_DMA_K(0, 0); ATT_DMA_V(0, VST0); ATT_DMA_K(1, KST); ATT_DMA_V(1, VST0 + VSTB); if (T > 2) ATT_DMA_K(2, 2 * KST);
    bf16x8 qf[4];
#pragma unroll
    for (int ks = 0; ks < 4; ++ks) qf[ks] = *(const bf16x8*)(U + (size_t)(row0 + r32) * NINP + h * 128 + sub * 64 + 16 * ks + 8 * hi);
    f32x16 o[4];
#pragma unroll
    for (int d = 0; d < 4; ++d)
#pragma unroll
        for (int i = 0; i < 16; ++i) o[d][i] = 0.f;
    float lsum = 0.f;
    const f32x16 zero16 = {0.f, 0.f, 0.f, 0.f, 0.f, 0.f, 0.f, 0.f, 0.f, 0.f, 0.f, 0.f, 0.f, 0.f, 0.f, 0.f};
    const int koff = r32 * 256 + (((8 * sub + hi) ^ (r32 & 15)) << 4);
    const int voff = ((lane >> 4) & 1) * 32 + (lane & 3) * 8 + (4 * hi + ((lane & 15) >> 2)) * 64;
#define ATT_KF(kst_, half, ks) (*(const LAS bf16x8*)(lds + (kst_) + (half) * 8192 + (koff ^ ((ks) << 5))))
#define ATT_VTR(vst_, off) __builtin_bit_cast(s16x4, __builtin_amdgcn_ds_read_tr16_b64_v4i16((LAS v4i16_t*)(lds + (vst_) + voff + (off))))
    ATT_WAITBAR();
    f32x16 s0 = zero16, s1 = zero16;
    {
        f32x16 sc = zero16;
#pragma unroll
        for (int ks = 0; ks < 4; ++ks) sc = ATT_MFMA(ATT_KF(META_K_OFF, 0, ks), qf[ks], sc);
#pragma unroll
        for (int ks = 0; ks < 4; ++ks) { s0 = ATT_MFMA(ATT_KF(0, 0, ks), qf[ks], s0); s1 = ATT_MFMA(ATT_KF(0, 1, ks), qf[ks], s1); }
#pragma unroll
        for (int i = 0; i < 8; ++i) { sc[i] = __builtin_amdgcn_exp2f(sc[i]); lsum += sc[i]; }
        v4u pw; pw.x = cvtpk(sc[0], sc[1]); pw.y = cvtpk(sc[2], sc[3]); pw.z = cvtpk(sc[4], sc[5]); pw.w = cvtpk(sc[6], sc[7]);
        const bf16x8 pm = __builtin_bit_cast(bf16x8, pw);
#pragma unroll
        for (int d = 0; d < 4; ++d) { const s16x4 lo = ATT_VTR(META_V_OFF, d * 1024), hh = ATT_VTR(META_V_OFF, d * 1024 + 512);
            const bf16x8 vf = {lo[0], lo[1], lo[2], lo[3], hh[0], hh[1], hh[2], hh[3]};
            o[d] = ATT_MFMA(pm, vf, o[d]); }
    }
    ATT_WAITBAR();
    int vm0 = 0, vm2 = 2;
#define SBAR() __builtin_amdgcn_sched_barrier(0)
#define ATT_VTRP(vp_, off) __builtin_bit_cast(s16x4, __builtin_amdgcn_ds_read_tr16_b64_v4i16((LAS v4i16_t*)((vp_) + (off))))
#define ATT_VLOAD(buf, vst_, d, kp) do { _Pragma("unroll") for (int ks_ = 0; ks_ < 2; ++ks_) { vlo[buf][ks_] = ATT_VTRP(vst_, (d) * 4096 + (2 * (kp) + ks_) * 1024); vhi[buf][ks_] = ATT_VTRP(vst_, (d) * 4096 + (2 * (kp) + ks_) * 1024 + 512); } } while (0)
#define ATT_GQ(MF) do { MF; SBAR(); } while (0)
#define ATT_GS(NV, b4, PW, w0, w1) do { ls = (((ls + NV[b4]) + NV[b4 + 1]) + NV[b4 + 2]) + NV[b4 + 3];     PW[w0] = cvtpk(NV[b4], NV[b4 + 1]); PW[w1] = cvtpk(NV[b4 + 2], NV[b4 + 3]); } while (0)
#define ATT_GB(MF, NV, i0, GS) do { MF; NV[i0] = __builtin_amdgcn_exp2f(NV[i0]); NV[i0 + 1] = __builtin_amdgcn_exp2f(NV[i0 + 1]); GS; SBAR(); } while (0)
#define ATT_VF(buf, ks_) (bf16x8){vlo[buf][ks_][0], vlo[buf][ks_][1], vlo[buf][ks_][2], vlo[buf][ks_][3], vhi[buf][ks_][0], vhi[buf][ks_][1], vhi[buf][ks_][2], vhi[buf][ks_][3]}
#define ATT_STEP(C0, C1, C2, C3, D0, D1, D2, D3, tt) do { \
        const int t_ = (tt); const int knext = ((t_ + 1) & 3) * KST, kdst = ((t_ + 3) & 3) * KST, vdst = VST0 + vm2 * VSTB; \
        LAS unsigned char* vcur = lds + VST0 + vm0 * VSTB + voff; asm volatile("" : "+v"(vcur));     \
        const bool dk = t_ + 3 < T, dv = t_ + 2 < T; const size_t tok_ = dk ? (size_t)(t_ + 3) * 64 * NINP : 0, tov_ = dv ? (size_t)(t_ + 2) * 64 * NINP : 0; \
        const int dK0 = dk ? kdst + kd0 : DUMMY_OFF + wave * 1024, dK1 = dk ? kdst + kd1 : DUMMY_OFF + wave * 1024, dV0 = dv ? vdst + vd0 : DUMMY_OFF + wave * 1024, dV1 = dv ? vdst + vd1 : DUMMY_OFF + wave * 1024; \
        ATT_DMA(kbase0 + tok_, dK0); ATT_DMA(kbase1 + tok_, dK1); ATT_DMA(vbase0 + tov_, dV0); ATT_DMA(vbase1 + tov_, dV1); \
        if (t_ <= cw) { \
            bf16x8 kf[4]; s16x4 vlo[2][2], vhi[2][2]; f32x16 N0, N1; float ls = 0.f; \
            SBAR(); \
            kf[0] = ATT_KF(knext, 0, 0); kf[1] = ATT_KF(knext, 1, 0); kf[2] = ATT_KF(knext, 0, 1); kf[3] = ATT_KF(knext, 1, 1); SBAR(); \
            ATT_GQ(N0 = ATT_MFMA(kf[0], qf[0], zero16)); \
            ATT_GQ(N1 = ATT_MFMA(kf[1], qf[0], zero16)); \
            kf[0] = ATT_KF(knext, 0, 2); kf[1] = ATT_KF(knext, 1, 2); SBAR(); \
            ATT_GQ(N0 = ATT_MFMA(kf[2], qf[1], N0)); \
            ATT_GQ(N1 = ATT_MFMA(kf[3], qf[1], N1)); \
            kf[2] = ATT_KF(knext, 0, 3); kf[3] = ATT_KF(knext, 1, 3); SBAR(); \
            ATT_GQ(N0 = ATT_MFMA(kf[0], qf[2], N0)); \
            ATT_GQ(N1 = ATT_MFMA(kf[1], qf[2], N1)); \
            ATT_VLOAD(0, vcur, 0, 0); SBAR(); \
            ATT_GQ(N0 = ATT_MFMA(kf[2], qf[3], N0)); \
            ATT_GQ(N1 = ATT_MFMA(kf[3], qf[3], N1)); \
            const bf16x8 pf0 = __builtin_bit_cast(bf16x8, C0), pf1 = __builtin_bit_cast(bf16x8, C1), pf2 = __builtin_bit_cast(bf16x8, C2), pf3 = __builtin_bit_cast(bf16x8, C3); \
            ATT_VLOAD(1, vcur, 0, 1); SBAR(); \
            ATT_GB(o[0] = ATT_MFMA(pf0, ATT_VF(0, 0), o[0]), N0, 0, (void)0); ATT_GB(o[0] = ATT_MFMA(pf1, ATT_VF(0, 1), o[0]), N0, 2, (void)0); \
            ATT_VLOAD(0, vcur, 1, 0); SBAR(); \
            ATT_GB(o[0] = ATT_MFMA(pf2, ATT_VF(1, 0), o[0]), N0, 4, ATT_GS(N0, 0, D0, 0, 1)); ATT_GB(o[0] = ATT_MFMA(pf3, ATT_VF(1, 1), o[0]), N0, 6, (void)0); \
            ATT_VLOAD(1, vcur, 1, 1); SBAR(); \
            ATT_GB(o[1] = ATT_MFMA(pf0, ATT_VF(0, 0), o[1]), N0, 8, ATT_GS(N0, 4, D0, 2, 3)); ATT_GB(o[1] = ATT_MFMA(pf1, ATT_VF(0, 1), o[1]), N0, 10, (void)0); \
            ATT_VLOAD(0, vcur, 2, 0); SBAR(); \
            ATT_GB(o[1] = ATT_MFMA(pf2, ATT_VF(1, 0), o[1]), N0, 12, ATT_GS(N0, 8, D1, 0, 1)); ATT_GB(o[1] = ATT_MFMA(pf3, ATT_VF(1, 1), o[1]), N0, 14, (void)0); \
            ATT_VLOAD(1, vcur, 2, 1); SBAR(); \
            ATT_GB(o[2] = ATT_MFMA(pf0, ATT_VF(0, 0), o[2]), N1, 0, ATT_GS(N0, 12, D1, 2, 3)); ATT_GB(o[2] = ATT_MFMA(pf1, ATT_VF(0, 1), o[2]), N1, 2, (void)0); \
            ATT_VLOAD(0, vcur, 3, 0); SBAR(); \
            ATT_GB(o[2] = ATT_MFMA(pf2, ATT_VF(1, 0), o[2]), N1, 4, ATT_GS(N1, 0, D2, 0, 1)); ATT_GB(o[2] = ATT_MFMA(pf3, ATT_VF(1, 1), o[2]), N1, 6, (void)0); \
            ATT_VLOAD(1, vcur, 3, 1); SBAR(); \
            ATT_GB(o[3] = ATT_MFMA(pf0, ATT_VF(0, 0), o[3]), N1, 8, ATT_GS(N1, 4, D2, 2, 3)); ATT_GB(o[3] = ATT_MFMA(pf1, ATT_VF(0, 1), o[3]), N1, 10, (void)0); \
            ATT_GB(o[3] = ATT_MFMA(pf2, ATT_VF(1, 0), o[3]), N1, 12, ATT_GS(N1, 8, D3, 0, 1)); ATT_GB(o[3] = ATT_MFMA(pf3, ATT_VF(1, 1), o[3]), N1, 14, (void)0); \
            ATT_GS(N1, 12, D3, 2, 3); \
            lsum += (t_ < cw) ? ls : 0.f;     \
        } \
          \
        asm volatile("s_waitcnt vmcnt(4) lgkmcnt(0)\n\ts_barrier" ::: "memory"); \
        vm0 = (vm0 == 2) ? 0 : vm0 + 1; vm2 = (vm2 == 2) ? 0 : vm2 + 1; \
    } while (0)
    v4u pa0, pa1, pa2, pa3, pb0, pb1, pb2, pb3;
    pb0 = pb1 = pb2 = pb3 = (v4u){0u, 0u, 0u, 0u};
    {
#pragma unroll
        for (int i = 0; i < 16; ++i) { s0[i] = __builtin_amdgcn_exp2f(s0[i]); s1[i] = __builtin_amdgcn_exp2f(s1[i]); }
        float ls = 0.f;
        ATT_GS(s0, 0, pa0, 0, 1); ATT_GS(s0, 4, pa0, 2, 3); ATT_GS(s0, 8, pa1, 0, 1); ATT_GS(s0, 12, pa1, 2, 3);
        ATT_GS(s1, 0, pa2, 0, 1); ATT_GS(s1, 4, pa2, 2, 3); ATT_GS(s1, 8, pa3, 0, 1); ATT_GS(s1, 12, pa3, 2, 3);
        lsum += ls;
    }
    for (int t = 0; t < T; t += 2) { ATT_STEP(pa0, pa1, pa2, pa3, pb0, pb1, pb2, pb3, t); ATT_STEP(pb0, pb1, pb2, pb3, pa0, pa1, pa2, pa3, t + 1); }
    ATT_WAITBAR();
#undef ATT_STEP
#undef ATT_VLOAD
#undef ATT_GQ
#undef ATT_GS
#undef ATT_GB
#undef ATT_VF
#undef SBAR
    int le = lane; asm volatile("" : "+v"(le));
    const int r32e = le & 31, hie = le >> 5;
    lsum += __shfl_xor(lsum, 32);
    LAS float* wsf = (LAS float*)(lds + WSF_OFF + wave * 128);
    float wn[4];
#pragma unroll
    for (int d = 0; d < 4; ++d) wn[d] = F.in[14][32 * d + r32e];
    const float fac = (sub == 0 ? 1.0f : lam) / lsum;
    if (hie == 0) wsf[r32e] = fac;
    LDS_WAIT(); asm volatile("" ::: "memory");
    LAS float* xo = (LAS float*)(lds + (wave & 3) * 16384) + le;
    if (sub == 1) {
#pragma unroll
        for (int i = 0; i < 16; ++i) { const float f = wsf[crow(i, hie)];
#pragma unroll
            for (int d = 0; d < 4; ++d) xo[(d * 16 + i) * 64] = o[d][i] * f; }
    }
    ATT_WAITBAR();
    if (sub == 0) {
        LAS bf16* stg = (LAS bf16*)(lds + STG_OFF + wave * 8192);
#pragma unroll
        for (int d = 0; d < 4; ++d) wn[d] *= 0.8f;
#pragma unroll
        for (int i = 0; i < 16; ++i) { const int q = crow(i, hie); const float f1 = wsf[q];
            float v[4], ss = 0.f;
#pragma unroll
            for (int d = 0; d < 4; ++d) { v[d] = o[d][i] * f1 - xo[(d * 16 + i) * 64]; ss += v[d] * v[d]; }
            ss += __shfl_xor(ss, 1); ss += __shfl_xor(ss, 2); ss += __shfl_xor(ss, 4); ss += __shfl_xor(ss, 8); ss += __shfl_xor(ss, 16);
            const float r = __builtin_amdgcn_rsqf(ss * (1.0f / 128.0f) + EPS);
#pragma unroll
            for (int d = 0; d < 4; ++d) stg[q * 128 + 32 * d + r32e] = (bf16)(cvtpk(v[d] * r * wn[d], 0.f) & 0xffffu); }
        LDS_WAIT(); asm volatile("" ::: "memory");
#pragma unroll
        for (int it = 0; it < 8; ++it) { const int q = 4 * it + (le >> 4), ch = le & 15;
            const v4u val = *(const LAS v4u*)(stg + q * 128 + 8 * ch);
            *(v4u*)(WSP(bf16, WS_MIX) + (size_t)(row0 + q) * DM + 1024 + h * 128 + 8 * ch) = val; }
    }
    ATT_WAITBAR();
#undef ATT_DMA_K
#undef ATT_DMA_V
#undef ATT_KF
#undef ATT_VTR
}
}


namespace ssd {
constexpr int S64 = 144, S128 = 272;
constexpr int O_CC = 0, O_BC = 17408, O_BT = 34816, O_XT = 53248, O_XS = 62464, O_XC = 71680, O_M = 80896, O_SI = 90112, O_SC = 107520;
#define SSD_MF(a, b, c) __builtin_amdgcn_mfma_f32_16x16x32_bf16((a), (b), (c), 0, 0, 0)
#define SSD_FRAG(img, stride, row, k) (*(const LAS bf16x8*)(lds + (img) + (row) * (stride) + 2 * (k)))
#define SSD_BAR() do { asm volatile("s_waitcnt vmcnt(0) lgkmcnt(0)" ::: "memory"); __builtin_amdgcn_s_barrier(); asm volatile("" ::: "memory"); } while (0)

__device__ __forceinline__ v4u pack8(const float (&v)[8]) { v4u o; o.x = pk2(v[0], v[1]); o.y = pk2(v[2], v[3]); o.z = pk2(v[4], v[5]); o.w = pk2(v[6], v[7]); return o; }
__device__ __forceinline__ unsigned bfe16(const v4u& r, int e) { const unsigned w = (e < 2) ? r.x : (e < 4) ? r.y : (e < 6) ? r.z : r.w; return (e & 1) ? (w >> 16) : (w & 0xffffu); }

template <bool PASSB>
__device__ __forceinline__ void ssd_item(Frame& F, int item, int& bgj) {
    LAS unsigned char* lds = F.lds;
    int lane0 = F.lane; asm volatile("" : "+v"(lane0));
    const int wave = F.wave;
    const int k = item & 7, hd = (item >> 3) & 15, b = item >> 7, g = hd >> 3;
    const float Ah = -__expf(F.in[18][hd]), Dk = F.in[19][hd];
    LAS float* sc = (LAS float*)(lds + O_SC);
    const int pt = wave >> 1, nb = 4 * (wave & 1);
    f32x4 stt[4];
#pragma unroll
    for (int j = 0; j < 4; ++j) stt[j] = (f32x4){0.f, 0.f, 0.f, 0.f};
    float* sst = WSP(float, WS_SST) + (size_t)((b * SH + hd) * 8) * 8192;
    float* atot = WSP(float, WS_ATOT) + (b * SH + hd) * 8;
    if (PASSB) {
        const int fr = lane0 & 15, fq = lane0 >> 4;
        for (int kk = 0; kk < k; ++kk) { const float dec = __expf(atot[kk]);
#pragma unroll
            for (int j = 0; j < 4; ++j) { const f32x4 s = *(const f32x4*)(sst + (size_t)kk * 8192 + (16 * pt + fr) * 128 + 16 * (nb + j) + 4 * fq); stt[j] = stt[j] * dec + s; } }
    }
    float asum = 0.f;
    const int c_lo = (k == 0) ? 0 : 8 * k + 1, c_hi = 8 * k + 8;
    const int role = (wave < 2) ? 0 : (wave < 4) ? 1 : (wave < 6 && PASSB) ? 2 : 3;
    v4u raw[8]; float dtv = 0.f;
    { const int li = (wave * 64 + lane0) & 127, cg = (role == 0) ? (li & 7) : (li & 15), l0 = (role == 0) ? 4 * (li >> 3) : 8 * (li >> 4);
      if (role == 0) { const bf16* src = WSP(bf16, WS_XS) + (size_t)(b * LPAD + 64 * c_lo + l0) * 1024 + hd * 64 + 8 * cg;
#pragma unroll
          for (int i = 0; i < 4; ++i) raw[i] = *(const v4u*)(src + (size_t)i * 1024); }
      else if (role < 3) { const bf16* src = WSP(bf16, WS_BC) + (size_t)(b * LPAD + 64 * c_lo + l0) * 512 + (role == 2 ? 256 : 0) + g * 128 + 8 * cg;
#pragma unroll
          for (int i = 0; i < 8; ++i) raw[i] = *(const v4u*)(src + (size_t)i * 512); }
      if (wave == 7) dtv = WSP(float, WS_DT)[(size_t)(b * LPAD + 64 * c_lo + lane0) * 16 + hd]; }
    for (int c = c_lo; c <= c_hi; ++c) {
        int lane = lane0; asm volatile("" : "+v"(lane));
        const int tid = wave * 64 + lane, fr = lane & 15, fq = lane >> 4, li = tid & 127;
        const int cg = (role == 0) ? (li & 7) : (li & 15), l0 = (role == 0) ? 4 * (li >> 3) : 8 * (li >> 4);
        u32x2v zv[2];
        if (PASSB && c >= 1) {
#pragma unroll
            for (int j = 0; j < 2; ++j) zv[j] = *(const u32x2v*)(WSP(bf16, WS_ACT) + (size_t)(b * SEQ + 64 * (c - 1) + 16 * pt + fr) * NINP + 3072 + hd * 64 + 16 * (2 * (wave & 1) + j) + 4 * fq);
        }
        const int cn = (c < c_hi) ? c + 1 : c;
        f32x4 cv[8]; TItem ct; bool chave = false; int chh = 0;
        if (role == 0) {
            if (PASSB) {
#pragma unroll
                for (int i = 0; i < 4; ++i) *(LAS v4u*)(lds + O_XC + (l0 + i) * S64 + 16 * cg) = raw[i]; }
#pragma unroll
            for (int e = 0; e < 8; ++e) { u32x2v w2; w2.x = bfe16(raw[0], e) | (bfe16(raw[1], e) << 16); w2.y = bfe16(raw[2], e) | (bfe16(raw[3], e) << 16); *(LAS u32x2v*)(lds + O_XT + (8 * cg + e) * S64 + 2 * l0) = w2; }
            const bf16* src = WSP(bf16, WS_XS) + (size_t)(b * LPAD + 64 * cn + l0) * 1024 + hd * 64 + 8 * cg;
#pragma unroll
            for (int i = 0; i < 4; ++i) raw[i] = *(const v4u*)(src + (size_t)i * 1024);
        } else if (role == 1) {
            if (PASSB) {
#pragma unroll
                for (int i = 0; i < 8; ++i) *(LAS v4u*)(lds + O_BC + (l0 + i) * S128 + 16 * cg) = raw[i]; }
#pragma unroll
            for (int e = 0; e < 8; ++e) { v4u w4; w4.x = bfe16(raw[0], e) | (bfe16(raw[1], e) << 16); w4.y = bfe16(raw[2], e) | (bfe16(raw[3], e) << 16); w4.z = bfe16(raw[4], e) | (bfe16(raw[5], e) << 16); w4.w = bfe16(raw[6], e) | (bfe16(raw[7], e) << 16);
                *(LAS v4u*)(lds + O_BT + (8 * cg + e) * S64 + 2 * l0) = w4; }
            const bf16* src = WSP(bf16, WS_BC) + (size_t)(b * LPAD + 64 * cn + l0) * 512 + g * 128 + 8 * cg;
#pragma unroll
            for (int i = 0; i < 8; ++i) raw[i] = *(const v4u*)(src + (size_t)i * 512);
        } else if (role == 2) {
#pragma unroll
            for (int i = 0; i < 8; ++i) *(LAS v4u*)(lds + O_CC + (l0 + i) * S128 + 16 * cg) = raw[i];
            const bf16* src = WSP(bf16, WS_BC) + (size_t)(b * LPAD + 64 * cn + l0) * 512 + 256 + g * 128 + 8 * cg;
#pragma unroll
            for (int i = 0; i < 8; ++i) raw[i] = *(const v4u*)(src + (size_t)i * 512);
        }
        if (wave == 7) {
            const float dt = dtv;
            dtv = WSP(float, WS_DT)[(size_t)(b * LPAD + 64 * cn + lane) * 16 + hd];
            float a = dt * Ah;
#pragma unroll
            for (int o2 = 1; o2 < 64; o2 <<= 1) { const float t = __shfl_up(a, o2); if (lane >= o2) a += t; }
            const float aend = __shfl(a, 63);
            sc[lane] = dt; sc[64 + lane] = a; sc[128 + lane] = dt * __expf(aend - a);
            if (lane == 0) sc[192] = aend;
        }
        if (PASSB && F.NGW == 2048) { const int hix = bgj * 2048 + F.gw, cit = IT_BG + (hix >> 1); chh = hix & 1; chave = bgj < 8 && cit < IT_END; ++bgj;
            if (chave) { ct = mk_item(F, cit); transpose_load_h(ct, lane, chh, cv); } }
        asm volatile("s_waitcnt lgkmcnt(0)" ::: "memory"); __builtin_amdgcn_s_barrier(); asm volatile("" ::: "memory");
        const float aend = sc[192];
        for (int amp2_ = 0; amp2_ < (MK_AMP == 2 ? 3 : 1); ++amp2_) {
        { const int p = tid >> 3, lg = (tid & 7) * 8;
          const v4u xv = *(const LAS v4u*)(lds + O_XT + p * S64 + 2 * lg); const unsigned xw[4] = {xv.x, xv.y, xv.z, xv.w}; float v[8];
#pragma unroll
          for (int e = 0; e < 4; ++e) { v[2 * e] = bf2f(xw[e] & 0xffffu) * sc[128 + lg + 2 * e]; v[2 * e + 1] = bf2f(xw[e] >> 16) * sc[128 + lg + 2 * e + 1]; }
          *(LAS v4u*)(lds + O_XS + p * S64 + 2 * lg) = pack8(v); }
        if (PASSB) {
#pragma unroll
            for (int j = 0; j < 4; ++j) { u32x2v w2; w2.x = pk2(stt[j][0], stt[j][1]); w2.y = pk2(stt[j][2], stt[j][3]); *(LAS u32x2v*)(lds + O_SI + (16 * pt + fr) * S128 + 2 * (16 * (nb + j) + 4 * fq)) = w2; }
            const int l = 16 * pt + fr; const float al = sc[64 + l];
#pragma unroll
            for (int j = 0; j < 2; ++j) { const int st = 2 * (wave & 1) + j; f32x4 acc = (f32x4){0.f, 0.f, 0.f, 0.f};
                if (st <= pt) {
#pragma unroll
                    for (int ks = 0; ks < 4; ++ks) acc = SSD_MF(SSD_FRAG(O_BC, S128, 16 * st + fr, 32 * ks + 8 * fq), SSD_FRAG(O_CC, S128, l, 32 * ks + 8 * fq), acc);
                    asm volatile("s_nop 15\n\ts_nop 3" : "+v"(acc)); }
                float m[4];
#pragma unroll
                for (int i = 0; i < 4; ++i) { const int s = 16 * st + 4 * fq + i; m[i] = (s <= l) ? acc[i] * __expf(al - sc[64 + s]) * sc[s] : 0.f; }
                u32x2v w2; w2.x = pk2(m[0], m[1]); w2.y = pk2(m[2], m[3]); *(LAS u32x2v*)(lds + O_M + l * S64 + 2 * (16 * st + 4 * fq)) = w2; }
        }
        }
        asm volatile("s_waitcnt lgkmcnt(0)" ::: "memory"); __builtin_amdgcn_s_barrier(); asm volatile("" ::: "memory");
        for (int amp3_ = 0; amp3_ < (MK_AMP == 3 ? 3 : 1); ++amp3_) {
        if (PASSB && c >= 1) {
            const int l = 16 * pt + fr, row = b * SEQ + 64 * (c - 1) + l; const float el = __expf(sc[64 + l]);
            float sq = 0.f;
#pragma unroll
            for (int j = 0; j < 2; ++j) { const int ptile = 2 * (wave & 1) + j; f32x4 acc = (f32x4){0.f, 0.f, 0.f, 0.f};
#pragma unroll
                for (int ks = 0; ks < 4; ++ks) acc = SSD_MF(SSD_FRAG(O_SI, S128, 16 * ptile + fr, 32 * ks + 8 * fq), SSD_FRAG(O_CC, S128, l, 32 * ks + 8 * fq), acc);
                acc = acc * el;
#pragma unroll
                for (int ks = 0; ks < 2; ++ks) acc = SSD_MF(SSD_FRAG(O_XT, S64, 16 * ptile + fr, 32 * ks + 8 * fq), SSD_FRAG(O_M, S64, l, 32 * ks + 8 * fq), acc);
                const int pc = 16 * ptile + 4 * fq;
                const u32x2v xv = *(const LAS u32x2v*)(lds + O_XC + l * S64 + 2 * pc);
                float y[4];
                y[0] = (acc[0] + Dk * bf2f(xv.x & 0xffffu)) * silu1(bf2f(zv[j].x & 0xffffu)); y[1] = (acc[1] + Dk * bf2f(xv.x >> 16)) * silu1(bf2f(zv[j].x >> 16));
                y[2] = (acc[2] + Dk * bf2f(xv.y & 0xffffu)) * silu1(bf2f(zv[j].y & 0xffffu)); y[3] = (acc[3] + Dk * bf2f(xv.y >> 16)) * silu1(bf2f(zv[j].y >> 16));
                sq += (y[0] * y[0] + y[1] * y[1]) + (y[2] * y[2] + y[3] * y[3]);
                u32x2v w2; w2.x = pk2(y[0], y[1]); w2.y = pk2(y[2], y[3]);
                *(u32x2v*)(WSP(bf16, WS_MIX) + (size_t)row * DM + hd * 64 + pc) = w2; }
            sq += __shfl_xor(sq, 16); sq += __shfl_xor(sq, 32);
            if (fq == 0) WSP(float, WS_SSQS)[(size_t)row * 32 + 2 * hd + (wave & 1)] = sq;
        }
        }
        { const float dec = __expf(aend);
#pragma unroll
          for (int j = 0; j < 4; ++j) { f32x4 acc = stt[j] * dec;
#pragma unroll
              for (int ks = 0; ks < 2; ++ks) acc = SSD_MF(SSD_FRAG(O_BT, S64, 16 * (nb + j) + fr, 32 * ks + 8 * fq), SSD_FRAG(O_XS, S64, 16 * pt + fr, 32 * ks + 8 * fq), acc);
              stt[j] = acc; } }
        asum += aend;
        if (PASSB) { if (chave) transpose_finish_h(ct, lane, chh, cv); }
        asm volatile("s_waitcnt lgkmcnt(0)" ::: "memory"); __builtin_amdgcn_s_barrier(); asm volatile("" ::: "memory");
    }
    if (!PASSB) { const int fr = lane0 & 15, fq = lane0 >> 4;
#pragma unroll
        for (int j = 0; j < 4; ++j) *(f32x4*)(sst + (size_t)k * 8192 + (16 * pt + fr) * 128 + 16 * (nb + j) + 4 * fq) = stt[j];
        if (wave == 0 && lane0 == 0) atot[k] = asum;
    }
}
}

struct ConvItem { int c, pp, b, p; v4u rv[4]; bool fast; };
__device__ __forceinline__ void conv_issue(Frame& F, int it, ConvItem& q) {
    const bf16* U = WSP(bf16, WS_ACT); const float* um = WSP(float, WS_META + MO_U);
    const int cg = it % (CONVD / 8); q.pp = (it / (CONVD / 8)) % LPAD; q.b = it / ((CONVD / 8) * LPAD); q.c = 8 * cg; q.p = q.pp - PPAD;
#pragma unroll
    for (int w = 0; w < 4; ++w) q.rv[w] = (v4u){0u, 0u, 0u, 0u};
    if (q.p >= 0) {
        if (q.p - 3 >= NMETA) { const bf16* src = U + (size_t)(q.b * SEQ + q.p - 3 - NMETA) * NINP + 4096 + q.c;
#pragma unroll
            for (int w = 0; w < 4; ++w) q.rv[w] = *(const v4u*)(src + (size_t)w * NINP); }
        else {
#pragma unroll
            for (int w = 0; w < 4; ++w) { const int ps = q.p - 3 + w; v4u v = (v4u){0u, 0u, 0u, 0u};
                if (ps >= NMETA) v = *(const v4u*)(U + (size_t)(q.b * SEQ + ps - NMETA) * NINP + 4096 + q.c);
                else if (ps >= 0) { const f32x4 r0 = *(const f32x4*)(um + (size_t)ps * NIN + 4096 + q.c), r1 = *(const f32x4*)(um + (size_t)ps * NIN + 4096 + q.c + 4);
                    v.x = pk2(r0[0], r0[1]); v.y = pk2(r0[2], r0[3]); v.z = pk2(r1[0], r1[1]); v.w = pk2(r1[2], r1[3]); }
                q.rv[w] = v; } }
    }
}
__device__ __forceinline__ void conv_finish(Frame& F, const ConvItem& q) {
    const float* cw = F.in[15]; const float* cb = F.in[16]; const int c = q.c;
    float a[8];
#pragma unroll
    for (int e = 0; e < 8; ++e) a[e] = 0.f;
    if (q.p >= 0) {
        const f32x4 b0 = *(const f32x4*)(cb + c), b1 = *(const f32x4*)(cb + c + 4);
        a[0] = b0[0]; a[1] = b0[1]; a[2] = b0[2]; a[3] = b0[3]; a[4] = b1[0]; a[5] = b1[1]; a[6] = b1[2]; a[7] = b1[3];
#pragma unroll
        for (int w = 0; w < 4; ++w) { const f32x4 w0 = *(const f32x4*)(cw + w * CONVD + c), w1 = *(const f32x4*)(cw + w * CONVD + c + 4);
            a[0] += bf2f(q.rv[w].x & 0xffffu) * w0[0]; a[1] += bf2f(q.rv[w].x >> 16) * w0[1]; a[2] += bf2f(q.rv[w].y & 0xffffu) * w0[2]; a[3] += bf2f(q.rv[w].y >> 16) * w0[3];
            a[4] += bf2f(q.rv[w].z & 0xffffu) * w1[0]; a[5] += bf2f(q.rv[w].z >> 16) * w1[1]; a[6] += bf2f(q.rv[w].w & 0xffffu) * w1[2]; a[7] += bf2f(q.rv[w].w >> 16) * w1[3]; }
#pragma unroll
        for (int e = 0; e < 8; ++e) a[e] = silu1(a[e]);
    }
    v4u o; o.x = pk2(a[0], a[1]); o.y = pk2(a[2], a[3]); o.z = pk2(a[4], a[5]); o.w = pk2(a[6], a[7]);
    if (c < 1024) *(v4u*)(WSP(bf16, WS_XS) + (size_t)(q.b * LPAD + q.pp) * 1024 + c) = o;
    else *(v4u*)(WSP(bf16, WS_BC) + (size_t)(q.b * LPAD + q.pp) * 512 + (c - 1024)) = o;
}
__device__ __forceinline__ void p4_conv(Frame& F) {
    const float* um = WSP(float, WS_META + MO_U);
    const int gt = F.gw * 64 + F.lane, NT = F.NGW * 64, NITEM = NBATCH * LPAD * (CONVD / 8);
    for (int it = gt; it < NITEM; it += 3 * NT) {
        ConvItem q0, q1, q2; const int i1 = it + NT, i2 = it + 2 * NT;
        conv_issue(F, it, q0); if (i1 < NITEM) conv_issue(F, i1, q1); if (i2 < NITEM) conv_issue(F, i2, q2);
        conv_finish(F, q0); if (i1 < NITEM) conv_finish(F, q1); if (i2 < NITEM) conv_finish(F, q2);
    }
    for (int it = gt; it < NBATCH * LPAD * SH; it += NT) { const int hd = it & 15, pp = (it >> 4) % LPAD, b = (it >> 4) / LPAD, p = pp - PPAD;
        float v = 0.f;
        if (p >= 0) { const float x = (p < NMETA ? um[(size_t)p * NIN + NINP + hd] : WSP(float, WS_DTR)[(size_t)(b * SEQ + p - NMETA) * 16 + hd]) + F.in[17][hd];
            v = fmaxf(x, 0.f) + log1pf(__expf(-fabsf(x))); }
        WSP(float, WS_DT)[it] = v; }
}
__device__ __forceinline__ void p4_mixer_attn(Frame& F) {
    p4_conv(F);
    float lam; { const float s1 = wave_sum(F.in[10][F.lane] * F.in[11][F.lane]), s2 = wave_sum(F.in[12][F.lane] * F.in[13][F.lane]); lam = __expf(s1) - __expf(s2) + 0.2f; }
    lam = __builtin_bit_cast(float, __builtin_amdgcn_readfirstlane(__builtin_bit_cast(int, lam)));
    for (int r_ = 0; r_ < (MK_REPEAT_PHASE == 41 ? 2 : 1); ++r_)
    for (int u = blockIdx.x; u < NBATCH * NHEAD * 16; u += F.G) { const int bh = (u & 7) * 2 + ((u >> 3) >> 4), idx = (u >> 3) & 15;
        att::attn_meta_tile(F, bh); att::attn_unit(F, bh, idx, lam); att::attn_unit(F, bh, 31 - idx, lam); }
}
__device__ __forceinline__ void p5_ssd_a(Frame& F) { int bgj = 0; for (int it = blockIdx.x; it < NBATCH * SH * 8; it += F.G) ssd::ssd_item<false>(F, it, bgj); }
__device__ __forceinline__ void p6_ssd_b(Frame& F) { int bgj = 0; for (int it = blockIdx.x; it < NBATCH * SH * 8; it += F.G) ssd::ssd_item<true>(F, it, bgj);
    if (F.NGW != 2048) convert_items(F, IT_BG, IT_END, F.gw, F.NGW); }
struct Args { const float* in[26]; float* out; unsigned char* ws; int ph_lo, ph_hi; };
__global__ void __launch_bounds__(NWAVES * 64, 2) hymba_fwd(Args args) {
    extern __shared__ __attribute__((aligned(16))) unsigned char lds[];
    Frame F;
    F.lds = (LAS unsigned char*)lds;
    F.tid = threadIdx.x; F.lane = F.tid & 63; F.wave = __builtin_amdgcn_readfirstlane(F.tid >> 6);
    F.G = gridDim.x; F.gw = blockIdx.x * NWAVES + F.wave; F.NGW = F.G * NWAVES;
#pragma unroll
    for (int i = 0; i < 26; ++i) F.in[i] = args.in[i];
    F.out = args.out; F.ws = args.ws; F.inp = args.in;
    volatile LAS unsigned* MISC = (volatile LAS unsigned*)(F.lds + MISC_OFF);
    for (int u = F.tid; u < 128; u += NWAVES * 64) MISC[u] = 0u;
    __syncthreads();
    XcdBarrier bar; bar.bar = (unsigned*)(F.ws + WS_CTL) + CW_BAR; bar.x = 0; bar.st = nullptr;
    if (N_LAUNCHES == 1) bar = xcd_barrier_post((unsigned*)(F.ws + WS_CTL) + CW_BAR, MISC + 8);
    const int lo = args.ph_lo, hi = args.ph_hi;
#define IN(k) (lo <= (k) && (k) < hi)
#ifndef MK_REPEAT_PHASE
#define MK_REPEAT_PHASE -1
#endif
#define REPS(k) for (int rep_ = 0; rep_ < ((k) == MK_REPEAT_PHASE ? 2 : 1); ++rep_)
#define REPBAR(k) do { if ((k) == MK_REPEAT_PHASE && rep_ == 0) xcd_barrier(bar); } while (0)
#define SEAM(k) do { if (IN(k) && IN((k) + 1)) xcd_barrier(bar); } while (0)
    using pg8::Gemm; using pg8::StaticOrder;
    LAS unsigned char* ring = F.lds + RING_OFF;

    if (IN(0)) { REPS(0) { p0_prologue(F); REPBAR(0); } SEAM(0); }
    if (IN(1)) {
        Gemm g{WSP(bf16, WS_XN), WSP(bf16, WS_W1GU), MR, NGU, DM}; StaticOrder S; S.init(MR, NGU, F.G, (int)blockIdx.x);
        pg8::Unit u0{0, 0}; (void)S.next(0, u0);
        pg8::EpiSwiGLU E{WSP(bf16, WS_ACT), DFF, WSP(float, WS_SSQ0), 1, build_rs_table(F, WSP(float, WS_SSQ0), 1, 1.0f / 2048.0f, u0.pm)};
        REPS(1) { pg8::gemm_phase<pg8::EpiSwiGLU, StaticOrder, true, true>(ring, g, S, E); REPBAR(1); }
        { const int first = S.nwg % F.G, nsl = F.G - first;
          const int w0 = (int)blockIdx.x >= first ? ((int)blockIdx.x - first) * NWAVES + F.wave : -1;
          meta_gateup(F, w0, nsl * NWAVES);
          constexpr int NMW = DFF / 16;
          convert_items(F, IT_CUT0, IT_BG, w0 >= NMW ? w0 - NMW : -1, nsl * NWAVES - NMW); }
        SEAM(1);
    }
    if (IN(2)) {
        meta_down(F);
        Gemm g{WSP(bf16, WS_ACT), WSP(bf16, WS_W1D), MR, DM, DFF}; StaticOrder S; S.init(MR, DM, F.G, (int)blockIdx.x);
        pg8::EpiResT<false> E{F.in[0], nullptr, nullptr, WSP(bf16, WS_XN), WSP(float, WS_SSQ1), 0.5f, DM, nullptr, 0, pg8::RsTable{nullptr, -1, -1}};
        REPS(2) { pg8::gemm_phase<pg8::EpiResT<false>, StaticOrder, true, true>(ring, g, S, E); REPBAR(2); }
        SEAM(2);
    }
    if (IN(3)) {
        Gemm g{WSP(bf16, WS_XN), WSP(bf16, WS_WIN), MR, NINP, DM}; StaticOrder S; S.init(MR, NINP, F.G, (int)blockIdx.x);
        pg8::Unit u0{0, 0}; (void)S.next(0, u0);
        pg8::EpiInProj E{WSP(bf16, WS_ACT), NINP, WSP(float, WS_SSQ1), F.in[8], F.in[9], WSP(float, WS_ROPE), build_rs_table(F, WSP(float, WS_SSQ1), 32, 1.0f / 2048.0f, u0.pm)};
        REPS(3) { pg8::gemm_phase<pg8::EpiInProj, StaticOrder, true, true>(ring, g, S, E); REPBAR(3); }
        { const int first = S.nwg % F.G, nsl = F.G - first;
          meta_inproj_and_dt(F, (int)blockIdx.x >= first ? ((int)blockIdx.x - first) * NWAVES + F.wave : -1, NMETA_IT + NDT_IT, nsl * NWAVES); }
        SEAM(3);
    }
    if (IN(4)) { REPS(4) { p4_mixer_attn(F); REPBAR(4); } SEAM(4); }
    if (IN(5)) { REPS(5) { p5_ssd_a(F); REPBAR(5); } SEAM(5); }
    if (IN(6)) { REPS(6) { p6_ssd_b(F); REPBAR(6); } SEAM(6); }
    if (IN(7)) {
        Gemm g{WSP(bf16, WS_MIX), WSP(bf16, WS_WOUT), MR, DM, DM}; StaticOrder S; S.init(MR, DM, F.G, (int)blockIdx.x);
        pg8::Unit u0{0, 0}; (void)S.next(0, u0);
        pg8::EpiResT<true> E{nullptr, WSP(bf16, WS_XN), nullptr, WSP(bf16, WS_XN), WSP(float, WS_SSQ2), 1.0f, DM, WSP(float, WS_SSQS), 16, build_rs_table(F, WSP(float, WS_SSQS), 32, 1.0f / 1024.0f, u0.pm)};
        pg8::gemm_phase<pg8::EpiResT<true>, StaticOrder, true, true>(ring, g, S, E);
        SEAM(7);
    }
    if (IN(8)) {
        Gemm g{WSP(bf16, WS_XN), WSP(bf16, WS_W2GU), MR, NGU, DM}; StaticOrder S; S.init(MR, NGU, F.G, (int)blockIdx.x);
        pg8::Unit u0{0, 0}; (void)S.next(0, u0);
        pg8::EpiSwiGLU E{WSP(bf16, WS_ACT), DFF, WSP(float, WS_SSQ2), 32, build_rs_table(F, WSP(float, WS_SSQ2), 32, 1.0f / 2048.0f, u0.pm)};
        REPS(8) { pg8::gemm_phase<pg8::EpiSwiGLU, StaticOrder, true, true>(ring, g, S, E); REPBAR(8); }
        SEAM(8);
    }
    if (IN(9)) {
        Gemm g{WSP(bf16, WS_ACT), WSP(bf16, WS_W2D), MR, DM, DFF}; StaticOrder S; S.init(MR, DM, F.G, (int)blockIdx.x);
        pg8::EpiResT<false> E{nullptr, WSP(bf16, WS_XN), F.out, nullptr, nullptr, 0.5f, DM, nullptr, 0, pg8::RsTable{nullptr, -1, -1}};
        pg8::gemm_phase<pg8::EpiResT<false>, StaticOrder, true, true>(ring, g, S, E);
    }
#undef IN
#undef SEAM
}

extern "C" void kernel_launch(void* const* d_in, const int* in_sizes, int n_in, void* d_out, int out_size, void* d_ws, size_t ws_size, hipStream_t stream) {
    static int grid = 0;
    if (grid == 0) {
        if (n_in != 26 || in_sizes[0] != MR * DM || out_size != MR * DM || ws_size < WS_END) { fprintf(stderr, "kernel_launch: unexpected shapes (n_in %d, in0 %d, out %d, ws %zu)\n", n_in, n_in > 0 ? in_sizes[0] : -1, out_size, ws_size); grid = -1; return; }
        int dev = 0, cus = 0, per_cu = 0;
        if (hipGetDevice(&dev) != hipSuccess || hipDeviceGetAttribute(&cus, hipDeviceAttributeMultiprocessorCount, dev) != hipSuccess) { grid = -1; return; }
        if (hipFuncSetAttribute((const void*)hymba_fwd, hipFuncAttributeMaxDynamicSharedMemorySize, LDS_BYTES) != hipSuccess) { fprintf(stderr, "kernel_launch: hipFuncSetAttribute failed\n"); grid = -1; return; }
        if (hipOccupancyMaxActiveBlocksPerMultiprocessor(&per_cu, (const void*)hymba_fwd, NWAVES * 64, LDS_BYTES) != hipSuccess || per_cu < 1) { fprintf(stderr, "kernel_launch: occupancy query says %d blocks per CU\n", per_cu); (void)hipGetLastError(); grid = -1; return; }
        grid = cus;
    }
    if (grid < 0) return;
    (void)hipMemsetAsync((char*)d_ws + WS_CTL, 0, CTL_ZERO_BYTES, stream);
    Args a{};
    for (int i = 0; i < 26; ++i) a.in[i] = (const float*)d_in[i];
    a.out = (float*)d_out; a.ws = (unsigned char*)d_ws;
    for (int li = 0; li < N_LAUNCHES; ++li) {
        a.ph_lo = (N_LAUNCHES == 1) ? 0 : li; a.ph_hi = (N_LAUNCHES == 1) ? NPH : li + 1;
        hipLaunchKernelGGL(hymba_fwd, dim3(grid), dim3(NWAVES * 64), LDS_BYTES, stream, a);
    }
}
```

```cpp
#include <hip/hip_runtime.h>
#include <cstdio>
#include <cstdint>
#include <cmath>
#ifndef MK_AMP
#define MK_AMP 0
#endif
namespace pg8 {
#define PG8_LAS __attribute__((address_space(3)))
typedef unsigned short bf16_t;
typedef short bf16x8 __attribute__((ext_vector_type(8)));
typedef float f32x4 __attribute__((ext_vector_type(4)));
typedef unsigned u32x4 __attribute__((ext_vector_type(4)));
constexpr int BM = 256, BK = 64, HALF = 128, HTB = HALF * BK * 2  , STAGE_BYTES = 8 * HTB, NXCD = 8, WGM = 8;

__host__ __device__ __forceinline__ int lds_byte(int r, int c) { const int st = (r >> 4) * 2 + (c >> 5), rr = r & 15, cc = c & 31, ob = rr * 64 + cc * 2; return st * 1024 + (ob ^ (((ob >> 9) & 1) << 5)); }
__host__ __device__ __forceinline__ void stage_rc(int b, int& R, int& C) { const int st = b / 1024, sb = b % 1024, swz = sb ^ (((sb >> 9) & 1) << 5); R = (st >> 1) * 16 + swz / 64; C = (st & 1) * 32 + (swz % 64) / 2; }
__host__ __device__ __forceinline__ int perm32(int rho) { const int n = rho >> 4, i = rho & 15; return 8 * (i >> 2) + 4 * n + (i & 3); }

struct Unit { int pm, pn; };
struct Gemm { const bf16_t* A; const bf16_t* Bt; int M, N, K; };

struct StaticOrder {
    int nM, nN, nwg, G, c;
    __host__ __device__ void init(int M, int N, int G_, int c_) { nM = M / BM; nN = N / BM; nwg = nM * nN; G = G_; c = c_; }
    __host__ __device__ __forceinline__ bool next(int i, Unit& u) const {
        const long L = (long)i * G + c; if (L >= nwg) return false;
        int wgid = (int)L; { const int q = nwg / NXCD, r = nwg % NXCD, xcd = wgid % NXCD, off = wgid / NXCD; wgid = (xcd < r ? xcd * (q + 1) : r * (q + 1) + (xcd - r) * q) + off; }
        const int nig = WGM * nN, gid = wgid / nig, fm = gid * WGM, gsz = (nM - fm) < WGM ? (nM - fm) : WGM;
        u.pm = fm + ((wgid % nig) % gsz); u.pn = (wgid % nig) / gsz; return true;
    }
    __device__ __forceinline__ void a_ready(const Unit&) const {}
    __device__ __forceinline__ void done(const Unit&) const {}
};


__device__ __forceinline__ unsigned cvt_pk_bf16(float lo, float hi) { unsigned r; asm volatile("v_cvt_pk_bf16_f32 %0, %1, %2" : "=v"(r) : "v"(lo), "v"(hi)); return r; }
typedef unsigned u32x2 __attribute__((ext_vector_type(2)));
constexpr float RMS_EPS = 1e-6f;
__device__ __forceinline__ float row_rs(const float* ssq, int np, int row, float inv_n = 1.0f / 2048.0f) {
    float s;
    if (np == 1) s = ssq[row];
    else { const f32x4* p = (const f32x4*)(ssq + (size_t)row * 32); f32x4 a = p[0];
#pragma unroll
        for (int i = 1; i < 8; ++i) a += p[i];
        s = (a[0] + a[1]) + (a[2] + a[3]); }
    return __builtin_amdgcn_rsqf(s * inv_n + RMS_EPS);
}
struct RsTable { const PG8_LAS float* t; int tpm, tpm2; };
__device__ __forceinline__ float row_rs_t(const RsTable& T, const float* ssq, int np, float inv_n, int pm, int rin) { return (pm == T.tpm) ? T.t[rin] : (pm == T.tpm2) ? T.t[256 + rin] : row_rs(ssq, np, pm * BM + rin, inv_n); }
__device__ __forceinline__ float silu_f(float g) { return g * __builtin_amdgcn_rcpf(1.0f + __builtin_amdgcn_exp2f(-1.4426950408889634f * g)); }

struct EpiSwiGLU {
    static constexpr bool PERM = true, AFTER_DRAIN = false, HAS_MID = false, AMP = (MK_AMP == 11);
    bf16_t* O; int ldc; const float* ssq; int np; RsTable T;
    __device__ __forceinline__ void mid(f32x4 (&)[2][2][4][2], const Unit&, int, int, int, int) const {}
    __device__ __forceinline__ void operator()(const f32x4 (&acc)[2][2][4][2], const Unit& u, int wr, int wc, int fr, int fq) const {
        const int row0 = u.pm * BM + wr * 64 + fr, col0 = u.pn * HALF + wc * 32 + 8 * fq;
#pragma unroll
        for (int ai = 0; ai < 2; ++ai)
#pragma unroll
            for (int m = 0; m < 4; ++m) { const int row = row0 + ai * HALF + m * 16; const float rs = row_rs_t(T, ssq, np, 1.0f / 2048.0f, u.pm, wr * 64 + fr + ai * HALF + m * 16);
                float a[8];
#pragma unroll
                for (int n = 0; n < 2; ++n)
#pragma unroll
                    for (int i = 0; i < 4; ++i) { const float g = acc[ai][0][m][n][i] * rs, up = acc[ai][1][m][n][i] * rs; a[4 * n + i] = silu_f(g) * up; }
                u32x4 w; w.x = cvt_pk_bf16(a[0], a[1]); w.y = cvt_pk_bf16(a[2], a[3]); w.z = cvt_pk_bf16(a[4], a[5]); w.w = cvt_pk_bf16(a[6], a[7]);
                *(u32x4*)(O + (size_t)row * ldc + col0) = w; }
    }
};
template <bool MID> struct EpiResT {
    static constexpr bool PERM = false, AFTER_DRAIN = false, HAS_MID = MID, AMP = false;
    const float* basef; const bf16_t* baseh; float* out; bf16_t* xn; float* ssq; float scale; int ldc; const float* rsm; int kmid; RsTable T;
    __device__ __forceinline__ void mid(f32x4 (&acc)[2][2][4][2], const Unit& u, int wr, int wc, int fr, int fq) const {
        int fro = fr; asm volatile("" : "+v"(fro));
        const int rin0 = wr * 64 + fro;
#pragma unroll
        for (int ai = 0; ai < 2; ++ai)
#pragma unroll
            for (int m = 0; m < 4; ++m) { const float r = row_rs_t(T, rsm, 32, 1.0f / 1024.0f, u.pm, rin0 + ai * HALF + m * 16);
#pragma unroll
                for (int bj = 0; bj < 2; ++bj)
#pragma unroll
                    for (int n = 0; n < 2; ++n) acc[ai][bj][m][n] *= r; }
    }
    __device__ __forceinline__ void operator()(const f32x4 (&acc)[2][2][4][2], const Unit& u, int wr, int wc, int fr, int fq) const {
        const int row0 = u.pm * BM + wr * 64 + fr, col0 = u.pn * BM + wc * 32 + 4 * fq;
#pragma unroll
        for (int ai = 0; ai < 2; ++ai) {
            f32x4 bf[4][2][2]; u32x2 bh[4][2][2];
#pragma unroll
            for (int m = 0; m < 4; ++m)
#pragma unroll
                for (int bj = 0; bj < 2; ++bj)
#pragma unroll
                    for (int n = 0; n < 2; ++n) { const size_t o1 = (size_t)(row0 + ai * HALF + m * 16) * ldc + col0 + bj * HALF + n * 16;
                        if (basef) bf[m][bj][n] = *(const f32x4*)(basef + o1); else bh[m][bj][n] = *(const u32x2*)(baseh + o1); }
#pragma unroll
            for (int m = 0; m < 4; ++m) { const int row = row0 + ai * HALF + m * 16; const size_t off = (size_t)row * ldc + col0; float sq = 0.f;
#pragma unroll
                for (int bj = 0; bj < 2; ++bj)
#pragma unroll
                    for (int n = 0; n < 2; ++n) { const size_t o1 = off + bj * HALF + n * 16; f32x4 b;
                        if (basef) b = bf[m][bj][n];
                        else { const u32x2 h = bh[m][bj][n]; b[0] = __uint_as_float(h.x << 16); b[1] = __uint_as_float(h.x & 0xffff0000u); b[2] = __uint_as_float(h.y << 16); b[3] = __uint_as_float(h.y & 0xffff0000u); }
                        const f32x4 o = b + acc[ai][bj][m][n] * scale;
                        if (out) *(f32x4*)(out + o1) = o;
                        if (xn) { sq += (o[0] * o[0] + o[1] * o[1]) + (o[2] * o[2] + o[3] * o[3]); u32x2 w; w.x = cvt_pk_bf16(o[0], o[1]); w.y = cvt_pk_bf16(o[2], o[3]); *(u32x2*)(xn + o1) = w; } }
                if (xn) { sq += __shfl_xor(sq, 16); sq += __shfl_xor(sq, 32); if (fq == 0) ssq[(size_t)row * 32 + u.pn * 4 + wc] = sq; } }
        }
    }
};
struct EpiInProj {
    static constexpr bool PERM = true, AFTER_DRAIN = false, HAS_MID = false, AMP = (MK_AMP == 12);
    bf16_t* U; int ldc; const float* ssq; const float* qn; const float* kn; const float* rope; RsTable T;
    __device__ __forceinline__ void mid(f32x4 (&)[2][2][4][2], const Unit&, int, int, int, int) const {}
    __device__ __forceinline__ void operator()(const f32x4 (&acc)[2][2][4][2], const Unit& u, int wr, int wc, int fr, int fq) const {
        const int row0 = u.pm * BM + wr * 64 + fr, col0 = u.pn * BM + wc * 64 + 8 * fq;
        const bool isqk = u.pn < 8;
        f32x4 wv[2][2];
        if (isqk) { const float* wn = (u.pn < 4) ? qn : kn;
#pragma unroll
            for (int bj = 0; bj < 2; ++bj)
#pragma unroll
                for (int n = 0; n < 2; ++n) wv[bj][n] = *(const f32x4*)(wn + 32 * bj + 8 * fq + 4 * n); }
#pragma unroll
        for (int ai = 0; ai < 2; ++ai)
#pragma unroll
            for (int m = 0; m < 4; ++m) { const int row = row0 + ai * HALF + m * 16; const float rs = row_rs_t(T, ssq, 32, 1.0f / 2048.0f, u.pm, wr * 64 + fr + ai * HALF + m * 16);
                f32x4 v[2][2];
#pragma unroll
                for (int bj = 0; bj < 2; ++bj)
#pragma unroll
                    for (int n = 0; n < 2; ++n) v[bj][n] = acc[ai][bj][m][n] * rs;
                if (isqk) {
                    float sq = 0.f;
#pragma unroll
                    for (int bj = 0; bj < 2; ++bj)
#pragma unroll
                        for (int n = 0; n < 2; ++n) sq += (v[bj][n][0] * v[bj][n][0] + v[bj][n][1] * v[bj][n][1]) + (v[bj][n][2] * v[bj][n][2] + v[bj][n][3] * v[bj][n][3]);
                    sq += __shfl_xor(sq, 16); sq += __shfl_xor(sq, 32);
                    const float r = __builtin_amdgcn_rsqf(sq * (1.0f / 64.0f) + RMS_EPS);
#pragma unroll
                    for (int bj = 0; bj < 2; ++bj)
#pragma unroll
                        for (int n = 0; n < 2; ++n) v[bj][n] = v[bj][n] * r * wv[bj][n];
                    const int pos = (row & 4095) + 16;
                    const f32x4 c0 = *(const f32x4*)(rope + pos * 16), c1 = *(const f32x4*)(rope + pos * 16 + 4), s0 = *(const f32x4*)(rope + pos * 16 + 8), s1 = *(const f32x4*)(rope + pos * 16 + 12);
                    f32x4 p0, p1;
#pragma unroll
                    for (int i = 0; i < 4; ++i) { p0[i] = __shfl_xor(v[0][0][i], 16); p1[i] = __shfl_xor(v[0][1][i], 16); }
                    if (fq == 0) { v[0][0] = v[0][0] * c0 - p0 * s0; v[0][1] = v[0][1] * c1 - p1 * s1; }
                    else if (fq == 1) { v[0][0] = v[0][0] * c0 + p0 * s0; v[0][1] = v[0][1] * c1 + p1 * s1; }
                    if (u.pn < 4) { v[0][0] *= 0.18033688011112042f; v[0][1] *= 0.18033688011112042f; v[1][0] *= 0.18033688011112042f; v[1][1] *= 0.18033688011112042f; }
                }
#pragma unroll
                for (int bj = 0; bj < 2; ++bj) { u32x4 w; w.x = cvt_pk_bf16(v[bj][0][0], v[bj][0][1]); w.y = cvt_pk_bf16(v[bj][0][2], v[bj][0][3]); w.z = cvt_pk_bf16(v[bj][1][0], v[bj][1][1]); w.w = cvt_pk_bf16(v[bj][1][2], v[bj][1][3]);
                    *(u32x4*)(U + (size_t)row * ldc + col0 + 32 * bj) = w; } }
    }
};

template <class Epi, class Sched, bool ALIGN_EPI = false, bool SP2 = false>
__device__ __forceinline__ void gemm_phase(PG8_LAS unsigned char* lds, const Gemm g, const Sched& S, const Epi& E) {
    const int tid = threadIdx.x, wid = __builtin_amdgcn_readfirstlane(tid >> 6), lane = tid & 63, wr = wid >> 2, wc = wid & 3, fr = lane & 15, fq = lane >> 4;
    const int K = g.K, nt = K / BK;
    unsigned voffA[2], voffB[2];
#pragma unroll
    for (int i = 0; i < 2; ++i) { int R, C; stage_rc(tid * 16 + i * 8192, R, C); const int Rb = Epi::PERM ? ((R & ~31) + perm32(R & 31)) : R;
        voffA[i] = (unsigned)(R * K + C) * 2u; voffB[i] = (unsigned)(Rb * K + C) * 2u; }
    const size_t kstep = (size_t)(BK * 2);
    const size_t hstep = (size_t)HALF * K * 2;
    const size_t tstep = 2 * hstep;
    const unsigned ldsw = (unsigned)wid * 1024u;
    const int aoff = lds_byte(wr * 64 + fr, fq * 8), boff = lds_byte(wc * 32 + fr, fq * 8);
#define PG8_SA(b, h) (((b) * 2 + (h)) * HTB)
#define PG8_SB(b, h) ((4 + (b) * 2 + (h)) * HTB)
#define PG8_STAGE(bufoff, gbase, voff) do { _Pragma("unroll") for (int _i = 0; _i < 2; ++_i) \
        __builtin_amdgcn_global_load_lds((const unsigned*)((const char*)(gbase) + (voff)[_i]), (PG8_LAS unsigned*)(lds + (bufoff) + ldsw + _i * 8192), 16, 0, 0); } while (0)
#define PG8_LDA(dst, b, h) do { _Pragma("unroll") for (int m = 0; m < 4; ++m) _Pragma("unroll") for (int k = 0; k < 2; ++k) dst[m][k] = *(const PG8_LAS bf16x8*)(lds + PG8_SA(b, h) + aoff + m * 2048 + k * 1024); } while (0)
#define PG8_LDB(dst, b, h) do { _Pragma("unroll") for (int n = 0; n < 2; ++n) _Pragma("unroll") for (int k = 0; k < 2; ++k) dst[n][k] = *(const PG8_LAS bf16x8*)(lds + PG8_SB(b, h) + boff + n * 2048 + k * 1024); } while (0)
#define PG8_MMA(ai, bj, At, Bt) do { __builtin_amdgcn_s_setprio(1); _Pragma("unroll") for (int m = 0; m < 4; ++m) _Pragma("unroll") for (int n = 0; n < 2; ++n) _Pragma("unroll") for (int k = 0; k < 2; ++k) \
        acc[ai][bj][m][n] = __builtin_amdgcn_mfma_f32_16x16x32_bf16(Bt[n][k], At[m][k], acc[ai][bj][m][n], 0, 0, 0); __builtin_amdgcn_s_setprio(0); } while (0)
#define PG8_WAIT_V(n) asm volatile("s_waitcnt vmcnt(" #n ")" ::: "memory")
#define PG8_WAIT_L(n) asm volatile("s_waitcnt lgkmcnt(" #n ")" ::: "memory")
#define PG8_BAR __builtin_amdgcn_s_barrier()
#define PG8_SCHED __builtin_amdgcn_sched_barrier(0)
    Unit cur, nxt; int ui = 0;
    if (!S.next(0, cur)) return;
    f32x4 acc[2][2][4][2];
#pragma unroll
    for (int a = 0; a < 2; ++a)
#pragma unroll
        for (int b = 0; b < 2; ++b)
#pragma unroll
            for (int m = 0; m < 4; ++m)
#pragma unroll
                for (int n = 0; n < 2; ++n) acc[a][b][m][n] = (f32x4){0.f, 0.f, 0.f, 0.f};
    bf16x8 At[4][2], B0[2][2], B1[2][2];
    const char* cA = (const char*)g.A + (size_t)cur.pm * tstep; const char* cB = (const char*)g.Bt + (size_t)cur.pn * tstep;
    S.a_ready(cur);
    if constexpr (SP2) {
        PG8_STAGE(PG8_SB(0, 0), cB, voffB); PG8_STAGE(PG8_SB(0, 1), cB + hstep, voffB); PG8_STAGE(PG8_SA(0, 0), cA, voffA); PG8_STAGE(PG8_SA(0, 1), cA + hstep, voffA);
        if (wr == 1) PG8_BAR;
        PG8_WAIT_V(2); PG8_BAR;
        PG8_STAGE(PG8_SB(1, 0), cB + kstep, voffB); PG8_STAGE(PG8_SA(1, 0), cA + kstep, voffA); PG8_STAGE(PG8_SB(1, 1), cB + hstep + kstep, voffB);
        PG8_WAIT_V(6); PG8_BAR;
    } else {
        PG8_STAGE(PG8_SB(0, 0), cB, voffB); PG8_STAGE(PG8_SA(0, 0), cA, voffA); PG8_STAGE(PG8_SB(0, 1), cB + hstep, voffB); PG8_STAGE(PG8_SA(0, 1), cA + hstep, voffA);
        if (wr == 1) PG8_BAR;
        PG8_WAIT_V(4); PG8_BAR;
        PG8_STAGE(PG8_SB(1, 0), cB + kstep, voffB); PG8_STAGE(PG8_SA(1, 0), cA + kstep, voffA); PG8_STAGE(PG8_SB(1, 1), cB + hstep + kstep, voffB);
        PG8_WAIT_V(6); PG8_BAR;
    }
    for (;;) {
        const bool has_next = S.next(ui + 1, nxt);
        const char* nA = has_next ? (const char*)g.A + (size_t)nxt.pm * tstep : cA; const char* nB = has_next ? (const char*)g.Bt + (size_t)nxt.pn * tstep : cB;
        for (int t = 0; t < nt; t += 2) {
            const bool last = (t == nt - 2);
            if constexpr (Epi::HAS_MID) { if (t == E.kmid) E.mid(acc, cur, wr, wc, fr, fq); }
            const char* a1 = cA + (size_t)(t + 1) * kstep;
            const char* a2 = last ? nA : cA + (size_t)(t + 2) * kstep; const char* b2 = last ? nB : cB + (size_t)(t + 2) * kstep;
            const char* a3 = a2 + kstep; const char* b3 = b2 + kstep;
            if (last && has_next) S.a_ready(nxt);
            if constexpr (SP2) {
            PG8_LDB(B0, 0, 0); PG8_LDB(B1, 0, 1); PG8_SCHED; PG8_LDA(At, 0, 0); PG8_STAGE(PG8_SA(1, 1), a1 + hstep, voffA);
            PG8_WAIT_V(8); PG8_WAIT_L(0); PG8_BAR; PG8_MMA(0, 0, At, B0); PG8_MMA(0, 1, At, B1); PG8_BAR; PG8_SCHED;
            PG8_LDA(At, 0, 1); PG8_STAGE(PG8_SB(0, 0), b2, voffB); PG8_STAGE(PG8_SB(0, 1), b2 + hstep, voffB); PG8_STAGE(PG8_SA(0, 0), a2, voffA);
            PG8_WAIT_V(8); PG8_WAIT_L(0); PG8_BAR; PG8_MMA(1, 0, At, B0); PG8_MMA(1, 1, At, B1); PG8_BAR; PG8_SCHED;
            PG8_LDB(B0, 1, 0); PG8_LDB(B1, 1, 1); PG8_SCHED; PG8_LDA(At, 1, 0); PG8_STAGE(PG8_SA(0, 1), a2 + hstep, voffA);
            PG8_WAIT_V(8); PG8_WAIT_L(0); PG8_BAR; PG8_MMA(0, 0, At, B0); PG8_MMA(0, 1, At, B1); PG8_BAR; PG8_SCHED;
            PG8_LDA(At, 1, 1); PG8_STAGE(PG8_SB(1, 0), b3, voffB); PG8_STAGE(PG8_SB(1, 1), b3 + hstep, voffB); PG8_STAGE(PG8_SA(1, 0), a3, voffA);
            PG8_WAIT_V(8); PG8_WAIT_L(0); PG8_BAR; PG8_MMA(1, 0, At, B0); PG8_MMA(1, 1, At, B1); PG8_BAR; PG8_SCHED;
            } else {
            PG8_LDB(B0, 0, 0); PG8_SCHED; PG8_LDA(At, 0, 0); PG8_STAGE(PG8_SA(1, 1), a1 + hstep, voffA);
            PG8_WAIT_L(8); PG8_BAR; PG8_WAIT_L(0); PG8_MMA(0, 0, At, B0); PG8_BAR; PG8_SCHED;
            PG8_LDB(B1, 0, 1); PG8_STAGE(PG8_SB(0, 0), b2, voffB);
            PG8_BAR; PG8_WAIT_L(0); PG8_MMA(0, 1, At, B1); PG8_BAR;
            PG8_LDA(At, 0, 1); PG8_STAGE(PG8_SA(0, 0), a2, voffA);
            PG8_BAR; PG8_WAIT_L(0); PG8_MMA(1, 0, At, B0); PG8_BAR; PG8_SCHED;
            PG8_STAGE(PG8_SB(0, 1), b2 + hstep, voffB);
            PG8_WAIT_V(6); PG8_BAR; PG8_MMA(1, 1, At, B1); PG8_BAR;
            PG8_LDB(B0, 1, 0); PG8_SCHED; PG8_LDA(At, 1, 0); PG8_STAGE(PG8_SA(0, 1), a2 + hstep, voffA);
            PG8_WAIT_L(8); PG8_BAR; PG8_WAIT_L(0); PG8_MMA(0, 0, At, B0); PG8_BAR; PG8_SCHED;
            PG8_LDB(B1, 1, 1); PG8_STAGE(PG8_SB(1, 0), b3, voffB);
            PG8_BAR; PG8_WAIT_L(0); PG8_MMA(0, 1, At, B1); PG8_BAR;
            PG8_LDA(At, 1, 1); PG8_STAGE(PG8_SA(1, 0), a3, voffA);
            PG8_BAR; PG8_WAIT_L(0); PG8_MMA(1, 0, At, B0); PG8_BAR; PG8_SCHED;
            PG8_STAGE(PG8_SB(1, 1), b3 + hstep, voffB);
            PG8_WAIT_V(6); PG8_BAR; PG8_MMA(1, 1, At, B1); PG8_BAR;
            }
        }
        if constexpr (ALIGN_EPI) { if (wr == 0) PG8_BAR; }
        if constexpr (!Epi::AFTER_DRAIN) { for (int amp_ = 0; amp_ < (Epi::AMP ? 3 : 1); ++amp_) { E(acc, cur, wr, wc, fr, fq); asm volatile("" ::: "memory"); } S.done(cur); }
        if (!has_next) break;
#pragma unroll
        for (int a = 0; a < 2; ++a)
#pragma unroll
            for (int b = 0; b < 2; ++b)
#pragma unroll
                for (int m = 0; m < 4; ++m)
#pragma unroll
                    for (int n = 0; n < 2; ++n) acc[a][b][m][n] = (f32x4){0.f, 0.f, 0.f, 0.f};
        cur = nxt; cA = nA; cB = nB; ++ui;
        if constexpr (ALIGN_EPI) { if (wr == 1) PG8_BAR; }
    }
    PG8_WAIT_V(0);
    if constexpr (!ALIGN_EPI) { if (wr == 0) PG8_BAR; }
    PG8_BAR;
    if constexpr (Epi::AFTER_DRAIN) { E.fused(acc, cur, wr, wc, fr, fq, lds, wid, lane); S.done(cur); }
#undef PG8_SA
#undef PG8_SB
#undef PG8_STAGE
#undef PG8_LDA
#undef PG8_LDB
#undef PG8_MMA
#undef PG8_WAIT_V
#undef PG8_WAIT_L
#undef PG8_BAR
#undef PG8_SCHED
}
}

#ifndef PG8_SP2
#define PG8_SP2 true
#endif

constexpr int NWAVES = 8;
constexpr int DM = 2048, SEQ = 4096, NBATCH = 2, MR = NBATCH * SEQ, NMETA = 16, LPOS = SEQ + NMETA;
constexpr int DFF = 5632, NGU = 2 * DFF;
constexpr int NHEAD = 8, SH = 16, CONVD = 1536, NIN = 5648, NINP = 5632;
constexpr int PPAD = 48, LPAD = LPOS + PPAD;
constexpr float EPS = 1e-6f;
#ifndef MK_REPEAT_PHASE
#define MK_REPEAT_PHASE -1
#endif
#ifndef MK_N_LAUNCHES
#define MK_N_LAUNCHES 1
#endif
constexpr int NPH = 10;
constexpr int N_LAUNCHES = MK_N_LAUNCHES;

constexpr size_t MiB = 1u << 20;
constexpr size_t WS_CTL = 0, CTL_ZERO_BYTES = 1 * MiB;
constexpr size_t WS_W1GU = 2 * MiB, WS_W1D = 46 * MiB, WS_WIN = 68 * MiB, WS_WOUT = 91 * MiB, WS_W2GU = 99 * MiB, WS_W2D = 143 * MiB;
constexpr size_t WS_XN = 165 * MiB;
constexpr size_t WS_ACT = 197 * MiB;
constexpr size_t WS_MIX = 285 * MiB;
constexpr size_t WS_SSQ0 = 317 * MiB;
constexpr size_t WS_SSQ1 = 318 * MiB, WS_SSQ2 = 319 * MiB;
constexpr size_t WS_DTR = 320 * MiB;
constexpr size_t WS_ROPE = 321 * MiB;
constexpr size_t WS_META = 322 * MiB;
constexpr size_t MO_XN = 0, MO_SSQ0 = 65536, MO_ACT = 131072, MO_H1 = 327680, MO_XN1 = 458752, MO_U = 524288, MO_KM = 917504, MO_VM = 950272, MO_SSQ1 = 69632;
constexpr size_t WS_SST = 324 * MiB;
constexpr size_t WS_ATOT = 333 * MiB;
constexpr size_t WS_SSQS = 334 * MiB;
constexpr size_t WS_XS = 336 * MiB;
constexpr size_t WS_BC = 353 * MiB;
constexpr size_t WS_DT = 362 * MiB;
constexpr size_t WS_END = 363 * MiB;
constexpr int CW_BAR = 4096;

constexpr int RING_OFF = 0, RING_BYTES = 131072;
constexpr int LDS_BYTES = 147456, MISC_OFF = LDS_BYTES - 512;

#define GAS __attribute__((address_space(1)))
#define LAS __attribute__((address_space(3)))
typedef unsigned short bf16;
typedef unsigned v4u __attribute__((ext_vector_type(4)));
typedef float f32x4 __attribute__((ext_vector_type(4)));
typedef short bf16x8 __attribute__((ext_vector_type(8)));
typedef GAS unsigned gu32;
typedef GAS unsigned long long gu64;
#define RLX_AGENT __ATOMIC_RELAXED, __HIP_MEMORY_SCOPE_AGENT
#define LDS_WAIT() asm volatile("s_waitcnt lgkmcnt(0)" ::: "memory")
#define VM_WAIT() asm volatile("s_waitcnt vmcnt(0)" ::: "memory")
__device__ __forceinline__ unsigned long long rt() { return __builtin_amdgcn_s_memrealtime(); }
__device__ __forceinline__ unsigned f2bf(float f) { unsigned u = __builtin_bit_cast(unsigned, f); return (u + 0x7fffu + ((u >> 16) & 1u)) >> 16; }
typedef float f32x2_pk __attribute__((ext_vector_type(2))); typedef __bf16 bf16x2_pk __attribute__((ext_vector_type(2)));
__device__ __forceinline__ unsigned pk2(float lo, float hi) { f32x2_pk v = {lo, hi}; bf16x2_pk b = __builtin_convertvector(v, bf16x2_pk); return __builtin_bit_cast(unsigned, b); }

#define XB_TMO      128
#define XB_XCNT(j)  (256  + 64 * (j))
#define XB_XSUB(j)  (1280 + 64 * (j))
#define XB_XGEN(j)  (2304 + 64 * (j))
#define XB_TOP      3328
#define XB_TOPGEN   3392
#define XCD_BAR_WORDS 3456
#define XB_SPIN_CAP (1u << 18)

__device__ __forceinline__ unsigned xb_ld(unsigned* p)              { return __hip_atomic_load(p, __ATOMIC_RELAXED, __HIP_MEMORY_SCOPE_AGENT); }
__device__ __forceinline__ unsigned xb_add(unsigned* p, unsigned v) { return __hip_atomic_fetch_add(p, v, __ATOMIC_RELAXED, __HIP_MEMORY_SCOPE_AGENT); }
__device__ __forceinline__ unsigned xb_xcc_id() { return (unsigned)__builtin_amdgcn_s_getreg((3 << 11) | 20) & 0xFu; }
#define XB_SPIN(cond, bar) do { unsigned _sp = 0; while (cond) { __builtin_amdgcn_s_sleep(1); \
    if ((++_sp & 255u) == 0u) { if (xb_ld(&(bar)[XB_TMO])) break; if (_sp > XB_SPIN_CAP) { atomicAdd(&(bar)[XB_TMO], 1u); break; } } } } while (0)

struct XcdBarrier {
    unsigned* bar; unsigned x;
    volatile LAS unsigned* st;
};

__device__ __forceinline__ XcdBarrier xcd_barrier_post(unsigned* bar, volatile LAS unsigned* st) {
    XcdBarrier b; b.bar = bar; b.x = xb_xcc_id(); b.st = st;
    if (threadIdx.x == 0) (void)xb_add(&bar[XB_XCNT(b.x)], 1u);
    return b;
}
__device__ __forceinline__ void xcd_barrier_complete(unsigned* bar, unsigned x, unsigned& nloc, unsigned& nx) {
    const unsigned G = gridDim.x * gridDim.y * gridDim.z;
    unsigned sum, cnt, mine, sp = 0u;
    for (;;) {
        sum = 0u; cnt = 0u; mine = 0u;
#pragma unroll
        for (unsigned j = 0; j < 16; ++j) { const unsigned c = xb_ld(&bar[XB_XCNT(j)]); sum += c; cnt += (c > 0u) ? 1u : 0u; mine = (j == x) ? c : mine; }
        if (sum == G) break;
        __builtin_amdgcn_s_sleep(1);
        if ((++sp & 255u) == 0u) { if (xb_ld(&bar[XB_TMO])) break; if (sp > XB_SPIN_CAP) { atomicAdd(&bar[XB_TMO], 1u); break; } }
    }
    nloc = mine > 0u ? mine : 1u; nx = cnt > 0u ? cnt : 1u;
}

__device__ __forceinline__ void xcd_barrier(const XcdBarrier& b) {
    asm volatile("s_waitcnt vmcnt(0)" ::: "memory");
    __syncthreads();
    if (threadIdx.x == 0) {
        unsigned* bar = b.bar;
        __builtin_amdgcn_s_waitcnt(0);
        unsigned nloc = b.st[0], nx = b.st[1];
        if (nloc == 0u) { xcd_barrier_complete(bar, b.x, nloc, nx); b.st[0] = nloc; b.st[1] = nx; }
        const unsigned old = xb_add(&bar[XB_XSUB(b.x)], 1u);
        const unsigned gen = old / nloc;
        if (old + 1u == (gen + 1u) * nloc) {
            __builtin_amdgcn_fence(__ATOMIC_RELEASE, "agent");
            asm volatile("s_waitcnt vmcnt(0)" ::: "memory");
            const unsigned og = xb_add(&bar[XB_TOP], 1u);
            const unsigned tg = og / nx;
            if (og + 1u == (tg + 1u) * nx) xb_add(&bar[XB_TOPGEN], 1u);
            else XB_SPIN(xb_ld(&bar[XB_TOPGEN]) == tg, bar);
            __builtin_amdgcn_fence(__ATOMIC_ACQUIRE, "agent");
            xb_add(&bar[XB_XGEN(b.x)], 1u);
            asm volatile("s_waitcnt vmcnt(0)" ::: "memory");
        } else {
            XB_SPIN(xb_ld(&bar[XB_XGEN(b.x)]) == gen, bar);
            __builtin_amdgcn_fence(__ATOMIC_ACQUIRE, "agent");
            asm volatile("s_waitcnt vmcnt(0)" ::: "memory");
        }
    }
    __syncthreads();
}


typedef unsigned u32x2v __attribute__((ext_vector_type(2)));
__device__ __forceinline__ float bf2f(unsigned b) { return __uint_as_float(b << 16); }
__device__ __forceinline__ float wave_sum(float v) {
#pragma unroll
    for (int o = 1; o < 64; o <<= 1) v += __shfl_xor(v, o);
    return v;
}
__device__ __forceinline__ float wave_max(float v) {
#pragma unroll
    for (int o = 1; o < 64; o <<= 1) v = fmaxf(v, __shfl_xor(v, o));
    return v;
}
__device__ __forceinline__ float silu1(float g) { return g * __builtin_amdgcn_rcpf(1.0f + __builtin_amdgcn_exp2f(-1.4426950408889634f * g)); }

struct Frame {
    LAS unsigned char* lds;
    int tid, lane, wave, G, gw, NGW;
    const float* in[26]; float* out; unsigned char* ws; const float* const* inp;
};
#define WSP(T, off) ((T*)(F.ws + (off)))

constexpr int RST_OFF = RING_BYTES;
__device__ __forceinline__ pg8::RsTable build_rs_table(Frame& F, const float* ssq, int np, float inv_n, int pm, int pm2 = -1) {
    LAS float* t = (LAS float*)(F.lds + RST_OFF);
    if (F.tid < 256) t[F.tid] = pg8::row_rs(ssq, np, pm * 256 + F.tid, inv_n);
    else if (pm2 >= 0) t[F.tid] = pg8::row_rs(ssq, np, pm2 * 256 + F.tid - 256, inv_n);
    __syncthreads();
    return pg8::RsTable{t, pm, pm2};
}
__device__ __forceinline__ int rowmap(int kind, int n) {
    if (kind == 1) return 256 * (n >> 7) + (n & 127);
    if (kind == 2) return 256 * (n >> 7) + 128 + (n & 127);
    if (kind == 3) { if (n >= NINP) return n; const int pn = n >> 8, rem = n & 255, wc = rem >> 6, bj = (rem >> 5) & 1, j = rem & 31; return 256 * pn + 128 * bj + 32 * wc + j; }
    return n;
}
struct TItem { const float* W; int K, N; const float* kscale; bf16* WT; int kind, item, ks_off, krot; };
__device__ __forceinline__ void transpose_load(const TItem& t, int lane, f32x4 (&v)[16]) {
    const int nblk = (t.N + 63) >> 6, kb = t.item / nblk, nb = t.item - kb * nblk, k0 = 64 * kb, n0 = 64 * nb;
    const float* src = t.W + (size_t)(k0 + 8 * (lane >> 3)) * t.N;
#pragma unroll
    for (int h = 0; h < 2; ++h) { int nl = n0 + 32 * h + 4 * (lane & 7); nl = nl < t.N ? nl : t.N - 4;
#pragma unroll
        for (int i = 0; i < 8; ++i) v[8 * h + i] = __builtin_nontemporal_load((const f32x4*)(src + (size_t)i * t.N + nl)); }
}
__device__ __forceinline__ void transpose_finish(const TItem& t, int lane, f32x4 (&v)[16]) {
    const int nblk = (t.N + 63) >> 6, kb = t.item / nblk, nb = t.item - kb * nblk, k0 = 64 * kb, n0 = 64 * nb, r = lane >> 3;
    float sc[8];
    if (t.kscale && k0 >= t.ks_off) { const f32x4 s0 = *(const f32x4*)(t.kscale + k0 + 8 * r - t.ks_off), s1 = *(const f32x4*)(t.kscale + k0 + 8 * r - t.ks_off + 4);
        sc[0] = s0[0]; sc[1] = s0[1]; sc[2] = s0[2]; sc[3] = s0[3]; sc[4] = s1[0]; sc[5] = s1[1]; sc[6] = s1[2]; sc[7] = s1[3]; }
    else {
#pragma unroll
        for (int i = 0; i < 8; ++i) sc[i] = 1.0f; }
    int kd = k0 + t.krot; if (kd >= t.K) kd -= t.K;
#pragma unroll
    for (int h = 0; h < 2; ++h)
#pragma unroll
        for (int j = 0; j < 4; ++j) { const int n = n0 + 32 * h + 4 * (lane & 7) + j;
            v4u o; o.x = pg8::cvt_pk_bf16(v[8 * h + 0][j] * sc[0], v[8 * h + 1][j] * sc[1]); o.y = pg8::cvt_pk_bf16(v[8 * h + 2][j] * sc[2], v[8 * h + 3][j] * sc[3]);
            o.z = pg8::cvt_pk_bf16(v[8 * h + 4][j] * sc[4], v[8 * h + 5][j] * sc[5]); o.w = pg8::cvt_pk_bf16(v[8 * h + 6][j] * sc[6], v[8 * h + 7][j] * sc[7]);
            if (n < t.N) *(v4u*)(t.WT + (size_t)rowmap(t.kind, n) * t.K + kd + 8 * r) = o; }
}
__device__ __forceinline__ void transpose_load_h(const TItem& t, int lane, int h, f32x4 (&v)[8]) {
    const int nblk = (t.N + 63) >> 6, kb = t.item / nblk, nb = t.item - kb * nblk, k0 = 64 * kb, n0 = 64 * nb;
    const float* src = t.W + (size_t)(k0 + 8 * (lane >> 3)) * t.N;
    int nl = n0 + 32 * h + 4 * (lane & 7); nl = nl < t.N ? nl : t.N - 4;
#pragma unroll
    for (int i = 0; i < 8; ++i) v[i] = __builtin_nontemporal_load((const f32x4*)(src + (size_t)i * t.N + nl));
}
__device__ __forceinline__ void transpose_finish_h(const TItem& t, int lane, int h, f32x4 (&v)[8]) {
    const int nblk = (t.N + 63) >> 6, kb = t.item / nblk, nb = t.item - kb * nblk, k0 = 64 * kb, n0 = 64 * nb, r = lane >> 3;
    float sc[8];
    if (t.kscale && k0 >= t.ks_off) { const f32x4 s0 = *(const f32x4*)(t.kscale + k0 + 8 * r - t.ks_off), s1 = *(const f32x4*)(t.kscale + k0 + 8 * r - t.ks_off + 4);
        sc[0] = s0[0]; sc[1] = s0[1]; sc[2] = s0[2]; sc[3] = s0[3]; sc[4] = s1[0]; sc[5] = s1[1]; sc[6] = s1[2]; sc[7] = s1[3]; }
    else {
#pragma unroll
        for (int i = 0; i < 8; ++i) sc[i] = 1.0f; }
    int kd = k0 + t.krot; if (kd >= t.K) kd -= t.K;
#pragma unroll
    for (int j = 0; j < 4; ++j) { const int n = n0 + 32 * h + 4 * (lane & 7) + j;
        v4u o; o.x = pg8::cvt_pk_bf16(v[0][j] * sc[0], v[1][j] * sc[1]); o.y = pg8::cvt_pk_bf16(v[2][j] * sc[2], v[3][j] * sc[3]);
        o.z = pg8::cvt_pk_bf16(v[4][j] * sc[4], v[5][j] * sc[5]); o.w = pg8::cvt_pk_bf16(v[6][j] * sc[6], v[7][j] * sc[7]);
        if (n < t.N) *(v4u*)(t.WT + (size_t)rowmap(t.kind, n) * t.K + kd + 8 * r) = o; }
}
__device__ __forceinline__ void row_to_bf16(const float* xrow, bf16* orow, float* ssq, int lane) {
    const f32x4* xr = (const f32x4*)xrow + lane; float s = 0.f; f32x4 v[8];
#pragma unroll
    for (int j = 0; j < 8; ++j) { v[j] = __builtin_nontemporal_load(xr + 64 * j); s += (v[j][0] * v[j][0] + v[j][1] * v[j][1]) + (v[j][2] * v[j][2] + v[j][3] * v[j][3]); }
    s = wave_sum(s);
    u32x2v* o8 = (u32x2v*)orow + lane;
#pragma unroll
    for (int j = 0; j < 8; ++j) { u32x2v w; w.x = pk2(v[j][0], v[j][1]); w.y = pk2(v[j][2], v[j][3]); o8[64 * j] = w; }
    if (lane == 0) *ssq = s;
}
__constant__ float ROPE_INV[8] = {1.0f, 0.1939227432012558f, 0.03760603070259094f, 0.007292664609849453f, 0.0014142135623842478f, 0.00027424818836152554f, 5.318296098266728e-05f, 1.0313386155758053e-05f};
constexpr int I_G = 32 * 88, I_D = 88 * 32, I_IN = 32 * 89, I_O = 32 * 32;
constexpr int IT_W1G = 0, IT_W1U = IT_W1G + I_G, IT_WOUT = IT_W1U + I_G, IT_W1D = IT_WOUT + I_O, IT_WIN = IT_W1D + I_D, IT_W2U = IT_WIN + I_IN, IT_W2G = IT_W2U + I_G, IT_W2D = IT_W2G + I_G, IT_END = IT_W2D + I_D;
#ifndef MK_N1
#define MK_N1 6944
#endif
constexpr int IT_BG = IT_END - 8192;
constexpr int IT_CUT0 = IT_BG - MK_N1;
static_assert(IT_CUT0 >= IT_WOUT, "W1 gate/up are needed by P1");
__device__ __forceinline__ TItem mk_item(Frame& F, int it) {
    const int m = (it >= IT_W1U) + (it >= IT_WOUT) + (it >= IT_W1D) + (it >= IT_WIN) + (it >= IT_W2U) + (it >= IT_W2G) + (it >= IT_W2D);
    const int start = m == 0 ? IT_W1G : m == 1 ? IT_W1U : m == 2 ? IT_WOUT : m == 3 ? IT_W1D : m == 4 ? IT_WIN : m == 5 ? IT_W2U : m == 6 ? IT_W2G : IT_W2D;
    const unsigned long long WI = 0x1917180705150403ull, SI = 0xff161606ff140202ull;
    const int wi = (int)((WI >> (8 * m)) & 0xffu), si = (int)((SI >> (8 * m)) & 0xffu);
    const bool down = (m == 3 || m == 7);
    const size_t wto = m < 2 ? WS_W1GU : m == 2 ? WS_WOUT : m == 3 ? WS_W1D : m == 4 ? WS_WIN : m < 7 ? WS_W2GU : WS_W2D;
    const int kind = (m == 0 || m == 6) ? 1 : (m == 1 || m == 5) ? 2 : m == 4 ? 3 : 0;
    TItem t; t.W = F.inp[wi]; t.K = down ? DFF : DM; t.N = down ? DM : m == 2 ? DM : m == 4 ? NIN : DFF; t.kscale = si == 0xff ? nullptr : F.inp[si]; t.WT = WSP(bf16, wto); t.kind = kind; t.item = it - start;
    t.ks_off = m == 2 ? 1024 : 0; t.krot = m == 2 ? 1024 : 0;
    return t;
}
__device__ __forceinline__ void convert_items(Frame& F, int lo, int hi, int w, int nw) {
    if (w < 0) return;
    f32x4 va[16], vb[16]; int it = lo + w;
    if (it < hi) { TItem ta = mk_item(F, it); transpose_load(ta, F.lane, va);
        for (;;) {
            const int itb = it + nw; TItem tb = mk_item(F, itb < hi ? itb : it);
            if (itb < hi) transpose_load(tb, F.lane, vb);
            transpose_finish(ta, F.lane, va);
            if (itb >= hi) break;
            const int itc = itb + nw; ta = mk_item(F, itc < hi ? itc : itb);
            if (itc < hi) transpose_load(ta, F.lane, va);
            transpose_finish(tb, F.lane, vb);
            if (itc >= hi) break;
            it = itc;
        } }
}
__device__ __forceinline__ void p0_prologue(Frame& F) {
    convert_items(F, 0, IT_CUT0, F.gw, F.NGW);
    for (int m = F.gw; m < MR; m += 2 * F.NGW) {
        const int m2 = m + F.NGW;
        const f32x4* xa = (const f32x4*)(F.in[0] + (size_t)m * DM) + F.lane; const f32x4* xb = (const f32x4*)(F.in[0] + (size_t)(m2 < MR ? m2 : m) * DM) + F.lane;
        f32x4 va[8], vb[8]; float sa = 0.f, sb = 0.f;
#pragma unroll
        for (int j = 0; j < 8; ++j) { va[j] = __builtin_nontemporal_load(xa + 64 * j); vb[j] = __builtin_nontemporal_load(xb + 64 * j); }
#pragma unroll
        for (int j = 0; j < 8; ++j) { sa += (va[j][0] * va[j][0] + va[j][1] * va[j][1]) + (va[j][2] * va[j][2] + va[j][3] * va[j][3]); sb += (vb[j][0] * vb[j][0] + vb[j][1] * vb[j][1]) + (vb[j][2] * vb[j][2] + vb[j][3] * vb[j][3]); }
        sa = wave_sum(sa); sb = wave_sum(sb);
        u32x2v* oa = (u32x2v*)(WSP(bf16, WS_XN) + (size_t)m * DM) + F.lane; u32x2v* ob = (u32x2v*)(WSP(bf16, WS_XN) + (size_t)m2 * DM) + F.lane;
#pragma unroll
        for (int j = 0; j < 8; ++j) { u32x2v w; w.x = pk2(va[j][0], va[j][1]); w.y = pk2(va[j][2], va[j][3]); oa[64 * j] = w; }
        if (F.lane == 0) WSP(float, WS_SSQ0)[m] = sa;
        if (m2 < MR) {
#pragma unroll
            for (int j = 0; j < 8; ++j) { u32x2v w; w.x = pk2(vb[j][0], vb[j][1]); w.y = pk2(vb[j][2], vb[j][3]); ob[64 * j] = w; }
            if (F.lane == 0) WSP(float, WS_SSQ0)[m2] = sb; }
    }
    for (int p = F.gw; p < NMETA; p += F.NGW) row_to_bf16(F.in[1] + (size_t)p * DM, WSP(bf16, WS_META + MO_XN) + (size_t)p * DM, WSP(float, WS_META + MO_SSQ0) + p, F.lane);
    for (int e = F.gw * 64 + F.lane; e < LPOS * 8; e += F.NGW * 64) { const int pos = e >> 3, i = e & 7;
        const float ang = (float)pos * ROPE_INV[i];
        double tr = (double)ang * 0.15915494309189535; tr -= __builtin_rint(tr);
        const float tf = (float)tr;
        WSP(float, WS_ROPE)[pos * 16 + i] = __builtin_amdgcn_cosf(tf); WSP(float, WS_ROPE)[pos * 16 + 8 + i] = __builtin_amdgcn_sinf(tf); }
}

__device__ __forceinline__ f32x4 skinny16(const bf16* A, int lda, const bf16* Bt, int ldb, int k0, int k1, int lane, f32x4 acc) {
    const bf16* ap = A + (size_t)(lane & 15) * lda + 8 * (lane >> 4);
    const bf16* bp = Bt + (size_t)(lane & 15) * ldb + 8 * (lane >> 4);
#pragma unroll 16
    for (int k = k0; k < k1; k += 32) { const bf16x8 a = *(const bf16x8*)(ap + k), b = *(const bf16x8*)(bp + k);
        acc = __builtin_amdgcn_mfma_f32_16x16x32_bf16(a, b, acc, 0, 0, 0); }
    asm volatile("s_nop 15\n\ts_nop 3" : "+v"(acc));
    return acc;
}
__device__ __forceinline__ void meta_gateup(Frame& F, int w0, int wstride) {
    const bf16* A = WSP(bf16, WS_META + MO_XN); const float* ssq = WSP(float, WS_META + MO_SSQ0); bf16* act = WSP(bf16, WS_META + MO_ACT);
    if (w0 < 0) return;
    for (int it = w0; it < DFF / 16; it += wstride) { const int c0 = 16 * it, rg = 256 * (c0 >> 7) + (c0 & 127);
        f32x4 g = (f32x4){0.f, 0.f, 0.f, 0.f}, u = g;
        g = skinny16(A, DM, WSP(bf16, WS_W1GU) + (size_t)rg * DM, DM, 0, DM, F.lane, g);
        u = skinny16(A, DM, WSP(bf16, WS_W1GU) + (size_t)(rg + 128) * DM, DM, 0, DM, F.lane, u);
#pragma unroll
        for (int i = 0; i < 4; ++i) { const int row = 4 * (F.lane >> 4) + i; const float rs = __builtin_amdgcn_rsqf(ssq[row] * (1.0f / 2048.0f) + EPS);
            act[row * DFF + c0 + (F.lane & 15)] = (bf16)f2bf(silu1(g[i] * rs) * (u[i] * rs)); } }
}
__device__ __forceinline__ void meta_down(Frame& F) {
    const bf16* A = WSP(bf16, WS_META + MO_ACT); float* ssq1 = WSP(float, WS_META + MO_SSQ1); bf16* xn1 = WSP(bf16, WS_META + MO_XN1);
    LAS f32x4* red = (LAS f32x4*)(F.lds + 65536);
    for (int it = blockIdx.x; it < DM / 16; it += F.G) { const int c0 = 16 * it;
        __syncthreads();
        f32x4 a = (f32x4){0.f, 0.f, 0.f, 0.f};
        a = skinny16(A, DFF, WSP(bf16, WS_W1D) + (size_t)c0 * DFF, DFF, F.wave * (DFF / 8), (F.wave + 1) * (DFF / 8), F.lane, a);
        red[F.wave * 64 + F.lane] = a;
        __syncthreads();
        if (F.wave == 0) {
#pragma unroll
            for (int w = 1; w < 8; ++w) a += red[w * 64 + F.lane];
#pragma unroll
            for (int i = 0; i < 4; ++i) { const int row = 4 * (F.lane >> 4) + i, col = c0 + (F.lane & 15); const float o = F.in[1][row * DM + col] + 0.5f * a[i];
                xn1[row * DM + col] = (bf16)f2bf(o);
                float sq = o * o; sq += __shfl_xor(sq, 1); sq += __shfl_xor(sq, 2); sq += __shfl_xor(sq, 4); sq += __shfl_xor(sq, 8);
                if ((F.lane & 15) == 0) ssq1[row * 128 + it] = sq; } }
        __syncthreads();
    }
}
constexpr int NMETA_IT = NIN / 16, NDT_IT = MR / 16;
__device__ __forceinline__ void meta_inproj_and_dt(Frame& F, int it0, int it_end, int wstride) {
    const int nmeta = NMETA_IT;
    if (it0 < 0) return;
    for (int it = it0; it < it_end; it += wstride) {
        if (it < nmeta) {
            const float* ssq1 = WSP(float, WS_META + MO_SSQ1); float* um = WSP(float, WS_META + MO_U);
            float rs[4];
#pragma unroll
            for (int i = 0; i < 4; ++i) { const f32x4* pp = (const f32x4*)(ssq1 + (4 * (F.lane >> 4) + i) * 128 + 8 * (F.lane & 15)); const f32x4 v = pp[0] + pp[1]; float s2 = (v[0] + v[1]) + (v[2] + v[3]);
                s2 += __shfl_xor(s2, 1); s2 += __shfl_xor(s2, 2); s2 += __shfl_xor(s2, 4); s2 += __shfl_xor(s2, 8);
                rs[i] = __builtin_amdgcn_rsqf(s2 * (1.0f / 2048.0f) + EPS); }
            const int r0 = 16 * it;
            int c0;
            if (r0 >= NINP) c0 = r0; else { const int pn = r0 >> 8, rem = r0 & 255, bj = rem >> 7, wc = (rem & 127) >> 5, j = rem & 31; c0 = 256 * pn + 64 * wc + 32 * bj + j; }
            f32x4 a = (f32x4){0.f, 0.f, 0.f, 0.f};
            a = skinny16(WSP(bf16, WS_META + MO_XN1), DM, WSP(bf16, WS_WIN) + (size_t)r0 * DM, DM, 0, DM, F.lane, a);
#pragma unroll
            for (int i = 0; i < 4; ++i) um[(size_t)(4 * (F.lane >> 4) + i) * NIN + c0 + (F.lane & 15)] = a[i] * rs[i];
        } else {
            const int m0 = 16 * (it - nmeta);
            f32x4 a = (f32x4){0.f, 0.f, 0.f, 0.f};
            a = skinny16(WSP(bf16, WS_XN) + (size_t)m0 * DM, DM, WSP(bf16, WS_WIN) + (size_t)NINP * DM, DM, 0, DM, F.lane, a);
#pragma unroll
            for (int i = 0; i < 4; ++i) { const int row = m0 + 4 * (F.lane >> 4) + i; WSP(float, WS_DTR)[(size_t)row * 16 + (F.lane & 15)] = a[i] * pg8::row_rs(WSP(float, WS_SSQ1), 32, row); }
        }
    }
}


namespace att {
typedef float f32x16 __attribute__((ext_vector_type(16)));
typedef short s16x4 __attribute__((ext_vector_type(4)));
typedef short v4i16_t __attribute__((ext_vector_type(4)));
typedef float f32x2_t __attribute__((ext_vector_type(2))); typedef __bf16 bf16x2_t __attribute__((ext_vector_type(2)));
constexpr int STAGE = 32768, VOFF = 16384;
__device__ __forceinline__ int crow(int r, int hi) { return (r & 3) + 8 * (r >> 2) + 4 * hi; }
__device__ __forceinline__ unsigned cvtpk(float lo, float hi) { f32x2_t v = {lo, hi}; bf16x2_t b = __builtin_convertvector(v, bf16x2_t); return __builtin_bit_cast(unsigned, b); }
#define ATT_WAITBAR() asm volatile("s_waitcnt vmcnt(0) lgkmcnt(0)\n\ts_barrier" ::: "memory")
__device__ __forceinline__ void glds16(const void* gsrc, unsigned lds_dst) { unsigned keep;
    asm volatile("s_mov_b32 %0, m0\n\ts_mov_b32 m0, %2\n\ts_nop 0\n\tglobal_load_lds_dwordx4 %1, off\n\ts_mov_b32 m0, %0" : "=&s"(keep) : "v"(gsrc), "s"(lds_dst) : "memory"); }
#define ATT_DMA(src, dstoff) glds16((const void*)(src), (unsigned)__builtin_amdgcn_readfirstlane((int)(dstoff)))
#define ATT_MFMA(a, b, c) __builtin_amdgcn_mfma_f32_32x32x16_bf16((a), (b), (c), 0, 0, 0)
__device__ __forceinline__ float fadd_s(float a, float b) { float r; asm("v_add_f32 %0, %1, %2" : "=v"(r) : "v"(a), "v"(b)); return r; }

constexpr int KST = 16384, VST0 = 4 * KST, VSTB = 16384, WSF_OFF = VST0 + 3 * VSTB, STG_OFF = VST0, DUMMY_OFF = WSF_OFF + 1024;
constexpr int META_K_OFF = 126976, META_V_OFF = 135168;
__device__ __forceinline__ void attn_meta_tile(Frame& F, int bh) {
    LAS unsigned char* lds = F.lds; const int wave = F.wave, lane = F.lane, h = bh & 7;
    { const float* um = WSP(float, WS_META + MO_U);
      float mv[4];
#pragma unroll
      for (int i4 = 0; i4 < 4; ++i4) { const int itm = 4 * wave + i4; mv[i4] = um[(size_t)(itm >> 1) * NIN + 1024 + h * 128 + (itm & 1) * 64 + lane]; }
#pragma unroll
      for (int i4 = 0; i4 < 4; ++i4) { const int itm = 4 * wave + i4, p = itm >> 1, sh = itm & 1, d = lane;
          float v = mv[i4];
          const float r = __builtin_amdgcn_rsqf(wave_sum(v * v) * (1.0f / 64.0f) + EPS);
          v = v * r * F.in[9][d];
          const float pr = __shfl_xor(v, 8); const float* rp = WSP(float, WS_ROPE) + p * 16;
          if (d < 8) v = v * rp[d] - pr * rp[8 + d]; else if (d < 16) v = v * rp[d - 8] + pr * rp[d];
          const int dd = sh * 64 + d;
          *(LAS bf16*)(lds + META_K_OFF + p * 256 + (((dd >> 3) ^ p) << 4) + (dd & 7) * 2) = (bf16)f2bf(v); }
      { const int e = 4 * (wave * 64 + lane), key = e >> 7, d = e & 127; const f32x4 vv = *(const f32x4*)(um + (size_t)key * NIN + 2048 + h * 128 + d);
        u32x2v w2; w2.x = pk2(vv[0], vv[1]); w2.y = pk2(vv[2], vv[3]); *(LAS u32x2v*)(lds + META_V_OFF + (d >> 5) * 1024 + key * 64 + (d & 31) * 2) = w2; } }
}
__device__ __forceinline__ void attn_unit(Frame& F, int bh, int jq, float lam) {
    LAS unsigned char* lds = F.lds;
    const bf16* U = WSP(bf16, WS_ACT);
    int lane = F.lane; asm volatile("" : "+v"(lane));
    const int wave = F.wave, r32 = lane & 31, hi = lane >> 5;
    const int b = bh >> 3, h = bh & 7, rb = wave & 3, sub = wave >> 2;
    const int cw = 2 * jq + (rb >> 1);
    const int row0 = b * SEQ + 128 * jq + 32 * rb;
    const int T = 2 * jq + 2;
    const int kk0 = 8 * wave + (lane >> 4), kk1 = kk0 + 4;
    const bf16* kbase0 = U + (size_t)(b * SEQ + kk0) * NINP + 1024 + h * 128 + 8 * ((lane & 15) ^ (kk0 & 15));
    const bf16* kbase1 = U + (size_t)(b * SEQ + kk1) * NINP + 1024 + h * 128 + 8 * ((lane & 15) ^ (kk1 & 15));
    const int v0 = 2 * wave, v1 = 2 * wave + 1;
    const bf16* vbase0 = U + (size_t)(b * SEQ + 16 * (v0 & 3) + (lane >> 2)) * NINP + 2048 + h * 128 + 32 * (v0 >> 2) + 8 * (lane & 3);
    const bf16* vbase1 = U + (size_t)(b * SEQ + 16 * (v1 & 3) + (lane >> 2)) * NINP + 2048 + h * 128 + 32 * (v1 >> 2) + 8 * (lane & 3);
    const int kd0 = 2 * wave * 1024, kd1 = kd0 + 1024, vd0 = v0 * 1024, vd1 = v1 * 1024;
#define ATT_DMA_K(t, ks_) do { const size_t to_ = (size_t)(t) * 64 * NINP; ATT_DMA(kbase0 + to_, (ks_) + kd0); ATT_DMA(kbase1 + to_, (ks_) + kd1); } while (0)
#define ATT_DMA_V(t, vs_) do { const size_t to_ = (size_t)(t) * 64 * NINP; ATT_DMA(vbase0 + to_, (vs_) + vd0); ATT_DMA(vbase1 + to_, (vs_) + vd1); } while (0)
    ATT_DMA_K(0, 0); ATT_DMA_V(0, VST0); ATT_DMA_K(1, KST); ATT_DMA_V(1, VST0 + VSTB); if (T > 2) ATT_DMA_K(2, 2 * KST);
    bf16x8 qf[4];
#pragma unroll
    for (int ks = 0; ks < 4; ++ks) qf[ks] = *(const bf16x8*)(U + (size_t)(row0 + r32) * NINP + h * 128 + sub * 64 + 16 * ks + 8 * hi);
    f32x16 o[4];
#pragma unroll
    for (int d = 0; d < 4; ++d)
#pragma unroll
        for (int i = 0; i < 16; ++i) o[d][i] = 0.f;
    float lsum = 0.f;
    const f32x16 zero16 = {0.f, 0.f, 0.f, 0.f, 0.f, 0.f, 0.f, 0.f, 0.f, 0.f, 0.f, 0.f, 0.f, 0.f, 0.f, 0.f};
    const int koff = r32 * 256 + (((8 * sub + hi) ^ (r32 & 15)) << 4);
    const int voff = ((lane >> 4) & 1) * 32 + (lane & 3) * 8 + (4 * hi + ((lane & 15) >> 2)) * 64;
#define ATT_KF(kst_, half, ks) (*(const LAS bf16x8*)(lds + (kst_) + (half) * 8192 + (koff ^ ((ks) << 5))))
#define ATT_VTR(vst_, off) __builtin_bit_cast(s16x4, __builtin_amdgcn_ds_read_tr16_b64_v4i16((LAS v4i16_t*)(lds + (vst_) + voff + (off))))
    ATT_WAITBAR();
    f32x16 s0 = zero16, s1 = zero16;
    {
        f32x16 sc = zero16;
#pragma unroll
        for (int ks = 0; ks < 4; ++ks) sc = ATT_MFMA(ATT_KF(META_K_OFF, 0, ks), qf[ks], sc);
#pragma unroll
        for (int ks = 0; ks < 4; ++ks) { s0 = ATT_MFMA(ATT_KF(0, 0, ks), qf[ks], s0); s1 = ATT_MFMA(ATT_KF(0, 1, ks), qf[ks], s1); }
#pragma unroll
        for (int i = 0; i < 8; ++i) { sc[i] = __builtin_amdgcn_exp2f(sc[i]); lsum += sc[i]; }
        v4u pw; pw.x = cvtpk(sc[0], sc[1]); pw.y = cvtpk(sc[2], sc[3]); pw.z = cvtpk(sc[4], sc[5]); pw.w = cvtpk(sc[6], sc[7]);
        const bf16x8 pm = __builtin_bit_cast(bf16x8, pw);
#pragma unroll
        for (int d = 0; d < 4; ++d) { const s16x4 lo = ATT_VTR(META_V_OFF, d * 1024), hh = ATT_VTR(META_V_OFF, d * 1024 + 512);
            const bf16x8 vf = {lo[0], lo[1], lo[2], lo[3], hh[0], hh[1], hh[2], hh[3]};
            o[d] = ATT_MFMA(pm, vf, o[d]); }
    }
    ATT_WAITBAR();
    int vm0 = 0, vm2 = 2;
#define SBAR() __builtin_amdgcn_sched_barrier(0)
#define ATT_VTRP(vp_, off) __builtin_bit_cast(s16x4, __builtin_amdgcn_ds_read_tr16_b64_v4i16((LAS v4i16_t*)((vp_) + (off))))
#define ATT_VLOAD(buf, vst_, d, kp) do { _Pragma("unroll") for (int ks_ = 0; ks_ < 2; ++ks_) { vlo[buf][ks_] = ATT_VTRP(vst_, (d) * 4096 + (2 * (kp) + ks_) * 1024); vhi[buf][ks_] = ATT_VTRP(vst_, (d) * 4096 + (2 * (kp) + ks_) * 1024 + 512); } } while (0)
#define ATT_GQ(MF) do { MF; SBAR(); } while (0)
#define ATT_GS(NV, b4, PW, w0, w1) do { ls = (((ls + NV[b4]) + NV[b4 + 1]) + NV[b4 + 2]) + NV[b4 + 3];     PW[w0] = cvtpk(NV[b4], NV[b4 + 1]); PW[w1] = cvtpk(NV[b4 + 2], NV[b4 + 3]); } while (0)
#define ATT_GB(MF, NV, i0, GS) do { MF; NV[i0] = __builtin_amdgcn_exp2f(NV[i0]); NV[i0 + 1] = __builtin_amdgcn_exp2f(NV[i0 + 1]); GS; SBAR(); } while (0)
#define ATT_VF(buf, ks_) (bf16x8){vlo[buf][ks_][0], vlo[buf][ks_][1], vlo[buf][ks_][2], vlo[buf][ks_][3], vhi[buf][ks_][0], vhi[buf][ks_][1], vhi[buf][ks_][2], vhi[buf][ks_][3]}
#define ATT_STEP(C0, C1, C2, C3, D0, D1, D2, D3, tt) do { \
        const int t_ = (tt); const int knext = ((t_ + 1) & 3) * KST, kdst = ((t_ + 3) & 3) * KST, vdst = VST0 + vm2 * VSTB; \
        LAS unsigned char* vcur = lds + VST0 + vm0 * VSTB + voff; asm volatile("" : "+v"(vcur));     \
        const bool dk = t_ + 3 < T, dv = t_ + 2 < T; const size_t tok_ = dk ? (size_t)(t_ + 3) * 64 * NINP : 0, tov_ = dv ? (size_t)(t_ + 2) * 64 * NINP : 0; \
        const int dK0 = dk ? kdst + kd0 : DUMMY_OFF + wave * 1024, dK1 = dk ? kdst + kd1 : DUMMY_OFF + wave * 1024, dV0 = dv ? vdst + vd0 : DUMMY_OFF + wave * 1024, dV1 = dv ? vdst + vd1 : DUMMY_OFF + wave * 1024; \
        ATT_DMA(kbase0 + tok_, dK0); ATT_DMA(kbase1 + tok_, dK1); ATT_DMA(vbase0 + tov_, dV0); ATT_DMA(vbase1 + tov_, dV1); \
        if (t_ <= cw) { \
            bf16x8 kf[4]; s16x4 vlo[2][2], vhi[2][2]; f32x16 N0, N1; float ls = 0.f; \
            SBAR(); \
            kf[0] = ATT_KF(knext, 0, 0); kf[1] = ATT_KF(knext, 1, 0); kf[2] = ATT_KF(knext, 0, 1); kf[3] = ATT_KF(knext, 1, 1); SBAR(); \
            ATT_GQ(N0 = ATT_MFMA(kf[0], qf[0], zero16)); \
            ATT_GQ(N1 = ATT_MFMA(kf[1], qf[0], zero16)); \
            kf[0] = ATT_KF(knext, 0, 2); kf[1] = ATT_KF(knext, 1, 2); SBAR(); \
            ATT_GQ(N0 = ATT_MFMA(kf[2], qf[1], N0)); \
            ATT_GQ(N1 = ATT_MFMA(kf[3], qf[1], N1)); \
            kf[2] = ATT_KF(knext, 0, 3); kf[3] = ATT_KF(knext, 1, 3); SBAR(); \
            ATT_GQ(N0 = ATT_MFMA(kf[0], qf[2], N0)); \
            ATT_GQ(N1 = ATT_MFMA(kf[1], qf[2], N1)); \
            ATT_VLOAD(0, vcur, 0, 0); SBAR(); \
            ATT_GQ(N0 = ATT_MFMA(kf[2], qf[3], N0)); \
            ATT_GQ(N1 = ATT_MFMA(kf[3], qf[3], N1)); \
            const bf16x8 pf0 = __builtin_bit_cast(bf16x8, C0), pf1 = __builtin_bit_cast(bf16x8, C1), pf2 = __builtin_bit_cast(bf16x8, C2), pf3 = __builtin_bit_cast(bf16x8, C3); \
            ATT_VLOAD(1, vcur, 0, 1); SBAR(); \
            ATT_GB(o[0] = ATT_MFMA(pf0, ATT_VF(0, 0), o[0]), N0, 0, (void)0); ATT_GB(o[0] = ATT_MFMA(pf1, ATT_VF(0, 1), o[0]), N0, 2, (void)0); \
            ATT_VLOAD(0, vcur, 1, 0); SBAR(); \
            ATT_GB(o[0] = ATT_MFMA(pf2, ATT_VF(1, 0), o[0]), N0, 4, ATT_GS(N0, 0, D0, 0, 1)); ATT_GB(o[0] = ATT_MFMA(pf3, ATT_VF(1, 1), o[0]), N0, 6, (void)0); \
            ATT_VLOAD(1, vcur, 1, 1); SBAR(); \
            ATT_GB(o[1] = ATT_MFMA(pf0, ATT_VF(0, 0), o[1]), N0, 8, ATT_GS(N0, 4, D0, 2, 3)); ATT_GB(o[1] = ATT_MFMA(pf1, ATT_VF(0, 1), o[1]), N0, 10, (void)0); \
            ATT_VLOAD(0, vcur, 2, 0); SBAR(); \
            ATT_GB(o[1] = ATT_MFMA(pf2, ATT_VF(1, 0), o[1]), N0, 12, ATT_GS(N0, 8, D1, 0, 1)); ATT_GB(o[1] = ATT_MFMA(pf3, ATT_VF(1, 1), o[1]), N0, 14, (void)0); \
            ATT_VLOAD(1, vcur, 2, 1); SBAR(); \
            ATT_GB(o[2] = ATT_MFMA(pf0, ATT_VF(0, 0), o[2]), N1, 0, ATT_GS(N0, 12, D1, 2, 3)); ATT_GB(o[2] = ATT_MFMA(pf1, ATT_VF(0, 1), o[2]), N1, 2, (void)0); \
            ATT_VLOAD(0, vcur, 3, 0); SBAR(); \
            ATT_GB(o[2] = ATT_MFMA(pf2, ATT_VF(1, 0), o[2]), N1, 4, ATT_GS(N1, 0, D2, 0, 1)); ATT_GB(o[2] = ATT_MFMA(pf3, ATT_VF(1, 1), o[2]), N1, 6, (void)0); \
            ATT_VLOAD(1, vcur, 3, 1); SBAR(); \
            ATT_GB(o[3] = ATT_MFMA(pf0, ATT_VF(0, 0), o[3]), N1, 8, ATT_GS(N1, 4, D2, 2, 3)); ATT_GB(o[3] = ATT_MFMA(pf1, ATT_VF(0, 1), o[3]), N1, 10, (void)0); \
            ATT_GB(o[3] = ATT_MFMA(pf2, ATT_VF(1, 0), o[3]), N1, 12, ATT_GS(N1, 8, D3, 0, 1)); ATT_GB(o[3] = ATT_MFMA(pf3, ATT_VF(1, 1), o[3]), N1, 14, (void)0); \
            ATT_GS(N1, 12, D3, 2, 3); \
            lsum += (t_ < cw) ? ls : 0.f;     \
        } \
          \
        asm volatile("s_waitcnt vmcnt(4) lgkmcnt(0)\n\ts_barrier" ::: "memory"); \
        vm0 = (vm0 == 2) ? 0 : vm0 + 1; vm2 = (vm2 == 2) ? 0 : vm2 + 1; \
    } while (0)
    v4u pa0, pa1, pa2, pa3, pb0, pb1, pb2, pb3;
    pb0 = pb1 = pb2 = pb3 = (v4u){0u, 0u, 0u, 0u};
    {
#pragma unroll
        for (int i = 0; i < 16; ++i) { s0[i] = __builtin_amdgcn_exp2f(s0[i]); s1[i] = __builtin_amdgcn_exp2f(s1[i]); }
        float ls = 0.f;
        ATT_GS(s0, 0, pa0, 0, 1); ATT_GS(s0, 4, pa0, 2, 3); ATT_GS(s0, 8, pa1, 0, 1); ATT_GS(s0, 12, pa1, 2, 3);
        ATT_GS(s1, 0, pa2, 0, 1); ATT_GS(s1, 4, pa2, 2, 3); ATT_GS(s1, 8, pa3, 0, 1); ATT_GS(s1, 12, pa3, 2, 3);
        lsum += ls;
    }
    for (int t = 0; t < T; t += 2) { ATT_STEP(pa0, pa1, pa2, pa3, pb0, pb1, pb2, pb3, t); ATT_STEP(pb0, pb1, pb2, pb3, pa0, pa1, pa2, pa3, t + 1); }
    ATT_WAITBAR();
#undef ATT_STEP
#undef ATT_VLOAD
#undef ATT_GQ
#undef ATT_GS
#undef ATT_GB
#undef ATT_VF
#undef SBAR
    int le = lane; asm volatile("" : "+v"(le));
    const int r32e = le & 31, hie = le >> 5;
    lsum += __shfl_xor(lsum, 32);
    LAS float* wsf = (LAS float*)(lds + WSF_OFF + wave * 128);
    float wn[4];
#pragma unroll
    for (int d = 0; d < 4; ++d) wn[d] = F.in[14][32 * d + r32e];
    const float fac = (sub == 0 ? 1.0f : lam) / lsum;
    if (hie == 0) wsf[r32e] = fac;
    LDS_WAIT(); asm volatile("" ::: "memory");
    LAS float* xo = (LAS float*)(lds + (wave & 3) * 16384) + le;
    if (sub == 1) {
#pragma unroll
        for (int i = 0; i < 16; ++i) { const float f = wsf[crow(i, hie)];
#pragma unroll
            for (int d = 0; d < 4; ++d) xo[(d * 16 + i) * 64] = o[d][i] * f; }
    }
    ATT_WAITBAR();
    if (sub == 0) {
        LAS bf16* stg = (LAS bf16*)(lds + STG_OFF + wave * 8192);
#pragma unroll
        for (int d = 0; d < 4; ++d) wn[d] *= 0.8f;
#pragma unroll
        for (int i = 0; i < 16; ++i) { const int q = crow(i, hie); const float f1 = wsf[q];
            float v[4], ss = 0.f;
#pragma unroll
            for (int d = 0; d < 4; ++d) { v[d] = o[d][i] * f1 - xo[(d * 16 + i) * 64]; ss += v[d] * v[d]; }
            ss += __shfl_xor(ss, 1); ss += __shfl_xor(ss, 2); ss += __shfl_xor(ss, 4); ss += __shfl_xor(ss, 8); ss += __shfl_xor(ss, 16);
            const float r = __builtin_amdgcn_rsqf(ss * (1.0f / 128.0f) + EPS);
#pragma unroll
            for (int d = 0; d < 4; ++d) stg[q * 128 + 32 * d + r32e] = (bf16)(cvtpk(v[d] * r * wn[d], 0.f) & 0xffffu); }
        LDS_WAIT(); asm volatile("" ::: "memory");
#pragma unroll
        for (int it = 0; it < 8; ++it) { const int q = 4 * it + (le >> 4), ch = le & 15;
            const v4u val = *(const LAS v4u*)(stg + q * 128 + 8 * ch);
            *(v4u*)(WSP(bf16, WS_MIX) + (size_t)(row0 + q) * DM + 1024 + h * 128 + 8 * ch) = val; }
    }
    ATT_WAITBAR();
#undef ATT_DMA_K
#undef ATT_DMA_V
#undef ATT_KF
#undef ATT_VTR
}
}


namespace ssd {
constexpr int S64 = 144, S128 = 272;
constexpr int O_CC = 0, O_BC = 17408, O_BT = 34816, O_XT = 53248, O_XS = 62464, O_XC = 71680, O_M = 80896, O_SI = 90112, O_SC = 107520;
#define SSD_MF(a, b, c) __builtin_amdgcn_mfma_f32_16x16x32_bf16((a), (b), (c), 0, 0, 0)
#define SSD_FRAG(img, stride, row, k) (*(const LAS bf16x8*)(lds + (img) + (row) * (stride) + 2 * (k)))
#define SSD_BAR() do { asm volatile("s_waitcnt vmcnt(0) lgkmcnt(0)" ::: "memory"); __builtin_amdgcn_s_barrier(); asm volatile("" ::: "memory"); } while (0)

__device__ __forceinline__ v4u pack8(const float (&v)[8]) { v4u o; o.x = pk2(v[0], v[1]); o.y = pk2(v[2], v[3]); o.z = pk2(v[4], v[5]); o.w = pk2(v[6], v[7]); return o; }
__device__ __forceinline__ unsigned bfe16(const v4u& r, int e) { const unsigned w = (e < 2) ? r.x : (e < 4) ? r.y : (e < 6) ? r.z : r.w; return (e & 1) ? (w >> 16) : (w & 0xffffu); }

template <bool PASSB>
__device__ __forceinline__ void ssd_item(Frame& F, int item, int& bgj) {
    LAS unsigned char* lds = F.lds;
    int lane0 = F.lane; asm volatile("" : "+v"(lane0));
    const int wave = F.wave;
    const int k = item & 7, hd = (item >> 3) & 15, b = item >> 7, g = hd >> 3;
    const float Ah = -__expf(F.in[18][hd]), Dk = F.in[19][hd];
    LAS float* sc = (LAS float*)(lds + O_SC);
    const int pt = wave >> 1, nb = 4 * (wave & 1);
    f32x4 stt[4];
#pragma unroll
    for (int j = 0; j < 4; ++j) stt[j] = (f32x4){0.f, 0.f, 0.f, 0.f};
    float* sst = WSP(float, WS_SST) + (size_t)((b * SH + hd) * 8) * 8192;
    float* atot = WSP(float, WS_ATOT) + (b * SH + hd) * 8;
    if (PASSB) {
        const int fr = lane0 & 15, fq = lane0 >> 4;
        for (int kk = 0; kk < k; ++kk) { const float dec = __expf(atot[kk]);
#pragma unroll
            for (int j = 0; j < 4; ++j) { const f32x4 s = *(const f32x4*)(sst + (size_t)kk * 8192 + (16 * pt + fr) * 128 + 16 * (nb + j) + 4 * fq); stt[j] = stt[j] * dec + s; } }
    }
    float asum = 0.f;
    const int c_lo = (k == 0) ? 0 : 8 * k + 1, c_hi = 8 * k + 8;
    const int role = (wave < 2) ? 0 : (wave < 4) ? 1 : (wave < 6 && PASSB) ? 2 : 3;
    v4u raw[8]; float dtv = 0.f;
    { const int li = (wave * 64 + lane0) & 127, cg = (role == 0) ? (li & 7) : (li & 15), l0 = (role == 0) ? 4 * (li >> 3) : 8 * (li >> 4);
      if (role == 0) { const bf16* src = WSP(bf16, WS_XS) + (size_t)(b * LPAD + 64 * c_lo + l0) * 1024 + hd * 64 + 8 * cg;
#pragma unroll
          for (int i = 0; i < 4; ++i) raw[i] = *(const v4u*)(src + (size_t)i * 1024); }
      else if (role < 3) { const bf16* src = WSP(bf16, WS_BC) + (size_t)(b * LPAD + 64 * c_lo + l0) * 512 + (role == 2 ? 256 : 0) + g * 128 + 8 * cg;
#pragma unroll
          for (int i = 0; i < 8; ++i) raw[i] = *(const v4u*)(src + (size_t)i * 512); }
      if (wave == 7) dtv = WSP(float, WS_DT)[(size_t)(b * LPAD + 64 * c_lo + lane0) * 16 + hd]; }
    for (int c = c_lo; c <= c_hi; ++c) {
        int lane = lane0; asm volatile("" : "+v"(lane));
        const int tid = wave * 64 + lane, fr = lane & 15, fq = lane >> 4, li = tid & 127;
        const int cg = (role == 0) ? (li & 7) : (li & 15), l0 = (role == 0) ? 4 * (li >> 3) : 8 * (li >> 4);
        u32x2v zv[2];
        if (PASSB && c >= 1) {
#pragma unroll
            for (int j = 0; j < 2; ++j) zv[j] = *(const u32x2v*)(WSP(bf16, WS_ACT) + (size_t)(b * SEQ + 64 * (c - 1) + 16 * pt + fr) * NINP + 3072 + hd * 64 + 16 * (2 * (wave & 1) + j) + 4 * fq);
        }
        const int cn = (c < c_hi) ? c + 1 : c;
        f32x4 cv[8]; TItem ct; bool chave = false; int chh = 0;
        if (role == 0) {
            if (PASSB) {
#pragma unroll
                for (int i = 0; i < 4; ++i) *(LAS v4u*)(lds + O_XC + (l0 + i) * S64 + 16 * cg) = raw[i]; }
#pragma unroll
            for (int e = 0; e < 8; ++e) { u32x2v w2; w2.x = bfe16(raw[0], e) | (bfe16(raw[1], e) << 16); w2.y = bfe16(raw[2], e) | (bfe16(raw[3], e) << 16); *(LAS u32x2v*)(lds + O_XT + (8 * cg + e) * S64 + 2 * l0) = w2; }
            const bf16* src = WSP(bf16, WS_XS) + (size_t)(b * LPAD + 64 * cn + l0) * 1024 + hd * 64 + 8 * cg;
#pragma unroll
            for (int i = 0; i < 4; ++i) raw[i] = *(const v4u*)(src + (size_t)i * 1024);
        } else if (role == 1) {
            if (PASSB) {
#pragma unroll
                for (int i = 0; i < 8; ++i) *(LAS v4u*)(lds + O_BC + (l0 + i) * S128 + 16 * cg) = raw[i]; }
#pragma unroll
            for (int e = 0; e < 8; ++e) { v4u w4; w4.x = bfe16(raw[0], e) | (bfe16(raw[1], e) << 16); w4.y = bfe16(raw[2], e) | (bfe16(raw[3], e) << 16); w4.z = bfe16(raw[4], e) | (bfe16(raw[5], e) << 16); w4.w = bfe16(raw[6], e) | (bfe16(raw[7], e) << 16);
                *(LAS v4u*)(lds + O_BT + (8 * cg + e) * S64 + 2 * l0) = w4; }
            const bf16* src = WSP(bf16, WS_BC) + (size_t)(b * LPAD + 64 * cn + l0) * 512 + g * 128 + 8 * cg;
#pragma unroll
            for (int i = 0; i < 8; ++i) raw[i] = *(const v4u*)(src + (size_t)i * 512);
        } else if (role == 2) {
#pragma unroll
            for (int i = 0; i < 8; ++i) *(LAS v4u*)(lds + O_CC + (l0 + i) * S128 + 16 * cg) = raw[i];
            const bf16* src = WSP(bf16, WS_BC) + (size_t)(b * LPAD + 64 * cn + l0) * 512 + 256 + g * 128 + 8 * cg;
#pragma unroll
            for (int i = 0; i < 8; ++i) raw[i] = *(const v4u*)(src + (size_t)i * 512);
        }
        if (wave == 7) {
            const float dt = dtv;
            dtv = WSP(float, WS_DT)[(size_t)(b * LPAD + 64 * cn + lane) * 16 + hd];
            float a = dt * Ah;
#pragma unroll
            for (int o2 = 1; o2 < 64; o2 <<= 1) { const float t = __shfl_up(a, o2); if (lane >= o2) a += t; }
            const float aend = __shfl(a, 63);
            sc[lane] = dt; sc[64 + lane] = a; sc[128 + lane] = dt * __expf(aend - a);
            if (lane == 0) sc[192] = aend;
        }
        if (PASSB && F.NGW == 2048) { const int hix = bgj * 2048 + F.gw, cit = IT_BG + (hix >> 1); chh = hix & 1; chave = bgj < 8 && cit < IT_END; ++bgj;
            if (chave) { ct = mk_item(F, cit); transpose_load_h(ct, lane, chh, cv); } }
        asm volatile("s_waitcnt lgkmcnt(0)" ::: "memory"); __builtin_amdgcn_s_barrier(); asm volatile("" ::: "memory");
        const float aend = sc[192];
        for (int amp2_ = 0; amp2_ < (MK_AMP == 2 ? 3 : 1); ++amp2_) {
        { const int p = tid >> 3, lg = (tid & 7) * 8;
          const v4u xv = *(const LAS v4u*)(lds + O_XT + p * S64 + 2 * lg); const unsigned xw[4] = {xv.x, xv.y, xv.z, xv.w}; float v[8];
#pragma unroll
          for (int e = 0; e < 4; ++e) { v[2 * e] = bf2f(xw[e] & 0xffffu) * sc[128 + lg + 2 * e]; v[2 * e + 1] = bf2f(xw[e] >> 16) * sc[128 + lg + 2 * e + 1]; }
          *(LAS v4u*)(lds + O_XS + p * S64 + 2 * lg) = pack8(v); }
        if (PASSB) {
#pragma unroll
            for (int j = 0; j < 4; ++j) { u32x2v w2; w2.x = pk2(stt[j][0], stt[j][1]); w2.y = pk2(stt[j][2], stt[j][3]); *(LAS u32x2v*)(lds + O_SI + (16 * pt + fr) * S128 + 2 * (16 * (nb + j) + 4 * fq)) = w2; }
            const int l = 16 * pt + fr; const float al = sc[64 + l];
#pragma unroll
            for (int j = 0; j < 2; ++j) { const int st = 2 * (wave & 1) + j; f32x4 acc = (f32x4){0.f, 0.f, 0.f, 0.f};
                if (st <= pt) {
#pragma unroll
                    for (int ks = 0; ks < 4; ++ks) acc = SSD_MF(SSD_FRAG(O_BC, S128, 16 * st + fr, 32 * ks + 8 * fq), SSD_FRAG(O_CC, S128, l, 32 * ks + 8 * fq), acc);
                    asm volatile("s_nop 15\n\ts_nop 3" : "+v"(acc)); }
                float m[4];
#pragma unroll
                for (int i = 0; i < 4; ++i) { const int s = 16 * st + 4 * fq + i; m[i] = (s <= l) ? acc[i] * __expf(al - sc[64 + s]) * sc[s] : 0.f; }
                u32x2v w2; w2.x = pk2(m[0], m[1]); w2.y = pk2(m[2], m[3]); *(LAS u32x2v*)(lds + O_M + l * S64 + 2 * (16 * st + 4 * fq)) = w2; }
        }
        }
        asm volatile("s_waitcnt lgkmcnt(0)" ::: "memory"); __builtin_amdgcn_s_barrier(); asm volatile("" ::: "memory");
        for (int amp3_ = 0; amp3_ < (MK_AMP == 3 ? 3 : 1); ++amp3_) {
        if (PASSB && c >= 1) {
            const int l = 16 * pt + fr, row = b * SEQ + 64 * (c - 1) + l; const float el = __expf(sc[64 + l]);
            float sq = 0.f;
#pragma unroll
            for (int j = 0; j < 2; ++j) { const int ptile = 2 * (wave & 1) + j; f32x4 acc = (f32x4){0.f, 0.f, 0.f, 0.f};
#pragma unroll
                for (int ks = 0; ks < 4; ++ks) acc = SSD_MF(SSD_FRAG(O_SI, S128, 16 * ptile + fr, 32 * ks + 8 * fq), SSD_FRAG(O_CC, S128, l, 32 * ks + 8 * fq), acc);
                acc = acc * el;
#pragma unroll
                for (int ks = 0; ks < 2; ++ks) acc = SSD_MF(SSD_FRAG(O_XT, S64, 16 * ptile + fr, 32 * ks + 8 * fq), SSD_FRAG(O_M, S64, l, 32 * ks + 8 * fq), acc);
                const int pc = 16 * ptile + 4 * fq;
                const u32x2v xv = *(const LAS u32x2v*)(lds + O_XC + l * S64 + 2 * pc);
                float y[4];
                y[0] = (acc[0] + Dk * bf2f(xv.x & 0xffffu)) * silu1(bf2f(zv[j].x & 0xffffu)); y[1] = (acc[1] + Dk * bf2f(xv.x >> 16)) * silu1(bf2f(zv[j].x >> 16));
                y[2] = (acc[2] + Dk * bf2f(xv.y & 0xffffu)) * silu1(bf2f(zv[j].y & 0xffffu)); y[3] = (acc[3] + Dk * bf2f(xv.y >> 16)) * silu1(bf2f(zv[j].y >> 16));
                sq += (y[0] * y[0] + y[1] * y[1]) + (y[2] * y[2] + y[3] * y[3]);
                u32x2v w2; w2.x = pk2(y[0], y[1]); w2.y = pk2(y[2], y[3]);
                *(u32x2v*)(WSP(bf16, WS_MIX) + (size_t)row * DM + hd * 64 + pc) = w2; }
            sq += __shfl_xor(sq, 16); sq += __shfl_xor(sq, 32);
            if (fq == 0) WSP(float, WS_SSQS)[(size_t)row * 32 + 2 * hd + (wave & 1)] = sq;
        }
        }
        { const float dec = __expf(aend);
#pragma unroll
          for (int j = 0; j < 4; ++j) { f32x4 acc = stt[j] * dec;
#pragma unroll
              for (int ks = 0; ks < 2; ++ks) acc = SSD_MF(SSD_FRAG(O_BT, S64, 16 * (nb + j) + fr, 32 * ks + 8 * fq), SSD_FRAG(O_XS, S64, 16 * pt + fr, 32 * ks + 8 * fq), acc);
              stt[j] = acc; } }
        asum += aend;
        if (PASSB) { if (chave) transpose_finish_h(ct, lane, chh, cv); }
        asm volatile("s_waitcnt lgkmcnt(0)" ::: "memory"); __builtin_amdgcn_s_barrier(); asm volatile("" ::: "memory");
    }
    if (!PASSB) { const int fr = lane0 & 15, fq = lane0 >> 4;
#pragma unroll
        for (int j = 0; j < 4; ++j) *(f32x4*)(sst + (size_t)k * 8192 + (16 * pt + fr) * 128 + 16 * (nb + j) + 4 * fq) = stt[j];
        if (wave == 0 && lane0 == 0) atot[k] = asum;
    }
}

constexpr int A_XS0 = 0, A_XS1 = 9216, A_BT0 = 18432, A_BT1 = 36864, A_W = 55296, A_ACS = 57600, A_DT = 59904, A_TOT = 62208;
__device__ __forceinline__ void ssd_pass_a(Frame& F, int item) {
    LAS unsigned char* lds = F.lds;
    int lane = F.lane; asm volatile("" : "+v"(lane));
    const int wave = F.wave, tid = wave * 64 + lane, fr = lane & 15, fq = lane >> 4;
    const int k = item & 7, hd = (item >> 3) & 15, b = item >> 7, g = hd >> 3;
    const float Ah = -__expf(F.in[18][hd]);
    const int c_lo = (k == 0) ? 0 : 8 * k + 1, c_hi = 8 * k + 8, nt = c_hi - c_lo + 1;
    const int pt = wave >> 1, nb = 4 * (wave & 1);
    const int role = (wave < 2) ? 0 : (wave < 4) ? 1 : 3;
    const int li = tid & 127, cg = (role == 0) ? (li & 7) : (li & 15), l0 = (role == 0) ? 4 * (li >> 3) : 8 * (li >> 4);
    LAS float* wl = (LAS float*)(lds + A_W); LAS float* acs = (LAS float*)(lds + A_ACS); LAS float* dts = (LAS float*)(lds + A_DT); LAS float* tot = (LAS float*)(lds + A_TOT);
    v4u raw[8];
    { if (role == 0) { const bf16* src = WSP(bf16, WS_XS) + (size_t)(b * LPAD + 64 * c_lo + l0) * 1024 + hd * 64 + 8 * cg;
#pragma unroll
          for (int i = 0; i < 4; ++i) raw[i] = *(const v4u*)(src + (size_t)i * 1024); }
      else if (role == 1) { const bf16* src = WSP(bf16, WS_BC) + (size_t)(b * LPAD + 64 * c_lo + l0) * 512 + g * 128 + 8 * cg;
#pragma unroll
          for (int i = 0; i < 8; ++i) raw[i] = *(const v4u*)(src + (size_t)i * 512); } }
    for (int t = wave; t < nt; t += NWAVES) {
        const float dt = WSP(float, WS_DT)[(size_t)(b * LPAD + 64 * (c_lo + t) + lane) * 16 + hd];
        float a = dt * Ah;
#define SSD_DPP_ADD(ctrl, rmask) a += __builtin_bit_cast(float, __builtin_amdgcn_update_dpp(0, __builtin_bit_cast(int, a), (ctrl), (rmask), 0xf, false))
        SSD_DPP_ADD(0x111, 0xf); SSD_DPP_ADD(0x112, 0xf); SSD_DPP_ADD(0x114, 0xf); SSD_DPP_ADD(0x118, 0xf); SSD_DPP_ADD(0x142, 0xa); SSD_DPP_ADD(0x143, 0xc);
#undef SSD_DPP_ADD
        acs[t * 64 + lane] = a; dts[t * 64 + lane] = dt; if (lane == 63) tot[t] = a;
    }
    asm volatile("s_waitcnt lgkmcnt(0)" ::: "memory"); __builtin_amdgcn_s_barrier(); asm volatile("" ::: "memory");
    float atotal = 0.f;
    { float tv[9];
#pragma unroll
      for (int t = 0; t < 9; ++t) { tv[t] = (t < nt) ? tot[t] : 0.f; atotal += tv[t]; }
      for (int t = wave; t < nt; t += NWAVES) { float off = 0.f;
#pragma unroll
          for (int u = 0; u < 9; ++u) off += (u < t) ? tv[u] : 0.f;
          wl[t * 64 + lane] = dts[t * 64 + lane] * __expf(atotal - (off + acs[t * 64 + lane])); } }
    f32x4 stt[4];
#pragma unroll
    for (int j = 0; j < 4; ++j) stt[j] = (f32x4){0.f, 0.f, 0.f, 0.f};
    asm volatile("s_waitcnt lgkmcnt(0)" ::: "memory"); __builtin_amdgcn_s_barrier(); asm volatile("" ::: "memory");
    for (int t = 0; t < nt; ++t) {
        const int xs_img = (t & 1) ? A_XS1 : A_XS0, bt_img = (t & 1) ? A_BT1 : A_BT0;
        const int cn = c_lo + ((t + 1 < nt) ? t + 1 : t);
        if (role == 0) {
            const f32x4 w4 = *(const LAS f32x4*)(wl + t * 64 + l0);
#pragma unroll
            for (int e = 0; e < 8; ++e) { u32x2v w2;
                w2.x = pk2(bf2f(bfe16(raw[0], e)) * w4[0], bf2f(bfe16(raw[1], e)) * w4[1]); w2.y = pk2(bf2f(bfe16(raw[2], e)) * w4[2], bf2f(bfe16(raw[3], e)) * w4[3]);
                *(LAS u32x2v*)(lds + xs_img + (8 * cg + e) * S64 + 2 * l0) = w2; }
            const bf16* src = WSP(bf16, WS_XS) + (size_t)(b * LPAD + 64 * cn + l0) * 1024 + hd * 64 + 8 * cg;
#pragma unroll
            for (int i = 0; i < 4; ++i) raw[i] = *(const v4u*)(src + (size_t)i * 1024);
        } else if (role == 1) {
#pragma unroll
            for (int e = 0; e < 8; ++e) { v4u w4; w4.x = bfe16(raw[0], e) | (bfe16(raw[1], e) << 16); w4.y = bfe16(raw[2], e) | (bfe16(raw[3], e) << 16); w4.z = bfe16(raw[4], e) | (bfe16(raw[5], e) << 16); w4.w = bfe16(raw[6], e) | (bfe16(raw[7], e) << 16);
                *(LAS v4u*)(lds + bt_img + (8 * cg + e) * S64 + 2 * l0) = w4; }
            const bf16* src = WSP(bf16, WS_BC) + (size_t)(b * LPAD + 64 * cn + l0) * 512 + g * 128 + 8 * cg;
#pragma unroll
            for (int i = 0; i < 8; ++i) raw[i] = *(const v4u*)(src + (size_t)i * 512);
        }
        asm volatile("s_waitcnt lgkmcnt(0)" ::: "memory"); __builtin_amdgcn_s_barrier(); asm volatile("" ::: "memory");
#pragma unroll
        for (int j = 0; j < 4; ++j) { f32x4 acc = stt[j];
#pragma unroll
            for (int ks = 0; ks < 2; ++ks) acc = SSD_MF(SSD_FRAG(bt_img, S64, 16 * (nb + j) + fr, 32 * ks + 8 * fq), SSD_FRAG(xs_img, S64, 16 * pt + fr, 32 * ks + 8 * fq), acc);
            stt[j] = acc; }
    }
    float* sst = WSP(float, WS_SST) + (size_t)((b * SH + hd) * 8) * 8192;
#pragma unroll
    for (int j = 0; j < 4; ++j) *(f32x4*)(sst + (size_t)k * 8192 + (16 * pt + fr) * 128 + 16 * (nb + j) + 4 * fq) = stt[j];
    if (wave == 0 && lane == 0) WSP(float, WS_ATOT)[(b * SH + hd) * 8 + k] = atotal;
    asm volatile("s_waitcnt lgkmcnt(0)" ::: "memory"); __builtin_amdgcn_s_barrier(); asm volatile("" ::: "memory");
}
}

struct ConvItem { int c, pp, b, p; v4u rv[4]; bool fast; };
__device__ __forceinline__ void conv_issue(Frame& F, int it, ConvItem& q) {
    const bf16* U = WSP(bf16, WS_ACT); const float* um = WSP(float, WS_META + MO_U);
    const int cg = it % (CONVD / 8); q.pp = (it / (CONVD / 8)) % LPAD; q.b = it / ((CONVD / 8) * LPAD); q.c = 8 * cg; q.p = q.pp - PPAD;
#pragma unroll
    for (int w = 0; w < 4; ++w) q.rv[w] = (v4u){0u, 0u, 0u, 0u};
    if (q.p >= 0) {
        if (q.p - 3 >= NMETA) { const bf16* src = U + (size_t)(q.b * SEQ + q.p - 3 - NMETA) * NINP + 4096 + q.c;
#pragma unroll
            for (int w = 0; w < 4; ++w) q.rv[w] = *(const v4u*)(src + (size_t)w * NINP); }
        else {
#pragma unroll
            for (int w = 0; w < 4; ++w) { const int ps = q.p - 3 + w; v4u v = (v4u){0u, 0u, 0u, 0u};
                if (ps >= NMETA) v = *(const v4u*)(U + (size_t)(q.b * SEQ + ps - NMETA) * NINP + 4096 + q.c);
                else if (ps >= 0) { const f32x4 r0 = *(const f32x4*)(um + (size_t)ps * NIN + 4096 + q.c), r1 = *(const f32x4*)(um + (size_t)ps * NIN + 4096 + q.c + 4);
                    v.x = pk2(r0[0], r0[1]); v.y = pk2(r0[2], r0[3]); v.z = pk2(r1[0], r1[1]); v.w = pk2(r1[2], r1[3]); }
                q.rv[w] = v; } }
    }
}
__device__ __forceinline__ void conv_finish(Frame& F, const ConvItem& q) {
    const float* cw = F.in[15]; const float* cb = F.in[16]; const int c = q.c;
    float a[8];
#pragma unroll
    for (int e = 0; e < 8; ++e) a[e] = 0.f;
    if (q.p >= 0) {
        const f32x4 b0 = *(const f32x4*)(cb + c), b1 = *(const f32x4*)(cb + c + 4);
        a[0] = b0[0]; a[1] = b0[1]; a[2] = b0[2]; a[3] = b0[3]; a[4] = b1[0]; a[5] = b1[1]; a[6] = b1[2]; a[7] = b1[3];
#pragma unroll
        for (int w = 0; w < 4; ++w) { const f32x4 w0 = *(const f32x4*)(cw + w * CONVD + c), w1 = *(const f32x4*)(cw + w * CONVD + c + 4);
            a[0] += bf2f(q.rv[w].x & 0xffffu) * w0[0]; a[1] += bf2f(q.rv[w].x >> 16) * w0[1]; a[2] += bf2f(q.rv[w].y & 0xffffu) * w0[2]; a[3] += bf2f(q.rv[w].y >> 16) * w0[3];
            a[4] += bf2f(q.rv[w].z & 0xffffu) * w1[0]; a[5] += bf2f(q.rv[w].z >> 16) * w1[1]; a[6] += bf2f(q.rv[w].w & 0xffffu) * w1[2]; a[7] += bf2f(q.rv[w].w >> 16) * w1[3]; }
#pragma unroll
        for (int e = 0; e < 8; ++e) a[e] = silu1(a[e]);
    }
    v4u o; o.x = pk2(a[0], a[1]); o.y = pk2(a[2], a[3]); o.z = pk2(a[4], a[5]); o.w = pk2(a[6], a[7]);
    if (c < 1024) *(v4u*)(WSP(bf16, WS_XS) + (size_t)(q.b * LPAD + q.pp) * 1024 + c) = o;
    else *(v4u*)(WSP(bf16, WS_BC) + (size_t)(q.b * LPAD + q.pp) * 512 + (c - 1024)) = o;
}
__device__ __forceinline__ void p4_conv(Frame& F) {
    const float* um = WSP(float, WS_META + MO_U);
    const int gt = F.gw * 64 + F.lane, NT = F.NGW * 64, NITEM = NBATCH * LPAD * (CONVD / 8);
    for (int it = gt; it < NITEM; it += 3 * NT) {
        ConvItem q0, q1, q2; const int i1 = it + NT, i2 = it + 2 * NT;
        conv_issue(F, it, q0); if (i1 < NITEM) conv_issue(F, i1, q1); if (i2 < NITEM) conv_issue(F, i2, q2);
        conv_finish(F, q0); if (i1 < NITEM) conv_finish(F, q1); if (i2 < NITEM) conv_finish(F, q2);
    }
    for (int it = gt; it < NBATCH * LPAD * SH; it += NT) { const int hd = it & 15, pp = (it >> 4) % LPAD, b = (it >> 4) / LPAD, p = pp - PPAD;
        float v = 0.f;
        if (p >= 0) { const float x = (p < NMETA ? um[(size_t)p * NIN + NINP + hd] : WSP(float, WS_DTR)[(size_t)(b * SEQ + p - NMETA) * 16 + hd]) + F.in[17][hd];
            v = fmaxf(x, 0.f) + log1pf(__expf(-fabsf(x))); }
        WSP(float, WS_DT)[it] = v; }
}
__device__ __forceinline__ void p4_mixer_attn(Frame& F) {
    p4_conv(F);
    float lam; { const float s1 = wave_sum(F.in[10][F.lane] * F.in[11][F.lane]), s2 = wave_sum(F.in[12][F.lane] * F.in[13][F.lane]); lam = __expf(s1) - __expf(s2) + 0.2f; }
    lam = __builtin_bit_cast(float, __builtin_amdgcn_readfirstlane(__builtin_bit_cast(int, lam)));
    for (int r_ = 0; r_ < (MK_REPEAT_PHASE == 41 ? 2 : 1); ++r_)
    for (int u = blockIdx.x; u < NBATCH * NHEAD * 16; u += F.G) { const int bh = (u & 7) * 2 + ((u >> 3) >> 4), idx = (u >> 3) & 15;
        att::attn_meta_tile(F, bh); att::attn_unit(F, bh, idx, lam); att::attn_unit(F, bh, 31 - idx, lam); }
}
__device__ __forceinline__ void p5_ssd_a(Frame& F) { for (int it = blockIdx.x; it < NBATCH * SH * 8; it += F.G) ssd::ssd_pass_a(F, it); }
__device__ __forceinline__ void p6_ssd_b(Frame& F) { int bgj = 0; for (int it = blockIdx.x; it < NBATCH * SH * 8; it += F.G) ssd::ssd_item<true>(F, it, bgj);
    if (F.NGW != 2048) convert_items(F, IT_BG, IT_END, F.gw, F.NGW); }
struct Args { const float* in[26]; float* out; unsigned char* ws; int ph_lo, ph_hi; };
__global__ void __launch_bounds__(NWAVES * 64, 2) hymba_fwd(Args args) {
    extern __shared__ __attribute__((aligned(16))) unsigned char lds[];
    Frame F;
    F.lds = (LAS unsigned char*)lds;
    F.tid = threadIdx.x; F.lane = F.tid & 63; F.wave = __builtin_amdgcn_readfirstlane(F.tid >> 6);
    F.G = gridDim.x; F.gw = blockIdx.x * NWAVES + F.wave; F.NGW = F.G * NWAVES;
#pragma unroll
    for (int i = 0; i < 26; ++i) F.in[i] = args.in[i];
    F.out = args.out; F.ws = args.ws; F.inp = args.in;
    volatile LAS unsigned* MISC = (volatile LAS unsigned*)(F.lds + MISC_OFF);
    for (int u = F.tid; u < 128; u += NWAVES * 64) MISC[u] = 0u;
    __syncthreads();
    XcdBarrier bar; bar.bar = (unsigned*)(F.ws + WS_CTL) + CW_BAR; bar.x = 0; bar.st = nullptr;
    if (N_LAUNCHES == 1) bar = xcd_barrier_post((unsigned*)(F.ws + WS_CTL) + CW_BAR, MISC + 8);
    const int lo = args.ph_lo, hi = args.ph_hi;
#define IN(k) (lo <= (k) && (k) < hi)
#ifndef MK_REPEAT_PHASE
#define MK_REPEAT_PHASE -1
#endif
#define REPS(k) for (int rep_ = 0; rep_ < ((k) == MK_REPEAT_PHASE ? 2 : 1); ++rep_)
#define REPBAR(k) do { if ((k) == MK_REPEAT_PHASE && rep_ == 0) xcd_barrier(bar); } while (0)
#define SEAM(k) do { if (IN(k) && IN((k) + 1)) xcd_barrier(bar); } while (0)
    using pg8::Gemm; using pg8::StaticOrder;
    LAS unsigned char* ring = F.lds + RING_OFF;

    if (IN(0)) { REPS(0) { p0_prologue(F); REPBAR(0); } SEAM(0); }
    if (IN(1)) {
        Gemm g{WSP(bf16, WS_XN), WSP(bf16, WS_W1GU), MR, NGU, DM}; StaticOrder S; S.init(MR, NGU, F.G, (int)blockIdx.x);
        pg8::Unit u0{0, 0}; (void)S.next(0, u0);
        pg8::EpiSwiGLU E{WSP(bf16, WS_ACT), DFF, WSP(float, WS_SSQ0), 1, build_rs_table(F, WSP(float, WS_SSQ0), 1, 1.0f / 2048.0f, u0.pm)};
        REPS(1) { pg8::gemm_phase<pg8::EpiSwiGLU, StaticOrder, true, true>(ring, g, S, E); REPBAR(1); }
        { const int first = S.nwg % F.G, nsl = F.G - first;
          const int w0 = (int)blockIdx.x >= first ? ((int)blockIdx.x - first) * NWAVES + F.wave : -1;
          meta_gateup(F, w0, nsl * NWAVES);
          constexpr int NMW = DFF / 16;
          convert_items(F, IT_CUT0, IT_BG, w0 >= NMW ? w0 - NMW : -1, nsl * NWAVES - NMW); }
        SEAM(1);
    }
    if (IN(2)) {
        meta_down(F);
        Gemm g{WSP(bf16, WS_ACT), WSP(bf16, WS_W1D), MR, DM, DFF}; StaticOrder S; S.init(MR, DM, F.G, (int)blockIdx.x);
        pg8::EpiResT<false> E{F.in[0], nullptr, nullptr, WSP(bf16, WS_XN), WSP(float, WS_SSQ1), 0.5f, DM, nullptr, 0, pg8::RsTable{nullptr, -1, -1}};
        REPS(2) { pg8::gemm_phase<pg8::EpiResT<false>, StaticOrder, true, true>(ring, g, S, E); REPBAR(2); }
        SEAM(2);
    }
    if (IN(3)) {
        Gemm g{WSP(bf16, WS_XN), WSP(bf16, WS_WIN), MR, NINP, DM}; StaticOrder S; S.init(MR, NINP, F.G, (int)blockIdx.x);
        pg8::Unit u0{0, 0}; (void)S.next(0, u0);
        pg8::EpiInProj E{WSP(bf16, WS_ACT), NINP, WSP(float, WS_SSQ1), F.in[8], F.in[9], WSP(float, WS_ROPE), build_rs_table(F, WSP(float, WS_SSQ1), 32, 1.0f / 2048.0f, u0.pm)};
        REPS(3) { pg8::gemm_phase<pg8::EpiInProj, StaticOrder, true, true>(ring, g, S, E); REPBAR(3); }
        { const int first = S.nwg % F.G, nsl = F.G - first;
          meta_inproj_and_dt(F, (int)blockIdx.x >= first ? ((int)blockIdx.x - first) * NWAVES + F.wave : -1, NMETA_IT + NDT_IT, nsl * NWAVES); }
        SEAM(3);
    }
    if (IN(4)) { REPS(4) { p4_mixer_attn(F); REPBAR(4); } SEAM(4); }
    if (IN(5)) { REPS(5) { p5_ssd_a(F); REPBAR(5); } SEAM(5); }
    if (IN(6)) { REPS(6) { p6_ssd_b(F); REPBAR(6); } SEAM(6); }
    if (IN(7)) {
        Gemm g{WSP(bf16, WS_MIX), WSP(bf16, WS_WOUT), MR, DM, DM}; StaticOrder S; S.init(MR, DM, F.G, (int)blockIdx.x);
        pg8::Unit u0{0, 0}; (void)S.next(0, u0);
        pg8::EpiResT<true> E{nullptr, WSP(bf16, WS_XN), nullptr, WSP(bf16, WS_XN), WSP(float, WS_SSQ2), 1.0f, DM, WSP(float, WS_SSQS), 16, build_rs_table(F, WSP(float, WS_SSQS), 32, 1.0f / 1024.0f, u0.pm)};
        pg8::gemm_phase<pg8::EpiResT<true>, StaticOrder, true, true>(ring, g, S, E);
        SEAM(7);
    }
    if (IN(8)) {
        Gemm g{WSP(bf16, WS_XN), WSP(bf16, WS_W2GU), MR, NGU, DM}; StaticOrder S; S.init(MR, NGU, F.G, (int)blockIdx.x);
        pg8::Unit u0{0, 0}; (void)S.next(0, u0);
        pg8::EpiSwiGLU E{WSP(bf16, WS_ACT), DFF, WSP(float, WS_SSQ2), 32, build_rs_table(F, WSP(float, WS_SSQ2), 32, 1.0f / 2048.0f, u0.pm)};
        REPS(8) { pg8::gemm_phase<pg8::EpiSwiGLU, StaticOrder, true, true>(ring, g, S, E); REPBAR(8); }
        SEAM(8);
    }
    if (IN(9)) {
        Gemm g{WSP(bf16, WS_ACT), WSP(bf16, WS_W2D), MR, DM, DFF}; StaticOrder S; S.init(MR, DM, F.G, (int)blockIdx.x);
        pg8::EpiResT<false> E{nullptr, WSP(bf16, WS_XN), F.out, nullptr, nullptr, 0.5f, DM, nullptr, 0, pg8::RsTable{nullptr, -1, -1}};
        pg8::gemm_phase<pg8::EpiResT<false>, StaticOrder, true, true>(ring, g, S, E);
    }
#undef IN
#undef SEAM
}

extern "C" void kernel_launch(void* const* d_in, const int* in_sizes, int n_in, void* d_out, int out_size, void* d_ws, size_t ws_size, hipStream_t stream) {
    static int grid = 0;
    if (grid == 0) {
        if (n_in != 26 || in_sizes[0] != MR * DM || out_size != MR * DM || ws_size < WS_END) { fprintf(stderr, "kernel_launch: unexpected shapes (n_in %d, in0 %d, out %d, ws %zu)\n", n_in, n_in > 0 ? in_sizes[0] : -1, out_size, ws_size); grid = -1; return; }
        int dev = 0, cus = 0, per_cu = 0;
        if (hipGetDevice(&dev) != hipSuccess || hipDeviceGetAttribute(&cus, hipDeviceAttributeMultiprocessorCount, dev) != hipSuccess) { grid = -1; return; }
        if (hipFuncSetAttribute((const void*)hymba_fwd, hipFuncAttributeMaxDynamicSharedMemorySize, LDS_BYTES) != hipSuccess) { fprintf(stderr, "kernel_launch: hipFuncSetAttribute failed\n"); grid = -1; return; }
        if (hipOccupancyMaxActiveBlocksPerMultiprocessor(&per_cu, (const void*)hymba_fwd, NWAVES * 64, LDS_BYTES) != hipSuccess || per_cu < 1) { fprintf(stderr, "kernel_launch: occupancy query says %d blocks per CU\n", per_cu); (void)hipGetLastError(); grid = -1; return; }
        grid = cus;
    }
    if (grid < 0) return;
    (void)hipMemsetAsync((char*)d_ws + WS_CTL, 0, CTL_ZERO_BYTES, stream);
    Args a{};
    for (int i = 0; i < 26; ++i) a.in[i] = (const float*)d_in[i];
    a.out = (float*)d_out; a.ws = (unsigned char*)d_ws;
    for (int li = 0; li < N_LAUNCHES; ++li) {
        a.ph_lo = (N_LAUNCHES == 1) ? 0 : li; a.ph_hi = (N_LAUNCHES == 1) ? NPH : li + 1;
        hipLaunchKernelGGL(hymba_fwd, dim3(grid), dim3(NWAVES * 64), LDS_BYTES, stream, a);
    }
}
```

```cpp
#include <hip/hip_runtime.h>
#include <cstdio>
#include <cstdint>
#include <cmath>
#ifndef MK_AMP
#define MK_AMP 0
#endif
namespace pg8 {
#define PG8_LAS __attribute__((address_space(3)))
typedef unsigned short bf16_t;
typedef short bf16x8 __attribute__((ext_vector_type(8)));
typedef float f32x4 __attribute__((ext_vector_type(4)));
typedef unsigned u32x4 __attribute__((ext_vector_type(4)));
constexpr int BM = 256, BK = 64, HALF = 128, HTB = HALF * BK * 2  , STAGE_BYTES = 8 * HTB, NXCD = 8, WGM = 8;

__host__ __device__ __forceinline__ int lds_byte(int r, int c) { const int st = (r >> 4) * 2 + (c >> 5), rr = r & 15, cc = c & 31, ob = rr * 64 + cc * 2; return st * 1024 + (ob ^ (((ob >> 9) & 1) << 5)); }
__host__ __device__ __forceinline__ void stage_rc(int b, int& R, int& C) { const int st = b / 1024, sb = b % 1024, swz = sb ^ (((sb >> 9) & 1) << 5); R = (st >> 1) * 16 + swz / 64; C = (st & 1) * 32 + (swz % 64) / 2; }
__host__ __device__ __forceinline__ int perm32(int rho) { const int n = rho >> 4, i = rho & 15; return 8 * (i >> 2) + 4 * n + (i & 3); }

struct Unit { int pm, pn; };
struct Gemm { const bf16_t* A; const bf16_t* Bt; int M, N, K; };

struct StaticOrder {
    int nM, nN, nwg, G, c;
    __host__ __device__ void init(int M, int N, int G_, int c_) { nM = M / BM; nN = N / BM; nwg = nM * nN; G = G_; c = c_; }
    __host__ __device__ __forceinline__ bool next(int i, Unit& u) const {
        const long L = (long)i * G + c; if (L >= nwg) return false;
        int wgid = (int)L; { const int q = nwg / NXCD, r = nwg % NXCD, xcd = wgid % NXCD, off = wgid / NXCD; wgid = (xcd < r ? xcd * (q + 1) : r * (q + 1) + (xcd - r) * q) + off; }
        const int nig = WGM * nN, gid = wgid / nig, fm = gid * WGM, gsz = (nM - fm) < WGM ? (nM - fm) : WGM;
        u.pm = fm + ((wgid % nig) % gsz); u.pn = (wgid % nig) / gsz; return true;
    }
    __device__ __forceinline__ void a_ready(const Unit&) const {}
    __device__ __forceinline__ void done(const Unit&) const {}
};


__device__ __forceinline__ unsigned cvt_pk_bf16(float lo, float hi) { unsigned r; asm volatile("v_cvt_pk_bf16_f32 %0, %1, %2" : "=v"(r) : "v"(lo), "v"(hi)); return r; }
typedef unsigned u32x2 __attribute__((ext_vector_type(2)));
constexpr float RMS_EPS = 1e-6f;
__device__ __forceinline__ float row_rs(const float* ssq, int np, int row, float inv_n = 1.0f / 2048.0f) {
    float s;
    if (np == 1) s = ssq[row];
    else { const f32x4* p = (const f32x4*)(ssq + (size_t)row * 32); f32x4 a = p[0];
#pragma unroll
        for (int i = 1; i < 8; ++i) a += p[i];
        s = (a[0] + a[1]) + (a[2] + a[3]); }
    return __builtin_amdgcn_rsqf(s * inv_n + RMS_EPS);
}
struct RsTable { const PG8_LAS float* t; int tpm, tpm2; };
__device__ __forceinline__ float row_rs_t(const RsTable& T, const float* ssq, int np, float inv_n, int pm, int rin) { return (pm == T.tpm) ? T.t[rin] : (pm == T.tpm2) ? T.t[256 + rin] : row_rs(ssq, np, pm * BM + rin, inv_n); }
__device__ __forceinline__ float silu_f(float g) { return g * __builtin_amdgcn_rcpf(1.0f + __builtin_amdgcn_exp2f(-1.4426950408889634f * g)); }

struct EpiSwiGLU {
    static constexpr bool PERM = true, AFTER_DRAIN = false, HAS_MID = false, AMP = (MK_AMP == 11);
    bf16_t* O; int ldc; const float* ssq; int np; RsTable T;
    __device__ __forceinline__ void mid(f32x4 (&)[2][2][4][2], const Unit&, int, int, int, int) const {}
    __device__ __forceinline__ void operator()(const f32x4 (&acc)[2][2][4][2], const Unit& u, int wr, int wc, int fr, int fq) const {
        const int row0 = u.pm * BM + wr * 64 + fr, col0 = u.pn * HALF + wc * 32 + 8 * fq;
#pragma unroll
        for (int ai = 0; ai < 2; ++ai)
#pragma unroll
            for (int m = 0; m < 4; ++m) { const int row = row0 + ai * HALF + m * 16; const float rs = row_rs_t(T, ssq, np, 1.0f / 2048.0f, u.pm, wr * 64 + fr + ai * HALF + m * 16);
                float a[8];
#pragma unroll
                for (int n = 0; n < 2; ++n)
#pragma unroll
                    for (int i = 0; i < 4; ++i) { const float g = acc[ai][0][m][n][i] * rs, up = acc[ai][1][m][n][i] * rs; a[4 * n + i] = silu_f(g) * up; }
                u32x4 w; w.x = cvt_pk_bf16(a[0], a[1]); w.y = cvt_pk_bf16(a[2], a[3]); w.z = cvt_pk_bf16(a[4], a[5]); w.w = cvt_pk_bf16(a[6], a[7]);
                *(u32x4*)(O + (size_t)row * ldc + col0) = w; }
    }
};
template <bool MID> struct EpiResT {
    static constexpr bool PERM = false, AFTER_DRAIN = false, HAS_MID = MID, AMP = false;
    const float* basef; const bf16_t* baseh; float* out; bf16_t* xn; float* ssq; float scale; int ldc; const float* rsm; int kmid; RsTable T;
    __device__ __forceinline__ void mid(f32x4 (&acc)[2][2][4][2], const Unit& u, int wr, int wc, int fr, int fq) const {
        int fro = fr; asm volatile("" : "+v"(fro));
        const int rin0 = wr * 64 + fro;
#pragma unroll
        for (int ai = 0; ai < 2; ++ai)
#pragma unroll
            for (int m = 0; m < 4; ++m) { const float r = row_rs_t(T, rsm, 32, 1.0f / 1024.0f, u.pm, rin0 + ai * HALF + m * 16);
#pragma unroll
                for (int bj = 0; bj < 2; ++bj)
#pragma unroll
                    for (int n = 0; n < 2; ++n) acc[ai][bj][m][n] *= r; }
    }
    __device__ __forceinline__ void operator()(const f32x4 (&acc)[2][2][4][2], const Unit& u, int wr, int wc, int fr, int fq) const {
        const int row0 = u.pm * BM + wr * 64 + fr, col0 = u.pn * BM + wc * 32 + 4 * fq;
#pragma unroll
        for (int ai = 0; ai < 2; ++ai) {
            f32x4 bf[4][2][2]; u32x2 bh[4][2][2];
#pragma unroll
            for (int m = 0; m < 4; ++m)
#pragma unroll
                for (int bj = 0; bj < 2; ++bj)
#pragma unroll
                    for (int n = 0; n < 2; ++n) { const size_t o1 = (size_t)(row0 + ai * HALF + m * 16) * ldc + col0 + bj * HALF + n * 16;
                        if (basef) bf[m][bj][n] = *(const f32x4*)(basef + o1); else bh[m][bj][n] = *(const u32x2*)(baseh + o1); }
#pragma unroll
            for (int m = 0; m < 4; ++m) { const int row = row0 + ai * HALF + m * 16; const size_t off = (size_t)row * ldc + col0; float sq = 0.f;
#pragma unroll
                for (int bj = 0; bj < 2; ++bj)
#pragma unroll
                    for (int n = 0; n < 2; ++n) { const size_t o1 = off + bj * HALF + n * 16; f32x4 b;
                        if (basef) b = bf[m][bj][n];
                        else { const u32x2 h = bh[m][bj][n]; b[0] = __uint_as_float(h.x << 16); b[1] = __uint_as_float(h.x & 0xffff0000u); b[2] = __uint_as_float(h.y << 16); b[3] = __uint_as_float(h.y & 0xffff0000u); }
                        const f32x4 o = b + acc[ai][bj][m][n] * scale;
                        if (out) *(f32x4*)(out + o1) = o;
                        if (xn) { sq += (o[0] * o[0] + o[1] * o[1]) + (o[2] * o[2] + o[3] * o[3]); u32x2 w; w.x = cvt_pk_bf16(o[0], o[1]); w.y = cvt_pk_bf16(o[2], o[3]); *(u32x2*)(xn + o1) = w; } }
                if (xn) { sq += __shfl_xor(sq, 16); sq += __shfl_xor(sq, 32); if (fq == 0) ssq[(size_t)row * 32 + u.pn * 4 + wc] = sq; } }
        }
    }
};
struct EpiInProj {
    static constexpr bool PERM = true, AFTER_DRAIN = false, HAS_MID = false, AMP = (MK_AMP == 12);
    bf16_t* U; int ldc; const float* ssq; const float* qn; const float* kn; const float* rope; RsTable T;
    __device__ __forceinline__ void mid(f32x4 (&)[2][2][4][2], const Unit&, int, int, int, int) const {}
    __device__ __forceinline__ void operator()(const f32x4 (&acc)[2][2][4][2], const Unit& u, int wr, int wc, int fr, int fq) const {
        const int row0 = u.pm * BM + wr * 64 + fr, col0 = u.pn * BM + wc * 64 + 8 * fq;
        const bool isqk = u.pn < 8;
        f32x4 wv[2][2];
        if (isqk) { const float* wn = (u.pn < 4) ? qn : kn;
#pragma unroll
            for (int bj = 0; bj < 2; ++bj)
#pragma unroll
                for (int n = 0; n < 2; ++n) wv[bj][n] = *(const f32x4*)(wn + 32 * bj + 8 * fq + 4 * n); }
#pragma unroll
        for (int ai = 0; ai < 2; ++ai)
#pragma unroll
            for (int m = 0; m < 4; ++m) { const int row = row0 + ai * HALF + m * 16; const float rs = row_rs_t(T, ssq, 32, 1.0f / 2048.0f, u.pm, wr * 64 + fr + ai * HALF + m * 16);
                f32x4 v[2][2];
#pragma unroll
                for (int bj = 0; bj < 2; ++bj)
#pragma unroll
                    for (int n = 0; n < 2; ++n) v[bj][n] = acc[ai][bj][m][n] * rs;
                if (isqk) {
                    float sq = 0.f;
#pragma unroll
                    for (int bj = 0; bj < 2; ++bj)
#pragma unroll
                        for (int n = 0; n < 2; ++n) sq += (v[bj][n][0] * v[bj][n][0] + v[bj][n][1] * v[bj][n][1]) + (v[bj][n][2] * v[bj][n][2] + v[bj][n][3] * v[bj][n][3]);
                    sq += __shfl_xor(sq, 16); sq += __shfl_xor(sq, 32);
                    const float r = __builtin_amdgcn_rsqf(sq * (1.0f / 64.0f) + RMS_EPS);
#pragma unroll
                    for (int bj = 0; bj < 2; ++bj)
#pragma unroll
                        for (int n = 0; n < 2; ++n) v[bj][n] = v[bj][n] * r * wv[bj][n];
                    const int pos = (row & 4095) + 16;
                    const f32x4 c0 = *(const f32x4*)(rope + pos * 16), c1 = *(const f32x4*)(rope + pos * 16 + 4), s0 = *(const f32x4*)(rope + pos * 16 + 8), s1 = *(const f32x4*)(rope + pos * 16 + 12);
                    f32x4 p0, p1;
#pragma unroll
                    for (int i = 0; i < 4; ++i) { p0[i] = __shfl_xor(v[0][0][i], 16); p1[i] = __shfl_xor(v[0][1][i], 16); }
                    if (fq == 0) { v[0][0] = v[0][0] * c0 - p0 * s0; v[0][1] = v[0][1] * c1 - p1 * s1; }
                    else if (fq == 1) { v[0][0] = v[0][0] * c0 + p0 * s0; v[0][1] = v[0][1] * c1 + p1 * s1; }
                    if (u.pn < 4) { v[0][0] *= 0.18033688011112042f; v[0][1] *= 0.18033688011112042f; v[1][0] *= 0.18033688011112042f; v[1][1] *= 0.18033688011112042f; }
                }
#pragma unroll
                for (int bj = 0; bj < 2; ++bj) { u32x4 w; w.x = cvt_pk_bf16(v[bj][0][0], v[bj][0][1]); w.y = cvt_pk_bf16(v[bj][0][2], v[bj][0][3]); w.z = cvt_pk_bf16(v[bj][1][0], v[bj][1][1]); w.w = cvt_pk_bf16(v[bj][1][2], v[bj][1][3]);
                    *(u32x4*)(U + (size_t)row * ldc + col0 + 32 * bj) = w; } }
    }
};

struct NoPre { __device__ __forceinline__ void issue() {} __device__ __forceinline__ void finish() {} };
struct RsPre { const float* ssq; int np; float inv_n; int pm; PG8_LAS float* t; f32x4 v[8]; float s1;
    __device__ __forceinline__ void issue() { const int tid = threadIdx.x; if (tid < 256) { const int row = pm * BM + tid;
            if (np == 1) s1 = ssq[row]; else { const f32x4* p = (const f32x4*)(ssq + (size_t)row * 32);
#pragma unroll
                for (int i = 0; i < 8; ++i) v[i] = p[i]; } } }
    __device__ __forceinline__ void finish() { const int tid = threadIdx.x; if (tid < 256) { float s;
            if (np == 1) s = s1; else { f32x4 a = v[0];
#pragma unroll
                for (int i = 1; i < 8; ++i) a += v[i];
                s = (a[0] + a[1]) + (a[2] + a[3]); }
            t[tid] = __builtin_amdgcn_rsqf(s * inv_n + RMS_EPS); } }
};
template <class Epi, class Sched, bool ALIGN_EPI = false, bool SP2 = false, class Pre = NoPre>
__device__ __forceinline__ void gemm_phase(PG8_LAS unsigned char* lds, const Gemm g, const Sched& S, const Epi& E, Pre pre = Pre()) {
    const int tid = threadIdx.x, wid = __builtin_amdgcn_readfirstlane(tid >> 6), lane = tid & 63, wr = wid >> 2, wc = wid & 3, fr = lane & 15, fq = lane >> 4;
    const int K = g.K, nt = K / BK;
    unsigned voffA[2], voffB[2];
#pragma unroll
    for (int i = 0; i < 2; ++i) { int R, C; stage_rc(tid * 16 + i * 8192, R, C); const int Rb = Epi::PERM ? ((R & ~31) + perm32(R & 31)) : R;
        voffA[i] = (unsigned)(R * K + C) * 2u; voffB[i] = (unsigned)(Rb * K + C) * 2u; }
    const size_t kstep = (size_t)(BK * 2);
    const size_t hstep = (size_t)HALF * K * 2;
    const size_t tstep = 2 * hstep;
    const unsigned ldsw = (unsigned)wid * 1024u;
    const int aoff = lds_byte(wr * 64 + fr, fq * 8), boff = lds_byte(wc * 32 + fr, fq * 8);
#define PG8_SA(b, h) (((b) * 2 + (h)) * HTB)
#define PG8_SB(b, h) ((4 + (b) * 2 + (h)) * HTB)
#define PG8_STAGE(bufoff, gbase, voff) do { _Pragma("unroll") for (int _i = 0; _i < 2; ++_i) \
        __builtin_amdgcn_global_load_lds((const unsigned*)((const char*)(gbase) + (voff)[_i]), (PG8_LAS unsigned*)(lds + (bufoff) + ldsw + _i * 8192), 16, 0, 0); } while (0)
#define PG8_LDA(dst, b, h) do { _Pragma("unroll") for (int m = 0; m < 4; ++m) _Pragma("unroll") for (int k = 0; k < 2; ++k) dst[m][k] = *(const PG8_LAS bf16x8*)(lds + PG8_SA(b, h) + aoff + m * 2048 + k * 1024); } while (0)
#define PG8_LDB(dst, b, h) do { _Pragma("unroll") for (int n = 0; n < 2; ++n) _Pragma("unroll") for (int k = 0; k < 2; ++k) dst[n][k] = *(const PG8_LAS bf16x8*)(lds + PG8_SB(b, h) + boff + n * 2048 + k * 1024); } while (0)
#define PG8_MMA(ai, bj, At, Bt) do { __builtin_amdgcn_s_setprio(1); _Pragma("unroll") for (int m = 0; m < 4; ++m) _Pragma("unroll") for (int n = 0; n < 2; ++n) _Pragma("unroll") for (int k = 0; k < 2; ++k) \
        acc[ai][bj][m][n] = __builtin_amdgcn_mfma_f32_16x16x32_bf16(Bt[n][k], At[m][k], acc[ai][bj][m][n], 0, 0, 0); __builtin_amdgcn_s_setprio(0); } while (0)
#define PG8_WAIT_V(n) asm volatile("s_waitcnt vmcnt(" #n ")" ::: "memory")
#define PG8_WAIT_L(n) asm volatile("s_waitcnt lgkmcnt(" #n ")" ::: "memory")
#define PG8_BAR __builtin_amdgcn_s_barrier()
#define PG8_SCHED __builtin_amdgcn_sched_barrier(0)
    Unit cur, nxt; int ui = 0;
    if (!S.next(0, cur)) return;
    f32x4 acc[2][2][4][2];
#pragma unroll
    for (int a = 0; a < 2; ++a)
#pragma unroll
        for (int b = 0; b < 2; ++b)
#pragma unroll
            for (int m = 0; m < 4; ++m)
#pragma unroll
                for (int n = 0; n < 2; ++n) acc[a][b][m][n] = (f32x4){0.f, 0.f, 0.f, 0.f};
    bf16x8 At[4][2], B0[2][2], B1[2][2];
    const char* cA = (const char*)g.A + (size_t)cur.pm * tstep; const char* cB = (const char*)g.Bt + (size_t)cur.pn * tstep;
    S.a_ready(cur);
    pre.issue();
    if constexpr (SP2) {
        PG8_STAGE(PG8_SB(0, 0), cB, voffB); PG8_STAGE(PG8_SB(0, 1), cB + hstep, voffB); PG8_STAGE(PG8_SA(0, 0), cA, voffA); PG8_STAGE(PG8_SA(0, 1), cA + hstep, voffA);
        if (wr == 1) PG8_BAR;
        PG8_WAIT_V(2); pre.finish(); PG8_BAR;
        PG8_STAGE(PG8_SB(1, 0), cB + kstep, voffB); PG8_STAGE(PG8_SA(1, 0), cA + kstep, voffA); PG8_STAGE(PG8_SB(1, 1), cB + hstep + kstep, voffB);
        PG8_WAIT_V(6); PG8_BAR;
    } else {
        PG8_STAGE(PG8_SB(0, 0), cB, voffB); PG8_STAGE(PG8_SA(0, 0), cA, voffA); PG8_STAGE(PG8_SB(0, 1), cB + hstep, voffB); PG8_STAGE(PG8_SA(0, 1), cA + hstep, voffA);
        if (wr == 1) PG8_BAR;
        PG8_WAIT_V(4); pre.finish(); PG8_BAR;
        PG8_STAGE(PG8_SB(1, 0), cB + kstep, voffB); PG8_STAGE(PG8_SA(1, 0), cA + kstep, voffA); PG8_STAGE(PG8_SB(1, 1), cB + hstep + kstep, voffB);
        PG8_WAIT_V(6); PG8_BAR;
    }
    for (;;) {
        const bool has_next = S.next(ui + 1, nxt);
        const char* nA = has_next ? (const char*)g.A + (size_t)nxt.pm * tstep : cA; const char* nB = has_next ? (const char*)g.Bt + (size_t)nxt.pn * tstep : cB;
        for (int t = 0; t < nt; t += 2) {
            const bool last = (t == nt - 2);
            if constexpr (Epi::HAS_MID) { if (t == E.kmid) E.mid(acc, cur, wr, wc, fr, fq); }
            const char* a1 = cA + (size_t)(t + 1) * kstep;
            const char* a2 = last ? nA : cA + (size_t)(t + 2) * kstep; const char* b2 = last ? nB : cB + (size_t)(t + 2) * kstep;
            const char* a3 = a2 + kstep; const char* b3 = b2 + kstep;
            if (last && has_next) S.a_ready(nxt);
            if constexpr (SP2) {
            PG8_LDB(B0, 0, 0); PG8_LDB(B1, 0, 1); PG8_SCHED; PG8_LDA(At, 0, 0); PG8_STAGE(PG8_SA(1, 1), a1 + hstep, voffA);
            PG8_WAIT_V(8); PG8_WAIT_L(0); PG8_BAR; PG8_MMA(0, 0, At, B0); PG8_MMA(0, 1, At, B1); PG8_BAR; PG8_SCHED;
            PG8_LDA(At, 0, 1); PG8_STAGE(PG8_SB(0, 0), b2, voffB); PG8_STAGE(PG8_SB(0, 1), b2 + hstep, voffB); PG8_STAGE(PG8_SA(0, 0), a2, voffA);
            PG8_WAIT_V(8); PG8_WAIT_L(0); PG8_BAR; PG8_MMA(1, 0, At, B0); PG8_MMA(1, 1, At, B1); PG8_BAR; PG8_SCHED;
            PG8_LDB(B0, 1, 0); PG8_LDB(B1, 1, 1); PG8_SCHED; PG8_LDA(At, 1, 0); PG8_STAGE(PG8_SA(0, 1), a2 + hstep, voffA);
            PG8_WAIT_V(8); PG8_WAIT_L(0); PG8_BAR; PG8_MMA(0, 0, At, B0); PG8_MMA(0, 1, At, B1); PG8_BAR; PG8_SCHED;
            PG8_LDA(At, 1, 1); PG8_STAGE(PG8_SB(1, 0), b3, voffB); PG8_STAGE(PG8_SB(1, 1), b3 + hstep, voffB); PG8_STAGE(PG8_SA(1, 0), a3, voffA);
            PG8_WAIT_V(8); PG8_WAIT_L(0); PG8_BAR; PG8_MMA(1, 0, At, B0); PG8_MMA(1, 1, At, B1); PG8_BAR; PG8_SCHED;
            } else {
            PG8_LDB(B0, 0, 0); PG8_SCHED; PG8_LDA(At, 0, 0); PG8_STAGE(PG8_SA(1, 1), a1 + hstep, voffA);
            PG8_WAIT_L(8); PG8_BAR; PG8_WAIT_L(0); PG8_MMA(0, 0, At, B0); PG8_BAR; PG8_SCHED;
            PG8_LDB(B1, 0, 1); PG8_STAGE(PG8_SB(0, 0), b2, voffB);
            PG8_BAR; PG8_WAIT_L(0); PG8_MMA(0, 1, At, B1); PG8_BAR;
            PG8_LDA(At, 0, 1); PG8_STAGE(PG8_SA(0, 0), a2, voffA);
            PG8_BAR; PG8_WAIT_L(0); PG8_MMA(1, 0, At, B0); PG8_BAR; PG8_SCHED;
            PG8_STAGE(PG8_SB(0, 1), b2 + hstep, voffB);
            PG8_WAIT_V(6); PG8_BAR; PG8_MMA(1, 1, At, B1); PG8_BAR;
            PG8_LDB(B0, 1, 0); PG8_SCHED; PG8_LDA(At, 1, 0); PG8_STAGE(PG8_SA(0, 1), a2 + hstep, voffA);
            PG8_WAIT_L(8); PG8_BAR; PG8_WAIT_L(0); PG8_MMA(0, 0, At, B0); PG8_BAR; PG8_SCHED;
            PG8_LDB(B1, 1, 1); PG8_STAGE(PG8_SB(1, 0), b3, voffB);
            PG8_BAR; PG8_WAIT_L(0); PG8_MMA(0, 1, At, B1); PG8_BAR;
            PG8_LDA(At, 1, 1); PG8_STAGE(PG8_SA(1, 0), a3, voffA);
            PG8_BAR; PG8_WAIT_L(0); PG8_MMA(1, 0, At, B0); PG8_BAR; PG8_SCHED;
            PG8_STAGE(PG8_SB(1, 1), b3 + hstep, voffB);
            PG8_WAIT_V(6); PG8_BAR; PG8_MMA(1, 1, At, B1); PG8_BAR;
            }
        }
        if constexpr (ALIGN_EPI) { if (wr == 0) PG8_BAR; }
        if constexpr (!Epi::AFTER_DRAIN) { for (int amp_ = 0; amp_ < (Epi::AMP ? 3 : 1); ++amp_) { E(acc, cur, wr, wc, fr, fq); asm volatile("" ::: "memory"); } S.done(cur); }
        if (!has_next) break;
#pragma unroll
        for (int a = 0; a < 2; ++a)
#pragma unroll
            for (int b = 0; b < 2; ++b)
#pragma unroll
                for (int m = 0; m < 4; ++m)
#pragma unroll
                    for (int n = 0; n < 2; ++n) acc[a][b][m][n] = (f32x4){0.f, 0.f, 0.f, 0.f};
        cur = nxt; cA = nA; cB = nB; ++ui;
        if constexpr (ALIGN_EPI) { if (wr == 1) PG8_BAR; }
    }
    PG8_WAIT_V(0);
    if constexpr (!ALIGN_EPI) { if (wr == 0) PG8_BAR; }
    PG8_BAR;
    if constexpr (Epi::AFTER_DRAIN) { E.fused(acc, cur, wr, wc, fr, fq, lds, wid, lane); S.done(cur); }
#undef PG8_SA
#undef PG8_SB
#undef PG8_STAGE
#undef PG8_LDA
#undef PG8_LDB
#undef PG8_MMA
#undef PG8_WAIT_V
#undef PG8_WAIT_L
#undef PG8_BAR
#undef PG8_SCHED
}
}

#ifndef PG8_SP2
#define PG8_SP2 true
#endif

constexpr int NWAVES = 8;
constexpr int DM = 2048, SEQ = 4096, NBATCH = 2, MR = NBATCH * SEQ, NMETA = 16, LPOS = SEQ + NMETA;
constexpr int DFF = 5632, NGU = 2 * DFF;
constexpr int NHEAD = 8, SH = 16, CONVD = 1536, NIN = 5648, NINP = 5632;
constexpr int PPAD = 48, LPAD = LPOS + PPAD;
constexpr float EPS = 1e-6f;
#ifndef MK_REPEAT_PHASE
#define MK_REPEAT_PHASE -1
#endif
#ifndef MK_N_LAUNCHES
#define MK_N_LAUNCHES 1
#endif
constexpr int NPH = 10;
constexpr int N_LAUNCHES = MK_N_LAUNCHES;

constexpr size_t MiB = 1u << 20;
constexpr size_t WS_CTL = 0, CTL_ZERO_BYTES = 1 * MiB;
constexpr size_t WS_W1GU = 2 * MiB, WS_W1D = 46 * MiB, WS_WIN = 68 * MiB, WS_WOUT = 91 * MiB, WS_W2GU = 99 * MiB, WS_W2D = 143 * MiB;
constexpr size_t WS_XN = 165 * MiB;
constexpr size_t WS_ACT = 197 * MiB;
constexpr size_t WS_MIX = 285 * MiB;
constexpr size_t WS_SSQ0 = 317 * MiB;
constexpr size_t WS_SSQ1 = 318 * MiB, WS_SSQ2 = 319 * MiB;
constexpr size_t WS_DTR = 320 * MiB;
constexpr size_t WS_ROPE = 321 * MiB;
constexpr size_t WS_META = 322 * MiB;
constexpr size_t MO_XN = 0, MO_SSQ0 = 65536, MO_ACT = 131072, MO_H1 = 327680, MO_XN1 = 458752, MO_U = 524288, MO_KM = 917504, MO_VM = 950272, MO_SSQ1 = 69632;
constexpr size_t WS_SST = 324 * MiB;
constexpr size_t WS_ATOT = 333 * MiB;
constexpr size_t WS_SSQS = 334 * MiB;
constexpr size_t WS_XS = 336 * MiB;
constexpr size_t WS_BC = 353 * MiB;
constexpr size_t WS_DT = 362 * MiB;
constexpr size_t WS_END = 363 * MiB;
constexpr int CW_BAR = 4096;

constexpr int RING_OFF = 0, RING_BYTES = 131072;
constexpr int LDS_BYTES = 147456, MISC_OFF = LDS_BYTES - 512;

#define GAS __attribute__((address_space(1)))
#define LAS __attribute__((address_space(3)))
typedef unsigned short bf16;
typedef unsigned v4u __attribute__((ext_vector_type(4)));
typedef float f32x4 __attribute__((ext_vector_type(4)));
typedef short bf16x8 __attribute__((ext_vector_type(8)));
typedef GAS unsigned gu32;
typedef GAS unsigned long long gu64;
#define RLX_AGENT __ATOMIC_RELAXED, __HIP_MEMORY_SCOPE_AGENT
#define LDS_WAIT() asm volatile("s_waitcnt lgkmcnt(0)" ::: "memory")
#define VM_WAIT() asm volatile("s_waitcnt vmcnt(0)" ::: "memory")
__device__ __forceinline__ unsigned long long rt() { return __builtin_amdgcn_s_memrealtime(); }
__device__ __forceinline__ unsigned f2bf(float f) { unsigned u = __builtin_bit_cast(unsigned, f); return (u + 0x7fffu + ((u >> 16) & 1u)) >> 16; }
typedef float f32x2_pk __attribute__((ext_vector_type(2))); typedef __bf16 bf16x2_pk __attribute__((ext_vector_type(2)));
__device__ __forceinline__ unsigned pk2(float lo, float hi) { f32x2_pk v = {lo, hi}; bf16x2_pk b = __builtin_convertvector(v, bf16x2_pk); return __builtin_bit_cast(unsigned, b); }

#define XB_TMO      128
#define XB_XCNT(j)  (256  + 64 * (j))
#define XB_XSUB(j)  (1280 + 64 * (j))
#define XB_XGEN(j)  (2304 + 64 * (j))
#define XB_TOP      3328
#define XB_TOPGEN   3392
#define XCD_BAR_WORDS 3456
#define XB_SPIN_CAP (1u << 18)

__device__ __forceinline__ unsigned xb_ld(unsigned* p)              { return __hip_atomic_load(p, __ATOMIC_RELAXED, __HIP_MEMORY_SCOPE_AGENT); }
__device__ __forceinline__ unsigned xb_add(unsigned* p, unsigned v) { return __hip_atomic_fetch_add(p, v, __ATOMIC_RELAXED, __HIP_MEMORY_SCOPE_AGENT); }
__device__ __forceinline__ unsigned xb_xcc_id() { return (unsigned)__builtin_amdgcn_s_getreg((3 << 11) | 20) & 0xFu; }
#define XB_SPIN(cond, bar) do { unsigned _sp = 0; while (cond) { __builtin_amdgcn_s_sleep(1); \
    if ((++_sp & 255u) == 0u) { if (xb_ld(&(bar)[XB_TMO])) break; if (_sp > XB_SPIN_CAP) { atomicAdd(&(bar)[XB_TMO], 1u); break; } } } } while (0)

struct XcdBarrier {
    unsigned* bar; unsigned x;
    volatile LAS unsigned* st;
};

__device__ __forceinline__ XcdBarrier xcd_barrier_post(unsigned* bar, volatile LAS unsigned* st) {
    XcdBarrier b; b.bar = bar; b.x = xb_xcc_id(); b.st = st;
    if (threadIdx.x == 0) (void)xb_add(&bar[XB_XCNT(b.x)], 1u);
    return b;
}
__device__ __forceinline__ void xcd_barrier_complete(unsigned* bar, unsigned x, unsigned& nloc, unsigned& nx) {
    const unsigned G = gridDim.x * gridDim.y * gridDim.z;
    unsigned sum, cnt, mine, sp = 0u;
    for (;;) {
        sum = 0u; cnt = 0u; mine = 0u;
#pragma unroll
        for (unsigned j = 0; j < 16; ++j) { const unsigned c = xb_ld(&bar[XB_XCNT(j)]); sum += c; cnt += (c > 0u) ? 1u : 0u; mine = (j == x) ? c : mine; }
        if (sum == G) break;
        __builtin_amdgcn_s_sleep(1);
        if ((++sp & 255u) == 0u) { if (xb_ld(&bar[XB_TMO])) break; if (sp > XB_SPIN_CAP) { atomicAdd(&bar[XB_TMO], 1u); break; } }
    }
    nloc = mine > 0u ? mine : 1u; nx = cnt > 0u ? cnt : 1u;
}

__device__ __forceinline__ void xcd_barrier(const XcdBarrier& b) {
    asm volatile("s_waitcnt vmcnt(0)" ::: "memory");
    __syncthreads();
    if (threadIdx.x == 0) {
        unsigned* bar = b.bar;
        __builtin_amdgcn_s_waitcnt(0);
        unsigned nloc = b.st[0], nx = b.st[1];
        if (nloc == 0u) { xcd_barrier_complete(bar, b.x, nloc, nx); b.st[0] = nloc; b.st[1] = nx; }
        const unsigned old = xb_add(&bar[XB_XSUB(b.x)], 1u);
        const unsigned gen = old / nloc;
        if (old + 1u == (gen + 1u) * nloc) {
            __builtin_amdgcn_fence(__ATOMIC_RELEASE, "agent");
            asm volatile("s_waitcnt vmcnt(0)" ::: "memory");
            const unsigned og = xb_add(&bar[XB_TOP], 1u);
            const unsigned tg = og / nx;
            if (og + 1u == (tg + 1u) * nx) xb_add(&bar[XB_TOPGEN], 1u);
            else XB_SPIN(xb_ld(&bar[XB_TOPGEN]) == tg, bar);
            __builtin_amdgcn_fence(__ATOMIC_ACQUIRE, "agent");
            xb_add(&bar[XB_XGEN(b.x)], 1u);
            asm volatile("s_waitcnt vmcnt(0)" ::: "memory");
        } else {
            XB_SPIN(xb_ld(&bar[XB_XGEN(b.x)]) == gen, bar);
            __builtin_amdgcn_fence(__ATOMIC_ACQUIRE, "agent");
            asm volatile("s_waitcnt vmcnt(0)" ::: "memory");
        }
    }
    __syncthreads();
}


typedef unsigned u32x2v __attribute__((ext_vector_type(2)));
__device__ __forceinline__ float bf2f(unsigned b) { return __uint_as_float(b << 16); }
__device__ __forceinline__ float wave_sum(float v) {
#pragma unroll
    for (int o = 1; o < 64; o <<= 1) v += __shfl_xor(v, o);
    return v;
}
__device__ __forceinline__ float wave_max(float v) {
#pragma unroll
    for (int o = 1; o < 64; o <<= 1) v = fmaxf(v, __shfl_xor(v, o));
    return v;
}
__device__ __forceinline__ float silu1(float g) { return g * __builtin_amdgcn_rcpf(1.0f + __builtin_amdgcn_exp2f(-1.4426950408889634f * g)); }

struct Frame {
    LAS unsigned char* lds;
    int tid, lane, wave, G, gw, NGW;
    const float* in[26]; float* out; unsigned char* ws; const float* const* inp;
};
#define WSP(T, off) ((T*)(F.ws + (off)))

constexpr int RST_OFF = RING_BYTES;
__device__ __forceinline__ pg8::RsTable build_rs_table(Frame& F, const float* ssq, int np, float inv_n, int pm, int pm2 = -1) {
    LAS float* t = (LAS float*)(F.lds + RST_OFF);
    if (F.tid < 256) t[F.tid] = pg8::row_rs(ssq, np, pm * 256 + F.tid, inv_n);
    else if (pm2 >= 0) t[F.tid] = pg8::row_rs(ssq, np, pm2 * 256 + F.tid - 256, inv_n);
    __syncthreads();
    return pg8::RsTable{t, pm, pm2};
}
__device__ __forceinline__ int rowmap(int kind, int n) {
    if (kind == 1) return 256 * (n >> 7) + (n & 127);
    if (kind == 2) return 256 * (n >> 7) + 128 + (n & 127);
    if (kind == 3) { if (n >= NINP) return n; const int pn = n >> 8, rem = n & 255, wc = rem >> 6, bj = (rem >> 5) & 1, j = rem & 31; return 256 * pn + 128 * bj + 32 * wc + j; }
    return n;
}
struct TItem { const float* W; int K, N; const float* kscale; bf16* WT; int kind, item, ks_off, krot; };
__device__ __forceinline__ void transpose_load(const TItem& t, int lane, f32x4 (&v)[16]) {
    const int nblk = (t.N + 63) >> 6, kb = t.item / nblk, nb = t.item - kb * nblk, k0 = 64 * kb, n0 = 64 * nb;
    const float* src = t.W + (size_t)(k0 + 8 * (lane >> 3)) * t.N;
#pragma unroll
    for (int h = 0; h < 2; ++h) { int nl = n0 + 32 * h + 4 * (lane & 7); nl = nl < t.N ? nl : t.N - 4;
#pragma unroll
        for (int i = 0; i < 8; ++i) v[8 * h + i] = __builtin_nontemporal_load((const f32x4*)(src + (size_t)i * t.N + nl)); }
}
__device__ __forceinline__ void transpose_finish(const TItem& t, int lane, f32x4 (&v)[16]) {
    const int nblk = (t.N + 63) >> 6, kb = t.item / nblk, nb = t.item - kb * nblk, k0 = 64 * kb, n0 = 64 * nb, r = lane >> 3;
    float sc[8];
    if (t.kscale && k0 >= t.ks_off) { const f32x4 s0 = *(const f32x4*)(t.kscale + k0 + 8 * r - t.ks_off), s1 = *(const f32x4*)(t.kscale + k0 + 8 * r - t.ks_off + 4);
        sc[0] = s0[0]; sc[1] = s0[1]; sc[2] = s0[2]; sc[3] = s0[3]; sc[4] = s1[0]; sc[5] = s1[1]; sc[6] = s1[2]; sc[7] = s1[3]; }
    else {
#pragma unroll
        for (int i = 0; i < 8; ++i) sc[i] = 1.0f; }
    int kd = k0 + t.krot; if (kd >= t.K) kd -= t.K;
#pragma unroll
    for (int h = 0; h < 2; ++h)
#pragma unroll
        for (int j = 0; j < 4; ++j) { const int n = n0 + 32 * h + 4 * (lane & 7) + j;
            v4u o; o.x = pg8::cvt_pk_bf16(v[8 * h + 0][j] * sc[0], v[8 * h + 1][j] * sc[1]); o.y = pg8::cvt_pk_bf16(v[8 * h + 2][j] * sc[2], v[8 * h + 3][j] * sc[3]);
            o.z = pg8::cvt_pk_bf16(v[8 * h + 4][j] * sc[4], v[8 * h + 5][j] * sc[5]); o.w = pg8::cvt_pk_bf16(v[8 * h + 6][j] * sc[6], v[8 * h + 7][j] * sc[7]);
            if (n < t.N) *(v4u*)(t.WT + (size_t)rowmap(t.kind, n) * t.K + kd + 8 * r) = o; }
}
__device__ __forceinline__ void transpose_load_h(const TItem& t, int lane, int h, f32x4 (&v)[8]) {
    const int nblk = (t.N + 63) >> 6, kb = t.item / nblk, nb = t.item - kb * nblk, k0 = 64 * kb, n0 = 64 * nb;
    const float* src = t.W + (size_t)(k0 + 8 * (lane >> 3)) * t.N;
    int nl = n0 + 32 * h + 4 * (lane & 7); nl = nl < t.N ? nl : t.N - 4;
#pragma unroll
    for (int i = 0; i < 8; ++i) v[i] = __builtin_nontemporal_load((const f32x4*)(src + (size_t)i * t.N + nl));
}
__device__ __forceinline__ void transpose_finish_h(const TItem& t, int lane, int h, f32x4 (&v)[8]) {
    const int nblk = (t.N + 63) >> 6, kb = t.item / nblk, nb = t.item - kb * nblk, k0 = 64 * kb, n0 = 64 * nb, r = lane >> 3;
    float sc[8];
    if (t.kscale && k0 >= t.ks_off) { const f32x4 s0 = *(const f32x4*)(t.kscale + k0 + 8 * r - t.ks_off), s1 = *(const f32x4*)(t.kscale + k0 + 8 * r - t.ks_off + 4);
        sc[0] = s0[0]; sc[1] = s0[1]; sc[2] = s0[2]; sc[3] = s0[3]; sc[4] = s1[0]; sc[5] = s1[1]; sc[6] = s1[2]; sc[7] = s1[3]; }
    else {
#pragma unroll
        for (int i = 0; i < 8; ++i) sc[i] = 1.0f; }
    int kd = k0 + t.krot; if (kd >= t.K) kd -= t.K;
#pragma unroll
    for (int j = 0; j < 4; ++j) { const int n = n0 + 32 * h + 4 * (lane & 7) + j;
        v4u o; o.x = pg8::cvt_pk_bf16(v[0][j] * sc[0], v[1][j] * sc[1]); o.y = pg8::cvt_pk_bf16(v[2][j] * sc[2], v[3][j] * sc[3]);
        o.z = pg8::cvt_pk_bf16(v[4][j] * sc[4], v[5][j] * sc[5]); o.w = pg8::cvt_pk_bf16(v[6][j] * sc[6], v[7][j] * sc[7]);
        if (n < t.N) *(v4u*)(t.WT + (size_t)rowmap(t.kind, n) * t.K + kd + 8 * r) = o; }
}
__device__ __forceinline__ void row_to_bf16(const float* xrow, bf16* orow, float* ssq, int lane) {
    const f32x4* xr = (const f32x4*)xrow + lane; float s = 0.f; f32x4 v[8];
#pragma unroll
    for (int j = 0; j < 8; ++j) { v[j] = __builtin_nontemporal_load(xr + 64 * j); s += (v[j][0] * v[j][0] + v[j][1] * v[j][1]) + (v[j][2] * v[j][2] + v[j][3] * v[j][3]); }
    s = wave_sum(s);
    u32x2v* o8 = (u32x2v*)orow + lane;
#pragma unroll
    for (int j = 0; j < 8; ++j) { u32x2v w; w.x = pk2(v[j][0], v[j][1]); w.y = pk2(v[j][2], v[j][3]); o8[64 * j] = w; }
    if (lane == 0) *ssq = s;
}
__constant__ float ROPE_INV[8] = {1.0f, 0.1939227432012558f, 0.03760603070259094f, 0.007292664609849453f, 0.0014142135623842478f, 0.00027424818836152554f, 5.318296098266728e-05f, 1.0313386155758053e-05f};
constexpr int I_G = 32 * 88, I_D = 88 * 32, I_IN = 32 * 89, I_O = 32 * 32;
constexpr int IT_W1G = 0, IT_W1U = IT_W1G + I_G, IT_WOUT = IT_W1U + I_G, IT_W1D = IT_WOUT + I_O, IT_WIN = IT_W1D + I_D, IT_W2U = IT_WIN + I_IN, IT_W2G = IT_W2U + I_G, IT_W2D = IT_W2G + I_G, IT_END = IT_W2D + I_D;
#ifndef MK_N1
#define MK_N1 6944
#endif
constexpr int IT_BG = IT_END - 8192;
constexpr int IT_CUT0 = IT_BG - MK_N1;
static_assert(IT_CUT0 >= IT_WOUT, "W1 gate/up are needed by P1");
__device__ __forceinline__ TItem mk_item(Frame& F, int it) {
    const int m = (it >= IT_W1U) + (it >= IT_WOUT) + (it >= IT_W1D) + (it >= IT_WIN) + (it >= IT_W2U) + (it >= IT_W2G) + (it >= IT_W2D);
    const int start = m == 0 ? IT_W1G : m == 1 ? IT_W1U : m == 2 ? IT_WOUT : m == 3 ? IT_W1D : m == 4 ? IT_WIN : m == 5 ? IT_W2U : m == 6 ? IT_W2G : IT_W2D;
    const unsigned long long WI = 0x1917180705150403ull, SI = 0xff161606ff140202ull;
    const int wi = (int)((WI >> (8 * m)) & 0xffu), si = (int)((SI >> (8 * m)) & 0xffu);
    const bool down = (m == 3 || m == 7);
    const size_t wto = m < 2 ? WS_W1GU : m == 2 ? WS_WOUT : m == 3 ? WS_W1D : m == 4 ? WS_WIN : m < 7 ? WS_W2GU : WS_W2D;
    const int kind = (m == 0 || m == 6) ? 1 : (m == 1 || m == 5) ? 2 : m == 4 ? 3 : 0;
    TItem t; t.W = F.inp[wi]; t.K = down ? DFF : DM; t.N = down ? DM : m == 2 ? DM : m == 4 ? NIN : DFF; t.kscale = si == 0xff ? nullptr : F.inp[si]; t.WT = WSP(bf16, wto); t.kind = kind; t.item = it - start;
    t.ks_off = m == 2 ? 1024 : 0; t.krot = m == 2 ? 1024 : 0;
    return t;
}
__device__ __forceinline__ void convert_items(Frame& F, int lo, int hi, int w, int nw) {
    if (w < 0) return;
    f32x4 va[16], vb[16]; int it = lo + w;
    if (it < hi) { TItem ta = mk_item(F, it); transpose_load(ta, F.lane, va);
        for (;;) {
            const int itb = it + nw; TItem tb = mk_item(F, itb < hi ? itb : it);
            if (itb < hi) transpose_load(tb, F.lane, vb);
            transpose_finish(ta, F.lane, va);
            if (itb >= hi) break;
            const int itc = itb + nw; ta = mk_item(F, itc < hi ? itc : itb);
            if (itc < hi) transpose_load(ta, F.lane, va);
            transpose_finish(tb, F.lane, vb);
            if (itc >= hi) break;
            it = itc;
        } }
}
__device__ __forceinline__ void p0_prologue(Frame& F) {
    convert_items(F, 0, IT_CUT0, F.gw, F.NGW);
    for (int m = F.gw; m < MR; m += 2 * F.NGW) {
        const int m2 = m + F.NGW;
        const f32x4* xa = (const f32x4*)(F.in[0] + (size_t)m * DM) + F.lane; const f32x4* xb = (const f32x4*)(F.in[0] + (size_t)(m2 < MR ? m2 : m) * DM) + F.lane;
        f32x4 va[8], vb[8]; float sa = 0.f, sb = 0.f;
#pragma unroll
        for (int j = 0; j < 8; ++j) { va[j] = __builtin_nontemporal_load(xa + 64 * j); vb[j] = __builtin_nontemporal_load(xb + 64 * j); }
#pragma unroll
        for (int j = 0; j < 8; ++j) { sa += (va[j][0] * va[j][0] + va[j][1] * va[j][1]) + (va[j][2] * va[j][2] + va[j][3] * va[j][3]); sb += (vb[j][0] * vb[j][0] + vb[j][1] * vb[j][1]) + (vb[j][2] * vb[j][2] + vb[j][3] * vb[j][3]); }
        sa = wave_sum(sa); sb = wave_sum(sb);
        u32x2v* oa = (u32x2v*)(WSP(bf16, WS_XN) + (size_t)m * DM) + F.lane; u32x2v* ob = (u32x2v*)(WSP(bf16, WS_XN) + (size_t)m2 * DM) + F.lane;
#pragma unroll
        for (int j = 0; j < 8; ++j) { u32x2v w; w.x = pk2(va[j][0], va[j][1]); w.y = pk2(va[j][2], va[j][3]); oa[64 * j] = w; }
        if (F.lane == 0) WSP(float, WS_SSQ0)[m] = sa;
        if (m2 < MR) {
#pragma unroll
            for (int j = 0; j < 8; ++j) { u32x2v w; w.x = pk2(vb[j][0], vb[j][1]); w.y = pk2(vb[j][2], vb[j][3]); ob[64 * j] = w; }
            if (F.lane == 0) WSP(float, WS_SSQ0)[m2] = sb; }
    }
    for (int p = F.gw; p < NMETA; p += F.NGW) row_to_bf16(F.in[1] + (size_t)p * DM, WSP(bf16, WS_META + MO_XN) + (size_t)p * DM, WSP(float, WS_META + MO_SSQ0) + p, F.lane);
    for (int e = F.gw * 64 + F.lane; e < LPOS * 8; e += F.NGW * 64) { const int pos = e >> 3, i = e & 7;
        const float ang = (float)pos * ROPE_INV[i];
        double tr = (double)ang * 0.15915494309189535; tr -= __builtin_rint(tr);
        const float tf = (float)tr;
        WSP(float, WS_ROPE)[pos * 16 + i] = __builtin_amdgcn_cosf(tf); WSP(float, WS_ROPE)[pos * 16 + 8 + i] = __builtin_amdgcn_sinf(tf); }
}

__device__ __forceinline__ f32x4 skinny16(const bf16* A, int lda, const bf16* Bt, int ldb, int k0, int k1, int lane, f32x4 acc) {
    const bf16* ap = A + (size_t)(lane & 15) * lda + 8 * (lane >> 4);
    const bf16* bp = Bt + (size_t)(lane & 15) * ldb + 8 * (lane >> 4);
#pragma unroll 16
    for (int k = k0; k < k1; k += 32) { const bf16x8 a = *(const bf16x8*)(ap + k), b = *(const bf16x8*)(bp + k);
        acc = __builtin_amdgcn_mfma_f32_16x16x32_bf16(a, b, acc, 0, 0, 0); }
    asm volatile("s_nop 15\n\ts_nop 3" : "+v"(acc));
    return acc;
}
__device__ __forceinline__ void meta_gateup(Frame& F, int w0, int wstride) {
    const bf16* A = WSP(bf16, WS_META + MO_XN); const float* ssq = WSP(float, WS_META + MO_SSQ0); bf16* act = WSP(bf16, WS_META + MO_ACT);
    if (w0 < 0) return;
    for (int it = w0; it < DFF / 16; it += wstride) { const int c0 = 16 * it, rg = 256 * (c0 >> 7) + (c0 & 127);
        f32x4 g = (f32x4){0.f, 0.f, 0.f, 0.f}, u = g;
        g = skinny16(A, DM, WSP(bf16, WS_W1GU) + (size_t)rg * DM, DM, 0, DM, F.lane, g);
        u = skinny16(A, DM, WSP(bf16, WS_W1GU) + (size_t)(rg + 128) * DM, DM, 0, DM, F.lane, u);
#pragma unroll
        for (int i = 0; i < 4; ++i) { const int row = 4 * (F.lane >> 4) + i; const float rs = __builtin_amdgcn_rsqf(ssq[row] * (1.0f / 2048.0f) + EPS);
            act[row * DFF + c0 + (F.lane & 15)] = (bf16)f2bf(silu1(g[i] * rs) * (u[i] * rs)); } }
}
__device__ __forceinline__ void meta_down(Frame& F) {
    const bf16* A = WSP(bf16, WS_META + MO_ACT); float* ssq1 = WSP(float, WS_META + MO_SSQ1); bf16* xn1 = WSP(bf16, WS_META + MO_XN1);
    LAS f32x4* red = (LAS f32x4*)(F.lds + 65536);
    for (int it = blockIdx.x; it < DM / 16; it += F.G) { const int c0 = 16 * it;
        __syncthreads();
        f32x4 a = (f32x4){0.f, 0.f, 0.f, 0.f};
        a = skinny16(A, DFF, WSP(bf16, WS_W1D) + (size_t)c0 * DFF, DFF, F.wave * (DFF / 8), (F.wave + 1) * (DFF / 8), F.lane, a);
        red[F.wave * 64 + F.lane] = a;
        __syncthreads();
        if (F.wave == 0) {
#pragma unroll
            for (int w = 1; w < 8; ++w) a += red[w * 64 + F.lane];
#pragma unroll
            for (int i = 0; i < 4; ++i) { const int row = 4 * (F.lane >> 4) + i, col = c0 + (F.lane & 15); const float o = F.in[1][row * DM + col] + 0.5f * a[i];
                xn1[row * DM + col] = (bf16)f2bf(o);
                float sq = o * o; sq += __shfl_xor(sq, 1); sq += __shfl_xor(sq, 2); sq += __shfl_xor(sq, 4); sq += __shfl_xor(sq, 8);
                if ((F.lane & 15) == 0) ssq1[row * 128 + it] = sq; } }
        __syncthreads();
    }
}
constexpr int NMETA_IT = NIN / 16, NDT_IT = MR / 16;
__device__ __forceinline__ void meta_inproj_and_dt(Frame& F, int it0, int it_end, int wstride) {
    const int nmeta = NMETA_IT;
    if (it0 < 0) return;
    for (int it = it0; it < it_end; it += wstride) {
        if (it < nmeta) {
            const float* ssq1 = WSP(float, WS_META + MO_SSQ1); float* um = WSP(float, WS_META + MO_U);
            float rs[4];
#pragma unroll
            for (int i = 0; i < 4; ++i) { const f32x4* pp = (const f32x4*)(ssq1 + (4 * (F.lane >> 4) + i) * 128 + 8 * (F.lane & 15)); const f32x4 v = pp[0] + pp[1]; float s2 = (v[0] + v[1]) + (v[2] + v[3]);
                s2 += __shfl_xor(s2, 1); s2 += __shfl_xor(s2, 2); s2 += __shfl_xor(s2, 4); s2 += __shfl_xor(s2, 8);
                rs[i] = __builtin_amdgcn_rsqf(s2 * (1.0f / 2048.0f) + EPS); }
            const int r0 = 16 * it;
            int c0;
            if (r0 >= NINP) c0 = r0; else { const int pn = r0 >> 8, rem = r0 & 255, bj = rem >> 7, wc = (rem & 127) >> 5, j = rem & 31; c0 = 256 * pn + 64 * wc + 32 * bj + j; }
            f32x4 a = (f32x4){0.f, 0.f, 0.f, 0.f};
            a = skinny16(WSP(bf16, WS_META + MO_XN1), DM, WSP(bf16, WS_WIN) + (size_t)r0 * DM, DM, 0, DM, F.lane, a);
#pragma unroll
            for (int i = 0; i < 4; ++i) um[(size_t)(4 * (F.lane >> 4) + i) * NIN + c0 + (F.lane & 15)] = a[i] * rs[i];
        } else {
            const int m0 = 16 * (it - nmeta);
            f32x4 a = (f32x4){0.f, 0.f, 0.f, 0.f};
            a = skinny16(WSP(bf16, WS_XN) + (size_t)m0 * DM, DM, WSP(bf16, WS_WIN) + (size_t)NINP * DM, DM, 0, DM, F.lane, a);
#pragma unroll
            for (int i = 0; i < 4; ++i) { const int row = m0 + 4 * (F.lane >> 4) + i; WSP(float, WS_DTR)[(size_t)row * 16 + (F.lane & 15)] = a[i] * pg8::row_rs(WSP(float, WS_SSQ1), 32, row); }
        }
    }
}


namespace att {
typedef float f32x16 __attribute__((ext_vector_type(16)));
typedef short s16x4 __attribute__((ext_vector_type(4)));
typedef short v4i16_t __attribute__((ext_vector_type(4)));
typedef float f32x2_t __attribute__((ext_vector_type(2))); typedef __bf16 bf16x2_t __attribute__((ext_vector_type(2)));
constexpr int STAGE = 32768, VOFF = 16384;
__device__ __forceinline__ int crow(int r, int hi) { return (r & 3) + 8 * (r >> 2) + 4 * hi; }
__device__ __forceinline__ unsigned cvtpk(float lo, float hi) { f32x2_t v = {lo, hi}; bf16x2_t b = __builtin_convertvector(v, bf16x2_t); return __builtin_bit_cast(unsigned, b); }
#define ATT_WAITBAR() asm volatile("s_waitcnt vmcnt(0) lgkmcnt(0)\n\ts_barrier" ::: "memory")
__device__ __forceinline__ void glds16(const void* gsrc, unsigned lds_dst) { unsigned keep;
    asm volatile("s_mov_b32 %0, m0\n\ts_mov_b32 m0, %2\n\ts_nop 0\n\tglobal_load_lds_dwordx4 %1, off\n\ts_mov_b32 m0, %0" : "=&s"(keep) : "v"(gsrc), "s"(lds_dst) : "memory"); }
#define ATT_DMA(src, dstoff) glds16((const void*)(src), (unsigned)__builtin_amdgcn_readfirstlane((int)(dstoff)))
#define ATT_MFMA(a, b, c) __builtin_amdgcn_mfma_f32_32x32x16_bf16((a), (b), (c), 0, 0, 0)
__device__ __forceinline__ float fadd_s(float a, float b) { float r; asm("v_add_f32 %0, %1, %2" : "=v"(r) : "v"(a), "v"(b)); return r; }

constexpr int KST = 16384, VST0 = 4 * KST, VSTB = 16384, WSF_OFF = VST0 + 3 * VSTB, STG_OFF = VST0, DUMMY_OFF = WSF_OFF + 1024;
constexpr int META_K_OFF = 126976, META_V_OFF = 135168;
__device__ __forceinline__ void attn_meta_tile(Frame& F, int bh) {
    LAS unsigned char* lds = F.lds; const int wave = F.wave, lane = F.lane, h = bh & 7;
    { const float* um = WSP(float, WS_META + MO_U);
      float mv[4];
#pragma unroll
      for (int i4 = 0; i4 < 4; ++i4) { const int itm = 4 * wave + i4; mv[i4] = um[(size_t)(itm >> 1) * NIN + 1024 + h * 128 + (itm & 1) * 64 + lane]; }
#pragma unroll
      for (int i4 = 0; i4 < 4; ++i4) { const int itm = 4 * wave + i4, p = itm >> 1, sh = itm & 1, d = lane;
          float v = mv[i4];
          const float r = __builtin_amdgcn_rsqf(wave_sum(v * v) * (1.0f / 64.0f) + EPS);
          v = v * r * F.in[9][d];
          const float pr = __shfl_xor(v, 8); const float* rp = WSP(float, WS_ROPE) + p * 16;
          if (d < 8) v = v * rp[d] - pr * rp[8 + d]; else if (d < 16) v = v * rp[d - 8] + pr * rp[d];
          const int dd = sh * 64 + d;
          *(LAS bf16*)(lds + META_K_OFF + p * 256 + (((dd >> 3) ^ p) << 4) + (dd & 7) * 2) = (bf16)f2bf(v); }
      { const int e = 4 * (wave * 64 + lane), key = e >> 7, d = e & 127; const f32x4 vv = *(const f32x4*)(um + (size_t)key * NIN + 2048 + h * 128 + d);
        u32x2v w2; w2.x = pk2(vv[0], vv[1]); w2.y = pk2(vv[2], vv[3]); *(LAS u32x2v*)(lds + META_V_OFF + (d >> 5) * 1024 + key * 64 + (d & 31) * 2) = w2; } }
}
__device__ __forceinline__ void attn_unit(Frame& F, int bh, int jq, float lam) {
    LAS unsigned char* lds = F.lds;
    const bf16* U = WSP(bf16, WS_ACT);
    int lane = F.lane; asm volatile("" : "+v"(lane));
    const int wave = F.wave, r32 = lane & 31, hi = lane >> 5;
    const int b = bh >> 3, h = bh & 7, rb = wave & 3, sub = wave >> 2;
    const int cw = 2 * jq + (rb >> 1);
    const int row0 = b * SEQ + 128 * jq + 32 * rb;
    const int T = 2 * jq + 2;
    const int kk0 = 8 * wave + (lane >> 4), kk1 = kk0 + 4;
    const bf16* kbase0 = U + (size_t)(b * SEQ + kk0) * NINP + 1024 + h * 128 + 8 * ((lane & 15) ^ (kk0 & 15));
    const bf16* kbase1 = U + (size_t)(b * SEQ + kk1) * NINP + 1024 + h * 128 + 8 * ((lane & 15) ^ (kk1 & 15));
    const int v0 = 2 * wave, v1 = 2 * wave + 1;
    const bf16* vbase0 = U + (size_t)(b * SEQ + 16 * (v0 & 3) + (lane >> 2)) * NINP + 2048 + h * 128 + 32 * (v0 >> 2) + 8 * (lane & 3);
    const bf16* vbase1 = U + (size_t)(b * SEQ + 16 * (v1 & 3) + (lane >> 2)) * NINP + 2048 + h * 128 + 32 * (v1 >> 2) + 8 * (lane & 3);
    const int kd0 = 2 * wave * 1024, kd1 = kd0 + 1024, vd0 = v0 * 1024, vd1 = v1 * 1024;
#define ATT_DMA_K(t, ks_) do { const size_t to_ = (size_t)(t) * 64 * NINP; ATT_DMA(kbase0 + to_, (ks_) + kd0); ATT_DMA(kbase1 + to_, (ks_) + kd1); } while (0)
#define ATT_DMA_V(t, vs_) do { const size_t to_ = (size_t)(t) * 64 * NINP; ATT_DMA(vbase0 + to_, (vs_) + vd0); ATT_DMA(vbase1 + to_, (vs_) + vd1); } while (0)
    ATT_DMA_K(0, 0); ATT_DMA_V(0, VST0); ATT_DMA_K(1, KST); ATT_DMA_V(1, VST0 + VSTB); if (T > 2) ATT_DMA_K(2, 2 * KST);
    bf16x8 qf[4];
#pragma unroll
    for (int ks = 0; ks < 4; ++ks) qf[ks] = *(const bf16x8*)(U + (size_t)(row0 + r32) * NINP + h * 128 + sub * 64 + 16 * ks + 8 * hi);
    f32x16 o[4];
#pragma unroll
    for (int d = 0; d < 4; ++d)
#pragma unroll
        for (int i = 0; i < 16; ++i) o[d][i] = 0.f;
    float lsum = 0.f;
    const f32x16 zero16 = {0.f, 0.f, 0.f, 0.f, 0.f, 0.f, 0.f, 0.f, 0.f, 0.f, 0.f, 0.f, 0.f, 0.f, 0.f, 0.f};
    const int koff = r32 * 256 + (((8 * sub + hi) ^ (r32 & 15)) << 4);
    const int voff = ((lane >> 4) & 1) * 32 + (lane & 3) * 8 + (4 * hi + ((lane & 15) >> 2)) * 64;
#define ATT_KF(kst_, half, ks) (*(const LAS bf16x8*)(lds + (kst_) + (half) * 8192 + (koff ^ ((ks) << 5))))
#define ATT_VTR(vst_, off) __builtin_bit_cast(s16x4, __builtin_amdgcn_ds_read_tr16_b64_v4i16((LAS v4i16_t*)(lds + (vst_) + voff + (off))))
    ATT_WAITBAR();
    f32x16 s0 = zero16, s1 = zero16;
    {
        f32x16 sc = zero16;
#pragma unroll
        for (int ks = 0; ks < 4; ++ks) sc = ATT_MFMA(ATT_KF(META_K_OFF, 0, ks), qf[ks], sc);
#pragma unroll
        for (int ks = 0; ks < 4; ++ks) { s0 = ATT_MFMA(ATT_KF(0, 0, ks), qf[ks], s0); s1 = ATT_MFMA(ATT_KF(0, 1, ks), qf[ks], s1); }
#pragma unroll
        for (int i = 0; i < 8; ++i) { sc[i] = __builtin_amdgcn_exp2f(sc[i]); lsum += sc[i]; }
        v4u pw; pw.x = cvtpk(sc[0], sc[1]); pw.y = cvtpk(sc[2], sc[3]); pw.z = cvtpk(sc[4], sc[5]); pw.w = cvtpk(sc[6], sc[7]);
        const bf16x8 pm = __builtin_bit_cast(bf16x8, pw);
#pragma unroll
        for (int d = 0; d < 4; ++d) { const s16x4 lo = ATT_VTR(META_V_OFF, d * 1024), hh = ATT_VTR(META_V_OFF, d * 1024 + 512);
            const bf16x8 vf = {lo[0], lo[1], lo[2], lo[3], hh[0], hh[1], hh[2], hh[3]};
            o[d] = ATT_MFMA(pm, vf, o[d]); }
    }
    ATT_WAITBAR();
    int vm0 = 0, vm2 = 2;
#define SBAR() __builtin_amdgcn_sched_barrier(0)
#define ATT_VTRP(vp_, off) __builtin_bit_cast(s16x4, __builtin_amdgcn_ds_read_tr16_b64_v4i16((LAS v4i16_t*)((vp_) + (off))))
#define ATT_VLOAD(buf, vst_, d, kp) do { _Pragma("unroll") for (int ks_ = 0; ks_ < 2; ++ks_) { vlo[buf][ks_] = ATT_VTRP(vst_, (d) * 4096 + (2 * (kp) + ks_) * 1024); vhi[buf][ks_] = ATT_VTRP(vst_, (d) * 4096 + (2 * (kp) + ks_) * 1024 + 512); } } while (0)
#define ATT_GQ(MF) do { MF; SBAR(); } while (0)
#define ATT_GS(NV, b4, PW, w0, w1) do { ls = (((ls + NV[b4]) + NV[b4 + 1]) + NV[b4 + 2]) + NV[b4 + 3];     PW[w0] = cvtpk(NV[b4], NV[b4 + 1]); PW[w1] = cvtpk(NV[b4 + 2], NV[b4 + 3]); } while (0)
#define ATT_GB(MF, NV, i0, GS) do { MF; NV[i0] = __builtin_amdgcn_exp2f(NV[i0]); NV[i0 + 1] = __builtin_amdgcn_exp2f(NV[i0 + 1]); GS; SBAR(); } while (0)
#define ATT_VF(buf, ks_) (bf16x8){vlo[buf][ks_][0], vlo[buf][ks_][1], vlo[buf][ks_][2], vlo[buf][ks_][3], vhi[buf][ks_][0], vhi[buf][ks_][1], vhi[buf][ks_][2], vhi[buf][ks_][3]}
#define ATT_STEP(C0, C1, C2, C3, D0, D1, D2, D3, tt) do { \
        const int t_ = (tt); const int knext = ((t_ + 1) & 3) * KST, kdst = ((t_ + 3) & 3) * KST, vdst = VST0 + vm2 * VSTB; \
        LAS unsigned char* vcur = lds + VST0 + vm0 * VSTB + voff; asm volatile("" : "+v"(vcur));     \
        const bool dk = t_ + 3 < T, dv = t_ + 2 < T; const size_t tok_ = dk ? (size_t)(t_ + 3) * 64 * NINP : 0, tov_ = dv ? (size_t)(t_ + 2) * 64 * NINP : 0; \
        const int dK0 = dk ? kdst + kd0 : DUMMY_OFF + wave * 1024, dK1 = dk ? kdst + kd1 : DUMMY_OFF + wave * 1024, dV0 = dv ? vdst + vd0 : DUMMY_OFF + wave * 1024, dV1 = dv ? vdst + vd1 : DUMMY_OFF + wave * 1024; \
        ATT_DMA(kbase0 + tok_, dK0); ATT_DMA(kbase1 + tok_, dK1); ATT_DMA(vbase0 + tov_, dV0); ATT_DMA(vbase1 + tov_, dV1); \
        if (t_ <= cw) { \
            bf16x8 kf[4]; s16x4 vlo[2][2], vhi[2][2]; f32x16 N0, N1; float ls = 0.f; \
            SBAR(); \
            kf[0] = ATT_KF(knext, 0, 0); kf[1] = ATT_KF(knext, 1, 0); kf[2] = ATT_KF(knext, 0, 1); kf[3] = ATT_KF(knext, 1, 1); SBAR(); \
            ATT_GQ(N0 = ATT_MFMA(kf[0], qf[0], zero16)); \
            ATT_GQ(N1 = ATT_MFMA(kf[1], qf[0], zero16)); \
            kf[0] = ATT_KF(knext, 0, 2); kf[1] = ATT_KF(knext, 1, 2); SBAR(); \
            ATT_GQ(N0 = ATT_MFMA(kf[2], qf[1], N0)); \
            ATT_GQ(N1 = ATT_MFMA(kf[3], qf[1], N1)); \
            kf[2] = ATT_KF(knext, 0, 3); kf[3] = ATT_KF(knext, 1, 3); SBAR(); \
            ATT_GQ(N0 = ATT_MFMA(kf[0], qf[2], N0)); \
            ATT_GQ(N1 = ATT_MFMA(kf[1], qf[2], N1)); \
            ATT_VLOAD(0, vcur, 0, 0); SBAR(); \
            ATT_GQ(N0 = ATT_MFMA(kf[2], qf[3], N0)); \
            ATT_GQ(N1 = ATT_MFMA(kf[3], qf[3], N1)); \
            const bf16x8 pf0 = __builtin_bit_cast(bf16x8, C0), pf1 = __builtin_bit_cast(bf16x8, C1), pf2 = __builtin_bit_cast(bf16x8, C2), pf3 = __builtin_bit_cast(bf16x8, C3); \
            ATT_VLOAD(1, vcur, 0, 1); SBAR(); \
            ATT_GB(o[0] = ATT_MFMA(pf0, ATT_VF(0, 0), o[0]), N0, 0, (void)0); ATT_GB(o[0] = ATT_MFMA(pf1, ATT_VF(0, 1), o[0]), N0, 2, (void)0); \
            ATT_VLOAD(0, vcur, 1, 0); SBAR(); \
            ATT_GB(o[0] = ATT_MFMA(pf2, ATT_VF(1, 0), o[0]), N0, 4, ATT_GS(N0, 0, D0, 0, 1)); ATT_GB(o[0] = ATT_MFMA(pf3, ATT_VF(1, 1), o[0]), N0, 6, (void)0); \
            ATT_VLOAD(1, vcur, 1, 1); SBAR(); \
            ATT_GB(o[1] = ATT_MFMA(pf0, ATT_VF(0, 0), o[1]), N0, 8, ATT_GS(N0, 4, D0, 2, 3)); ATT_GB(o[1] = ATT_MFMA(pf1, ATT_VF(0, 1), o[1]), N0, 10, (void)0); \
            ATT_VLOAD(0, vcur, 2, 0); SBAR(); \
            ATT_GB(o[1] = ATT_MFMA(pf2, ATT_VF(1, 0), o[1]), N0, 12, ATT_GS(N0, 8, D1, 0, 1)); ATT_GB(o[1] = ATT_MFMA(pf3, ATT_VF(1, 1), o[1]), N0, 14, (void)0); \
            ATT_VLOAD(1, vcur, 2, 1); SBAR(); \
            ATT_GB(o[2] = ATT_MFMA(pf0, ATT_VF(0, 0), o[2]), N1, 0, ATT_GS(N0, 12, D1, 2, 3)); ATT_GB(o[2] = ATT_MFMA(pf1, ATT_VF(0, 1), o[2]), N1, 2, (void)0); \
            ATT_VLOAD(0, vcur, 3, 0); SBAR(); \
            ATT_GB(o[2] = ATT_MFMA(pf2, ATT_VF(1, 0), o[2]), N1, 4, ATT_GS(N1, 0, D2, 0, 1)); ATT_GB(o[2] = ATT_MFMA(pf3, ATT_VF(1, 1), o[2]), N1, 6, (void)0); \
            ATT_VLOAD(1, vcur, 3, 1); SBAR(); \
            ATT_GB(o[3] = ATT_MFMA(pf0, ATT_VF(0, 0), o[3]), N1, 8, ATT_GS(N1, 4, D2, 2, 3)); ATT_GB(o[3] = ATT_MFMA(pf1, ATT_VF(0, 1), o[3]), N1, 10, (void)0); \
            ATT_GB(o[3] = ATT_MFMA(pf2, ATT_VF(1, 0), o[3]), N1, 12, ATT_GS(N1, 8, D3, 0, 1)); ATT_GB(o[3] = ATT_MFMA(pf3, ATT_VF(1, 1), o[3]), N1, 14, (void)0); \
            ATT_GS(N1, 12, D3, 2, 3); \
            lsum += (t_ < cw) ? ls : 0.f;     \
        } \
          \
        asm volatile("s_waitcnt vmcnt(4) lgkmcnt(0)\n\ts_barrier" ::: "memory"); \
        vm0 = (vm0 == 2) ? 0 : vm0 + 1; vm2 = (vm2 == 2) ? 0 : vm2 + 1; \
    } while (0)
    v4u pa0, pa1, pa2, pa3, pb0, pb1, pb2, pb3;
    pb0 = pb1 = pb2 = pb3 = (v4u){0u, 0u, 0u, 0u};
    {
#pragma unroll
        for (int i = 0; i < 16; ++i) { s0[i] = __builtin_amdgcn_exp2f(s0[i]); s1[i] = __builtin_amdgcn_exp2f(s1[i]); }
        float ls = 0.f;
        ATT_GS(s0, 0, pa0, 0, 1); ATT_GS(s0, 4, pa0, 2, 3); ATT_GS(s0, 8, pa1, 0, 1); ATT_GS(s0, 12, pa1, 2, 3);
        ATT_GS(s1, 0, pa2, 0, 1); ATT_GS(s1, 4, pa2, 2, 3); ATT_GS(s1, 8, pa3, 0, 1); ATT_GS(s1, 12, pa3, 2, 3);
        lsum += ls;
    }
    for (int t = 0; t < T; t += 2) { ATT_STEP(pa0, pa1, pa2, pa3, pb0, pb1, pb2, pb3, t); ATT_STEP(pb0, pb1, pb2, pb3, pa0, pa1, pa2, pa3, t + 1); }
    ATT_WAITBAR();
#undef ATT_STEP
#undef ATT_VLOAD
#undef ATT_GQ
#undef ATT_GS
#undef ATT_GB
#undef ATT_VF
#undef SBAR
    int le = lane; asm volatile("" : "+v"(le));
    const int r32e = le & 31, hie = le >> 5;
    lsum += __shfl_xor(lsum, 32);
    LAS float* wsf = (LAS float*)(lds + WSF_OFF + wave * 128);
    float wn[4];
#pragma unroll
    for (int d = 0; d < 4; ++d) wn[d] = F.in[14][32 * d + r32e];
    const float fac = (sub == 0 ? 1.0f : lam) / lsum;
    if (hie == 0) wsf[r32e] = fac;
    LDS_WAIT(); asm volatile("" ::: "memory");
    LAS float* xo = (LAS float*)(lds + (wave & 3) * 16384) + le;
    if (sub == 1) {
#pragma unroll
        for (int i = 0; i < 16; ++i) { const float f = wsf[crow(i, hie)];
#pragma unroll
            for (int d = 0; d < 4; ++d) xo[(d * 16 + i) * 64] = o[d][i] * f; }
    }
    ATT_WAITBAR();
    if (sub == 0) {
        LAS bf16* stg = (LAS bf16*)(lds + STG_OFF + wave * 8192);
#pragma unroll
        for (int d = 0; d < 4; ++d) wn[d] *= 0.8f;
#pragma unroll
        for (int i = 0; i < 16; ++i) { const int q = crow(i, hie); const float f1 = wsf[q];
            float v[4], ss = 0.f;
#pragma unroll
            for (int d = 0; d < 4; ++d) { v[d] = o[d][i] * f1 - xo[(d * 16 + i) * 64]; ss += v[d] * v[d]; }
            ss += __shfl_xor(ss, 1); ss += __shfl_xor(ss, 2); ss += __shfl_xor(ss, 4); ss += __shfl_xor(ss, 8); ss += __shfl_xor(ss, 16);
            const float r = __builtin_amdgcn_rsqf(ss * (1.0f / 128.0f) + EPS);
#pragma unroll
            for (int d = 0; d < 4; ++d) stg[q * 128 + 32 * d + r32e] = (bf16)(cvtpk(v[d] * r * wn[d], 0.f) & 0xffffu); }
        LDS_WAIT(); asm volatile("" ::: "memory");
#pragma unroll
        for (int it = 0; it < 8; ++it) { const int q = 4 * it + (le >> 4), ch = le & 15;
            const v4u val = *(const LAS v4u*)(stg + q * 128 + 8 * ch);
            *(v4u*)(WSP(bf16, WS_MIX) + (size_t)(row0 + q) * DM + 1024 + h * 128 + 8 * ch) = val; }
    }
    ATT_WAITBAR();
#undef ATT_DMA_K
#undef ATT_DMA_V
#undef ATT_KF
#undef ATT_VTR
}
}


namespace ssd {
constexpr int S64 = 144, S128 = 272;
constexpr int O_CC = 0, O_BC = 17408, O_BT = 34816, O_XT = 53248, O_XS = 62464, O_XC = 71680, O_M = 80896, O_SI = 90112, O_SC = 107520;
#define SSD_MF(a, b, c) __builtin_amdgcn_mfma_f32_16x16x32_bf16((a), (b), (c), 0, 0, 0)
#define SSD_FRAG(img, stride, row, k) (*(const LAS bf16x8*)(lds + (img) + (row) * (stride) + 2 * (k)))
#define SSD_BAR() do { asm volatile("s_waitcnt vmcnt(0) lgkmcnt(0)" ::: "memory"); __builtin_amdgcn_s_barrier(); asm volatile("" ::: "memory"); } while (0)

__device__ __forceinline__ v4u pack8(const float (&v)[8]) { v4u o; o.x = pk2(v[0], v[1]); o.y = pk2(v[2], v[3]); o.z = pk2(v[4], v[5]); o.w = pk2(v[6], v[7]); return o; }
__device__ __forceinline__ unsigned bfe16(const v4u& r, int e) { const unsigned w = (e < 2) ? r.x : (e < 4) ? r.y : (e < 6) ? r.z : r.w; return (e & 1) ? (w >> 16) : (w & 0xffffu); }

template <bool PASSB>
__device__ __forceinline__ void ssd_item(Frame& F, int item, int& bgj) {
    LAS unsigned char* lds = F.lds;
    int lane0 = F.lane; asm volatile("" : "+v"(lane0));
    const int wave = F.wave;
    const int k = item & 7, hd = (item >> 3) & 15, b = item >> 7, g = hd >> 3;
    const float Ah = -__expf(F.in[18][hd]), Dk = F.in[19][hd];
    LAS float* sc = (LAS float*)(lds + O_SC);
    const int pt = wave >> 1, nb = 4 * (wave & 1);
    f32x4 stt[4];
#pragma unroll
    for (int j = 0; j < 4; ++j) stt[j] = (f32x4){0.f, 0.f, 0.f, 0.f};
    float* sst = WSP(float, WS_SST) + (size_t)((b * SH + hd) * 8) * 8192;
    float* atot = WSP(float, WS_ATOT) + (b * SH + hd) * 8;
    if (PASSB) {
        const int fr = lane0 & 15, fq = lane0 >> 4;
        for (int kk = 0; kk < k; ++kk) { const float dec = __expf(atot[kk]);
#pragma unroll
            for (int j = 0; j < 4; ++j) { const f32x4 s = *(const f32x4*)(sst + (size_t)kk * 8192 + (16 * pt + fr) * 128 + 16 * (nb + j) + 4 * fq); stt[j] = stt[j] * dec + s; } }
    }
    float asum = 0.f;
    const int c_lo = (k == 0) ? 0 : 8 * k + 1, c_hi = 8 * k + 8;
    const int role = (wave < 2) ? 0 : (wave < 4) ? 1 : (wave < 6 && PASSB) ? 2 : 3;
    v4u raw[8]; float dtv = 0.f;
    { const int li = (wave * 64 + lane0) & 127, cg = (role == 0) ? (li & 7) : (li & 15), l0 = (role == 0) ? 4 * (li >> 3) : 8 * (li >> 4);
      if (role == 0) { const bf16* src = WSP(bf16, WS_XS) + (size_t)(b * LPAD + 64 * c_lo + l0) * 1024 + hd * 64 + 8 * cg;
#pragma unroll
          for (int i = 0; i < 4; ++i) raw[i] = *(const v4u*)(src + (size_t)i * 1024); }
      else if (role < 3) { const bf16* src = WSP(bf16, WS_BC) + (size_t)(b * LPAD + 64 * c_lo + l0) * 512 + (role == 2 ? 256 : 0) + g * 128 + 8 * cg;
#pragma unroll
          for (int i = 0; i < 8; ++i) raw[i] = *(const v4u*)(src + (size_t)i * 512); }
      if (wave == 7) dtv = WSP(float, WS_DT)[(size_t)(b * LPAD + 64 * c_lo + lane0) * 16 + hd]; }
    for (int c = c_lo; c <= c_hi; ++c) {
        int lane = lane0; asm volatile("" : "+v"(lane));
        const int tid = wave * 64 + lane, fr = lane & 15, fq = lane >> 4, li = tid & 127;
        const int cg = (role == 0) ? (li & 7) : (li & 15), l0 = (role == 0) ? 4 * (li >> 3) : 8 * (li >> 4);
        u32x2v zv[2];
        if (PASSB && c >= 1) {
#pragma unroll
            for (int j = 0; j < 2; ++j) zv[j] = *(const u32x2v*)(WSP(bf16, WS_ACT) + (size_t)(b * SEQ + 64 * (c - 1) + 16 * pt + fr) * NINP + 3072 + hd * 64 + 16 * (2 * (wave & 1) + j) + 4 * fq);
        }
        const int cn = (c < c_hi) ? c + 1 : c;
        f32x4 cv[8]; TItem ct; bool chave = false; int chh = 0;
        if (role == 0) {
            if (PASSB) {
#pragma unroll
                for (int i = 0; i < 4; ++i) *(LAS v4u*)(lds + O_XC + (l0 + i) * S64 + 16 * cg) = raw[i]; }
#pragma unroll
            for (int e = 0; e < 8; ++e) { u32x2v w2; w2.x = bfe16(raw[0], e) | (bfe16(raw[1], e) << 16); w2.y = bfe16(raw[2], e) | (bfe16(raw[3], e) << 16); *(LAS u32x2v*)(lds + O_XT + (8 * cg + e) * S64 + 2 * l0) = w2; }
            const bf16* src = WSP(bf16, WS_XS) + (size_t)(b * LPAD + 64 * cn + l0) * 1024 + hd * 64 + 8 * cg;
#pragma unroll
            for (int i = 0; i < 4; ++i) raw[i] = *(const v4u*)(src + (size_t)i * 1024);
        } else if (role == 1) {
            if (PASSB) {
#pragma unroll
                for (int i = 0; i < 8; ++i) *(LAS v4u*)(lds + O_BC + (l0 + i) * S128 + 16 * cg) = raw[i]; }
#pragma unroll
            for (int e = 0; e < 8; ++e) { v4u w4; w4.x = bfe16(raw[0], e) | (bfe16(raw[1], e) << 16); w4.y = bfe16(raw[2], e) | (bfe16(raw[3], e) << 16); w4.z = bfe16(raw[4], e) | (bfe16(raw[5], e) << 16); w4.w = bfe16(raw[6], e) | (bfe16(raw[7], e) << 16);
                *(LAS v4u*)(lds + O_BT + (8 * cg + e) * S64 + 2 * l0) = w4; }
            const bf16* src = WSP(bf16, WS_BC) + (size_t)(b * LPAD + 64 * cn + l0) * 512 + g * 128 + 8 * cg;
#pragma unroll
            for (int i = 0; i < 8; ++i) raw[i] = *(const v4u*)(src + (size_t)i * 512);
        } else if (role == 2) {
#pragma unroll
            for (int i = 0; i < 8; ++i) *(LAS v4u*)(lds + O_CC + (l0 + i) * S128 + 16 * cg) = raw[i];
            const bf16* src = WSP(bf16, WS_BC) + (size_t)(b * LPAD + 64 * cn + l0) * 512 + 256 + g * 128 + 8 * cg;
#pragma unroll
            for (int i = 0; i < 8; ++i) raw[i] = *(const v4u*)(src + (size_t)i * 512);
        }
        if (wave == 7) {
            const float dt = dtv;
            dtv = WSP(float, WS_DT)[(size_t)(b * LPAD + 64 * cn + lane) * 16 + hd];
            float a = dt * Ah;
#pragma unroll
            for (int o2 = 1; o2 < 64; o2 <<= 1) { const float t = __shfl_up(a, o2); if (lane >= o2) a += t; }
            const float aend = __shfl(a, 63);
            sc[lane] = dt; sc[64 + lane] = a; sc[128 + lane] = dt * __expf(aend - a);
            if (lane == 0) sc[192] = aend;
        }
        if (PASSB && F.NGW == 2048) { const int hix = bgj * 2048 + F.gw, cit = IT_BG + (hix >> 1); chh = hix & 1; chave = bgj < 8 && cit < IT_END; ++bgj;
            if (chave) { ct = mk_item(F, cit); transpose_load_h(ct, lane, chh, cv); } }
        asm volatile("s_waitcnt lgkmcnt(0)" ::: "memory"); __builtin_amdgcn_s_barrier(); asm volatile("" ::: "memory");
        const float aend = sc[192];
        for (int amp2_ = 0; amp2_ < (MK_AMP == 2 ? 3 : 1); ++amp2_) {
        { const int p = tid >> 3, lg = (tid & 7) * 8;
          const v4u xv = *(const LAS v4u*)(lds + O_XT + p * S64 + 2 * lg); const unsigned xw[4] = {xv.x, xv.y, xv.z, xv.w}; float v[8];
#pragma unroll
          for (int e = 0; e < 4; ++e) { v[2 * e] = bf2f(xw[e] & 0xffffu) * sc[128 + lg + 2 * e]; v[2 * e + 1] = bf2f(xw[e] >> 16) * sc[128 + lg + 2 * e + 1]; }
          *(LAS v4u*)(lds + O_XS + p * S64 + 2 * lg) = pack8(v); }
        if (PASSB) {
#pragma unroll
            for (int j = 0; j < 4; ++j) { u32x2v w2; w2.x = pk2(stt[j][0], stt[j][1]); w2.y = pk2(stt[j][2], stt[j][3]); *(LAS u32x2v*)(lds + O_SI + (16 * pt + fr) * S128 + 2 * (16 * (nb + j) + 4 * fq)) = w2; }
            const int l = 16 * pt + fr; const float al = sc[64 + l];
#pragma unroll
            for (int j = 0; j < 2; ++j) { const int st = 2 * (wave & 1) + j; f32x4 acc = (f32x4){0.f, 0.f, 0.f, 0.f};
                if (st <= pt) {
#pragma unroll
                    for (int ks = 0; ks < 4; ++ks) acc = SSD_MF(SSD_FRAG(O_BC, S128, 16 * st + fr, 32 * ks + 8 * fq), SSD_FRAG(O_CC, S128, l, 32 * ks + 8 * fq), acc);
                    asm volatile("s_nop 15\n\ts_nop 3" : "+v"(acc)); }
                float m[4];
#pragma unroll
                for (int i = 0; i < 4; ++i) { const int s = 16 * st + 4 * fq + i; m[i] = (s <= l) ? acc[i] * __expf(al - sc[64 + s]) * sc[s] : 0.f; }
                u32x2v w2; w2.x = pk2(m[0], m[1]); w2.y = pk2(m[2], m[3]); *(LAS u32x2v*)(lds + O_M + l * S64 + 2 * (16 * st + 4 * fq)) = w2; }
        }
        }
        asm volatile("s_waitcnt lgkmcnt(0)" ::: "memory"); __builtin_amdgcn_s_barrier(); asm volatile("" ::: "memory");
        for (int amp3_ = 0; amp3_ < (MK_AMP == 3 ? 3 : 1); ++amp3_) {
        if (PASSB && c >= 1) {
            const int l = 16 * pt + fr, row = b * SEQ + 64 * (c - 1) + l; const float el = __expf(sc[64 + l]);
            float sq = 0.f;
#pragma unroll
            for (int j = 0; j < 2; ++j) { const int ptile = 2 * (wave & 1) + j; f32x4 acc = (f32x4){0.f, 0.f, 0.f, 0.f};
#pragma unroll
                for (int ks = 0; ks < 4; ++ks) acc = SSD_MF(SSD_FRAG(O_SI, S128, 16 * ptile + fr, 32 * ks + 8 * fq), SSD_FRAG(O_CC, S128, l, 32 * ks + 8 * fq), acc);
                acc = acc * el;
#pragma unroll
                for (int ks = 0; ks < 2; ++ks) acc = SSD_MF(SSD_FRAG(O_XT, S64, 16 * ptile + fr, 32 * ks + 8 * fq), SSD_FRAG(O_M, S64, l, 32 * ks + 8 * fq), acc);
                const int pc = 16 * ptile + 4 * fq;
                const u32x2v xv = *(const LAS u32x2v*)(lds + O_XC + l * S64 + 2 * pc);
                float y[4];
                y[0] = (acc[0] + Dk * bf2f(xv.x & 0xffffu)) * silu1(bf2f(zv[j].x & 0xffffu)); y[1] = (acc[1] + Dk * bf2f(xv.x >> 16)) * silu1(bf2f(zv[j].x >> 16));
                y[2] = (acc[2] + Dk * bf2f(xv.y & 0xffffu)) * silu1(bf2f(zv[j].y & 0xffffu)); y[3] = (acc[3] + Dk * bf2f(xv.y >> 16)) * silu1(bf2f(zv[j].y >> 16));
                sq += (y[0] * y[0] + y[1] * y[1]) + (y[2] * y[2] + y[3] * y[3]);
                u32x2v w2; w2.x = pk2(y[0], y[1]); w2.y = pk2(y[2], y[3]);
                *(u32x2v*)(WSP(bf16, WS_MIX) + (size_t)row * DM + hd * 64 + pc) = w2; }
            sq += __shfl_xor(sq, 16); sq += __shfl_xor(sq, 32);
            if (fq == 0) WSP(float, WS_SSQS)[(size_t)row * 32 + 2 * hd + (wave & 1)] = sq;
        }
        }
        { const float dec = __expf(aend);
#pragma unroll
          for (int j = 0; j < 4; ++j) { f32x4 acc = stt[j] * dec;
#pragma unroll
              for (int ks = 0; ks < 2; ++ks) acc = SSD_MF(SSD_FRAG(O_BT, S64, 16 * (nb + j) + fr, 32 * ks + 8 * fq), SSD_FRAG(O_XS, S64, 16 * pt + fr, 32 * ks + 8 * fq), acc);
              stt[j] = acc; } }
        asum += aend;
        if (PASSB) { if (chave) transpose_finish_h(ct, lane, chh, cv); }
        asm volatile("s_waitcnt lgkmcnt(0)" ::: "memory"); __builtin_amdgcn_s_barrier(); asm volatile("" ::: "memory");
    }
    if (!PASSB) { const int fr = lane0 & 15, fq = lane0 >> 4;
#pragma unroll
        for (int j = 0; j < 4; ++j) *(f32x4*)(sst + (size_t)k * 8192 + (16 * pt + fr) * 128 + 16 * (nb + j) + 4 * fq) = stt[j];
        if (wave == 0 && lane0 == 0) atot[k] = asum;
    }
}

constexpr int A_XS0 = 0, A_XS1 = 9216, A_BT0 = 18432, A_BT1 = 36864, A_W = 55296, A_ACS = 57600, A_DT = 59904, A_TOT = 62208;
__device__ __forceinline__ void ssd_pass_a(Frame& F, int item) {
    LAS unsigned char* lds = F.lds;
    int lane = F.lane; asm volatile("" : "+v"(lane));
    const int wave = F.wave, tid = wave * 64 + lane, fr = lane & 15, fq = lane >> 4;
    const int k = item & 7, hd = (item >> 3) & 15, b = item >> 7, g = hd >> 3;
    const float Ah = -__expf(F.in[18][hd]);
    const int c_lo = (k == 0) ? 0 : 8 * k + 1, c_hi = 8 * k + 8, nt = c_hi - c_lo + 1;
    const int pt = wave >> 1, nb = 4 * (wave & 1);
    const int role = (wave < 2) ? 0 : (wave < 4) ? 1 : 3;
    const int li = tid & 127, cg = (role == 0) ? (li & 7) : (li & 15), l0 = (role == 0) ? 4 * (li >> 3) : 8 * (li >> 4);
    LAS float* wl = (LAS float*)(lds + A_W); LAS float* acs = (LAS float*)(lds + A_ACS); LAS float* dts = (LAS float*)(lds + A_DT); LAS float* tot = (LAS float*)(lds + A_TOT);
    v4u raw[8];
    { if (role == 0) { const bf16* src = WSP(bf16, WS_XS) + (size_t)(b * LPAD + 64 * c_lo + l0) * 1024 + hd * 64 + 8 * cg;
#pragma unroll
          for (int i = 0; i < 4; ++i) raw[i] = *(const v4u*)(src + (size_t)i * 1024); }
      else if (role == 1) { const bf16* src = WSP(bf16, WS_BC) + (size_t)(b * LPAD + 64 * c_lo + l0) * 512 + g * 128 + 8 * cg;
#pragma unroll
          for (int i = 0; i < 8; ++i) raw[i] = *(const v4u*)(src + (size_t)i * 512); } }
    for (int t = wave; t < nt; t += NWAVES) {
        const float dt = WSP(float, WS_DT)[(size_t)(b * LPAD + 64 * (c_lo + t) + lane) * 16 + hd];
        float a = dt * Ah;
#define SSD_DPP_ADD(ctrl, rmask) a += __builtin_bit_cast(float, __builtin_amdgcn_update_dpp(0, __builtin_bit_cast(int, a), (ctrl), (rmask), 0xf, false))
        SSD_DPP_ADD(0x111, 0xf); SSD_DPP_ADD(0x112, 0xf); SSD_DPP_ADD(0x114, 0xf); SSD_DPP_ADD(0x118, 0xf); SSD_DPP_ADD(0x142, 0xa); SSD_DPP_ADD(0x143, 0xc);
#undef SSD_DPP_ADD
        acs[t * 64 + lane] = a; dts[t * 64 + lane] = dt; if (lane == 63) tot[t] = a;
    }
    asm volatile("s_waitcnt lgkmcnt(0)" ::: "memory"); __builtin_amdgcn_s_barrier(); asm volatile("" ::: "memory");
    float atotal = 0.f;
    { float tv[9];
#pragma unroll
      for (int t = 0; t < 9; ++t) { tv[t] = (t < nt) ? tot[t] : 0.f; atotal += tv[t]; }
      for (int t = wave; t < nt; t += NWAVES) { float off = 0.f;
#pragma unroll
          for (int u = 0; u < 9; ++u) off += (u < t) ? tv[u] : 0.f;
          wl[t * 64 + lane] = dts[t * 64 + lane] * __expf(atotal - (off + acs[t * 64 + lane])); } }
    f32x4 stt[4];
#pragma unroll
    for (int j = 0; j < 4; ++j) stt[j] = (f32x4){0.f, 0.f, 0.f, 0.f};
    asm volatile("s_waitcnt lgkmcnt(0)" ::: "memory"); __builtin_amdgcn_s_barrier(); asm volatile("" ::: "memory");
    for (int t = 0; t < nt; ++t) {
        const int xs_img = (t & 1) ? A_XS1 : A_XS0, bt_img = (t & 1) ? A_BT1 : A_BT0;
        const int cn = c_lo + ((t + 1 < nt) ? t + 1 : t);
        if (role == 0) {
            const f32x4 w4 = *(const LAS f32x4*)(wl + t * 64 + l0);
#pragma unroll
            for (int e = 0; e < 8; ++e) { u32x2v w2;
                w2.x = pk2(bf2f(bfe16(raw[0], e)) * w4[0], bf2f(bfe16(raw[1], e)) * w4[1]); w2.y = pk2(bf2f(bfe16(raw[2], e)) * w4[2], bf2f(bfe16(raw[3], e)) * w4[3]);
                *(LAS u32x2v*)(lds + xs_img + (8 * cg + e) * S64 + 2 * l0) = w2; }
            const bf16* src = WSP(bf16, WS_XS) + (size_t)(b * LPAD + 64 * cn + l0) * 1024 + hd * 64 + 8 * cg;
#pragma unroll
            for (int i = 0; i < 4; ++i) raw[i] = *(const v4u*)(src + (size_t)i * 1024);
        } else if (role == 1) {
#pragma unroll
            for (int e = 0; e < 8; ++e) { v4u w4; w4.x = bfe16(raw[0], e) | (bfe16(raw[1], e) << 16); w4.y = bfe16(raw[2], e) | (bfe16(raw[3], e) << 16); w4.z = bfe16(raw[4], e) | (bfe16(raw[5], e) << 16); w4.w = bfe16(raw[6], e) | (bfe16(raw[7], e) << 16);
                *(LAS v4u*)(lds + bt_img + (8 * cg + e) * S64 + 2 * l0) = w4; }
            const bf16* src = WSP(bf16, WS_BC) + (size_t)(b * LPAD + 64 * cn + l0) * 512 + g * 128 + 8 * cg;
#pragma unroll
            for (int i = 0; i < 8; ++i) raw[i] = *(const v4u*)(src + (size_t)i * 512);
        }
        asm volatile("s_waitcnt lgkmcnt(0)" ::: "memory"); __builtin_amdgcn_s_barrier(); asm volatile("" ::: "memory");
#pragma unroll
        for (int j = 0; j < 4; ++j) { f32x4 acc = stt[j];
#pragma unroll
            for (int ks = 0; ks < 2; ++ks) acc = SSD_MF(SSD_FRAG(bt_img, S64, 16 * (nb + j) + fr, 32 * ks + 8 * fq), SSD_FRAG(xs_img, S64, 16 * pt + fr, 32 * ks + 8 * fq), acc);
            stt[j] = acc; }
    }
    float* sst = WSP(float, WS_SST) + (size_t)((b * SH + hd) * 8) * 8192;
#pragma unroll
    for (int j = 0; j < 4; ++j) *(f32x4*)(sst + (size_t)k * 8192 + (16 * pt + fr) * 128 + 16 * (nb + j) + 4 * fq) = stt[j];
    if (wave == 0 && lane == 0) WSP(float, WS_ATOT)[(b * SH + hd) * 8 + k] = atotal;
    asm volatile("s_waitcnt lgkmcnt(0)" ::: "memory"); __builtin_amdgcn_s_barrier(); asm volatile("" ::: "memory");
}
}

struct ConvItem { int c, pp, b, p; v4u rv[4]; bool fast; };
__device__ __forceinline__ void conv_issue(Frame& F, int it, ConvItem& q) {
    const bf16* U = WSP(bf16, WS_ACT); const float* um = WSP(float, WS_META + MO_U);
    const int cg = it % (CONVD / 8); q.pp = (it / (CONVD / 8)) % LPAD; q.b = it / ((CONVD / 8) * LPAD); q.c = 8 * cg; q.p = q.pp - PPAD;
#pragma unroll
    for (int w = 0; w < 4; ++w) q.rv[w] = (v4u){0u, 0u, 0u, 0u};
    if (q.p >= 0) {
        if (q.p - 3 >= NMETA) { const bf16* src = U + (size_t)(q.b * SEQ + q.p - 3 - NMETA) * NINP + 4096 + q.c;
#pragma unroll
            for (int w = 0; w < 4; ++w) q.rv[w] = *(const v4u*)(src + (size_t)w * NINP); }
        else {
#pragma unroll
            for (int w = 0; w < 4; ++w) { const int ps = q.p - 3 + w; v4u v = (v4u){0u, 0u, 0u, 0u};
                if (ps >= NMETA) v = *(const v4u*)(U + (size_t)(q.b * SEQ + ps - NMETA) * NINP + 4096 + q.c);
                else if (ps >= 0) { const f32x4 r0 = *(const f32x4*)(um + (size_t)ps * NIN + 4096 + q.c), r1 = *(const f32x4*)(um + (size_t)ps * NIN + 4096 + q.c + 4);
                    v.x = pk2(r0[0], r0[1]); v.y = pk2(r0[2], r0[3]); v.z = pk2(r1[0], r1[1]); v.w = pk2(r1[2], r1[3]); }
                q.rv[w] = v; } }
    }
}
__device__ __forceinline__ void conv_finish(Frame& F, const ConvItem& q) {
    const float* cw = F.in[15]; const float* cb = F.in[16]; const int c = q.c;
    float a[8];
#pragma unroll
    for (int e = 0; e < 8; ++e) a[e] = 0.f;
    if (q.p >= 0) {
        const f32x4 b0 = *(const f32x4*)(cb + c), b1 = *(const f32x4*)(cb + c + 4);
        a[0] = b0[0]; a[1] = b0[1]; a[2] = b0[2]; a[3] = b0[3]; a[4] = b1[0]; a[5] = b1[1]; a[6] = b1[2]; a[7] = b1[3];
#pragma unroll
        for (int w = 0; w < 4; ++w) { const f32x4 w0 = *(const f32x4*)(cw + w * CONVD + c), w1 = *(const f32x4*)(cw + w * CONVD + c + 4);
            a[0] += bf2f(q.rv[w].x & 0xffffu) * w0[0]; a[1] += bf2f(q.rv[w].x >> 16) * w0[1]; a[2] += bf2f(q.rv[w].y & 0xffffu) * w0[2]; a[3] += bf2f(q.rv[w].y >> 16) * w0[3];
            a[4] += bf2f(q.rv[w].z & 0xffffu) * w1[0]; a[5] += bf2f(q.rv[w].z >> 16) * w1[1]; a[6] += bf2f(q.rv[w].w & 0xffffu) * w1[2]; a[7] += bf2f(q.rv[w].w >> 16) * w1[3]; }
#pragma unroll
        for (int e = 0; e < 8; ++e) a[e] = silu1(a[e]);
    }
    v4u o; o.x = pk2(a[0], a[1]); o.y = pk2(a[2], a[3]); o.z = pk2(a[4], a[5]); o.w = pk2(a[6], a[7]);
    if (c < 1024) *(v4u*)(WSP(bf16, WS_XS) + (size_t)(q.b * LPAD + q.pp) * 1024 + c) = o;
    else *(v4u*)(WSP(bf16, WS_BC) + (size_t)(q.b * LPAD + q.pp) * 512 + (c - 1024)) = o;
}
__device__ __forceinline__ void p4_conv(Frame& F) {
    const float* um = WSP(float, WS_META + MO_U);
    const int gt = F.gw * 64 + F.lane, NT = F.NGW * 64, NITEM = NBATCH * LPAD * (CONVD / 8);
    for (int it = gt; it < NITEM; it += 3 * NT) {
        ConvItem q0, q1, q2; const int i1 = it + NT, i2 = it + 2 * NT;
        conv_issue(F, it, q0); if (i1 < NITEM) conv_issue(F, i1, q1); if (i2 < NITEM) conv_issue(F, i2, q2);
        conv_finish(F, q0); if (i1 < NITEM) conv_finish(F, q1); if (i2 < NITEM) conv_finish(F, q2);
    }
    for (int it = gt; it < NBATCH * LPAD * SH; it += NT) { const int hd = it & 15, pp = (it >> 4) % LPAD, b = (it >> 4) / LPAD, p = pp - PPAD;
        float v = 0.f;
        if (p >= 0) { const float x = (p < NMETA ? um[(size_t)p * NIN + NINP + hd] : WSP(float, WS_DTR)[(size_t)(b * SEQ + p - NMETA) * 16 + hd]) + F.in[17][hd];
            v = fmaxf(x, 0.f) + log1pf(__expf(-fabsf(x))); }
        WSP(float, WS_DT)[it] = v; }
}
__device__ __forceinline__ void p4_mixer_attn(Frame& F) {
    p4_conv(F);
    float lam; { const float s1 = wave_sum(F.in[10][F.lane] * F.in[11][F.lane]), s2 = wave_sum(F.in[12][F.lane] * F.in[13][F.lane]); lam = __expf(s1) - __expf(s2) + 0.2f; }
    lam = __builtin_bit_cast(float, __builtin_amdgcn_readfirstlane(__builtin_bit_cast(int, lam)));
    for (int r_ = 0; r_ < (MK_REPEAT_PHASE == 41 ? 2 : 1); ++r_)
    for (int u = blockIdx.x; u < NBATCH * NHEAD * 16; u += F.G) { const int bh = (u & 7) * 2 + ((u >> 3) >> 4), idx = (u >> 3) & 15;
        att::attn_meta_tile(F, bh); att::attn_unit(F, bh, idx, lam); att::attn_unit(F, bh, 31 - idx, lam); }
}
__device__ __forceinline__ void p5_ssd_a(Frame& F) { for (int it = blockIdx.x; it < NBATCH * SH * 8; it += F.G) ssd::ssd_pass_a(F, it); }
__device__ __forceinline__ void p6_ssd_b(Frame& F) { int bgj = 0; for (int it = blockIdx.x; it < NBATCH * SH * 8; it += F.G) ssd::ssd_item<true>(F, it, bgj);
    if (F.NGW != 2048) convert_items(F, IT_BG, IT_END, F.gw, F.NGW); }
struct Args { const float* in[26]; float* out; unsigned char* ws; int ph_lo, ph_hi; };
__global__ void __launch_bounds__(NWAVES * 64, 2) hymba_fwd(Args args) {
    extern __shared__ __attribute__((aligned(16))) unsigned char lds[];
    Frame F;
    F.lds = (LAS unsigned char*)lds;
    F.tid = threadIdx.x; F.lane = F.tid & 63; F.wave = __builtin_amdgcn_readfirstlane(F.tid >> 6);
    F.G = gridDim.x; F.gw = blockIdx.x * NWAVES + F.wave; F.NGW = F.G * NWAVES;
#pragma unroll
    for (int i = 0; i < 26; ++i) F.in[i] = args.in[i];
    F.out = args.out; F.ws = args.ws; F.inp = args.in;
    volatile LAS unsigned* MISC = (volatile LAS unsigned*)(F.lds + MISC_OFF);
    for (int u = F.tid; u < 128; u += NWAVES * 64) MISC[u] = 0u;
    __syncthreads();
    XcdBarrier bar; bar.bar = (unsigned*)(F.ws + WS_CTL) + CW_BAR; bar.x = 0; bar.st = nullptr;
    if (N_LAUNCHES == 1) bar = xcd_barrier_post((unsigned*)(F.ws + WS_CTL) + CW_BAR, MISC + 8);
    const int lo = args.ph_lo, hi = args.ph_hi;
#define IN(k) (lo <= (k) && (k) < hi)
#ifndef MK_REPEAT_PHASE
#define MK_REPEAT_PHASE -1
#endif
#define REPS(k) for (int rep_ = 0; rep_ < ((k) == MK_REPEAT_PHASE ? 2 : 1); ++rep_)
#define REPBAR(k) do { if ((k) == MK_REPEAT_PHASE && rep_ == 0) xcd_barrier(bar); } while (0)
#define SEAM(k) do { if (IN(k) && IN((k) + 1)) xcd_barrier(bar); } while (0)
    using pg8::Gemm; using pg8::StaticOrder;
    LAS unsigned char* ring = F.lds + RING_OFF;

    if (IN(0)) { REPS(0) { p0_prologue(F); REPBAR(0); } SEAM(0); }
    if (IN(1)) {
        Gemm g{WSP(bf16, WS_XN), WSP(bf16, WS_W1GU), MR, NGU, DM}; StaticOrder S; S.init(MR, NGU, F.G, (int)blockIdx.x);
        pg8::Unit u0{0, 0}; (void)S.next(0, u0);
        pg8::EpiSwiGLU E{WSP(bf16, WS_ACT), DFF, WSP(float, WS_SSQ0), 1, pg8::RsTable{(LAS float*)(F.lds + RST_OFF), u0.pm, -1}};
        pg8::RsPre P1{WSP(float, WS_SSQ0), 1, 1.0f / 2048.0f, u0.pm, (LAS float*)(F.lds + RST_OFF)};
        REPS(1) { pg8::gemm_phase<pg8::EpiSwiGLU, StaticOrder, true, true, pg8::RsPre>(ring, g, S, E, P1); REPBAR(1); }
        { const int first = S.nwg % F.G, nsl = F.G - first;
          const int w0 = (int)blockIdx.x >= first ? ((int)blockIdx.x - first) * NWAVES + F.wave : -1;
          meta_gateup(F, w0, nsl * NWAVES);
          constexpr int NMW = DFF / 16;
          convert_items(F, IT_CUT0, IT_BG, w0 >= NMW ? w0 - NMW : -1, nsl * NWAVES - NMW); }
        SEAM(1);
    }
    if (IN(2)) {
        meta_down(F);
        Gemm g{WSP(bf16, WS_ACT), WSP(bf16, WS_W1D), MR, DM, DFF}; StaticOrder S; S.init(MR, DM, F.G, (int)blockIdx.x);
        pg8::EpiResT<false> E{F.in[0], nullptr, nullptr, WSP(bf16, WS_XN), WSP(float, WS_SSQ1), 0.5f, DM, nullptr, 0, pg8::RsTable{nullptr, -1, -1}};
        REPS(2) { pg8::gemm_phase<pg8::EpiResT<false>, StaticOrder, true, true>(ring, g, S, E); REPBAR(2); }
        SEAM(2);
    }
    if (IN(3)) {
        Gemm g{WSP(bf16, WS_XN), WSP(bf16, WS_WIN), MR, NINP, DM}; StaticOrder S; S.init(MR, NINP, F.G, (int)blockIdx.x);
        pg8::Unit u0{0, 0}; (void)S.next(0, u0);
        pg8::EpiInProj E{WSP(bf16, WS_ACT), NINP, WSP(float, WS_SSQ1), F.in[8], F.in[9], WSP(float, WS_ROPE), pg8::RsTable{(LAS float*)(F.lds + RST_OFF), u0.pm, -1}};
        pg8::RsPre P3{WSP(float, WS_SSQ1), 32, 1.0f / 2048.0f, u0.pm, (LAS float*)(F.lds + RST_OFF)};
        REPS(3) { pg8::gemm_phase<pg8::EpiInProj, StaticOrder, true, true, pg8::RsPre>(ring, g, S, E, P3); REPBAR(3); }
        { const int first = S.nwg % F.G, nsl = F.G - first;
          meta_inproj_and_dt(F, (int)blockIdx.x >= first ? ((int)blockIdx.x - first) * NWAVES + F.wave : -1, NMETA_IT + NDT_IT, nsl * NWAVES); }
        SEAM(3);
    }
    if (IN(4)) { REPS(4) { p4_mixer_attn(F); REPBAR(4); } SEAM(4); }
    if (IN(5)) { REPS(5) { p5_ssd_a(F); REPBAR(5); } SEAM(5); }
    if (IN(6)) { REPS(6) { p6_ssd_b(F); REPBAR(6); } SEAM(6); }
    if (IN(7)) {
        Gemm g{WSP(bf16, WS_MIX), WSP(bf16, WS_WOUT), MR, DM, DM}; StaticOrder S; S.init(MR, DM, F.G, (int)blockIdx.x);
        pg8::Unit u0{0, 0}; (void)S.next(0, u0);
        pg8::EpiResT<true> E{nullptr, WSP(bf16, WS_XN), nullptr, WSP(bf16, WS_XN), WSP(float, WS_SSQ2), 1.0f, DM, WSP(float, WS_SSQS), 16, pg8::RsTable{(LAS float*)(F.lds + RST_OFF), u0.pm, -1}};
        pg8::RsPre P7{WSP(float, WS_SSQS), 32, 1.0f / 1024.0f, u0.pm, (LAS float*)(F.lds + RST_OFF)};
        pg8::gemm_phase<pg8::EpiResT<true>, StaticOrder, true, true, pg8::RsPre>(ring, g, S, E, P7);
        SEAM(7);
    }
    if (IN(8)) {
        Gemm g{WSP(bf16, WS_XN), WSP(bf16, WS_W2GU), MR, NGU, DM}; StaticOrder S; S.init(MR, NGU, F.G, (int)blockIdx.x);
        pg8::Unit u0{0, 0}; (void)S.next(0, u0);
        pg8::EpiSwiGLU E{WSP(bf16, WS_ACT), DFF, WSP(float, WS_SSQ2), 32, pg8::RsTable{(LAS float*)(F.lds + RST_OFF), u0.pm, -1}};
        pg8::RsPre P8{WSP(float, WS_SSQ2), 32, 1.0f / 2048.0f, u0.pm, (LAS float*)(F.lds + RST_OFF)};
        REPS(8) { pg8::gemm_phase<pg8::EpiSwiGLU, StaticOrder, true, true, pg8::RsPre>(ring, g, S, E, P8); REPBAR(8); }
        SEAM(8);
    }
    if (IN(9)) {
        Gemm g{WSP(bf16, WS_ACT), WSP(bf16, WS_W2D), MR, DM, DFF}; StaticOrder S; S.init(MR, DM, F.G, (int)blockIdx.x);
        pg8::EpiResT<false> E{nullptr, WSP(bf16, WS_XN), F.out, nullptr, nullptr, 0.5f, DM, nullptr, 0, pg8::RsTable{nullptr, -1, -1}};
        pg8::gemm_phase<pg8::EpiResT<false>, StaticOrder, true, true>(ring, g, S, E);
    }
#undef IN
#undef SEAM
}

extern "C" void kernel_launch(void* const* d_in, const int* in_sizes, int n_in, void* d_out, int out_size, void* d_ws, size_t ws_size, hipStream_t stream) {
    static int grid = 0;
    if (grid == 0) {
        if (n_in != 26 || in_sizes[0] != MR * DM || out_size != MR * DM || ws_size < WS_END) { fprintf(stderr, "kernel_launch: unexpected shapes (n_in %d, in0 %d, out %d, ws %zu)\n", n_in, n_in > 0 ? in_sizes[0] : -1, out_size, ws_size); grid = -1; return; }
        int dev = 0, cus = 0, per_cu = 0;
        if (hipGetDevice(&dev) != hipSuccess || hipDeviceGetAttribute(&cus, hipDeviceAttributeMultiprocessorCount, dev) != hipSuccess) { grid = -1; return; }
        if (hipFuncSetAttribute((const void*)hymba_fwd, hipFuncAttributeMaxDynamicSharedMemorySize, LDS_BYTES) != hipSuccess) { fprintf(stderr, "kernel_launch: hipFuncSetAttribute failed\n"); grid = -1; return; }
        if (hipOccupancyMaxActiveBlocksPerMultiprocessor(&per_cu, (const void*)hymba_fwd, NWAVES * 64, LDS_BYTES) != hipSuccess || per_cu < 1) { fprintf(stderr, "kernel_launch: occupancy query says %d blocks per CU\n", per_cu); (void)hipGetLastError(); grid = -1; return; }
        grid = cus;
    }
    if (grid < 0) return;
    (void)hipMemsetAsync((char*)d_ws + WS_CTL, 0, CTL_ZERO_BYTES, stream);
    Args a{};
    for (int i = 0; i < 26; ++i) a.in[i] = (const float*)d_in[i];
    a.out = (float*)d_out; a.ws = (unsigned char*)d_ws;
    for (int li = 0; li < N_LAUNCHES; ++li) {
        a.ph_lo = (N_LAUNCHES == 1) ? 0 : li; a.ph_hi = (N_LAUNCHES == 1) ? NPH : li + 1;
        hipLaunchKernelGGL(hymba_fwd, dim3(grid), dim3(NWAVES * 64), LDS_BYTES, stream, a);
    }
}
```

```cpp
#include <hip/hip_runtime.h>
#include <cstdio>
#include <cstdint>
#include <cmath>
#ifndef MK_AMP
#define MK_AMP 0
#endif
namespace pg8 {
#define PG8_LAS __attribute__((address_space(3)))
typedef unsigned short bf16_t;
typedef short bf16x8 __attribute__((ext_vector_type(8)));
typedef float f32x4 __attribute__((ext_vector_type(4)));
typedef unsigned u32x4 __attribute__((ext_vector_type(4)));
constexpr int BM = 256, BK = 64, HALF = 128, HTB = HALF * BK * 2  , STAGE_BYTES = 8 * HTB, NXCD = 8, WGM = 8;

__host__ __device__ __forceinline__ int lds_byte(int r, int c) { const int st = (r >> 4) * 2 + (c >> 5), rr = r & 15, cc = c & 31, ob = rr * 64 + cc * 2; return st * 1024 + (ob ^ (((ob >> 9) & 1) << 5)); }
__host__ __device__ __forceinline__ void stage_rc(int b, int& R, int& C) { const int st = b / 1024, sb = b % 1024, swz = sb ^ (((sb >> 9) & 1) << 5); R = (st >> 1) * 16 + swz / 64; C = (st & 1) * 32 + (swz % 64) / 2; }
__host__ __device__ __forceinline__ int perm32(int rho) { const int n = rho >> 4, i = rho & 15; return 8 * (i >> 2) + 4 * n + (i & 3); }

struct Unit { int pm, pn; };
struct Gemm { const bf16_t* A; const bf16_t* Bt; int M, N, K; const bf16_t* Ax = nullptr;
    __device__ __forceinline__ const char* arow(int pm, size_t tstep) const { return pm * BM < M ? (const char*)A + (size_t)pm * tstep : (const char*)Ax; } };

struct StaticOrder {
    int nM, nN, nwg, G, c, wgm;
    __host__ __device__ void init(int M, int N, int G_, int c_, int wgm_ = WGM) { nM = M / BM; nN = N / BM; nwg = nM * nN; G = G_; c = c_; wgm = wgm_; }
    __host__ __device__ __forceinline__ bool next(int i, Unit& u) const {
        const long L = (long)i * G + c; if (L >= nwg) return false;
        int wgid = (int)L; { const int q = nwg / NXCD, r = nwg % NXCD, xcd = wgid % NXCD, off = wgid / NXCD; wgid = (xcd < r ? xcd * (q + 1) : r * (q + 1) + (xcd - r) * q) + off; }
        const int nig = wgm * nN, gid = wgid / nig, fm = gid * wgm, gsz = (nM - fm) < wgm ? (nM - fm) : wgm;
        u.pm = fm + ((wgid % nig) % gsz); u.pn = (wgid % nig) / gsz; return true;
    }
    __device__ __forceinline__ void a_ready(const Unit&) const {}
    __device__ __forceinline__ void done(const Unit&) const {}
};

struct MetaPanelOrder { StaticOrder so; bool fold;
    __host__ __device__ void init(int M, int N, int G_, int c_, bool fold_) { so.init(M, N, G_, c_, fold_ ? 4 : WGM); fold = fold_; }
    __host__ __device__ __forceinline__ bool next(int i, Unit& u) const {
        if (so.next(i, u)) return true;
        if (!fold) return false;
        const int first = so.nwg % so.G, n_own = (so.nwg - so.c + so.G - 1) / so.G, t = so.c - first;
        if (i == n_own && t >= 0 && t < so.nN) { u.pm = so.nM; u.pn = t; return true; }
        return false;
    }
    __device__ __forceinline__ void a_ready(const Unit&) const {}
    __device__ __forceinline__ void done(const Unit&) const {}
};

struct InProjDtOrder { StaticOrder so; bool fold;
    __host__ __device__ void init(int M, int N, int G_, int c_, bool fold_) { so.init(M, N, G_, c_, fold_ ? 4 : WGM); fold = fold_; }
    __host__ __device__ __forceinline__ bool next(int i, Unit& u) const {
        if (so.next(i, u)) return true;
        if (!fold) return false;
        const int first = so.nwg % so.G, n_own = (so.nwg - so.c + so.G - 1) / so.G, t = so.c - first;
        if (i == n_own && t >= 0 && t < so.nM) { u.pm = 4 * (t & 7) + (t >> 3); u.pn = so.nN; return true; }
        if (i == n_own && t >= so.nM && t < so.nM + so.nN + 1) { u.pm = so.nM; u.pn = t - so.nM; return true; }
        return false;
    }
    __device__ __forceinline__ void a_ready(const Unit&) const {}
    __device__ __forceinline__ void done(const Unit&) const {}
};

__device__ __forceinline__ unsigned cvt_pk_bf16(float lo, float hi) { unsigned r; asm volatile("v_cvt_pk_bf16_f32 %0, %1, %2" : "=v"(r) : "v"(lo), "v"(hi)); return r; }
typedef unsigned u32x2 __attribute__((ext_vector_type(2)));
constexpr float RMS_EPS = 1e-6f;
__device__ __forceinline__ float row_rs(const float* ssq, int np, int row, float inv_n = 1.0f / 2048.0f) {
    float s;
    if (np == 1) s = ssq[row];
    else { const f32x4* p = (const f32x4*)(ssq + (size_t)row * 32); f32x4 a = p[0];
#pragma unroll
        for (int i = 1; i < 8; ++i) a += p[i];
        s = (a[0] + a[1]) + (a[2] + a[3]); }
    return __builtin_amdgcn_rsqf(s * inv_n + RMS_EPS);
}
struct RsTable { const PG8_LAS float* t; int tpm, tpm2; };
__device__ __forceinline__ float row_rs_t(const RsTable& T, const float* ssq, int np, float inv_n, int pm, int rin) { return (pm == T.tpm) ? T.t[rin] : (pm == T.tpm2) ? T.t[256 + rin] : row_rs(ssq, np, pm * BM + rin, inv_n); }
__device__ __forceinline__ float silu_f(float g) { return g * __builtin_amdgcn_rcpf(1.0f + __builtin_amdgcn_exp2f(-1.4426950408889634f * g)); }

struct EpiSwiGLU {
    static constexpr bool PERM = true, AFTER_DRAIN = false, HAS_MID = false, AMP = (MK_AMP == 11);
    bf16_t* O; int ldc; const float* ssq; int np; RsTable T; int mrows = 1 << 30; bf16_t* Om = nullptr; const float* ssqm = nullptr;
    __device__ __forceinline__ void mid(f32x4 (&)[2][2][4][2], const Unit&, int, int, int, int) const {}
    __device__ __forceinline__ void operator()(const f32x4 (&acc)[2][2][4][2], const Unit& u, int wr, int wc, int fr, int fq) const {
        const int row0 = u.pm * BM + wr * 64 + fr, col0 = u.pn * HALF + wc * 32 + 8 * fq;
        if (u.pm * BM >= mrows) {
            if (wr == 0) { const float rs = __builtin_amdgcn_rsqf(ssqm[fr] * (1.0f / 2048.0f) + RMS_EPS), c1 = -1.4426950408889634f * rs, rs2 = rs * rs;
                f32x4 o[2];
#pragma unroll
                for (int n = 0; n < 2; ++n) { const f32x4 g4 = acc[0][0][0][n], u4 = acc[0][1][0][n];
                    f32x4 e = g4 * c1; e[0] = __builtin_amdgcn_exp2f(e[0]); e[1] = __builtin_amdgcn_exp2f(e[1]); e[2] = __builtin_amdgcn_exp2f(e[2]); e[3] = __builtin_amdgcn_exp2f(e[3]);
                    f32x4 d = e + 1.0f; d[0] = __builtin_amdgcn_rcpf(d[0]); d[1] = __builtin_amdgcn_rcpf(d[1]); d[2] = __builtin_amdgcn_rcpf(d[2]); d[3] = __builtin_amdgcn_rcpf(d[3]);
                    o[n] = (g4 * u4) * (d * rs2); }
                u32x4 w; w.x = cvt_pk_bf16(o[0][0], o[0][1]); w.y = cvt_pk_bf16(o[0][2], o[0][3]); w.z = cvt_pk_bf16(o[1][0], o[1][1]); w.w = cvt_pk_bf16(o[1][2], o[1][3]);
                *(u32x4*)(Om + (size_t)fr * ldc + col0) = w; }
            return; }
#pragma unroll
        for (int ai = 0; ai < 2; ++ai)
#pragma unroll
            for (int m = 0; m < 4; ++m) { const int row = row0 + ai * HALF + m * 16; const float rs = row_rs_t(T, ssq, np, 1.0f / 2048.0f, u.pm, wr * 64 + fr + ai * HALF + m * 16);
                const float c1 = -1.4426950408889634f * rs, rs2 = rs * rs;
                f32x4 o[2];
#pragma unroll
                for (int n = 0; n < 2; ++n) { const f32x4 g4 = acc[ai][0][m][n], u4 = acc[ai][1][m][n];
                    f32x4 e = g4 * c1;
                    e[0] = __builtin_amdgcn_exp2f(e[0]); e[1] = __builtin_amdgcn_exp2f(e[1]); e[2] = __builtin_amdgcn_exp2f(e[2]); e[3] = __builtin_amdgcn_exp2f(e[3]);
                    f32x4 d = e + 1.0f;
                    d[0] = __builtin_amdgcn_rcpf(d[0]); d[1] = __builtin_amdgcn_rcpf(d[1]); d[2] = __builtin_amdgcn_rcpf(d[2]); d[3] = __builtin_amdgcn_rcpf(d[3]);
                    o[n] = (g4 * u4) * (d * rs2); }
                u32x4 w; w.x = cvt_pk_bf16(o[0][0], o[0][1]); w.y = cvt_pk_bf16(o[0][2], o[0][3]); w.z = cvt_pk_bf16(o[1][0], o[1][1]); w.w = cvt_pk_bf16(o[1][2], o[1][3]);
                *(u32x4*)(O + (size_t)row * ldc + col0) = w; }
    }
};
template <bool MID> struct EpiResT {
    static constexpr bool PERM = false, AFTER_DRAIN = false, HAS_MID = MID, AMP = false;
    const float* basef; const bf16_t* baseh; float* out; bf16_t* xn; float* ssq; float scale; int ldc; const float* rsm; int kmid; RsTable T;
    __device__ __forceinline__ void mid(f32x4 (&acc)[2][2][4][2], const Unit& u, int wr, int wc, int fr, int fq) const {
        int fro = fr; asm volatile("" : "+v"(fro));
        const int rin0 = wr * 64 + fro;
#pragma unroll
        for (int ai = 0; ai < 2; ++ai)
#pragma unroll
            for (int m = 0; m < 4; ++m) { const float r = row_rs_t(T, rsm, 32, 1.0f / 1024.0f, u.pm, rin0 + ai * HALF + m * 16);
#pragma unroll
                for (int bj = 0; bj < 2; ++bj)
#pragma unroll
                    for (int n = 0; n < 2; ++n) acc[ai][bj][m][n] *= r; }
    }
    __device__ __forceinline__ void operator()(const f32x4 (&acc)[2][2][4][2], const Unit& u, int wr, int wc, int fr, int fq) const {
        const int row0 = u.pm * BM + wr * 64 + fr, col0 = u.pn * BM + wc * 32 + 4 * fq;
#pragma unroll
        for (int ai = 0; ai < 2; ++ai) {
            f32x4 bf[4][2][2]; u32x2 bh[4][2][2];
#pragma unroll
            for (int m = 0; m < 4; ++m)
#pragma unroll
                for (int bj = 0; bj < 2; ++bj)
#pragma unroll
                    for (int n = 0; n < 2; ++n) { const size_t o1 = (size_t)(row0 + ai * HALF + m * 16) * ldc + col0 + bj * HALF + n * 16;
                        if (basef) bf[m][bj][n] = *(const f32x4*)(basef + o1); else bh[m][bj][n] = *(const u32x2*)(baseh + o1); }
#pragma unroll
            for (int m = 0; m < 4; ++m) { const int row = row0 + ai * HALF + m * 16; const size_t off = (size_t)row * ldc + col0; float sq = 0.f;
#pragma unroll
                for (int bj = 0; bj < 2; ++bj)
#pragma unroll
                    for (int n = 0; n < 2; ++n) { const size_t o1 = off + bj * HALF + n * 16; f32x4 b;
                        if (basef) b = bf[m][bj][n];
                        else { const u32x2 h = bh[m][bj][n]; b[0] = __uint_as_float(h.x << 16); b[1] = __uint_as_float(h.x & 0xffff0000u); b[2] = __uint_as_float(h.y << 16); b[3] = __uint_as_float(h.y & 0xffff0000u); }
                        const f32x4 o = b + acc[ai][bj][m][n] * scale;
                        if (out) *(f32x4*)(out + o1) = o;
                        if (xn) { sq += (o[0] * o[0] + o[1] * o[1]) + (o[2] * o[2] + o[3] * o[3]); u32x2 w; w.x = cvt_pk_bf16(o[0], o[1]); w.y = cvt_pk_bf16(o[2], o[3]); *(u32x2*)(xn + o1) = w; } }
                if (xn) { sq += __shfl_xor(sq, 16); sq += __shfl_xor(sq, 32); if (fq == 0) ssq[(size_t)row * 32 + u.pn * 4 + wc] = sq; } }
        }
    }
};
struct EpiInProj {
    static constexpr bool PERM = true, AFTER_DRAIN = false, HAS_MID = false, AMP = (MK_AMP == 12);
    bf16_t* U; int ldc; const float* ssq; const float* qn; const float* kn; const float* rope; RsTable T; float* dtr; int mrows; float* um; int ldu; const float* ssqm;
    __device__ __forceinline__ void mid(f32x4 (&)[2][2][4][2], const Unit&, int, int, int, int) const {}
    __device__ __forceinline__ void operator()(const f32x4 (&acc)[2][2][4][2], const Unit& u, int wr, int wc, int fr, int fq) const {
        const int row0 = u.pm * BM + wr * 64 + fr, col0 = u.pn * BM + wc * 64 + 8 * fq;
        if (u.pm * BM >= mrows) {
            if (wr == 0) {
                const f32x4* pp = (const f32x4*)(ssqm + fr * 128); f32x4 a = pp[0];
#pragma unroll
                for (int i = 1; i < 32; ++i) a += pp[i];
                const float rs = __builtin_amdgcn_rsqf(((a[0] + a[1]) + (a[2] + a[3])) * (1.0f / 2048.0f) + RMS_EPS);
                if (u.pn * BM >= ldc) { if (wc == 0 && fq < 2) {
#pragma unroll
                        for (int n = 0; n < 2; ++n) *(f32x4*)(um + (size_t)fr * ldu + ldc + 8 * fq + 4 * n) = acc[0][0][0][n] * rs; } }
                else {
#pragma unroll
                    for (int bj = 0; bj < 2; ++bj)
#pragma unroll
                        for (int n = 0; n < 2; ++n) *(f32x4*)(um + (size_t)fr * ldu + col0 + 32 * bj + 4 * n) = acc[0][bj][0][n] * rs; }
            }
            return; }
        if (u.pn * BM >= ldc) {
            if (wc == 0 && fq < 2) {
#pragma unroll
                for (int ai = 0; ai < 2; ++ai)
#pragma unroll
                    for (int m = 0; m < 4; ++m) { const int row = row0 + ai * HALF + m * 16; const float rs = row_rs_t(T, ssq, 32, 1.0f / 2048.0f, u.pm, wr * 64 + fr + ai * HALF + m * 16);
#pragma unroll
                        for (int n = 0; n < 2; ++n) *(f32x4*)(dtr + (size_t)row * 16 + 8 * fq + 4 * n) = acc[ai][0][m][n] * rs; } }
            return; }
        const bool isqk = u.pn < 8;
        f32x4 wv[2][2];
        if (isqk) { const float* wn = (u.pn < 4) ? qn : kn;
#pragma unroll
            for (int bj = 0; bj < 2; ++bj)
#pragma unroll
                for (int n = 0; n < 2; ++n) wv[bj][n] = *(const f32x4*)(wn + 32 * bj + 8 * fq + 4 * n); }
#pragma unroll
        for (int ai = 0; ai < 2; ++ai)
#pragma unroll
            for (int m = 0; m < 4; ++m) { const int row = row0 + ai * HALF + m * 16; const float rs = row_rs_t(T, ssq, 32, 1.0f / 2048.0f, u.pm, wr * 64 + fr + ai * HALF + m * 16);
                f32x4 v[2][2];
#pragma unroll
                for (int bj = 0; bj < 2; ++bj)
#pragma unroll
                    for (int n = 0; n < 2; ++n) v[bj][n] = acc[ai][bj][m][n] * rs;
                if (isqk) {
                    float sq = 0.f;
#pragma unroll
                    for (int bj = 0; bj < 2; ++bj)
#pragma unroll
                        for (int n = 0; n < 2; ++n) sq += (v[bj][n][0] * v[bj][n][0] + v[bj][n][1] * v[bj][n][1]) + (v[bj][n][2] * v[bj][n][2] + v[bj][n][3] * v[bj][n][3]);
                    sq += __shfl_xor(sq, 16); sq += __shfl_xor(sq, 32);
                    const float r = __builtin_amdgcn_rsqf(sq * (1.0f / 64.0f) + RMS_EPS);
#pragma unroll
                    for (int bj = 0; bj < 2; ++bj)
#pragma unroll
                        for (int n = 0; n < 2; ++n) v[bj][n] = v[bj][n] * r * wv[bj][n];
                    const int pos = (row & 4095) + 16;
                    const f32x4 c0 = *(const f32x4*)(rope + pos * 16), c1 = *(const f32x4*)(rope + pos * 16 + 4), s0 = *(const f32x4*)(rope + pos * 16 + 8), s1 = *(const f32x4*)(rope + pos * 16 + 12);
                    f32x4 p0, p1;
#pragma unroll
                    for (int i = 0; i < 4; ++i) { p0[i] = __shfl_xor(v[0][0][i], 16); p1[i] = __shfl_xor(v[0][1][i], 16); }
                    if (fq == 0) { v[0][0] = v[0][0] * c0 - p0 * s0; v[0][1] = v[0][1] * c1 - p1 * s1; }
                    else if (fq == 1) { v[0][0] = v[0][0] * c0 + p0 * s0; v[0][1] = v[0][1] * c1 + p1 * s1; }
                    if (u.pn < 4) { v[0][0] *= 0.18033688011112042f; v[0][1] *= 0.18033688011112042f; v[1][0] *= 0.18033688011112042f; v[1][1] *= 0.18033688011112042f; }
                }
#pragma unroll
                for (int bj = 0; bj < 2; ++bj) { u32x4 w; w.x = cvt_pk_bf16(v[bj][0][0], v[bj][0][1]); w.y = cvt_pk_bf16(v[bj][0][2], v[bj][0][3]); w.z = cvt_pk_bf16(v[bj][1][0], v[bj][1][1]); w.w = cvt_pk_bf16(v[bj][1][2], v[bj][1][3]);
                    *(u32x4*)(U + (size_t)row * ldc + col0 + 32 * bj) = w; } }
    }
};

struct NoPre { __device__ __forceinline__ void issue() {} __device__ __forceinline__ void after_issue() {} __device__ __forceinline__ void finish() {} };
struct RsPre { const float* ssq; int np; float inv_n; int pm; PG8_LAS float* t; f32x4 v[8]; float s1;
    __device__ __forceinline__ void after_issue() {}
    __device__ __forceinline__ void issue() { const int tid = threadIdx.x; if (tid < 256) { const int row = pm * BM + tid;
            if (np == 1) s1 = ssq[row]; else { const f32x4* p = (const f32x4*)(ssq + (size_t)row * 32);
#pragma unroll
                for (int i = 0; i < 8; ++i) v[i] = p[i]; } } }
    __device__ __forceinline__ void finish() { const int tid = threadIdx.x; if (tid < 256) { float s;
            if (np == 1) s = s1; else { f32x4 a = v[0];
#pragma unroll
                for (int i = 1; i < 8; ++i) a += v[i];
                s = (a[0] + a[1]) + (a[2] + a[3]); }
            t[tid] = __builtin_amdgcn_rsqf(s * inv_n + RMS_EPS); } }
};
template <class Epi, class Sched, bool ALIGN_EPI = false, bool SP2 = false, class Pre = NoPre>
__device__ __forceinline__ void gemm_phase(PG8_LAS unsigned char* lds, const Gemm g, const Sched& S, const Epi& E, Pre pre = Pre()) {
    const int tid = threadIdx.x, wid = __builtin_amdgcn_readfirstlane(tid >> 6), lane = tid & 63, wr = wid >> 2, wc = wid & 3, fr = lane & 15, fq = lane >> 4;
    const int K = g.K, nt = K / BK;
    unsigned voffA[2], voffB[2];
#pragma unroll
    for (int i = 0; i < 2; ++i) { int R, C; stage_rc(tid * 16 + i * 8192, R, C); const int Rb = Epi::PERM ? ((R & ~31) + perm32(R & 31)) : R;
        voffA[i] = (unsigned)(R * K + C) * 2u; voffB[i] = (unsigned)(Rb * K + C) * 2u; }
    const size_t kstep = (size_t)(BK * 2);
    const size_t hstep = (size_t)HALF * K * 2;
    const size_t tstep = 2 * hstep;
    const unsigned ldsw = (unsigned)wid * 1024u;
    const int aoff = lds_byte(wr * 64 + fr, fq * 8), boff = lds_byte(wc * 32 + fr, fq * 8);
#define PG8_SA(b, h) (((b) * 2 + (h)) * HTB)
#define PG8_SB(b, h) ((4 + (b) * 2 + (h)) * HTB)
#define PG8_STAGE(bufoff, gbase, voff) do { _Pragma("unroll") for (int _i = 0; _i < 2; ++_i) \
        __builtin_amdgcn_global_load_lds((const unsigned*)((const char*)(gbase) + (voff)[_i]), (PG8_LAS unsigned*)(lds + (bufoff) + ldsw + _i * 8192), 16, 0, 0); } while (0)
#define PG8_LDA(dst, b, h) do { _Pragma("unroll") for (int m = 0; m < 4; ++m) _Pragma("unroll") for (int k = 0; k < 2; ++k) dst[m][k] = *(const PG8_LAS bf16x8*)(lds + PG8_SA(b, h) + aoff + m * 2048 + k * 1024); } while (0)
#define PG8_LDB(dst, b, h) do { _Pragma("unroll") for (int n = 0; n < 2; ++n) _Pragma("unroll") for (int k = 0; k < 2; ++k) dst[n][k] = *(const PG8_LAS bf16x8*)(lds + PG8_SB(b, h) + boff + n * 2048 + k * 1024); } while (0)
#define PG8_MMA(ai, bj, At, Bt) do { __builtin_amdgcn_s_setprio(1); _Pragma("unroll") for (int m = 0; m < 4; ++m) _Pragma("unroll") for (int n = 0; n < 2; ++n) _Pragma("unroll") for (int k = 0; k < 2; ++k) \
        acc[ai][bj][m][n] = __builtin_amdgcn_mfma_f32_16x16x32_bf16(Bt[n][k], At[m][k], acc[ai][bj][m][n], 0, 0, 0); __builtin_amdgcn_s_setprio(0); } while (0)
#define PG8_WAIT_V(n) asm volatile("s_waitcnt vmcnt(" #n ")" ::: "memory")
#define PG8_WAIT_L(n) asm volatile("s_waitcnt lgkmcnt(" #n ")" ::: "memory")
#define PG8_BAR __builtin_amdgcn_s_barrier()
#define PG8_SCHED __builtin_amdgcn_sched_barrier(0)
    Unit cur, nxt; int ui = 0;
    if (!S.next(0, cur)) return;
    f32x4 acc[2][2][4][2];
#pragma unroll
    for (int a = 0; a < 2; ++a)
#pragma unroll
        for (int b = 0; b < 2; ++b)
#pragma unroll
            for (int m = 0; m < 4; ++m)
#pragma unroll
                for (int n = 0; n < 2; ++n) acc[a][b][m][n] = (f32x4){0.f, 0.f, 0.f, 0.f};
    bf16x8 At[4][2], B0[2][2], B1[2][2];
    const char* cA = g.arow(cur.pm, tstep); const char* cB = (const char*)g.Bt + (size_t)cur.pn * tstep;
    S.a_ready(cur);
    pre.issue();
    if constexpr (SP2) {
        PG8_STAGE(PG8_SB(0, 0), cB, voffB); PG8_STAGE(PG8_SB(0, 1), cB + hstep, voffB); PG8_STAGE(PG8_SA(0, 0), cA, voffA); PG8_STAGE(PG8_SA(0, 1), cA + hstep, voffA);
        pre.after_issue();
        if (wr == 1) PG8_BAR;
        PG8_WAIT_V(2); pre.finish(); PG8_BAR;
        PG8_STAGE(PG8_SB(1, 0), cB + kstep, voffB); PG8_STAGE(PG8_SA(1, 0), cA + kstep, voffA); PG8_STAGE(PG8_SB(1, 1), cB + hstep + kstep, voffB);
        PG8_WAIT_V(6); PG8_BAR;
    } else {
        PG8_STAGE(PG8_SB(0, 0), cB, voffB); PG8_STAGE(PG8_SA(0, 0), cA, voffA); PG8_STAGE(PG8_SB(0, 1), cB + hstep, voffB); PG8_STAGE(PG8_SA(0, 1), cA + hstep, voffA);
        if (wr == 1) PG8_BAR;
        PG8_WAIT_V(4); pre.finish(); PG8_BAR;
        PG8_STAGE(PG8_SB(1, 0), cB + kstep, voffB); PG8_STAGE(PG8_SA(1, 0), cA + kstep, voffA); PG8_STAGE(PG8_SB(1, 1), cB + hstep + kstep, voffB);
        PG8_WAIT_V(6); PG8_BAR;
    }
    for (;;) {
        const bool has_next = S.next(ui + 1, nxt);
        const char* nA = has_next ? g.arow(nxt.pm, tstep) : cA; const char* nB = has_next ? (const char*)g.Bt + (size_t)nxt.pn * tstep : cB;
        for (int t = 0; t < nt; t += 2) {
            const bool last = (t == nt - 2);
            if constexpr (Epi::HAS_MID) { if (t == E.kmid) E.mid(acc, cur, wr, wc, fr, fq); }
            const char* a1 = cA + (size_t)(t + 1) * kstep;
            const char* a2 = last ? nA : cA + (size_t)(t + 2) * kstep; const char* b2 = last ? nB : cB + (size_t)(t + 2) * kstep;
            const char* a3 = a2 + kstep; const char* b3 = b2 + kstep;
            if (last && has_next) S.a_ready(nxt);
            if constexpr (SP2) {
            PG8_LDB(B0, 0, 0); PG8_LDB(B1, 0, 1); PG8_SCHED; PG8_LDA(At, 0, 0); PG8_STAGE(PG8_SA(1, 1), a1 + hstep, voffA);
            PG8_WAIT_V(8); PG8_WAIT_L(0); PG8_BAR; PG8_MMA(0, 0, At, B0); PG8_MMA(0, 1, At, B1); PG8_BAR; PG8_SCHED;
            PG8_LDA(At, 0, 1); PG8_STAGE(PG8_SB(0, 0), b2, voffB); PG8_STAGE(PG8_SB(0, 1), b2 + hstep, voffB); PG8_STAGE(PG8_SA(0, 0), a2, voffA);
            PG8_WAIT_V(8); PG8_WAIT_L(0); PG8_BAR; PG8_MMA(1, 0, At, B0); PG8_MMA(1, 1, At, B1); PG8_BAR; PG8_SCHED;
            PG8_LDB(B0, 1, 0); PG8_LDB(B1, 1, 1); PG8_SCHED; PG8_LDA(At, 1, 0); PG8_STAGE(PG8_SA(0, 1), a2 + hstep, voffA);
            PG8_WAIT_V(8); PG8_WAIT_L(0); PG8_BAR; PG8_MMA(0, 0, At, B0); PG8_MMA(0, 1, At, B1); PG8_BAR; PG8_SCHED;
            PG8_LDA(At, 1, 1); PG8_STAGE(PG8_SB(1, 0), b3, voffB); PG8_STAGE(PG8_SB(1, 1), b3 + hstep, voffB); PG8_STAGE(PG8_SA(1, 0), a3, voffA);
            PG8_WAIT_V(8); PG8_WAIT_L(0); PG8_BAR; PG8_MMA(1, 0, At, B0); PG8_MMA(1, 1, At, B1); PG8_BAR; PG8_SCHED;
            } else {
            PG8_LDB(B0, 0, 0); PG8_SCHED; PG8_LDA(At, 0, 0); PG8_STAGE(PG8_SA(1, 1), a1 + hstep, voffA);
            PG8_WAIT_L(8); PG8_BAR; PG8_WAIT_L(0); PG8_MMA(0, 0, At, B0); PG8_BAR; PG8_SCHED;
            PG8_LDB(B1, 0, 1); PG8_STAGE(PG8_SB(0, 0), b2, voffB);
            PG8_BAR; PG8_WAIT_L(0); PG8_MMA(0, 1, At, B1); PG8_BAR;
            PG8_LDA(At, 0, 1); PG8_STAGE(PG8_SA(0, 0), a2, voffA);
            PG8_BAR; PG8_WAIT_L(0); PG8_MMA(1, 0, At, B0); PG8_BAR; PG8_SCHED;
            PG8_STAGE(PG8_SB(0, 1), b2 + hstep, voffB);
            PG8_WAIT_V(6); PG8_BAR; PG8_MMA(1, 1, At, B1); PG8_BAR;
            PG8_LDB(B0, 1, 0); PG8_SCHED; PG8_LDA(At, 1, 0); PG8_STAGE(PG8_SA(0, 1), a2 + hstep, voffA);
            PG8_WAIT_L(8); PG8_BAR; PG8_WAIT_L(0); PG8_MMA(0, 0, At, B0); PG8_BAR; PG8_SCHED;
            PG8_LDB(B1, 1, 1); PG8_STAGE(PG8_SB(1, 0), b3, voffB);
            PG8_BAR; PG8_WAIT_L(0); PG8_MMA(0, 1, At, B1); PG8_BAR;
            PG8_LDA(At, 1, 1); PG8_STAGE(PG8_SA(1, 0), a3, voffA);
            PG8_BAR; PG8_WAIT_L(0); PG8_MMA(1, 0, At, B0); PG8_BAR; PG8_SCHED;
            PG8_STAGE(PG8_SB(1, 1), b3 + hstep, voffB);
            PG8_WAIT_V(6); PG8_BAR; PG8_MMA(1, 1, At, B1); PG8_BAR;
            }
        }
        if constexpr (ALIGN_EPI) { if (wr == 0) PG8_BAR; }
        if constexpr (!Epi::AFTER_DRAIN) { for (int amp_ = 0; amp_ < (Epi::AMP ? 3 : 1); ++amp_) { E(acc, cur, wr, wc, fr, fq); asm volatile("" ::: "memory"); } S.done(cur); }
        if (!has_next) break;
#pragma unroll
        for (int a = 0; a < 2; ++a)
#pragma unroll
            for (int b = 0; b < 2; ++b)
#pragma unroll
                for (int m = 0; m < 4; ++m)
#pragma unroll
                    for (int n = 0; n < 2; ++n) acc[a][b][m][n] = (f32x4){0.f, 0.f, 0.f, 0.f};
        cur = nxt; cA = nA; cB = nB; ++ui;
        if constexpr (ALIGN_EPI) { if (wr == 1) PG8_BAR; }
    }
    PG8_WAIT_V(0);
    if constexpr (!ALIGN_EPI) { if (wr == 0) PG8_BAR; }
    PG8_BAR;
    if constexpr (Epi::AFTER_DRAIN) { E.fused(acc, cur, wr, wc, fr, fq, lds, wid, lane); S.done(cur); }
#undef PG8_SA
#undef PG8_SB
#undef PG8_STAGE
#undef PG8_LDA
#undef PG8_LDB
#undef PG8_MMA
#undef PG8_WAIT_V
#undef PG8_WAIT_L
#undef PG8_BAR
#undef PG8_SCHED
}
}

#ifndef PG8_SP2
#define PG8_SP2 true
#endif

constexpr int NWAVES = 8;
constexpr int DM = 2048, SEQ = 4096, NBATCH = 2, MR = NBATCH * SEQ, NMETA = 16, LPOS = SEQ + NMETA;
constexpr int DFF = 5632, NGU = 2 * DFF;
constexpr int NHEAD = 8, SH = 16, CONVD = 1536, NIN = 5648, NINP = 5632;
constexpr int PPAD = 48, LPAD = LPOS + PPAD;
constexpr float EPS = 1e-6f;
#ifndef MK_REPEAT_PHASE
#define MK_REPEAT_PHASE -1
#endif
#ifndef MK_N_LAUNCHES
#define MK_N_LAUNCHES 1
#endif
constexpr int NPH = 10;
constexpr int N_LAUNCHES = MK_N_LAUNCHES;

constexpr size_t MiB = 1u << 20;
constexpr size_t WS_CTL = 0, CTL_ZERO_BYTES = 1 * MiB;
constexpr size_t WS_W1GU = 2 * MiB, WS_W1D = 46 * MiB, WS_WIN = 68 * MiB, WS_WOUT = 91 * MiB, WS_W2GU = 99 * MiB, WS_W2D = 143 * MiB;
constexpr size_t WS_XN = 165 * MiB;
constexpr size_t WS_ACT = 197 * MiB;
constexpr size_t WS_MIX = 285 * MiB;
constexpr size_t WS_SSQ0 = 317 * MiB;
constexpr size_t WS_SSQ1 = 318 * MiB, WS_SSQ2 = 319 * MiB;
constexpr size_t WS_DTR = 320 * MiB;
constexpr size_t WS_ROPE = 321 * MiB;
constexpr size_t WS_META = 322 * MiB;
constexpr size_t MO_XN = 0, MO_SSQ0 = 65536, MO_ACT = 131072, MO_H1 = 327680, MO_XN1 = 458752, MO_U = 524288, MO_KM = 917504, MO_VM = 950272, MO_SSQ1 = 69632;
constexpr size_t WS_SST = 324 * MiB;
constexpr size_t WS_ATOT = 333 * MiB;
constexpr size_t WS_SSQS = 334 * MiB;
constexpr size_t WS_XS = 336 * MiB;
constexpr size_t WS_BC = 353 * MiB;
constexpr size_t WS_DT = 362 * MiB;
constexpr size_t WS_END = 363 * MiB;
constexpr int CW_BAR = 4096;

constexpr int RING_OFF = 0, RING_BYTES = 131072;
constexpr int LDS_BYTES = 147456, MISC_OFF = LDS_BYTES - 512;

#define GAS __attribute__((address_space(1)))
#define LAS __attribute__((address_space(3)))
typedef unsigned short bf16;
typedef unsigned v4u __attribute__((ext_vector_type(4)));
typedef float f32x4 __attribute__((ext_vector_type(4)));
typedef short bf16x8 __attribute__((ext_vector_type(8)));
typedef GAS unsigned gu32;
typedef GAS unsigned long long gu64;
#define RLX_AGENT __ATOMIC_RELAXED, __HIP_MEMORY_SCOPE_AGENT
#define LDS_WAIT() asm volatile("s_waitcnt lgkmcnt(0)" ::: "memory")
#define VM_WAIT() asm volatile("s_waitcnt vmcnt(0)" ::: "memory")
__device__ __forceinline__ unsigned long long rt() { return __builtin_amdgcn_s_memrealtime(); }
__device__ __forceinline__ unsigned f2bf(float f) { unsigned u = __builtin_bit_cast(unsigned, f); return (u + 0x7fffu + ((u >> 16) & 1u)) >> 16; }
typedef float f32x2_pk __attribute__((ext_vector_type(2))); typedef __bf16 bf16x2_pk __attribute__((ext_vector_type(2)));
__device__ __forceinline__ unsigned pk2(float lo, float hi) { f32x2_pk v = {lo, hi}; bf16x2_pk b = __builtin_convertvector(v, bf16x2_pk); return __builtin_bit_cast(unsigned, b); }

#define XB_TMO      128
#define XB_XCNT(j)  (256  + 64 * (j))
#define XB_XSUB(j)  (1280 + 64 * (j))
#define XB_XGEN(j)  (2304 + 64 * (j))
#define XB_TOP      3328
#define XB_TOPGEN   3392
#define XCD_BAR_WORDS 3456
#define XB_BAD      8192
#define XB_LOC(s, j) (8256 + 64 * (16 * (s) + (j)))
#define XB_RDY      16512
#define XB_SPIN_CAP (1u << 18)

__device__ __forceinline__ unsigned xb_ld(unsigned* p)              { return __hip_atomic_load(p, __ATOMIC_RELAXED, __HIP_MEMORY_SCOPE_AGENT); }
__device__ __forceinline__ unsigned xb_add(unsigned* p, unsigned v) { return __hip_atomic_fetch_add(p, v, __ATOMIC_RELAXED, __HIP_MEMORY_SCOPE_AGENT); }
__device__ __forceinline__ unsigned xb_xcc_id() { return (unsigned)__builtin_amdgcn_s_getreg((3 << 11) | 20) & 0xFu; }
#define XB_SPIN(cond, bar) do { unsigned _sp = 0; while (cond) { __builtin_amdgcn_s_sleep(1); \
    if ((++_sp & 255u) == 0u) { if (xb_ld(&(bar)[XB_TMO])) break; if (_sp > XB_SPIN_CAP) { atomicAdd(&(bar)[XB_TMO], 1u); break; } } } } while (0)

struct XcdBarrier {
    unsigned* bar; unsigned x;
    volatile LAS unsigned* st;
};

__device__ __forceinline__ XcdBarrier xcd_barrier_post(unsigned* bar, volatile LAS unsigned* st) {
    XcdBarrier b; b.bar = bar; b.x = xb_xcc_id(); b.st = st;
    if (threadIdx.x == 0) { (void)xb_add(&bar[XB_XCNT(b.x)], 1u); if ((blockIdx.x & 7u) != b.x) (void)xb_add(&bar[XB_BAD], 1u); }
    return b;
}
__device__ __forceinline__ void xcd_barrier_complete(unsigned* bar, unsigned x, unsigned& nloc, unsigned& nx) {
    const unsigned G = gridDim.x * gridDim.y * gridDim.z;
    unsigned sum, cnt, mine, sp = 0u;
    for (;;) {
        sum = 0u; cnt = 0u; mine = 0u;
#pragma unroll
        for (unsigned j = 0; j < 16; ++j) { const unsigned c = xb_ld(&bar[XB_XCNT(j)]); sum += c; cnt += (c > 0u) ? 1u : 0u; mine = (j == x) ? c : mine; }
        if (sum == G) break;
        __builtin_amdgcn_s_sleep(1);
        if ((++sp & 255u) == 0u) { if (xb_ld(&bar[XB_TMO])) break; if (sp > XB_SPIN_CAP) { atomicAdd(&bar[XB_TMO], 1u); break; } }
    }
    nloc = mine > 0u ? mine : 1u; nx = cnt > 0u ? cnt : 1u;
}

__device__ __forceinline__ void xcd_barrier(const XcdBarrier& b) {
    asm volatile("s_waitcnt vmcnt(0)" ::: "memory");
    __syncthreads();
    if (threadIdx.x == 0) {
        unsigned* bar = b.bar;
        __builtin_amdgcn_s_waitcnt(0);
        unsigned nloc = b.st[0], nx = b.st[1];
        if (nloc == 0u) { xcd_barrier_complete(bar, b.x, nloc, nx); b.st[0] = nloc; b.st[1] = nx; }
        const unsigned old = xb_add(&bar[XB_XSUB(b.x)], 1u);
        const unsigned gen = old / nloc;
        if (old + 1u == (gen + 1u) * nloc) {
            __builtin_amdgcn_fence(__ATOMIC_RELEASE, "agent");
            asm volatile("s_waitcnt vmcnt(0)" ::: "memory");
            const unsigned og = xb_add(&bar[XB_TOP], 1u);
            const unsigned tg = og / nx;
            if (og + 1u == (tg + 1u) * nx) xb_add(&bar[XB_TOPGEN], 1u);
            else XB_SPIN(xb_ld(&bar[XB_TOPGEN]) == tg, bar);
            __builtin_amdgcn_fence(__ATOMIC_ACQUIRE, "agent");
            xb_add(&bar[XB_XGEN(b.x)], 1u);
            asm volatile("s_waitcnt vmcnt(0)" ::: "memory");
        } else {
            XB_SPIN(xb_ld(&bar[XB_XGEN(b.x)]) == gen, bar);
            __builtin_amdgcn_fence(__ATOMIC_ACQUIRE, "agent");
            asm volatile("s_waitcnt vmcnt(0)" ::: "memory");
        }
    }
    __syncthreads();
}


__device__ __forceinline__ void xcd_local_barrier(const XcdBarrier& b, int s, unsigned rdy) {
    asm volatile("s_waitcnt vmcnt(0)" ::: "memory");
    __syncthreads();
    if (threadIdx.x == 0) {
        unsigned* w = &b.bar[XB_LOC(s, b.x)];
        const unsigned nloc = b.st[0];
        (void)xb_add(w, 1u);
        XB_SPIN(xb_ld(w) < nloc, b.bar);
        if (rdy) XB_SPIN(xb_ld(&b.bar[XB_RDY]) < rdy, b.bar);
        __builtin_amdgcn_fence(__ATOMIC_ACQUIRE, "agent");
        asm volatile("s_waitcnt vmcnt(0)" ::: "memory");
    }
    __syncthreads();
}

typedef unsigned u32x2v __attribute__((ext_vector_type(2)));
__device__ __forceinline__ float bf2f(unsigned b) { return __uint_as_float(b << 16); }
__device__ __forceinline__ float wave_sum(float v) {
#pragma unroll
    for (int o = 1; o < 64; o <<= 1) v += __shfl_xor(v, o);
    return v;
}
__device__ __forceinline__ float wave_max(float v) {
#pragma unroll
    for (int o = 1; o < 64; o <<= 1) v = fmaxf(v, __shfl_xor(v, o));
    return v;
}
__device__ __forceinline__ float silu1(float g) { return g * __builtin_amdgcn_rcpf(1.0f + __builtin_amdgcn_exp2f(-1.4426950408889634f * g)); }

struct Frame {
    LAS unsigned char* lds;
    int tid, lane, wave, G, gw, NGW;
    const float* in[26]; float* out; unsigned char* ws; const float* const* inp;
};
#define WSP(T, off) ((T*)(F.ws + (off)))

constexpr int RST_OFF = RING_BYTES;
__device__ __forceinline__ pg8::RsTable build_rs_table(Frame& F, const float* ssq, int np, float inv_n, int pm, int pm2 = -1) {
    LAS float* t = (LAS float*)(F.lds + RST_OFF);
    if (F.tid < 256) t[F.tid] = pg8::row_rs(ssq, np, pm * 256 + F.tid, inv_n);
    else if (pm2 >= 0) t[F.tid] = pg8::row_rs(ssq, np, pm2 * 256 + F.tid - 256, inv_n);
    __syncthreads();
    return pg8::RsTable{t, pm, pm2};
}
__device__ __forceinline__ int rowmap(int kind, int n) {
    if (kind == 1) return 256 * (n >> 7) + (n & 127);
    if (kind == 2) return 256 * (n >> 7) + 128 + (n & 127);
    if (kind == 3) { if (n >= NINP) return n; const int pn = n >> 8, rem = n & 255, wc = rem >> 6, bj = (rem >> 5) & 1, j = rem & 31; return 256 * pn + 128 * bj + 32 * wc + j; }
    return n;
}
struct TItem { const float* W; int K, N; const float* kscale; bf16* WT; int kind, item, ks_off, krot; };
__device__ __forceinline__ void transpose_load(const TItem& t, int lane, f32x4 (&v)[16]) {
    const int nblk = (t.N + 63) >> 6, kb = t.item / nblk, nb = t.item - kb * nblk, k0 = 64 * kb, n0 = 64 * nb;
    const float* src = t.W + (size_t)(k0 + 8 * (lane >> 3)) * t.N;
#pragma unroll
    for (int h = 0; h < 2; ++h) { int nl = n0 + 32 * h + 4 * (lane & 7); nl = nl < t.N ? nl : t.N - 4;
#pragma unroll
        for (int i = 0; i < 8; ++i) v[8 * h + i] = __builtin_nontemporal_load((const f32x4*)(src + (size_t)i * t.N + nl)); }
}
__device__ __forceinline__ void transpose_finish(const TItem& t, int lane, f32x4 (&v)[16]) {
    const int nblk = (t.N + 63) >> 6, kb = t.item / nblk, nb = t.item - kb * nblk, k0 = 64 * kb, n0 = 64 * nb, r = lane >> 3;
    float sc[8];
    if (t.kscale && k0 >= t.ks_off) { const f32x4 s0 = *(const f32x4*)(t.kscale + k0 + 8 * r - t.ks_off), s1 = *(const f32x4*)(t.kscale + k0 + 8 * r - t.ks_off + 4);
        sc[0] = s0[0]; sc[1] = s0[1]; sc[2] = s0[2]; sc[3] = s0[3]; sc[4] = s1[0]; sc[5] = s1[1]; sc[6] = s1[2]; sc[7] = s1[3]; }
    else {
#pragma unroll
        for (int i = 0; i < 8; ++i) sc[i] = 1.0f; }
    int kd = k0 + t.krot; if (kd >= t.K) kd -= t.K;
#pragma unroll
    for (int h = 0; h < 2; ++h)
#pragma unroll
        for (int j = 0; j < 4; ++j) { const int n = n0 + 32 * h + 4 * (lane & 7) + j;
            v4u o; o.x = pg8::cvt_pk_bf16(v[8 * h + 0][j] * sc[0], v[8 * h + 1][j] * sc[1]); o.y = pg8::cvt_pk_bf16(v[8 * h + 2][j] * sc[2], v[8 * h + 3][j] * sc[3]);
            o.z = pg8::cvt_pk_bf16(v[8 * h + 4][j] * sc[4], v[8 * h + 5][j] * sc[5]); o.w = pg8::cvt_pk_bf16(v[8 * h + 6][j] * sc[6], v[8 * h + 7][j] * sc[7]);
            if (n < t.N) *(v4u*)(t.WT + (size_t)rowmap(t.kind, n) * t.K + kd + 8 * r) = o; }
}
__device__ __forceinline__ void transpose_load_h(const TItem& t, int lane, int h, f32x4 (&v)[8]) {
    const int nblk = (t.N + 63) >> 6, kb = t.item / nblk, nb = t.item - kb * nblk, k0 = 64 * kb, n0 = 64 * nb;
    const float* src = t.W + (size_t)(k0 + 8 * (lane >> 3)) * t.N;
    int nl = n0 + 32 * h + 4 * (lane & 7); nl = nl < t.N ? nl : t.N - 4;
#pragma unroll
    for (int i = 0; i < 8; ++i) v[i] = __builtin_nontemporal_load((const f32x4*)(src + (size_t)i * t.N + nl));
}
__device__ __forceinline__ void transpose_finish_h(const TItem& t, int lane, int h, f32x4 (&v)[8]) {
    const int nblk = (t.N + 63) >> 6, kb = t.item / nblk, nb = t.item - kb * nblk, k0 = 64 * kb, n0 = 64 * nb, r = lane >> 3;
    float sc[8];
    if (t.kscale && k0 >= t.ks_off) { const f32x4 s0 = *(const f32x4*)(t.kscale + k0 + 8 * r - t.ks_off), s1 = *(const f32x4*)(t.kscale + k0 + 8 * r - t.ks_off + 4);
        sc[0] = s0[0]; sc[1] = s0[1]; sc[2] = s0[2]; sc[3] = s0[3]; sc[4] = s1[0]; sc[5] = s1[1]; sc[6] = s1[2]; sc[7] = s1[3]; }
    else {
#pragma unroll
        for (int i = 0; i < 8; ++i) sc[i] = 1.0f; }
    int kd = k0 + t.krot; if (kd >= t.K) kd -= t.K;
#pragma unroll
    for (int j = 0; j < 4; ++j) { const int n = n0 + 32 * h + 4 * (lane & 7) + j;
        v4u o; o.x = pg8::cvt_pk_bf16(v[0][j] * sc[0], v[1][j] * sc[1]); o.y = pg8::cvt_pk_bf16(v[2][j] * sc[2], v[3][j] * sc[3]);
        o.z = pg8::cvt_pk_bf16(v[4][j] * sc[4], v[5][j] * sc[5]); o.w = pg8::cvt_pk_bf16(v[6][j] * sc[6], v[7][j] * sc[7]);
        if (n < t.N) *(v4u*)(t.WT + (size_t)rowmap(t.kind, n) * t.K + kd + 8 * r) = o; }
}
__device__ __forceinline__ void row_to_bf16(const float* xrow, bf16* orow, float* ssq, int lane) {
    const f32x4* xr = (const f32x4*)xrow + lane; float s = 0.f; f32x4 v[8];
#pragma unroll
    for (int j = 0; j < 8; ++j) { v[j] = __builtin_nontemporal_load(xr + 64 * j); s += (v[j][0] * v[j][0] + v[j][1] * v[j][1]) + (v[j][2] * v[j][2] + v[j][3] * v[j][3]); }
    s = wave_sum(s);
    u32x2v* o8 = (u32x2v*)orow + lane;
#pragma unroll
    for (int j = 0; j < 8; ++j) { u32x2v w; w.x = pk2(v[j][0], v[j][1]); w.y = pk2(v[j][2], v[j][3]); o8[64 * j] = w; }
    if (lane == 0) *ssq = s;
}
__constant__ float ROPE_INV[8] = {1.0f, 0.1939227432012558f, 0.03760603070259094f, 0.007292664609849453f, 0.0014142135623842478f, 0.00027424818836152554f, 5.318296098266728e-05f, 1.0313386155758053e-05f};
constexpr int I_G = 32 * 88, I_D = 88 * 32, I_IN = 32 * 89, I_O = 32 * 32;
constexpr int IT_W1G = 0, IT_W1U = IT_W1G + I_G, IT_WOUT = IT_W1U + I_G, IT_W1D = IT_WOUT + I_O, IT_WIN = IT_W1D + I_D, IT_W2U = IT_WIN + I_IN, IT_W2G = IT_W2U + I_G, IT_W2D = IT_W2G + I_G, IT_END = IT_W2D + I_D;
#ifndef MK_N1
#define MK_N1 6944
#endif
constexpr int IT_BG = IT_END - 8192;
constexpr int IT_CUT0 = IT_BG - MK_N1;
static_assert(IT_CUT0 >= IT_WOUT, "W1 gate/up are needed by P1");
__device__ __forceinline__ TItem mk_item(Frame& F, int it) {
    const int m = (it >= IT_W1U) + (it >= IT_WOUT) + (it >= IT_W1D) + (it >= IT_WIN) + (it >= IT_W2U) + (it >= IT_W2G) + (it >= IT_W2D);
    const int start = m == 0 ? IT_W1G : m == 1 ? IT_W1U : m == 2 ? IT_WOUT : m == 3 ? IT_W1D : m == 4 ? IT_WIN : m == 5 ? IT_W2U : m == 6 ? IT_W2G : IT_W2D;
    const unsigned long long WI = 0x1917180705150403ull, SI = 0xff161606ff140202ull;
    const int wi = (int)((WI >> (8 * m)) & 0xffu), si = (int)((SI >> (8 * m)) & 0xffu);
    const bool down = (m == 3 || m == 7);
    const size_t wto = m < 2 ? WS_W1GU : m == 2 ? WS_WOUT : m == 3 ? WS_W1D : m == 4 ? WS_WIN : m < 7 ? WS_W2GU : WS_W2D;
    const int kind = (m == 0 || m == 6) ? 1 : (m == 1 || m == 5) ? 2 : m == 4 ? 3 : 0;
    TItem t; t.W = F.inp[wi]; t.K = down ? DFF : DM; t.N = down ? DM : m == 2 ? DM : m == 4 ? NIN : DFF; t.kscale = si == 0xff ? nullptr : F.inp[si]; t.WT = WSP(bf16, wto); t.kind = kind; t.item = it - start;
    t.ks_off = m == 2 ? 1024 : 0; t.krot = m == 2 ? 1024 : 0;
    return t;
}
__device__ __forceinline__ TItem mk_item_w2(Frame& F, int it) {
    const bool gate = it >= IT_W2G;
    TItem t; t.W = gate ? F.in[0x17] : F.in[0x18]; t.K = DM; t.N = DFF; t.kscale = F.in[0x16]; t.WT = WSP(bf16, WS_W2GU); t.kind = gate ? 1 : 2; t.item = it - (gate ? IT_W2G : IT_W2U); t.ks_off = 0; t.krot = 0;
    return t;
}
__device__ __forceinline__ void transpose_finish_hs(const TItem& t, int lane, int h, f32x4 (&v)[8], const f32x4 s0, const f32x4 s1) {
    const int nblk = (t.N + 63) >> 6, kb = t.item / nblk, nb = t.item - kb * nblk, k0 = 64 * kb, n0 = 64 * nb, r = lane >> 3;
    const float sc[8] = {s0[0], s0[1], s0[2], s0[3], s1[0], s1[1], s1[2], s1[3]};
#pragma unroll
    for (int j = 0; j < 4; ++j) { const int n = n0 + 32 * h + 4 * (lane & 7) + j;
        v4u o; o.x = pg8::cvt_pk_bf16(v[0][j] * sc[0], v[1][j] * sc[1]); o.y = pg8::cvt_pk_bf16(v[2][j] * sc[2], v[3][j] * sc[3]);
        o.z = pg8::cvt_pk_bf16(v[4][j] * sc[4], v[5][j] * sc[5]); o.w = pg8::cvt_pk_bf16(v[6][j] * sc[6], v[7][j] * sc[7]);
        if (n < t.N) *(v4u*)(t.WT + (size_t)rowmap(t.kind, n) * t.K + k0 + 8 * r) = o; }
}
__device__ __forceinline__ void convert_items(Frame& F, int lo, int hi, int w, int nw) {
    if (w < 0) return;
    f32x4 va[16], vb[16]; int it = lo + w;
    if (it < hi) { TItem ta = mk_item(F, it); transpose_load(ta, F.lane, va);
        for (;;) {
            const int itb = it + nw; TItem tb = mk_item(F, itb < hi ? itb : it);
            if (itb < hi) transpose_load(tb, F.lane, vb);
            transpose_finish(ta, F.lane, va);
            if (itb >= hi) break;
            const int itc = itb + nw; ta = mk_item(F, itc < hi ? itc : itb);
            if (itc < hi) transpose_load(ta, F.lane, va);
            transpose_finish(tb, F.lane, vb);
            if (itc >= hi) break;
            it = itc;
        } }
}
__device__ __forceinline__ void p0_prologue(Frame& F) {
    convert_items(F, 0, IT_CUT0, F.gw, F.NGW);
    for (int m = F.gw; m < MR; m += 2 * F.NGW) {
        const int m2 = m + F.NGW;
        const f32x4* xa = (const f32x4*)(F.in[0] + (size_t)m * DM) + F.lane; const f32x4* xb = (const f32x4*)(F.in[0] + (size_t)(m2 < MR ? m2 : m) * DM) + F.lane;
        f32x4 va[8], vb[8]; float sa = 0.f, sb = 0.f;
#pragma unroll
        for (int j = 0; j < 8; ++j) { va[j] = __builtin_nontemporal_load(xa + 64 * j); vb[j] = __builtin_nontemporal_load(xb + 64 * j); }
#pragma unroll
        for (int j = 0; j < 8; ++j) { sa += (va[j][0] * va[j][0] + va[j][1] * va[j][1]) + (va[j][2] * va[j][2] + va[j][3] * va[j][3]); sb += (vb[j][0] * vb[j][0] + vb[j][1] * vb[j][1]) + (vb[j][2] * vb[j][2] + vb[j][3] * vb[j][3]); }
        sa = wave_sum(sa); sb = wave_sum(sb);
        u32x2v* oa = (u32x2v*)(WSP(bf16, WS_XN) + (size_t)m * DM) + F.lane; u32x2v* ob = (u32x2v*)(WSP(bf16, WS_XN) + (size_t)m2 * DM) + F.lane;
#pragma unroll
        for (int j = 0; j < 8; ++j) { u32x2v w; w.x = pk2(va[j][0], va[j][1]); w.y = pk2(va[j][2], va[j][3]); oa[64 * j] = w; }
        if (F.lane == 0) WSP(float, WS_SSQ0)[m] = sa;
        if (m2 < MR) {
#pragma unroll
            for (int j = 0; j < 8; ++j) { u32x2v w; w.x = pk2(vb[j][0], vb[j][1]); w.y = pk2(vb[j][2], vb[j][3]); ob[64 * j] = w; }
            if (F.lane == 0) WSP(float, WS_SSQ0)[m2] = sb; }
    }
    for (int p = F.gw; p < NMETA; p += F.NGW) row_to_bf16(F.in[1] + (size_t)p * DM, WSP(bf16, WS_META + MO_XN) + (size_t)p * DM, WSP(float, WS_META + MO_SSQ0) + p, F.lane);
    for (int e = F.gw * 64 + F.lane; e < LPOS * 8; e += F.NGW * 64) { const int pos = e >> 3, i = e & 7;
        const float ang = (float)pos * ROPE_INV[i];
        double tr = (double)ang * 0.15915494309189535; tr -= __builtin_rint(tr);
        const float tf = (float)tr;
        WSP(float, WS_ROPE)[pos * 16 + i] = __builtin_amdgcn_cosf(tf); WSP(float, WS_ROPE)[pos * 16 + 8 + i] = __builtin_amdgcn_sinf(tf); }
}

__device__ __forceinline__ f32x4 skinny16(const bf16* A, int lda, const bf16* Bt, int ldb, int k0, int k1, int lane, f32x4 acc) {
    const bf16* ap = A + (size_t)(lane & 15) * lda + 8 * (lane >> 4);
    const bf16* bp = Bt + (size_t)(lane & 15) * ldb + 8 * (lane >> 4);
#pragma unroll 16
    for (int k = k0; k < k1; k += 32) { const bf16x8 a = *(const bf16x8*)(ap + k), b = *(const bf16x8*)(bp + k);
        acc = __builtin_amdgcn_mfma_f32_16x16x32_bf16(a, b, acc, 0, 0, 0); }
    asm volatile("s_nop 15\n\ts_nop 3" : "+v"(acc));
    return acc;
}
template <int NS>
__device__ __forceinline__ f32x4 skinny16_fixed(const bf16* A, int lda, const bf16* Bt, int ldb, int k0, int lane, f32x4 acc) {
    const bf16* ap = A + (size_t)(lane & 15) * lda + 8 * (lane >> 4) + k0;
    const bf16* bp = Bt + (size_t)(lane & 15) * ldb + 8 * (lane >> 4) + k0;
    bf16x8 av[NS], bv[NS];
#pragma unroll
    for (int i = 0; i < NS; ++i) { av[i] = *(const bf16x8*)(ap + 32 * i); bv[i] = *(const bf16x8*)(bp + 32 * i); }
#pragma unroll
    for (int i = 0; i < NS; ++i) acc = __builtin_amdgcn_mfma_f32_16x16x32_bf16(av[i], bv[i], acc, 0, 0, 0);
    asm volatile("s_nop 15\n\ts_nop 3" : "+v"(acc));
    return acc;
}
__device__ __forceinline__ void meta_gateup(Frame& F, int w0, int wstride) {
    const bf16* A = WSP(bf16, WS_META + MO_XN); const float* ssq = WSP(float, WS_META + MO_SSQ0); bf16* act = WSP(bf16, WS_META + MO_ACT);
    if (w0 < 0) return;
    for (int it = w0; it < DFF / 16; it += wstride) { const int c0 = 16 * it, rg = 256 * (c0 >> 7) + (c0 & 127);
        f32x4 g = (f32x4){0.f, 0.f, 0.f, 0.f}, u = g;
        g = skinny16(A, DM, WSP(bf16, WS_W1GU) + (size_t)rg * DM, DM, 0, DM, F.lane, g);
        u = skinny16(A, DM, WSP(bf16, WS_W1GU) + (size_t)(rg + 128) * DM, DM, 0, DM, F.lane, u);
#pragma unroll
        for (int i = 0; i < 4; ++i) { const int row = 4 * (F.lane >> 4) + i; const float rs = __builtin_amdgcn_rsqf(ssq[row] * (1.0f / 2048.0f) + EPS);
            act[row * DFF + c0 + (F.lane & 15)] = (bf16)f2bf(silu1(g[i] * rs) * (u[i] * rs)); } }
}
__device__ __forceinline__ void meta_down(Frame& F) {
    const bf16* A = WSP(bf16, WS_META + MO_ACT); float* ssq1 = WSP(float, WS_META + MO_SSQ1); bf16* xn1 = WSP(bf16, WS_META + MO_XN1);
    LAS f32x4* red = (LAS f32x4*)(F.lds + RST_OFF + 2048);
    if (F.G == 256) {
        const int it = (int)blockIdx.x & 127, kh = (int)blockIdx.x >> 7, c0 = 16 * it;
        float mb[4] = {0.f, 0.f, 0.f, 0.f};
        if (F.wave == 0 && kh == 0) {
#pragma unroll
            for (int i = 0; i < 4; ++i) mb[i] = F.in[1][(4 * (F.lane >> 4) + i) * DM + c0 + (F.lane & 15)]; }
        f32x4 a = (f32x4){0.f, 0.f, 0.f, 0.f};
        static_assert(8 * (10 + 12) * 32 == DFF, "10 + 12 K-steps of 32 per wave");
        if (kh == 1) a = skinny16_fixed<10>(A, DFF, WSP(bf16, WS_W1D) + (size_t)c0 * DFF, DFF, F.wave * 320, F.lane, a);
        else         a = skinny16_fixed<12>(A, DFF, WSP(bf16, WS_W1D) + (size_t)c0 * DFF, DFF, 2560 + F.wave * 384, F.lane, a);
        red[F.wave * 64 + F.lane] = a;
        __syncthreads();
        if (F.wave == 0) {
#pragma unroll
            for (int w = 1; w < 8; ++w) a += red[w * 64 + F.lane];
            float* px = WSP(float, WS_META + 1572864) + it * 256 + 4 * F.lane;
            unsigned* flag = (unsigned*)(F.ws + WS_CTL) + 32768 + it;
            if (kh == 1) {
                asm volatile("global_store_dwordx4 %0, %1, off sc1\n\ts_nop 1\n\ts_waitcnt vmcnt(0)" :: "v"(px), "v"(a) : "memory");
                if (F.lane == 0) __hip_atomic_store(flag, 1u, __ATOMIC_RELAXED, __HIP_MEMORY_SCOPE_AGENT);
            } else {
                if (F.lane == 0) { unsigned sp = 0; while (__hip_atomic_load(flag, __ATOMIC_RELAXED, __HIP_MEMORY_SCOPE_AGENT) == 0u && ++sp < (1u << 22)) __builtin_amdgcn_s_sleep(1); }
                __builtin_amdgcn_fence(__ATOMIC_ACQUIRE, "agent");
                a += *(const volatile f32x4*)px;
#pragma unroll
                for (int i = 0; i < 4; ++i) { const int row = 4 * (F.lane >> 4) + i, col = c0 + (F.lane & 15); const float o = mb[i] + 0.5f * a[i];
                    { const unsigned hb = f2bf(o); asm volatile("global_store_short %0, %1, off sc1" :: "v"(xn1 + row * DM + col), "v"(hb) : "memory"); }
                    float sq = o * o; sq += __shfl_xor(sq, 1); sq += __shfl_xor(sq, 2); sq += __shfl_xor(sq, 4); sq += __shfl_xor(sq, 8);
                    if ((F.lane & 15) == 0) asm volatile("global_store_dword %0, %1, off sc1" :: "v"(ssq1 + row * 128 + it), "v"(sq) : "memory"); }
                asm volatile("s_waitcnt vmcnt(0)" ::: "memory");
                if (F.lane == 0) (void)__hip_atomic_fetch_add((unsigned*)(F.ws + WS_CTL) + CW_BAR + XB_RDY, 1u, __ATOMIC_RELAXED, __HIP_MEMORY_SCOPE_AGENT);
            }
        }
        __syncthreads();
        return;
    }
    for (int it = blockIdx.x; it < DM / 16; it += F.G) { const int c0 = 16 * it;
        f32x4 a = (f32x4){0.f, 0.f, 0.f, 0.f};
        a = skinny16_fixed<DFF / 8 / 32>(A, DFF, WSP(bf16, WS_W1D) + (size_t)c0 * DFF, DFF, F.wave * (DFF / 8), F.lane, a);
        red[F.wave * 64 + F.lane] = a;
        __syncthreads();
        if (F.wave == 0) {
#pragma unroll
            for (int w = 1; w < 8; ++w) a += red[w * 64 + F.lane];
#pragma unroll
            for (int i = 0; i < 4; ++i) { const int row = 4 * (F.lane >> 4) + i, col = c0 + (F.lane & 15); const float o = F.in[1][row * DM + col] + 0.5f * a[i];
                xn1[row * DM + col] = (bf16)f2bf(o);
                float sq = o * o; sq += __shfl_xor(sq, 1); sq += __shfl_xor(sq, 2); sq += __shfl_xor(sq, 4); sq += __shfl_xor(sq, 8);
                if ((F.lane & 15) == 0) ssq1[row * 128 + it] = sq; } }
        __syncthreads();
    }
}
constexpr int NMETA_IT = NIN / 16, NDT_IT = MR / 16;
__device__ __forceinline__ void meta_inproj_and_dt(Frame& F, int it0, int it_end, int wstride) {
    const int nmeta = NMETA_IT;
    if (it0 < 0) return;
    for (int it = it0; it < it_end; it += wstride) {
        if (it < nmeta) {
            const float* ssq1 = WSP(float, WS_META + MO_SSQ1); float* um = WSP(float, WS_META + MO_U);
            float rs[4];
#pragma unroll
            for (int i = 0; i < 4; ++i) { const f32x4* pp = (const f32x4*)(ssq1 + (4 * (F.lane >> 4) + i) * 128 + 8 * (F.lane & 15)); const f32x4 v = pp[0] + pp[1]; float s2 = (v[0] + v[1]) + (v[2] + v[3]);
                s2 += __shfl_xor(s2, 1); s2 += __shfl_xor(s2, 2); s2 += __shfl_xor(s2, 4); s2 += __shfl_xor(s2, 8);
                rs[i] = __builtin_amdgcn_rsqf(s2 * (1.0f / 2048.0f) + EPS); }
            const int r0 = 16 * it;
            int c0;
            if (r0 >= NINP) c0 = r0; else { const int pn = r0 >> 8, rem = r0 & 255, bj = rem >> 7, wc = (rem & 127) >> 5, j = rem & 31; c0 = 256 * pn + 64 * wc + 32 * bj + j; }
            f32x4 a = (f32x4){0.f, 0.f, 0.f, 0.f};
            a = skinny16(WSP(bf16, WS_META + MO_XN1), DM, WSP(bf16, WS_WIN) + (size_t)r0 * DM, DM, 0, DM, F.lane, a);
#pragma unroll
            for (int i = 0; i < 4; ++i) um[(size_t)(4 * (F.lane >> 4) + i) * NIN + c0 + (F.lane & 15)] = a[i] * rs[i];
        } else {
            const int m0 = 16 * (it - nmeta);
            f32x4 a = (f32x4){0.f, 0.f, 0.f, 0.f};
            a = skinny16(WSP(bf16, WS_XN) + (size_t)m0 * DM, DM, WSP(bf16, WS_WIN) + (size_t)NINP * DM, DM, 0, DM, F.lane, a);
#pragma unroll
            for (int i = 0; i < 4; ++i) { const int row = m0 + 4 * (F.lane >> 4) + i; WSP(float, WS_DTR)[(size_t)row * 16 + (F.lane & 15)] = a[i] * pg8::row_rs(WSP(float, WS_SSQ1), 32, row); }
        }
    }
}


namespace att {
typedef float f32x16 __attribute__((ext_vector_type(16)));
typedef short s16x4 __attribute__((ext_vector_type(4)));
typedef short v4i16_t __attribute__((ext_vector_type(4)));
typedef float f32x2_t __attribute__((ext_vector_type(2))); typedef __bf16 bf16x2_t __attribute__((ext_vector_type(2)));
constexpr int STAGE = 32768, VOFF = 16384;
__device__ __forceinline__ int crow(int r, int hi) { return (r & 3) + 8 * (r >> 2) + 4 * hi; }
__device__ __forceinline__ unsigned cvtpk(float lo, float hi) { f32x2_t v = {lo, hi}; bf16x2_t b = __builtin_convertvector(v, bf16x2_t); return __builtin_bit_cast(unsigned, b); }
#define ATT_WAITBAR() asm volatile("s_waitcnt vmcnt(0) lgkmcnt(0)\n\ts_barrier" ::: "memory")
__device__ __forceinline__ void glds16(const void* gsrc, unsigned lds_dst) { unsigned keep;
    asm volatile("s_mov_b32 %0, m0\n\ts_mov_b32 m0, %2\n\ts_nop 0\n\tglobal_load_lds_dwordx4 %1, off\n\ts_mov_b32 m0, %0" : "=&s"(keep) : "v"(gsrc), "s"(lds_dst) : "memory"); }
#define ATT_DMA(src, dstoff) glds16((const void*)(src), (unsigned)__builtin_amdgcn_readfirstlane((int)(dstoff)))
#define ATT_MFMA(a, b, c) __builtin_amdgcn_mfma_f32_32x32x16_bf16((a), (b), (c), 0, 0, 0)
__device__ __forceinline__ float fadd_s(float a, float b) { float r; asm("v_add_f32 %0, %1, %2" : "=v"(r) : "v"(a), "v"(b)); return r; }

constexpr int KST = 16384, VST0 = 4 * KST, VSTB = 16384, WSF_OFF = VST0 + 3 * VSTB, STG_OFF = VST0, DUMMY_OFF = WSF_OFF + 1024;
constexpr int META_K_OFF = 126976, META_V_OFF = 135168, WN_OFF = 139264;
__device__ __forceinline__ void attn_meta_tile(Frame& F, int bh) {
    LAS unsigned char* lds = F.lds; const int wave = F.wave, lane = F.lane, h = bh & 7;
    { const float* um = WSP(float, WS_META + MO_U);
      float mv[4], rc[4], rsn[4];
      const int d = lane, dr = lane & 7;
#pragma unroll
      for (int i4 = 0; i4 < 4; ++i4) { const int itm = 4 * wave + i4, p = itm >> 1; mv[i4] = um[(size_t)p * NIN + 1024 + h * 128 + (itm & 1) * 64 + lane];
          const float* rp = WSP(float, WS_ROPE) + p * 16; rc[i4] = rp[dr]; rsn[i4] = rp[8 + dr]; }
      const float kn = F.in[9][d];
      const int e = 4 * (wave * 64 + lane), key = e >> 7, dv = e & 127; const f32x4 vv = *(const f32x4*)(um + (size_t)key * NIN + 2048 + h * 128 + dv);
      float wnv = 0.f; if (F.tid < 128) wnv = F.in[14][F.tid];
#pragma unroll
      for (int i4 = 0; i4 < 4; ++i4) { const int itm = 4 * wave + i4, p = itm >> 1, sh = itm & 1;
          float v = mv[i4];
          const float r = __builtin_amdgcn_rsqf(wave_sum(v * v) * (1.0f / 64.0f) + EPS);
          v = v * r * kn;
          const float pr = __shfl_xor(v, 8);
          if (d < 8) v = v * rc[i4] - pr * rsn[i4]; else if (d < 16) v = v * rc[i4] + pr * rsn[i4];
          const int dd = sh * 64 + d;
          *(LAS bf16*)(lds + META_K_OFF + p * 256 + (((dd >> 3) ^ p) << 4) + (dd & 7) * 2) = (bf16)f2bf(v); }
      { u32x2v w2; w2.x = pk2(vv[0], vv[1]); w2.y = pk2(vv[2], vv[3]); *(LAS u32x2v*)(lds + META_V_OFF + (dv >> 5) * 1024 + key * 64 + (dv & 31) * 2) = w2; }
      if (F.tid < 128) ((LAS float*)(lds + WN_OFF))[F.tid] = wnv * 0.8f; }
}
__device__ __forceinline__ void attn_unit(Frame& F, int bh, int jq, float lam) {
    LAS unsigned char* lds = F.lds;
    const bf16* U = WSP(bf16, WS_ACT);
    int lane = F.lane; asm volatile("" : "+v"(lane));
    const int wave = F.wave, r32 = lane & 31, hi = lane >> 5;
    const int b = bh >> 3, h = bh & 7, rb = wave & 3, sub = wave >> 2;
    const int cw = 2 * jq + (rb >> 1);
    const int row0 = b * SEQ + 128 * jq + 32 * rb;
    const int T = 2 * jq + 2;
    const int kk0 = 8 * wave + (lane >> 4), kk1 = kk0 + 4;
    const bf16* kbase0 = U + (size_t)(b * SEQ + kk0) * NINP + 1024 + h * 128 + 8 * ((lane & 15) ^ (kk0 & 15));
    const bf16* kbase1 = U + (size_t)(b * SEQ + kk1) * NINP + 1024 + h * 128 + 8 * ((lane & 15) ^ (kk1 & 15));
    const int v0 = 2 * wave, v1 = 2 * wave + 1;
    const bf16* vbase0 = U + (size_t)(b * SEQ + 16 * (v0 & 3) + (lane >> 2)) * NINP + 2048 + h * 128 + 32 * (v0 >> 2) + 8 * (lane & 3);
    const bf16* vbase1 = U + (size_t)(b * SEQ + 16 * (v1 & 3) + (lane >> 2)) * NINP + 2048 + h * 128 + 32 * (v1 >> 2) + 8 * (lane & 3);
    const int kd0 = 2 * wave * 1024, kd1 = kd0 + 1024, vd0 = v0 * 1024, vd1 = v1 * 1024;
#define ATT_DMA_K(t, ks_) do { const size_t to_ = (size_t)(t) * 64 * NINP; ATT_DMA(kbase0 + to_, (ks_) + kd0); ATT_DMA(kbase1 + to_, (ks_) + kd1); } while (0)
#define ATT_DMA_V(t, vs_) do { const size_t to_ = (size_t)(t) * 64 * NINP; ATT_DMA(vbase0 + to_, (vs_) + vd0); ATT_DMA(vbase1 + to_, (vs_) + vd1); } while (0)
    ATT_DMA_K(0, 0); ATT_DMA_V(0, VST0); ATT_DMA_K(1, KST); ATT_DMA_V(1, VST0 + VSTB); if (T > 2) ATT_DMA_K(2, 2 * KST);
    bf16x8 qf[4];
#pragma unroll
    for (int ks = 0; ks < 4; ++ks) qf[ks] = *(const bf16x8*)(U + (size_t)(row0 + r32) * NINP + h * 128 + sub * 64 + 16 * ks + 8 * hi);
    f32x16 o[4];
#pragma unroll
    for (int d = 0; d < 4; ++d)
#pragma unroll
        for (int i = 0; i < 16; ++i) o[d][i] = 0.f;
    float lsum = 0.f;
    const f32x16 zero16 = {0.f, 0.f, 0.f, 0.f, 0.f, 0.f, 0.f, 0.f, 0.f, 0.f, 0.f, 0.f, 0.f, 0.f, 0.f, 0.f};
    const int koff = r32 * 256 + (((8 * sub + hi) ^ (r32 & 15)) << 4);
    const int voff = ((lane >> 4) & 1) * 32 + (lane & 3) * 8 + (4 * hi + ((lane & 15) >> 2)) * 64;
#define ATT_KF(kst_, half, ks) (*(const LAS bf16x8*)(lds + (kst_) + (half) * 8192 + (koff ^ ((ks) << 5))))
#define ATT_VTR(vst_, off) __builtin_bit_cast(s16x4, __builtin_amdgcn_ds_read_tr16_b64_v4i16((LAS v4i16_t*)(lds + (vst_) + voff + (off))))
    ATT_WAITBAR();
    f32x16 s0 = zero16, s1 = zero16;
    {
        f32x16 sc = zero16;
#pragma unroll
        for (int ks = 0; ks < 4; ++ks) sc = ATT_MFMA(ATT_KF(META_K_OFF, 0, ks), qf[ks], sc);
#pragma unroll
        for (int ks = 0; ks < 4; ++ks) { s0 = ATT_MFMA(ATT_KF(0, 0, ks), qf[ks], s0); s1 = ATT_MFMA(ATT_KF(0, 1, ks), qf[ks], s1); }
#pragma unroll
        for (int i = 0; i < 8; ++i) { sc[i] = __builtin_amdgcn_exp2f(sc[i]); lsum += sc[i]; }
        v4u pw; pw.x = cvtpk(sc[0], sc[1]); pw.y = cvtpk(sc[2], sc[3]); pw.z = cvtpk(sc[4], sc[5]); pw.w = cvtpk(sc[6], sc[7]);
        const bf16x8 pm = __builtin_bit_cast(bf16x8, pw);
#pragma unroll
        for (int d = 0; d < 4; ++d) { const s16x4 lo = ATT_VTR(META_V_OFF, d * 1024), hh = ATT_VTR(META_V_OFF, d * 1024 + 512);
            const bf16x8 vf = {lo[0], lo[1], lo[2], lo[3], hh[0], hh[1], hh[2], hh[3]};
            o[d] = ATT_MFMA(pm, vf, o[d]); }
    }
    ATT_WAITBAR();
    int vm0 = 0, vm2 = 2;
#define SBAR() __builtin_amdgcn_sched_barrier(0)
#define ATT_VTRP(vp_, off) __builtin_bit_cast(s16x4, __builtin_amdgcn_ds_read_tr16_b64_v4i16((LAS v4i16_t*)((vp_) + (off))))
#define ATT_VLOAD(buf, vst_, d, kp) do { _Pragma("unroll") for (int ks_ = 0; ks_ < 2; ++ks_) { vlo[buf][ks_] = ATT_VTRP(vst_, (d) * 4096 + (2 * (kp) + ks_) * 1024); vhi[buf][ks_] = ATT_VTRP(vst_, (d) * 4096 + (2 * (kp) + ks_) * 1024 + 512); } } while (0)
#define ATT_GQ(MF) do { MF; SBAR(); } while (0)
#define ATT_GS(NV, b4, PW, w0, w1) do { ls = (((ls + NV[b4]) + NV[b4 + 1]) + NV[b4 + 2]) + NV[b4 + 3];     PW[w0] = cvtpk(NV[b4], NV[b4 + 1]); PW[w1] = cvtpk(NV[b4 + 2], NV[b4 + 3]); } while (0)
#define ATT_GB(MF, NV, i0, GS) do { MF; NV[i0] = __builtin_amdgcn_exp2f(NV[i0]); NV[i0 + 1] = __builtin_amdgcn_exp2f(NV[i0 + 1]); GS; SBAR(); } while (0)
#define ATT_VF(buf, ks_) (bf16x8){vlo[buf][ks_][0], vlo[buf][ks_][1], vlo[buf][ks_][2], vlo[buf][ks_][3], vhi[buf][ks_][0], vhi[buf][ks_][1], vhi[buf][ks_][2], vhi[buf][ks_][3]}
#define ATT_STEP(C0, C1, C2, C3, D0, D1, D2, D3, tt) do { \
        const int t_ = (tt); const int knext = ((t_ + 1) & 3) * KST, kdst = ((t_ + 3) & 3) * KST, vdst = VST0 + vm2 * VSTB; \
        LAS unsigned char* vcur = lds + VST0 + vm0 * VSTB + voff; asm volatile("" : "+v"(vcur));     \
        const bool dk = t_ + 3 < T, dv = t_ + 2 < T; const size_t tok_ = dk ? (size_t)(t_ + 3) * 64 * NINP : 0, tov_ = dv ? (size_t)(t_ + 2) * 64 * NINP : 0; \
        const int dK0 = dk ? kdst + kd0 : DUMMY_OFF + wave * 1024, dK1 = dk ? kdst + kd1 : DUMMY_OFF + wave * 1024, dV0 = dv ? vdst + vd0 : DUMMY_OFF + wave * 1024, dV1 = dv ? vdst + vd1 : DUMMY_OFF + wave * 1024; \
        ATT_DMA(kbase0 + tok_, dK0); ATT_DMA(kbase1 + tok_, dK1); ATT_DMA(vbase0 + tov_, dV0); ATT_DMA(vbase1 + tov_, dV1); \
        if (t_ <= cw) { \
            bf16x8 kf[4]; s16x4 vlo[2][2], vhi[2][2]; f32x16 N0, N1; float ls = 0.f; \
            SBAR(); \
            kf[0] = ATT_KF(knext, 0, 0); kf[1] = ATT_KF(knext, 1, 0); kf[2] = ATT_KF(knext, 0, 1); kf[3] = ATT_KF(knext, 1, 1); SBAR(); \
            ATT_GQ(N0 = ATT_MFMA(kf[0], qf[0], zero16)); \
            ATT_GQ(N1 = ATT_MFMA(kf[1], qf[0], zero16)); \
            kf[0] = ATT_KF(knext, 0, 2); kf[1] = ATT_KF(knext, 1, 2); SBAR(); \
            ATT_GQ(N0 = ATT_MFMA(kf[2], qf[1], N0)); \
            ATT_GQ(N1 = ATT_MFMA(kf[3], qf[1], N1)); \
            kf[2] = ATT_KF(knext, 0, 3); kf[3] = ATT_KF(knext, 1, 3); SBAR(); \
            ATT_GQ(N0 = ATT_MFMA(kf[0], qf[2], N0)); \
            ATT_GQ(N1 = ATT_MFMA(kf[1], qf[2], N1)); \
            ATT_VLOAD(0, vcur, 0, 0); SBAR(); \
            ATT_GQ(N0 = ATT_MFMA(kf[2], qf[3], N0)); \
            ATT_GQ(N1 = ATT_MFMA(kf[3], qf[3], N1)); \
            const bf16x8 pf0 = __builtin_bit_cast(bf16x8, C0), pf1 = __builtin_bit_cast(bf16x8, C1), pf2 = __builtin_bit_cast(bf16x8, C2), pf3 = __builtin_bit_cast(bf16x8, C3); \
            ATT_VLOAD(1, vcur, 0, 1); SBAR(); \
            ATT_GB(o[0] = ATT_MFMA(pf0, ATT_VF(0, 0), o[0]), N0, 0, (void)0); ATT_GB(o[0] = ATT_MFMA(pf1, ATT_VF(0, 1), o[0]), N0, 2, (void)0); \
            ATT_VLOAD(0, vcur, 1, 0); SBAR(); \
            ATT_GB(o[0] = ATT_MFMA(pf2, ATT_VF(1, 0), o[0]), N0, 4, ATT_GS(N0, 0, D0, 0, 1)); ATT_GB(o[0] = ATT_MFMA(pf3, ATT_VF(1, 1), o[0]), N0, 6, (void)0); \
            ATT_VLOAD(1, vcur, 1, 1); SBAR(); \
            ATT_GB(o[1] = ATT_MFMA(pf0, ATT_VF(0, 0), o[1]), N0, 8, ATT_GS(N0, 4, D0, 2, 3)); ATT_GB(o[1] = ATT_MFMA(pf1, ATT_VF(0, 1), o[1]), N0, 10, (void)0); \
            ATT_VLOAD(0, vcur, 2, 0); SBAR(); \
            ATT_GB(o[1] = ATT_MFMA(pf2, ATT_VF(1, 0), o[1]), N0, 12, ATT_GS(N0, 8, D1, 0, 1)); ATT_GB(o[1] = ATT_MFMA(pf3, ATT_VF(1, 1), o[1]), N0, 14, (void)0); \
            ATT_VLOAD(1, vcur, 2, 1); SBAR(); \
            ATT_GB(o[2] = ATT_MFMA(pf0, ATT_VF(0, 0), o[2]), N1, 0, ATT_GS(N0, 12, D1, 2, 3)); ATT_GB(o[2] = ATT_MFMA(pf1, ATT_VF(0, 1), o[2]), N1, 2, (void)0); \
            ATT_VLOAD(0, vcur, 3, 0); SBAR(); \
            ATT_GB(o[2] = ATT_MFMA(pf2, ATT_VF(1, 0), o[2]), N1, 4, ATT_GS(N1, 0, D2, 0, 1)); ATT_GB(o[2] = ATT_MFMA(pf3, ATT_VF(1, 1), o[2]), N1, 6, (void)0); \
            ATT_VLOAD(1, vcur, 3, 1); SBAR(); \
            ATT_GB(o[3] = ATT_MFMA(pf0, ATT_VF(0, 0), o[3]), N1, 8, ATT_GS(N1, 4, D2, 2, 3)); ATT_GB(o[3] = ATT_MFMA(pf1, ATT_VF(0, 1), o[3]), N1, 10, (void)0); \
            ATT_GB(o[3] = ATT_MFMA(pf2, ATT_VF(1, 0), o[3]), N1, 12, ATT_GS(N1, 8, D3, 0, 1)); ATT_GB(o[3] = ATT_MFMA(pf3, ATT_VF(1, 1), o[3]), N1, 14, (void)0); \
            ATT_GS(N1, 12, D3, 2, 3); \
            lsum += (t_ < cw) ? ls : 0.f;     \
        } \
          \
        asm volatile("s_waitcnt vmcnt(4) lgkmcnt(0)\n\ts_barrier" ::: "memory"); \
        vm0 = (vm0 == 2) ? 0 : vm0 + 1; vm2 = (vm2 == 2) ? 0 : vm2 + 1; \
    } while (0)
    v4u pa0, pa1, pa2, pa3, pb0, pb1, pb2, pb3;
    pb0 = pb1 = pb2 = pb3 = (v4u){0u, 0u, 0u, 0u};
    {
#pragma unroll
        for (int i = 0; i < 16; ++i) { s0[i] = __builtin_amdgcn_exp2f(s0[i]); s1[i] = __builtin_amdgcn_exp2f(s1[i]); }
        float ls = 0.f;
        ATT_GS(s0, 0, pa0, 0, 1); ATT_GS(s0, 4, pa0, 2, 3); ATT_GS(s0, 8, pa1, 0, 1); ATT_GS(s0, 12, pa1, 2, 3);
        ATT_GS(s1, 0, pa2, 0, 1); ATT_GS(s1, 4, pa2, 2, 3); ATT_GS(s1, 8, pa3, 0, 1); ATT_GS(s1, 12, pa3, 2, 3);
        lsum += ls;
    }
    for (int t = 0; t < T; t += 2) { ATT_STEP(pa0, pa1, pa2, pa3, pb0, pb1, pb2, pb3, t); ATT_STEP(pb0, pb1, pb2, pb3, pa0, pa1, pa2, pa3, t + 1); }
    ATT_WAITBAR();
#undef ATT_STEP
#undef ATT_VLOAD
#undef ATT_GQ
#undef ATT_GS
#undef ATT_GB
#undef ATT_VF
#undef SBAR
    int le = lane; asm volatile("" : "+v"(le));
    const int r32e = le & 31, hie = le >> 5;
    lsum += __shfl_xor(lsum, 32);
    LAS float* wsf = (LAS float*)(lds + WSF_OFF + wave * 128);
    const float fac = (sub == 0 ? 1.0f : lam) / lsum;
    if (hie == 0) wsf[r32e] = fac;
    LDS_WAIT(); asm volatile("" ::: "memory");
    LAS float* xo = (LAS float*)(lds + (wave & 3) * 16384) + le;
    const int ipark = sub == 0 ? 8 : 0, ikeep = sub == 0 ? 0 : 8;
#pragma unroll
    for (int i8 = 0; i8 < 8; ++i8) {
        { const int i = i8 + 8; const float f = wsf[crow(i, hie)];
#pragma unroll
          for (int d = 0; d < 4; ++d) o[d][i] *= f; }
        { const int i = i8; const float f = wsf[crow(i, hie)];
#pragma unroll
          for (int d = 0; d < 4; ++d) o[d][i] *= f; }
    }
    if (sub == 0) {
#pragma unroll
        for (int i = 8; i < 16; ++i)
#pragma unroll
            for (int d = 0; d < 4; ++d) xo[(d * 16 + i) * 64] = o[d][i];
    } else {
#pragma unroll
        for (int i = 0; i < 8; ++i)
#pragma unroll
            for (int d = 0; d < 4; ++d) xo[(d * 16 + i) * 64] = o[d][i];
    }
    ATT_WAITBAR();
    {
        LAS bf16* stg = (LAS bf16*)(lds + STG_OFF + (wave & 3) * 8192);
        const LAS float* wnl = (const LAS float*)(lds + WN_OFF);
        float wn[4];
#pragma unroll
        for (int d = 0; d < 4; ++d) wn[d] = wnl[32 * d + r32e];
#pragma unroll
        for (int i8 = 0; i8 < 8; ++i8) { float v[4], ss = 0.f; int q;
            if (sub == 0) { const int i = i8; q = crow(i, hie);
#pragma unroll
                for (int d = 0; d < 4; ++d) { v[d] = o[d][i] - xo[(d * 16 + i) * 64]; ss += v[d] * v[d]; } }
            else { const int i = i8 + 8; q = crow(i, hie);
#pragma unroll
                for (int d = 0; d < 4; ++d) { v[d] = xo[(d * 16 + i) * 64] - o[d][i]; ss += v[d] * v[d]; } }
            ss += __shfl_xor(ss, 1); ss += __shfl_xor(ss, 2); ss += __shfl_xor(ss, 4); ss += __shfl_xor(ss, 8); ss += __shfl_xor(ss, 16);
            const float r = __builtin_amdgcn_rsqf(ss * (1.0f / 128.0f) + EPS);
#pragma unroll
            for (int d = 0; d < 4; ++d) stg[q * 128 + 32 * d + r32e] = (bf16)(cvtpk(v[d] * r * wn[d], 0.f) & 0xffffu); }
        LDS_WAIT(); asm volatile("" ::: "memory");
#pragma unroll
        for (int it = 0; it < 4; ++it) { const int q = 16 * sub + 4 * it + (le >> 4), ch = le & 15;
            const v4u val = *(const LAS v4u*)(stg + q * 128 + 8 * ch);
            *(v4u*)(WSP(bf16, WS_MIX) + (size_t)(128 * jq + 32 * (wave & 3) + b * SEQ + q) * DM + 1024 + h * 128 + 8 * ch) = val; }
    }
    asm volatile("s_waitcnt lgkmcnt(0)\n\ts_barrier" ::: "memory");
#undef ATT_DMA_K
#undef ATT_DMA_V
#undef ATT_KF
#undef ATT_VTR
}
}


namespace ssd {
constexpr int S64 = 144, S128 = 272;
constexpr int O_CC = 0, O_BC = 17408, O_BT = 34816, O_XT = 53248, O_XS = 62464, O_XC = 71680, O_M = 80896, O_SI = 90112, O_SC = 107520;
#define SSD_MF(a, b, c) __builtin_amdgcn_mfma_f32_16x16x32_bf16((a), (b), (c), 0, 0, 0)
#define SSD_FRAG(img, stride, row, k) (*(const LAS bf16x8*)(lds + (img) + (row) * (stride) + 2 * (k)))
#define SSD_BAR() do { asm volatile("s_waitcnt vmcnt(0) lgkmcnt(0)" ::: "memory"); __builtin_amdgcn_s_barrier(); asm volatile("" ::: "memory"); } while (0)

__device__ __forceinline__ v4u pack8(const float (&v)[8]) { v4u o; o.x = pk2(v[0], v[1]); o.y = pk2(v[2], v[3]); o.z = pk2(v[4], v[5]); o.w = pk2(v[6], v[7]); return o; }
__device__ __forceinline__ unsigned bfe16(const v4u& r, int e) { const unsigned w = (e < 2) ? r.x : (e < 4) ? r.y : (e < 6) ? r.z : r.w; return (e & 1) ? (w >> 16) : (w & 0xffffu); }

template <bool PASSB>
__device__ __forceinline__ void ssd_item(Frame& F, int item, int& bgj) {
    LAS unsigned char* lds = F.lds;
    int lane0 = F.lane; asm volatile("" : "+v"(lane0));
    const int wave = F.wave;
    const int k = item & 7, hd = (item >> 3) & 15, b = item >> 7, g = hd >> 3;
    const float Ah = -__expf(F.in[18][hd]), Dk = F.in[19][hd];
    LAS float* sc = (LAS float*)(lds + O_SC);
    const int pt = wave >> 1, nb = 4 * (wave & 1);
    f32x4 stt[4];
#pragma unroll
    for (int j = 0; j < 4; ++j) stt[j] = (f32x4){0.f, 0.f, 0.f, 0.f};
    float* sst = WSP(float, WS_SST) + (size_t)((b * SH + hd) * 8) * 8192;
    float* atot = WSP(float, WS_ATOT) + (b * SH + hd) * 8;
    if (PASSB) {
        const int fr = lane0 & 15, fq = lane0 >> 4;
        float at[7], w[7], run = 0.f;
#pragma unroll
        for (int kk = 0; kk < 7; ++kk) at[kk] = atot[kk];
#pragma unroll
        for (int kk = 6; kk >= 0; --kk) { const bool in = kk < k; w[kk] = in ? __expf(run) : 0.f; run += in ? at[kk] : 0.f; }
        const float* sp = sst + (16 * pt + fr) * 128 + 16 * nb + 4 * fq;
        if (k > 0) { f32x4 sv[4][4];
#pragma unroll
            for (int kk = 0; kk < 4; ++kk)
#pragma unroll
                for (int j = 0; j < 4; ++j) sv[kk][j] = *(const f32x4*)(sp + (size_t)kk * 8192 + 16 * j);
#pragma unroll
            for (int kk = 0; kk < 4; ++kk)
#pragma unroll
                for (int j = 0; j < 4; ++j) stt[j] += sv[kk][j] * w[kk]; }
        if (k > 4) { f32x4 sv[3][4];
#pragma unroll
            for (int kk = 0; kk < 3; ++kk)
#pragma unroll
                for (int j = 0; j < 4; ++j) sv[kk][j] = *(const f32x4*)(sp + (size_t)(kk + 4) * 8192 + 16 * j);
#pragma unroll
            for (int kk = 0; kk < 3; ++kk)
#pragma unroll
                for (int j = 0; j < 4; ++j) stt[j] += sv[kk][j] * w[kk + 4]; }
    }
    float asum = 0.f;
    const int c_lo = (k == 0) ? 0 : 8 * k + 1, c_hi = 8 * k + 8;
    const int role = (wave < 2) ? 0 : (wave < 4) ? 1 : (wave < 6 && PASSB) ? 2 : 3;
    v4u raw[8]; float dtv = 0.f;
    { const int li = (wave * 64 + lane0) & 127, cg = (role == 0) ? (li & 7) : (li & 15), l0 = (role == 0) ? 4 * (li >> 3) : 8 * (li >> 4);
      if (role == 0) { const bf16* src = WSP(bf16, WS_XS) + (size_t)(b * LPAD + 64 * c_lo + l0) * 1024 + hd * 64 + 8 * cg;
#pragma unroll
          for (int i = 0; i < 4; ++i) raw[i] = *(const v4u*)(src + (size_t)i * 1024); }
      else if (role < 3) { const bf16* src = WSP(bf16, WS_BC) + (size_t)(b * LPAD + 64 * c_lo + l0) * 512 + (role == 2 ? 256 : 0) + g * 128 + 8 * cg;
#pragma unroll
          for (int i = 0; i < 8; ++i) raw[i] = *(const v4u*)(src + (size_t)i * 512); }
      if (wave == 7) dtv = WSP(float, WS_DT)[(size_t)(b * LPAD + 64 * c_lo + lane0) * 16 + hd]; }
    f32x4 cv[8], ks0, ks1; TItem ct; bool chave = false; int chh = 0;
    for (int c = c_lo; c <= c_hi; ++c) {
        int lane = lane0; asm volatile("" : "+v"(lane));
        const int tid = wave * 64 + lane, fr = lane & 15, fq = lane >> 4, li = tid & 127;
        const int cg = (role == 0) ? (li & 7) : (li & 15), l0 = (role == 0) ? 4 * (li >> 3) : 8 * (li >> 4);
        u32x2v zv[2];
        const int cn = (c < c_hi) ? c + 1 : c;
        if (role == 0) {
            if (PASSB) {
#pragma unroll
                for (int i = 0; i < 4; ++i) *(LAS v4u*)(lds + O_XC + (l0 + i) * S64 + 16 * cg) = raw[i]; }
#pragma unroll
            for (int e = 0; e < 8; ++e) { u32x2v w2; w2.x = bfe16(raw[0], e) | (bfe16(raw[1], e) << 16); w2.y = bfe16(raw[2], e) | (bfe16(raw[3], e) << 16); *(LAS u32x2v*)(lds + O_XT + (8 * cg + e) * S64 + 2 * l0) = w2; }
        } else if (role == 1) {
            if (PASSB) {
#pragma unroll
                for (int i = 0; i < 8; ++i) *(LAS v4u*)(lds + O_BC + (l0 + i) * S128 + 16 * cg) = raw[i]; }
#pragma unroll
            for (int e = 0; e < 8; ++e) { v4u w4; w4.x = bfe16(raw[0], e) | (bfe16(raw[1], e) << 16); w4.y = bfe16(raw[2], e) | (bfe16(raw[3], e) << 16); w4.z = bfe16(raw[4], e) | (bfe16(raw[5], e) << 16); w4.w = bfe16(raw[6], e) | (bfe16(raw[7], e) << 16);
                *(LAS v4u*)(lds + O_BT + (8 * cg + e) * S64 + 2 * l0) = w4; }
        } else if (role == 2) {
#pragma unroll
            for (int i = 0; i < 8; ++i) *(LAS v4u*)(lds + O_CC + (l0 + i) * S128 + 16 * cg) = raw[i];
        }
        if (wave == 7) {
            const float dt = dtv;
            float a = dt * Ah;
#pragma unroll
            for (int o2 = 1; o2 < 64; o2 <<= 1) { const float t = __shfl_up(a, o2); if (lane >= o2) a += t; }
            const float aend = __shfl(a, 63);
            sc[lane] = dt; sc[64 + lane] = a; sc[128 + lane] = dt * __expf(aend - a);
            if (lane == 0) sc[192] = aend;
        }
        if (PASSB) { if (chave) transpose_finish_hs(ct, lane, chh, cv, ks0, ks1); }
        asm volatile("s_waitcnt lgkmcnt(0)" ::: "memory"); __builtin_amdgcn_s_barrier(); asm volatile("" ::: "memory");
        const float aend = sc[192];
        if (role == 0) { const bf16* src = WSP(bf16, WS_XS) + (size_t)(b * LPAD + 64 * cn + l0) * 1024 + hd * 64 + 8 * cg;
#pragma unroll
            for (int i = 0; i < 4; ++i) raw[i] = *(const v4u*)(src + (size_t)i * 1024);
        } else if (role == 1) { const bf16* src = WSP(bf16, WS_BC) + (size_t)(b * LPAD + 64 * cn + l0) * 512 + g * 128 + 8 * cg;
#pragma unroll
            for (int i = 0; i < 8; ++i) raw[i] = *(const v4u*)(src + (size_t)i * 512);
        } else if (role == 2) { const bf16* src = WSP(bf16, WS_BC) + (size_t)(b * LPAD + 64 * cn + l0) * 512 + 256 + g * 128 + 8 * cg;
#pragma unroll
            for (int i = 0; i < 8; ++i) raw[i] = *(const v4u*)(src + (size_t)i * 512);
        }
        if (wave == 7) dtv = WSP(float, WS_DT)[(size_t)(b * LPAD + 64 * cn + lane) * 16 + hd];
        if (PASSB && c >= 1) {
#pragma unroll
            for (int j = 0; j < 2; ++j) zv[j] = *(const u32x2v*)(WSP(bf16, WS_ACT) + (size_t)(b * SEQ + 64 * (c - 1) + 16 * pt + fr) * NINP + 3072 + hd * 64 + 16 * (2 * (wave & 1) + j) + 4 * fq);
        }
        const float* bsrc = F.in[0] + 4 * lane; size_t bstr = 0; const float* ksrc = F.in[0x16];
        if (PASSB) { const int s32 = (F.gw + 8 * bgj) & 31, hix = (bgj * 64 + (F.gw >> 5)) * 21 + s32, cit = IT_BG + (hix >> 1);
            chh = hix & 1; chave = F.NGW == 2048 && bgj < 8 && s32 < 21 && cit < IT_W2D; ++bgj;
            if (chave) { ct = mk_item_w2(F, cit);
                const int nblk = (ct.N + 63) >> 6, kb = ct.item / nblk, nb_ = ct.item - kb * nblk; int nl = 64 * nb_ + 32 * chh + 4 * (lane & 7); nl = nl < ct.N ? nl : ct.N - 4;
                bsrc = ct.W + (size_t)(64 * kb + 8 * (lane >> 3)) * ct.N + nl; bstr = (size_t)ct.N; ksrc = ct.kscale + 64 * kb + 8 * (lane >> 3); }
            ks0 = *(const f32x4*)ksrc; ks1 = *(const f32x4*)(ksrc + 4);
#pragma unroll
            for (int i = 0; i < 3; ++i) cv[i] = __builtin_nontemporal_load((const f32x4*)(bsrc + (size_t)i * bstr)); }
        asm volatile("" ::: "memory");
        for (int amp2_ = 0; amp2_ < (MK_AMP == 2 ? 3 : 1); ++amp2_) {
        { const int p = tid >> 3, lg = (tid & 7) * 8;
          const v4u xv = *(const LAS v4u*)(lds + O_XT + p * S64 + 2 * lg); const unsigned xw[4] = {xv.x, xv.y, xv.z, xv.w}; float v[8];
#pragma unroll
          for (int e = 0; e < 4; ++e) { v[2 * e] = bf2f(xw[e] & 0xffffu) * sc[128 + lg + 2 * e]; v[2 * e + 1] = bf2f(xw[e] >> 16) * sc[128 + lg + 2 * e + 1]; }
          *(LAS v4u*)(lds + O_XS + p * S64 + 2 * lg) = pack8(v); }
        if (PASSB) {
            asm volatile("" ::: "memory");
#pragma unroll
            for (int i = 3; i < 6; ++i) cv[i] = __builtin_nontemporal_load((const f32x4*)(bsrc + (size_t)i * bstr));
            asm volatile("" ::: "memory");
#pragma unroll
            for (int j = 0; j < 4; ++j) { u32x2v w2; w2.x = pk2(stt[j][0], stt[j][1]); w2.y = pk2(stt[j][2], stt[j][3]); *(LAS u32x2v*)(lds + O_SI + (16 * pt + fr) * S128 + 2 * (16 * (nb + j) + 4 * fq)) = w2; }
            const int l = 16 * pt + fr; const float al = sc[64 + l];
#pragma unroll
            for (int j = 0; j < 2; ++j) { const int st = 2 * (wave & 1) + j; f32x4 acc = (f32x4){0.f, 0.f, 0.f, 0.f};
                if (st <= pt) {
#pragma unroll
                    for (int ks = 0; ks < 4; ++ks) acc = SSD_MF(SSD_FRAG(O_BC, S128, 16 * st + fr, 32 * ks + 8 * fq), SSD_FRAG(O_CC, S128, l, 32 * ks + 8 * fq), acc);
                    asm volatile("s_nop 15\n\ts_nop 3" : "+v"(acc)); }
                float m[4];
#pragma unroll
                for (int i = 0; i < 4; ++i) { const int s = 16 * st + 4 * fq + i; m[i] = (s <= l) ? acc[i] * __expf(al - sc[64 + s]) * sc[s] : 0.f; }
                u32x2v w2; w2.x = pk2(m[0], m[1]); w2.y = pk2(m[2], m[3]); *(LAS u32x2v*)(lds + O_M + l * S64 + 2 * (16 * st + 4 * fq)) = w2; }
        }
        }
        asm volatile("s_waitcnt lgkmcnt(0)" ::: "memory"); __builtin_amdgcn_s_barrier(); asm volatile("" ::: "memory");
        if (PASSB) {
#pragma unroll
            for (int i = 6; i < 8; ++i) cv[i] = __builtin_nontemporal_load((const f32x4*)(bsrc + (size_t)i * bstr));
            asm volatile("" ::: "memory"); }
        for (int amp3_ = 0; amp3_ < (MK_AMP == 3 ? 3 : 1); ++amp3_) {
        if (PASSB && c >= 1) {
            const int l = 16 * pt + fr, row = b * SEQ + 64 * (c - 1) + l; const float el = __expf(sc[64 + l]);
            float sq = 0.f;
#pragma unroll
            for (int j = 0; j < 2; ++j) { const int ptile = 2 * (wave & 1) + j; f32x4 acc = (f32x4){0.f, 0.f, 0.f, 0.f};
#pragma unroll
                for (int ks = 0; ks < 4; ++ks) acc = SSD_MF(SSD_FRAG(O_SI, S128, 16 * ptile + fr, 32 * ks + 8 * fq), SSD_FRAG(O_CC, S128, l, 32 * ks + 8 * fq), acc);
                acc = acc * el;
#pragma unroll
                for (int ks = 0; ks < 2; ++ks) acc = SSD_MF(SSD_FRAG(O_XT, S64, 16 * ptile + fr, 32 * ks + 8 * fq), SSD_FRAG(O_M, S64, l, 32 * ks + 8 * fq), acc);
                const int pc = 16 * ptile + 4 * fq;
                const u32x2v xv = *(const LAS u32x2v*)(lds + O_XC + l * S64 + 2 * pc);
                float y[4];
                y[0] = (acc[0] + Dk * bf2f(xv.x & 0xffffu)) * silu1(bf2f(zv[j].x & 0xffffu)); y[1] = (acc[1] + Dk * bf2f(xv.x >> 16)) * silu1(bf2f(zv[j].x >> 16));
                y[2] = (acc[2] + Dk * bf2f(xv.y & 0xffffu)) * silu1(bf2f(zv[j].y & 0xffffu)); y[3] = (acc[3] + Dk * bf2f(xv.y >> 16)) * silu1(bf2f(zv[j].y >> 16));
                sq += (y[0] * y[0] + y[1] * y[1]) + (y[2] * y[2] + y[3] * y[3]);
                u32x2v w2; w2.x = pk2(y[0], y[1]); w2.y = pk2(y[2], y[3]);
                *(u32x2v*)(WSP(bf16, WS_MIX) + (size_t)row * DM + hd * 64 + pc) = w2; }
            sq += __shfl_xor(sq, 16); sq += __shfl_xor(sq, 32);
            if (fq == 0) WSP(float, WS_SSQS)[(size_t)row * 32 + 2 * hd + (wave & 1)] = sq;
        }
        }
        { const float dec = __expf(aend);
#pragma unroll
          for (int j = 0; j < 4; ++j) { f32x4 acc = stt[j] * dec;
#pragma unroll
              for (int ks = 0; ks < 2; ++ks) acc = SSD_MF(SSD_FRAG(O_BT, S64, 16 * (nb + j) + fr, 32 * ks + 8 * fq), SSD_FRAG(O_XS, S64, 16 * pt + fr, 32 * ks + 8 * fq), acc);
              stt[j] = acc; } }
        asum += aend;
        asm volatile("s_waitcnt lgkmcnt(0)" ::: "memory"); __builtin_amdgcn_s_barrier(); asm volatile("" ::: "memory");
    }
    if (PASSB) { if (chave) transpose_finish_hs(ct, lane0, chh, cv, ks0, ks1); }
    if (!PASSB) { const int fr = lane0 & 15, fq = lane0 >> 4;
#pragma unroll
        for (int j = 0; j < 4; ++j) *(f32x4*)(sst + (size_t)k * 8192 + (16 * pt + fr) * 128 + 16 * (nb + j) + 4 * fq) = stt[j];
        if (wave == 0 && lane0 == 0) atot[k] = asum;
    }
}

constexpr int A_XS0 = 0, A_XS1 = 9216, A_BT0 = 18432, A_BT1 = 36864, A_W = 55296, A_ACS = 57600, A_DT = 59904, A_TOT = 62208;
__device__ __forceinline__ void ssd_pass_a(Frame& F, int item) {
    LAS unsigned char* lds = F.lds;
    int lane = F.lane; asm volatile("" : "+v"(lane));
    const int wave = F.wave, tid = wave * 64 + lane, fr = lane & 15, fq = lane >> 4;
    const int k = item & 7, hd = (item >> 3) & 15, b = item >> 7, g = hd >> 3;
    const float Ah = -__expf(F.in[18][hd]);
    const int c_lo = (k == 0) ? 0 : 8 * k + 1, c_hi = 8 * k + 8, nt = c_hi - c_lo + 1;
    const int pt = wave >> 1, nb = 4 * (wave & 1);
    const int role = (wave < 2) ? 0 : (wave < 4) ? 1 : 3;
    const int li = tid & 127, cg = (role == 0) ? (li & 7) : (li & 15), l0 = (role == 0) ? 4 * (li >> 3) : 8 * (li >> 4);
    LAS float* wl = (LAS float*)(lds + A_W); LAS float* acs = (LAS float*)(lds + A_ACS); LAS float* dts = (LAS float*)(lds + A_DT); LAS float* tot = (LAS float*)(lds + A_TOT);
    v4u raw[8];
    { if (role == 0) { const bf16* src = WSP(bf16, WS_XS) + (size_t)(b * LPAD + 64 * c_lo + l0) * 1024 + hd * 64 + 8 * cg;
#pragma unroll
          for (int i = 0; i < 4; ++i) raw[i] = *(const v4u*)(src + (size_t)i * 1024); }
      else if (role == 1) { const bf16* src = WSP(bf16, WS_BC) + (size_t)(b * LPAD + 64 * c_lo + l0) * 512 + g * 128 + 8 * cg;
#pragma unroll
          for (int i = 0; i < 8; ++i) raw[i] = *(const v4u*)(src + (size_t)i * 512); } }
    for (int t = wave; t < nt; t += NWAVES) {
        const float dt = WSP(float, WS_DT)[(size_t)(b * LPAD + 64 * (c_lo + t) + lane) * 16 + hd];
        float a = dt * Ah;
#define SSD_DPP_ADD(ctrl, rmask) a += __builtin_bit_cast(float, __builtin_amdgcn_update_dpp(0, __builtin_bit_cast(int, a), (ctrl), (rmask), 0xf, false))
        SSD_DPP_ADD(0x111, 0xf); SSD_DPP_ADD(0x112, 0xf); SSD_DPP_ADD(0x114, 0xf); SSD_DPP_ADD(0x118, 0xf); SSD_DPP_ADD(0x142, 0xa); SSD_DPP_ADD(0x143, 0xc);
#undef SSD_DPP_ADD
        acs[t * 64 + lane] = a; dts[t * 64 + lane] = dt; if (lane == 63) tot[t] = a;
    }
    asm volatile("s_waitcnt lgkmcnt(0)" ::: "memory"); __builtin_amdgcn_s_barrier(); asm volatile("" ::: "memory");
    float atotal = 0.f;
    { float tv[9];
#pragma unroll
      for (int t = 0; t < 9; ++t) { tv[t] = (t < nt) ? tot[t] : 0.f; atotal += tv[t]; }
      for (int t = wave; t < nt; t += NWAVES) { float off = 0.f;
#pragma unroll
          for (int u = 0; u < 9; ++u) off += (u < t) ? tv[u] : 0.f;
          wl[t * 64 + lane] = dts[t * 64 + lane] * __expf(atotal - (off + acs[t * 64 + lane])); } }
    f32x4 stt[4];
#pragma unroll
    for (int j = 0; j < 4; ++j) stt[j] = (f32x4){0.f, 0.f, 0.f, 0.f};
    asm volatile("s_waitcnt lgkmcnt(0)" ::: "memory"); __builtin_amdgcn_s_barrier(); asm volatile("" ::: "memory");
    for (int t = 0; t < nt; ++t) {
        const int xs_img = (t & 1) ? A_XS1 : A_XS0, bt_img = (t & 1) ? A_BT1 : A_BT0;
        const int cn = c_lo + ((t + 1 < nt) ? t + 1 : t);
        if (role == 0) {
            const f32x4 w4 = *(const LAS f32x4*)(wl + t * 64 + l0);
#pragma unroll
            for (int e = 0; e < 8; ++e) { u32x2v w2;
                w2.x = pk2(bf2f(bfe16(raw[0], e)) * w4[0], bf2f(bfe16(raw[1], e)) * w4[1]); w2.y = pk2(bf2f(bfe16(raw[2], e)) * w4[2], bf2f(bfe16(raw[3], e)) * w4[3]);
                *(LAS u32x2v*)(lds + xs_img + (8 * cg + e) * S64 + 2 * l0) = w2; }
            const bf16* src = WSP(bf16, WS_XS) + (size_t)(b * LPAD + 64 * cn + l0) * 1024 + hd * 64 + 8 * cg;
#pragma unroll
            for (int i = 0; i < 4; ++i) raw[i] = *(const v4u*)(src + (size_t)i * 1024);
        } else if (role == 1) {
#pragma unroll
            for (int e = 0; e < 8; ++e) { v4u w4; w4.x = bfe16(raw[0], e) | (bfe16(raw[1], e) << 16); w4.y = bfe16(raw[2], e) | (bfe16(raw[3], e) << 16); w4.z = bfe16(raw[4], e) | (bfe16(raw[5], e) << 16); w4.w = bfe16(raw[6], e) | (bfe16(raw[7], e) << 16);
                *(LAS v4u*)(lds + bt_img + (8 * cg + e) * S64 + 2 * l0) = w4; }
            const bf16* src = WSP(bf16, WS_BC) + (size_t)(b * LPAD + 64 * cn + l0) * 512 + g * 128 + 8 * cg;
#pragma unroll
            for (int i = 0; i < 8; ++i) raw[i] = *(const v4u*)(src + (size_t)i * 512);
        }
        asm volatile("s_waitcnt lgkmcnt(0)" ::: "memory"); __builtin_amdgcn_s_barrier(); asm volatile("" ::: "memory");
#pragma unroll
        for (int j = 0; j < 4; ++j) { f32x4 acc = stt[j];
#pragma unroll
            for (int ks = 0; ks < 2; ++ks) acc = SSD_MF(SSD_FRAG(bt_img, S64, 16 * (nb + j) + fr, 32 * ks + 8 * fq), SSD_FRAG(xs_img, S64, 16 * pt + fr, 32 * ks + 8 * fq), acc);
            stt[j] = acc; }
    }
    float* sst = WSP(float, WS_SST) + (size_t)((b * SH + hd) * 8) * 8192;
#pragma unroll
    for (int j = 0; j < 4; ++j) *(f32x4*)(sst + (size_t)k * 8192 + (16 * pt + fr) * 128 + 16 * (nb + j) + 4 * fq) = stt[j];
    if (wave == 0 && lane == 0) WSP(float, WS_ATOT)[(b * SH + hd) * 8 + k] = atotal;
    asm volatile("s_waitcnt lgkmcnt(0)" ::: "memory"); __builtin_amdgcn_s_barrier(); asm volatile("" ::: "memory");
}
}

struct ConvItem { int c, pp, b, p; v4u rv[4]; bool fast; };
__device__ __forceinline__ void conv_issue(Frame& F, int it, ConvItem& q) {
    const bf16* U = WSP(bf16, WS_ACT); const float* um = WSP(float, WS_META + MO_U);
    const int cg = it % (CONVD / 8); q.pp = (it / (CONVD / 8)) % LPAD; q.b = it / ((CONVD / 8) * LPAD); q.c = 8 * cg; q.p = q.pp - PPAD;
#pragma unroll
    for (int w = 0; w < 4; ++w) q.rv[w] = (v4u){0u, 0u, 0u, 0u};
    if (q.p >= 0) {
        if (q.p - 3 >= NMETA) { const bf16* src = U + (size_t)(q.b * SEQ + q.p - 3 - NMETA) * NINP + 4096 + q.c;
#pragma unroll
            for (int w = 0; w < 4; ++w) q.rv[w] = *(const v4u*)(src + (size_t)w * NINP); }
        else {
#pragma unroll
            for (int w = 0; w < 4; ++w) { const int ps = q.p - 3 + w; v4u v = (v4u){0u, 0u, 0u, 0u};
                if (ps >= NMETA) v = *(const v4u*)(U + (size_t)(q.b * SEQ + ps - NMETA) * NINP + 4096 + q.c);
                else if (ps >= 0) { const f32x4 r0 = *(const f32x4*)(um + (size_t)ps * NIN + 4096 + q.c), r1 = *(const f32x4*)(um + (size_t)ps * NIN + 4096 + q.c + 4);
                    v.x = pk2(r0[0], r0[1]); v.y = pk2(r0[2], r0[3]); v.z = pk2(r1[0], r1[1]); v.w = pk2(r1[2], r1[3]); }
                q.rv[w] = v; } }
    }
}
__device__ __forceinline__ void conv_finish(Frame& F, const ConvItem& q) {
    const float* cw = F.in[15]; const float* cb = F.in[16]; const int c = q.c;
    float a[8];
#pragma unroll
    for (int e = 0; e < 8; ++e) a[e] = 0.f;
    if (q.p >= 0) {
        const f32x4 b0 = *(const f32x4*)(cb + c), b1 = *(const f32x4*)(cb + c + 4);
        a[0] = b0[0]; a[1] = b0[1]; a[2] = b0[2]; a[3] = b0[3]; a[4] = b1[0]; a[5] = b1[1]; a[6] = b1[2]; a[7] = b1[3];
#pragma unroll
        for (int w = 0; w < 4; ++w) { const f32x4 w0 = *(const f32x4*)(cw + w * CONVD + c), w1 = *(const f32x4*)(cw + w * CONVD + c + 4);
            a[0] += bf2f(q.rv[w].x & 0xffffu) * w0[0]; a[1] += bf2f(q.rv[w].x >> 16) * w0[1]; a[2] += bf2f(q.rv[w].y & 0xffffu) * w0[2]; a[3] += bf2f(q.rv[w].y >> 16) * w0[3];
            a[4] += bf2f(q.rv[w].z & 0xffffu) * w1[0]; a[5] += bf2f(q.rv[w].z >> 16) * w1[1]; a[6] += bf2f(q.rv[w].w & 0xffffu) * w1[2]; a[7] += bf2f(q.rv[w].w >> 16) * w1[3]; }
#pragma unroll
        for (int e = 0; e < 8; ++e) a[e] = silu1(a[e]);
    }
    v4u o; o.x = pk2(a[0], a[1]); o.y = pk2(a[2], a[3]); o.z = pk2(a[4], a[5]); o.w = pk2(a[6], a[7]);
    if (c < 1024) *(v4u*)(WSP(bf16, WS_XS) + (size_t)(q.b * LPAD + q.pp) * 1024 + c) = o;
    else *(v4u*)(WSP(bf16, WS_BC) + (size_t)(q.b * LPAD + q.pp) * 512 + (c - 1024)) = o;
}
__device__ __forceinline__ v4u conv_row(Frame& F, int b, int ps, int c) {
    const bf16* U = WSP(bf16, WS_ACT); const float* um = WSP(float, WS_META + MO_U);
    v4u v = (v4u){0u, 0u, 0u, 0u};
    if (ps >= NMETA) v = *(const v4u*)(U + (size_t)(b * SEQ + ps - NMETA) * NINP + 4096 + c);
    else if (ps >= 0) { const f32x4 r0 = *(const f32x4*)(um + (size_t)ps * NIN + 4096 + c), r1 = *(const f32x4*)(um + (size_t)ps * NIN + 4096 + c + 4);
        v.x = pk2(r0[0], r0[1]); v.y = pk2(r0[2], r0[3]); v.z = pk2(r1[0], r1[1]); v.w = pk2(r1[2], r1[3]); }
    return v;
}
typedef float f32x2c __attribute__((ext_vector_type(2)));
__device__ __forceinline__ v4u conv_out(const v4u& q0, const v4u& q1, const v4u& q2, const v4u& q3, const f32x2c (&wv)[4][4], const f32x2c (&bv)[4]) {
    v4u o; unsigned ow[4];
#pragma unroll
    for (int j = 0; j < 4; ++j) { const unsigned x0 = j == 0 ? q0.x : j == 1 ? q0.y : j == 2 ? q0.z : q0.w, x1 = j == 0 ? q1.x : j == 1 ? q1.y : j == 2 ? q1.z : q1.w,
                                                 x2 = j == 0 ? q2.x : j == 1 ? q2.y : j == 2 ? q2.z : q2.w, x3 = j == 0 ? q3.x : j == 1 ? q3.y : j == 2 ? q3.z : q3.w;
        f32x2c a = bv[j];
        a += (f32x2c){__uint_as_float(x0 << 16), __uint_as_float(x0 & 0xffff0000u)} * wv[0][j];
        a += (f32x2c){__uint_as_float(x1 << 16), __uint_as_float(x1 & 0xffff0000u)} * wv[1][j];
        a += (f32x2c){__uint_as_float(x2 << 16), __uint_as_float(x2 & 0xffff0000u)} * wv[2][j];
        a += (f32x2c){__uint_as_float(x3 << 16), __uint_as_float(x3 & 0xffff0000u)} * wv[3][j];
        f32x2c e = a * -1.4426950408889634f; e[0] = __builtin_amdgcn_exp2f(e[0]); e[1] = __builtin_amdgcn_exp2f(e[1]);
        f32x2c d = e + 1.0f; d[0] = __builtin_amdgcn_rcpf(d[0]); d[1] = __builtin_amdgcn_rcpf(d[1]);
        const f32x2c r = a * d; ow[j] = pk2(r[0], r[1]); }
    o.x = ow[0]; o.y = ow[1]; o.z = ow[2]; o.w = ow[3]; return o;
}
__device__ __forceinline__ void p4_conv(Frame& F) {
    const float* um = WSP(float, WS_META + MO_U);
    const int gt = F.gw * 64 + F.lane, NT = F.NGW * 64;
    constexpr int PB = 13, NPB = LPAD / PB, NCG = CONVD / 8, NTASK = NBATCH * NPB * NCG;
    static_assert(NPB * PB == LPAD && NCG % 64 == 0, "13-position blocks tile the padded axis; a wave stays inside one block");
    const float* cw = F.in[15]; const float* cb = F.in[16];
    for (int id = gt; id < NTASK; id += NT) {
        const int cg = id % NCG, pblk = (id / NCG) % NPB, b = id / (NCG * NPB), c = 8 * cg, pp0 = pblk * PB, p0 = pp0 - PPAD;
        f32x2c wv[4][4], bv[4];
#pragma unroll
        for (int w = 0; w < 4; ++w) { const f32x4 w0 = *(const f32x4*)(cw + w * CONVD + c), w1 = *(const f32x4*)(cw + w * CONVD + c + 4);
            wv[w][0] = (f32x2c){w0[0], w0[1]}; wv[w][1] = (f32x2c){w0[2], w0[3]}; wv[w][2] = (f32x2c){w1[0], w1[1]}; wv[w][3] = (f32x2c){w1[2], w1[3]}; }
        { const f32x4 b0 = *(const f32x4*)(cb + c), b1 = *(const f32x4*)(cb + c + 4); bv[0] = (f32x2c){b0[0], b0[1]}; bv[1] = (f32x2c){b0[2], b0[3]}; bv[2] = (f32x2c){b1[0], b1[1]}; bv[3] = (f32x2c){b1[2], b1[3]}; }
        v4u rows[PB + 3];
        if (p0 - 3 >= NMETA) { const bf16* src = WSP(bf16, WS_ACT) + (size_t)(b * SEQ + p0 - 3 - NMETA) * NINP + 4096 + c;
#pragma unroll
            for (int i = 0; i < PB + 3; ++i) rows[i] = *(const v4u*)(src + (size_t)i * NINP); }
        else {
#pragma unroll
            for (int i = 0; i < PB + 3; ++i) rows[i] = conv_row(F, b, p0 - 3 + i, c); }
        bf16* dst = (c < 1024) ? WSP(bf16, WS_XS) + (size_t)(b * LPAD + pp0) * 1024 + c : WSP(bf16, WS_BC) + (size_t)(b * LPAD + pp0) * 512 + (c - 1024);
        const int dstride = (c < 1024) ? 1024 : 512;
#pragma unroll
        for (int i = 0; i < PB; ++i) { v4u o = conv_out(rows[i], rows[i + 1], rows[i + 2], rows[i + 3], wv, bv);
            if (p0 + i < 0) o = (v4u){0u, 0u, 0u, 0u};
            *(v4u*)(dst + (size_t)i * dstride) = o; }
    }
    for (int it = gt; it < NBATCH * LPAD * SH; it += NT) { const int hd = it & 15, pp = (it >> 4) % LPAD, b = (it >> 4) / LPAD, p = pp - PPAD;
        float v = 0.f;
        if (p >= 0) { const float x = (p < NMETA ? um[(size_t)p * NIN + NINP + hd] : WSP(float, WS_DTR)[(size_t)(b * SEQ + p - NMETA) * 16 + hd]) + F.in[17][hd];
            v = fmaxf(x, 0.f) + log1pf(__expf(-fabsf(x))); }
        WSP(float, WS_DT)[it] = v; }
}
__device__ __forceinline__ void p4_mixer_attn(Frame& F) {
    const float lq1 = F.in[10][F.lane], lk1 = F.in[11][F.lane], lq2 = F.in[12][F.lane], lk2 = F.in[13][F.lane];
    p4_conv(F);
    float lam; { const float s1 = wave_sum(lq1 * lk1), s2 = wave_sum(lq2 * lk2); lam = __expf(s1) - __expf(s2) + 0.2f; }
    lam = __builtin_bit_cast(float, __builtin_amdgcn_readfirstlane(__builtin_bit_cast(int, lam)));
    for (int r_ = 0; r_ < (MK_REPEAT_PHASE == 41 ? 2 : 1); ++r_)
    for (int u = blockIdx.x; u < NBATCH * NHEAD * 16; u += F.G) { const int bh = (u & 7) * 2 + ((u >> 3) >> 4), idx = (u >> 3) & 15;
        att::attn_meta_tile(F, bh); att::attn_unit(F, bh, idx, lam); att::attn_unit(F, bh, 31 - idx, lam); }
}
__device__ __forceinline__ void p5_ssd_a(Frame& F) { for (int it = blockIdx.x; it < NBATCH * SH * 8; it += F.G) ssd::ssd_pass_a(F, it); }
__device__ __forceinline__ void p6_ssd_b(Frame& F) { int bgj = 0; for (int it = blockIdx.x; it < NBATCH * SH * 8; it += F.G) ssd::ssd_item<true>(F, it, bgj);
    if (F.NGW != 2048) convert_items(F, IT_BG, IT_W2D, F.gw, F.NGW); }
struct Args { const float* in[26]; float* out; unsigned char* ws; int ph_lo, ph_hi; };
__global__ void __launch_bounds__(NWAVES * 64, 2) hymba_fwd(Args args) {
    extern __shared__ __attribute__((aligned(16))) unsigned char lds[];
    Frame F;
    F.lds = (LAS unsigned char*)lds;
    F.tid = threadIdx.x; F.lane = F.tid & 63; F.wave = __builtin_amdgcn_readfirstlane(F.tid >> 6);
    F.G = gridDim.x; F.gw = blockIdx.x * NWAVES + F.wave; F.NGW = F.G * NWAVES;
#pragma unroll
    for (int i = 0; i < 26; ++i) F.in[i] = args.in[i];
    F.out = args.out; F.ws = args.ws; F.inp = args.in;
    volatile LAS unsigned* MISC = (volatile LAS unsigned*)(F.lds + MISC_OFF);
    for (int u = F.tid; u < 128; u += NWAVES * 64) MISC[u] = 0u;
    __syncthreads();
    XcdBarrier bar; bar.bar = (unsigned*)(F.ws + WS_CTL) + CW_BAR; bar.x = 0; bar.st = nullptr;
    if (N_LAUNCHES == 1) bar = xcd_barrier_post((unsigned*)(F.ws + WS_CTL) + CW_BAR, MISC + 8);
    const int lo = args.ph_lo, hi = args.ph_hi;
#define IN(k) (lo <= (k) && (k) < hi)
#ifndef MK_REPEAT_PHASE
#define MK_REPEAT_PHASE -1
#endif
#define REPS(k) for (int rep_ = 0; rep_ < ((k) == MK_REPEAT_PHASE ? 2 : 1); ++rep_)
#define REPBAR(k) do { if ((k) == MK_REPEAT_PHASE && rep_ == 0) xcd_barrier(bar); } while (0)
#define SEAM(k) do { if (IN(k) && IN((k) + 1)) xcd_barrier(bar); } while (0)
    using pg8::Gemm; using pg8::StaticOrder;
    LAS unsigned char* ring = F.lds + RING_OFF;

    if (IN(0)) { REPS(0) { p0_prologue(F); REPBAR(0); } SEAM(0); }
    if (N_LAUNCHES == 1) {
        if (threadIdx.x == 0) { unsigned ok = (F.G == 256 && xb_ld(&bar.bar[XB_BAD]) == 0u) ? 1u : 0u;
            for (unsigned j = 0; j < 8; ++j) ok &= (xb_ld(&bar.bar[XB_XCNT(j)]) == 32u) ? 1u : 0u;
            MISC[10] = ok; }
        __syncthreads();
    }
    const bool local_ok = N_LAUNCHES == 1 && MISC[10] != 0u;
#define SEAM_LOCAL(k, s, rdy) do { if (IN(k) && IN((k) + 1)) { if (local_ok) xcd_local_barrier(bar, (s), (rdy)); else xcd_barrier(bar); } } while (0)
    if (IN(1)) {
        Gemm g{WSP(bf16, WS_XN), WSP(bf16, WS_W1GU), MR, NGU, DM, WSP(bf16, WS_META + MO_XN)}; pg8::MetaPanelOrder S; S.init(MR, NGU, F.G, (int)blockIdx.x, F.G == 256);
        pg8::Unit u0{0, 0}; (void)S.next(0, u0);
        pg8::EpiSwiGLU E{WSP(bf16, WS_ACT), DFF, WSP(float, WS_SSQ0), 1, pg8::RsTable{(LAS float*)(F.lds + RST_OFF), u0.pm, -1}, MR, WSP(bf16, WS_META + MO_ACT), WSP(float, WS_META + MO_SSQ0)};
        pg8::RsPre P1{WSP(float, WS_SSQ0), 1, 1.0f / 2048.0f, u0.pm, (LAS float*)(F.lds + RST_OFF)};
        REPS(1) { pg8::gemm_phase<pg8::EpiSwiGLU, pg8::MetaPanelOrder, true, true, pg8::RsPre>(ring, g, S, E, P1); REPBAR(1); }
        { const int first = S.so.nwg % F.G, nsl = F.G - first, t = (int)blockIdx.x - first;
          if (S.fold) {
              constexpr int NX = NGU / 256;
              convert_items(F, IT_CUT0, IT_BG, t >= NX ? (t - NX) * NWAVES + F.wave : -1, (nsl - NX) * NWAVES);
          } else {
              const int w0 = t >= 0 ? t * NWAVES + F.wave : -1;
              meta_gateup(F, w0, nsl * NWAVES);
              constexpr int NMW = DFF / 16;
              convert_items(F, IT_CUT0, IT_BG, w0 >= NMW ? w0 - NMW : -1, nsl * NWAVES - NMW); } }
        SEAM(1);
    }
    if (IN(2)) {
        Gemm g{WSP(bf16, WS_ACT), WSP(bf16, WS_W1D), MR, DM, DFF}; StaticOrder S; S.init(MR, DM, F.G, (int)blockIdx.x, 4);
        pg8::EpiResT<false> E{nullptr, WSP(bf16, WS_XN), nullptr, WSP(bf16, WS_XN), WSP(float, WS_SSQ1), 0.5f, DM, nullptr, 0, pg8::RsTable{nullptr, -1, -1}};
        struct MetaPre { Frame& F; __device__ __forceinline__ void issue() {} __device__ __forceinline__ void after_issue() { meta_down(F); } __device__ __forceinline__ void finish() {} };
        REPS(2) { pg8::gemm_phase<pg8::EpiResT<false>, StaticOrder, true, true, MetaPre>(ring, g, S, E, MetaPre{F}); REPBAR(2); }
        SEAM_LOCAL(2, 2, 128u);
    }
    if (IN(3)) {
        Gemm g{WSP(bf16, WS_XN), WSP(bf16, WS_WIN), MR, NINP, DM, WSP(bf16, WS_META + MO_XN1)}; pg8::InProjDtOrder S; S.init(MR, NINP, F.G, (int)blockIdx.x, F.G == 256);
        pg8::Unit u0{0, 0}; (void)S.next(0, u0);
        pg8::EpiInProj E{WSP(bf16, WS_ACT), NINP, WSP(float, WS_SSQ1), F.in[8], F.in[9], WSP(float, WS_ROPE), pg8::RsTable{(LAS float*)(F.lds + RST_OFF), u0.pm, -1}, WSP(float, WS_DTR), MR, WSP(float, WS_META + MO_U), NIN, WSP(float, WS_META + MO_SSQ1)};
        pg8::RsPre P3{WSP(float, WS_SSQ1), 32, 1.0f / 2048.0f, u0.pm, (LAS float*)(F.lds + RST_OFF)};
        REPS(3) { pg8::gemm_phase<pg8::EpiInProj, pg8::InProjDtOrder, true, true, pg8::RsPre>(ring, g, S, E, P3); REPBAR(3); }
        { const int first = S.so.nwg % F.G, nsl = F.G - first, t = (int)blockIdx.x - first;
          if (!S.fold) meta_inproj_and_dt(F, t >= 0 ? t * NWAVES + F.wave : -1, NMETA_IT + NDT_IT, nsl * NWAVES); }
        SEAM(3);
    }
    if (IN(4)) { REPS(4) { p4_mixer_attn(F); REPBAR(4); } SEAM(4); }
    if (IN(5)) { REPS(5) { p5_ssd_a(F); REPBAR(5); } SEAM(5); }
    if (IN(6)) { REPS(6) { p6_ssd_b(F); REPBAR(6); } SEAM(6); }
    if (IN(7)) {
        Gemm g{WSP(bf16, WS_MIX), WSP(bf16, WS_WOUT), MR, DM, DM}; StaticOrder S; S.init(MR, DM, F.G, (int)blockIdx.x, 4);
        pg8::Unit u0{0, 0}; (void)S.next(0, u0);
        pg8::EpiResT<true> E{nullptr, WSP(bf16, WS_XN), nullptr, WSP(bf16, WS_XN), WSP(float, WS_SSQ2), 1.0f, DM, WSP(float, WS_SSQS), 16, pg8::RsTable{(LAS float*)(F.lds + RST_OFF), u0.pm, -1}};
        pg8::RsPre P7{WSP(float, WS_SSQS), 32, 1.0f / 1024.0f, u0.pm, (LAS float*)(F.lds + RST_OFF)};
        pg8::gemm_phase<pg8::EpiResT<true>, StaticOrder, true, true, pg8::RsPre>(ring, g, S, E, P7);
        SEAM_LOCAL(7, 0, 0u);
    }
    if (IN(8)) {
        Gemm g{WSP(bf16, WS_XN), WSP(bf16, WS_W2GU), MR, NGU, DM}; StaticOrder S; S.init(MR, NGU, F.G, (int)blockIdx.x, 4);
        pg8::Unit u0{0, 0}; (void)S.next(0, u0);
        pg8::EpiSwiGLU E{WSP(bf16, WS_ACT), DFF, WSP(float, WS_SSQ2), 32, pg8::RsTable{(LAS float*)(F.lds + RST_OFF), u0.pm, -1}};
        pg8::RsPre P8{WSP(float, WS_SSQ2), 32, 1.0f / 2048.0f, u0.pm, (LAS float*)(F.lds + RST_OFF)};
        REPS(8) { pg8::gemm_phase<pg8::EpiSwiGLU, StaticOrder, true, true, pg8::RsPre>(ring, g, S, E, P8); REPBAR(8); }
        { const int first = S.nwg % F.G, nsl = F.G - first;
          convert_items(F, IT_W2D, IT_END, (int)blockIdx.x >= first ? ((int)blockIdx.x - first) * NWAVES + F.wave : -1, nsl * NWAVES);
          if (local_ok && IN(9) && (int)blockIdx.x >= first) {
              asm volatile("s_waitcnt vmcnt(0)" ::: "memory"); __syncthreads();
              if (threadIdx.x == 0) { const unsigned old = xb_add(&bar.bar[XB_LOC(7, bar.x)], 1u);
                  if (old + 1u == (unsigned)(nsl / 8)) { __builtin_amdgcn_fence(__ATOMIC_RELEASE, "agent"); asm volatile("s_waitcnt vmcnt(0)" ::: "memory"); (void)xb_add(&bar.bar[XB_RDY], 1u); } } } }
        SEAM_LOCAL(8, 1, 136u);
    }
    if (IN(9)) {
        Gemm g{WSP(bf16, WS_ACT), WSP(bf16, WS_W2D), MR, DM, DFF}; StaticOrder S; S.init(MR, DM, F.G, (int)blockIdx.x, 4);
        pg8::EpiResT<false> E{nullptr, WSP(bf16, WS_XN), F.out, nullptr, nullptr, 0.5f, DM, nullptr, 0, pg8::RsTable{nullptr, -1, -1}};
        pg8::gemm_phase<pg8::EpiResT<false>, StaticOrder, true, true>(ring, g, S, E);
    }
#undef IN
#undef SEAM
}

extern "C" void kernel_launch(void* const* d_in, const int* in_sizes, int n_in, void* d_out, int out_size, void* d_ws, size_t ws_size, hipStream_t stream) {
    static int grid = 0;
    if (grid == 0) {
        if (n_in != 26 || in_sizes[0] != MR * DM || out_size != MR * DM || ws_size < WS_END) { fprintf(stderr, "kernel_launch: unexpected shapes (n_in %d, in0 %d, out %d, ws %zu)\n", n_in, n_in > 0 ? in_sizes[0] : -1, out_size, ws_size); grid = -1; return; }
        int dev = 0, cus = 0, per_cu = 0;
        if (hipGetDevice(&dev) != hipSuccess || hipDeviceGetAttribute(&cus, hipDeviceAttributeMultiprocessorCount, dev) != hipSuccess) { grid = -1; return; }
        if (hipFuncSetAttribute((const void*)hymba_fwd, hipFuncAttributeMaxDynamicSharedMemorySize, LDS_BYTES) != hipSuccess) { fprintf(stderr, "kernel_launch: hipFuncSetAttribute failed\n"); grid = -1; return; }
        if (hipOccupancyMaxActiveBlocksPerMultiprocessor(&per_cu, (const void*)hymba_fwd, NWAVES * 64, LDS_BYTES) != hipSuccess || per_cu < 1) { fprintf(stderr, "kernel_launch: occupancy query says %d blocks per CU\n", per_cu); (void)hipGetLastError(); grid = -1; return; }
        grid = cus;
    }
    if (grid < 0) return;
    (void)hipMemsetAsync((char*)d_ws + WS_CTL, 0, CTL_ZERO_BYTES, stream);
    Args a{};
    for (int i = 0; i < 26; ++i) a.in[i] = (const float*)d_in[i];
    a.out = (float*)d_out; a.ws = (unsigned char*)d_ws;
    for (int li = 0; li < N_LAUNCHES; ++li) {
        a.ph_lo = (N_LAUNCHES == 1) ? 0 : li; a.ph_hi = (N_LAUNCHES == 1) ? NPH : li + 1;
        hipLaunchKernelGGL(hymba_fwd, dim3(grid), dim3(NWAVES * 64), LDS_BYTES, stream, a);
    }
}
```
